# Optimizing an MI355X kernel written in HIP

```python
import jax
import jax.numpy as jnp
from jax import lax
import numpy as np

D_MODEL = 2048
BATCH = 1
SEQ = 16384
DEPTH = 2

GRID_W = 64
CTX_LEN = 256
NORM_EPS = 1e-6
CHUNK = 32

MIX_HALF = D_MODEL // 2

HEAD_DIM = 128
ATT_HEADS = MIX_HALF // HEAD_DIM
ATT_KV_HEADS = 2
WINDOW = 128
ATT_BLOCK = 128
ROPE_THETA = 10000.0

HGRN_HEADS = 8
HGRN_DK = 128
HGRN_DV = MIX_HALF // HGRN_HEADS
N_HGRN_LAYERS = (DEPTH + 1) // 2

GLA_HEADS = 4
GLA_DK = MIX_HALF // 2 // GLA_HEADS
GLA_DV = MIX_HALF // GLA_HEADS
GLA_GATE_RANK = 16
GLA_GATE_NORMALIZER = 16.0

RWKV_N = 64
RWKV_HEADS = MIX_HALF // RWKV_N
RWKV_DECAY_RANK = 96
RWKV_A_RANK = 96
RWKV_GATE_RANK = 256
RWKV_LN_EPS = 64e-5

D_FF = 5632
N_EXPERTS = 8
TOP_K = 2
D_FF_EXPERT = 7168

ATT_Q = ATT_HEADS * HEAD_DIM
ATT_KV = ATT_KV_HEADS * HEAD_DIM
HGRN_K = HGRN_HEADS * HGRN_DK
HGRN_V = HGRN_HEADS * HGRN_DV
EVEN_COLS = (ATT_Q, ATT_KV, ATT_KV, HGRN_K, HGRN_V, HGRN_K, HGRN_K, HGRN_V)
EVEN_IN = sum(EVEN_COLS)
EVEN_OUT = ATT_Q + HGRN_V
GLA_K = GLA_HEADS * GLA_DK
GLA_V = GLA_HEADS * GLA_DV
GLA_COLS = (GLA_K, GLA_K, GLA_V, GLA_GATE_RANK, GLA_GATE_RANK, GLA_V)
GLA_IN = sum(GLA_COLS)
RWKV_C = RWKV_HEADS * RWKV_N
RWKV_COLS = (RWKV_C, RWKV_C, RWKV_C, RWKV_DECAY_RANK, RWKV_DECAY_RANK, RWKV_A_RANK, RWKV_GATE_RANK)
RWKV_IN = sum(RWKV_COLS)
ODD_IN = GLA_IN + RWKV_IN
ODD_OUT = GLA_V + RWKV_C

kernel_name = 'hybrid_diffusion_trunk'


def rmsnorm(x, gain):
    xf = x.astype(jnp.float32)
    y = xf * lax.rsqrt(jnp.mean(xf * xf, axis=-1, keepdims=True) + NORM_EPS)
    return (y * gain.astype(jnp.float32)).astype(x.dtype)


def split_last(t, sizes):
    return jnp.split(t, np.cumsum(sizes)[:-1].tolist(), axis=-1)


def to_heads(t, n_heads):
    return t.reshape(t.shape[:-1] + (n_heads, -1))


def adaln(cvec, w, b):
    return jnp.split(jax.nn.silu(cvec) @ w + b, 6, axis=-1)


def axial_rope_tables(rows):
    n_freq = HEAD_DIM // 4
    t = jnp.arange(rows * GRID_W)
    row = (t // GRID_W).astype(jnp.float32)
    col = (t % GRID_W).astype(jnp.float32)
    inv = ROPE_THETA ** (-jnp.arange(n_freq, dtype=jnp.float32) / n_freq)
    ang = jnp.stack([row[:, None] * inv, col[:, None] * inv], axis=1)
    return jnp.cos(ang), jnp.sin(ang)


def apply_axial_rope(x, cos, sin):
    n_freq = HEAD_DIM // 4
    xr = x.reshape(x.shape[:-1] + (2, 2, n_freq))
    x1, x2 = xr[..., 0, :], xr[..., 1, :]
    cb, sb = cos[None, :, None], sin[None, :, None]
    out = jnp.stack([x1 * cb - x2 * sb, x1 * sb + x2 * cb], axis=-2)
    return out.reshape(x.shape)


def sink_softmax(scores, sink):
    m = sink
    for s in scores:
        m = jnp.maximum(m, jnp.max(s, axis=-1, keepdims=True))
    probs = [jnp.exp(s - m) for s in scores]
    denom = jnp.exp(sink - m)
    for p in probs:
        denom = denom + jnp.sum(p, axis=-1, keepdims=True)
    return [p / denom for p in probs]


def window_sink_attention(q, k, v, kc, vc, sink):
    B, S, H, Dh = q.shape
    G = k.shape[2]
    R = H // G
    nb = S // ATT_BLOCK
    qb = q.reshape(B, nb, ATT_BLOCK, G, R, Dh) * (Dh ** -0.5)

    def band(t):
        pad = jnp.zeros((B, ATT_BLOCK) + t.shape[2:], t.dtype)
        tb = jnp.concatenate([pad, t, pad], axis=1).reshape((B, nb + 2, ATT_BLOCK) + t.shape[2:])
        return jnp.concatenate([tb[:, :-2], tb[:, 1:-1], tb[:, 2:]], axis=2)

    kw, vw = band(k), band(v)
    s_win = jnp.einsum('bnqgrd,bnkgd->bngrqk', qb, kw)
    s_ctx = jnp.einsum('bnqgrd,bcgd->bngrqc', qb, kc)
    qi = jnp.arange(ATT_BLOCK)[:, None]
    kj = jnp.arange(3 * ATT_BLOCK)[None, :]
    kpos = jnp.arange(nb)[:, None, None] * ATT_BLOCK + (kj - ATT_BLOCK)[None]
    valid = (jnp.abs(kj - ATT_BLOCK - qi) <= WINDOW)[None] & (kpos >= 0) & (kpos < S)
    s_win = jnp.where(valid[None, :, None, None], s_win, -jnp.inf)
    p_win, p_ctx = sink_softmax([s_win, s_ctx], sink.reshape(G, R)[None, None, :, :, None, None])
    o = jnp.einsum('bngrqk,bnkgd->bnqgrd', p_win, vw) + jnp.einsum('bngrqc,bcgd->bnqgrd', p_ctx, vc)
    return o.reshape(B, S, H * Dh)


def context_sink_attention(qc, kc, vc, sink):
    B, L, H, Dh = qc.shape
    G = kc.shape[2]
    R = H // G
    qg = qc.reshape(B, L, G, R, Dh) * (Dh ** -0.5)
    s = jnp.einsum('blgrd,bcgd->bgrlc', qg, kc)
    (p,) = sink_softmax([s], sink.reshape(G, R)[None, :, :, None, None])
    return jnp.einsum('bgrlc,bcgd->blgrd', p, vc).reshape(B, L, H * Dh)


def chunk_gated_recurrence(q, k, v, log_decay, state0, reverse):
    if reverse:
        q, k, v, log_decay = [jnp.flip(t, axis=1) for t in (q, k, v, log_decay)]
    B, T, H, K = q.shape
    V = v.shape[-1]
    n = T // CHUNK
    qc, kc, gc = [t.reshape(B, n, CHUNK, H, K) for t in (q, k, log_decay)]
    vc = v.reshape(B, n, CHUNK, H, V)
    G = jnp.cumsum(gc, axis=2)
    G_last = G[:, :, -1:]
    q_dec = qc * jnp.exp(G)
    k_inv = kc * jnp.exp(-G)
    k_tail = kc * jnp.exp(G_last - G)
    causal = jnp.tril(jnp.ones((CHUNK, CHUNK), dtype=bool))
    A = jnp.where(causal, jnp.einsum('bnihk,bnjhk->bnhij', q_dec, k_inv), 0.0)
    o = jnp.einsum('bnhij,bnjhv->bnihv', A, vc)
    kv = jnp.einsum('bnjhk,bnjhv->nbhkv', k_tail, vc)
    decay = jnp.moveaxis(jnp.exp(G_last[:, :, 0]), 1, 0)

    def step(S, inp):
        d, kv_n = inp
        return d[..., None] * S + kv_n, S

    S_final, S_start = lax.scan(step, state0, (decay, kv))
    o = o + jnp.einsum('bnihk,nbhkv->bnihv', q_dec, S_start)
    o = o.reshape(B, T, H, V)
    if reverse:
        o = jnp.flip(o, axis=1)
    return o, S_final


def rwkv7_scan(r, w, k, v, a, b, state0, reverse):
    def step(S, inp):
        r_t, w_t, k_t, v_t, a_t, b_t = inp
        sa = jnp.einsum('bhvk,bhk->bhv', S, a_t)
        S = S * w_t[:, :, None, :] + sa[..., None] * b_t[:, :, None, :] + v_t[..., None] * k_t[:, :, None, :]
        return S, jnp.einsum('bhvk,bhk->bhv', S, r_t)

    xs = tuple(jnp.moveaxis(t, 1, 0) for t in (r, w, k, v, a, b))
    S_final, o = lax.scan(step, state0, xs, reverse=reverse)
    return jnp.moveaxis(o, 0, 1), S_final


def bidirectional_prefix_scan(scan_fn, ctx_fwd, ctx_bwd, lat_fwd, lat_bwd, state0):
    oc_f, s_f = scan_fn(*ctx_fwd, state0, False)
    oc_b, s_b = scan_fn(*ctx_bwd, state0, True)
    ol_f, _ = scan_fn(*lat_fwd, s_f, False)
    ol_b, _ = scan_fn(*lat_bwd, s_b, True)
    return oc_f + oc_b, ol_f + ol_b


def centred_token_shift(p, mu_prev, mu_next):
    zero = jnp.zeros_like(p[:, :1])
    prev = jnp.concatenate([zero, p[:, :-1]], axis=1)
    nxt = jnp.concatenate([p[:, 1:], zero], axis=1)
    return p + mu_prev * (prev - p) + mu_next * (nxt - p)


def even_mixer(h, hc, w_in, w_out, attn_sink, hgrn_norm, hgrn_lb, rope_cos, rope_sin, need_ctx):
    B, S, _ = h.shape
    L = hc.shape[1]
    T = L + S
    ctx_sl, lat_sl = slice(0, L), slice(L, T)
    proj = (jnp.concatenate([hc, h], axis=1) @ w_in).astype(jnp.float32)
    qa, ka, va, qh, ih, f_fw, f_bw, gh = split_last(proj, EVEN_COLS)
    qa = to_heads(qa, ATT_HEADS)
    ka = to_heads(ka, ATT_KV_HEADS)
    va = to_heads(va, ATT_KV_HEADS)
    att = window_sink_attention(apply_axial_rope(qa[:, lat_sl], rope_cos, rope_sin),
                                apply_axial_rope(ka[:, lat_sl], rope_cos, rope_sin),
                                va[:, lat_sl], ka[:, ctx_sl], va[:, ctx_sl], attn_sink)
    qh = to_heads(jax.nn.silu(qh), HGRN_HEADS)
    ih = to_heads(ih, HGRN_HEADS)
    f_fw = to_heads(hgrn_lb + (1.0 - hgrn_lb) * jax.nn.sigmoid(f_fw), HGRN_HEADS)
    f_bw = to_heads(hgrn_lb + (1.0 - hgrn_lb) * jax.nn.sigmoid(f_bw), HGRN_HEADS)

    def hg_in(f, sl):
        return (qh[:, sl], 1.0 - f[:, sl], ih[:, sl], jnp.log(f[:, sl]))

    state0 = jnp.zeros((B, HGRN_HEADS, HGRN_DK, HGRN_DV), jnp.float32)
    o_ctx, o_lat = bidirectional_prefix_scan(chunk_gated_recurrence, hg_in(f_fw, ctx_sl), hg_in(f_bw, ctx_sl),
                                             hg_in(f_fw, lat_sl), hg_in(f_bw, lat_sl), state0)
    out_gate = jax.nn.silu(gh)

    def hg_out(o, sl):
        return rmsnorm(o, hgrn_norm).reshape(B, -1, HGRN_V) * out_gate[:, sl]

    y = jnp.concatenate([att, hg_out(o_lat, lat_sl)], axis=-1).astype(h.dtype) @ w_out
    if not need_ctx:
        return y, None
    att_c = context_sink_attention(qa[:, ctx_sl], ka[:, ctx_sl], va[:, ctx_sl], attn_sink)
    yc = jnp.concatenate([att_c, hg_out(o_ctx, ctx_sl)], axis=-1).astype(h.dtype) @ w_out
    return y, yc


def odd_mixer(h, hc, w_in, w_out, gla_gate_up_f, gla_gate_up_b, gla_gate_bias_f, gla_gate_bias_b, gla_norm,
              rwkv_mu_prev, rwkv_mu_next, rwkv_w0_f, rwkv_w0_b, rwkv_w2_f, rwkv_w2_b, rwkv_a0, rwkv_a2,
              rwkv_g2, rwkv_k_k, rwkv_k_a, rwkv_r_k, rwkv_ln_w, rwkv_ln_b, need_ctx):
    B, S, _ = h.shape
    L = hc.shape[1]
    T = L + S
    ctx_sl, lat_sl = slice(0, L), slice(L, T)
    proj = (jnp.concatenate([hc, h], axis=1) @ w_in).astype(jnp.float32)
    gla_p, rwkv_p = proj[..., :GLA_IN], proj[..., GLA_IN:]
    gq, gk, gv, gd_f, gd_b, gr = split_last(gla_p, GLA_COLS)
    gq = to_heads(gq, GLA_HEADS) * (GLA_DK ** -0.5)
    gk = to_heads(gk, GLA_HEADS)
    gv = to_heads(gv, GLA_HEADS)
    lg_f = to_heads(jax.nn.log_sigmoid(gd_f @ gla_gate_up_f + gla_gate_bias_f) / GLA_GATE_NORMALIZER, GLA_HEADS)
    lg_b = to_heads(jax.nn.log_sigmoid(gd_b @ gla_gate_up_b + gla_gate_bias_b) / GLA_GATE_NORMALIZER, GLA_HEADS)

    def gla_in(lg, sl):
        return (gq[:, sl], gk[:, sl], gv[:, sl], lg[:, sl])

    gstate0 = jnp.zeros((B, GLA_HEADS, GLA_DK, GLA_DV), jnp.float32)
    go_ctx, go_lat = bidirectional_prefix_scan(chunk_gated_recurrence, gla_in(lg_f, ctx_sl), gla_in(lg_b, ctx_sl),
                                               gla_in(lg_f, lat_sl), gla_in(lg_b, lat_sl), gstate0)
    gla_gate = jax.nn.silu(gr)

    def gla_out(o, sl):
        return rmsnorm(o, gla_norm).reshape(B, -1, GLA_V) * gla_gate[:, sl]

    rw = jnp.concatenate([centred_token_shift(rwkv_p[:, ctx_sl], rwkv_mu_prev, rwkv_mu_next),
                          centred_token_shift(rwkv_p[:, lat_sl], rwkv_mu_prev, rwkv_mu_next)], axis=1)
    rr, rk, rv, wd_f, wd_b, ad, gd = split_last(rw, RWKV_COLS)

    def decay(w0, wd, w2):
        wl = -jax.nn.softplus(-(w0 + jnp.tanh(wd) @ w2)) - 0.5
        return to_heads(jnp.exp(-jnp.exp(wl)), RWKV_HEADS)

    dec_f = decay(rwkv_w0_f, wd_f, rwkv_w2_f)
    dec_b = decay(rwkv_w0_b, wd_b, rwkv_w2_b)
    a = jax.nn.sigmoid(rwkv_a0 + ad @ rwkv_a2)
    g_out = jax.nn.sigmoid(gd) @ rwkv_g2
    kk = to_heads(rk * rwkv_k_k, RWKV_HEADS)
    kk = kk * lax.rsqrt(jnp.sum(kk * kk, axis=-1, keepdims=True) + 1e-12)
    k_mod = to_heads(rk * (1.0 + (a - 1.0) * rwkv_k_a), RWKV_HEADS)
    r = to_heads(rr, RWKV_HEADS)
    v = to_heads(rv, RWKV_HEADS)
    b_vec = kk * to_heads(a, RWKV_HEADS)

    def rw_in(dec, sl):
        return (r[:, sl], dec[:, sl], k_mod[:, sl], v[:, sl], -kk[:, sl], b_vec[:, sl])

    rstate0 = jnp.zeros((B, RWKV_HEADS, RWKV_N, RWKV_N), jnp.float32)
    ro_ctx, ro_lat = bidirectional_prefix_scan(rwkv7_scan, rw_in(dec_f, ctx_sl), rw_in(dec_b, ctx_sl),
                                               rw_in(dec_f, lat_sl), rw_in(dec_b, lat_sl), rstate0)

    def rwkv_out(o, sl):
        mu = jnp.mean(o, axis=-1, keepdims=True)
        var = jnp.mean(jnp.square(o - mu), axis=-1, keepdims=True)
        on = ((o - mu) * lax.rsqrt(var + RWKV_LN_EPS)).reshape(B, -1, RWKV_C) * rwkv_ln_w + rwkv_ln_b
        bonus = (jnp.sum(r[:, sl] * k_mod[:, sl] * rwkv_r_k, axis=-1, keepdims=True) * v[:, sl]).reshape(B, -1, RWKV_C)
        return (on + bonus) * g_out[:, sl]

    y = jnp.concatenate([gla_out(go_lat, lat_sl), rwkv_out(ro_lat, lat_sl)], axis=-1).astype(h.dtype) @ w_out
    if not need_ctx:
        return y, None
    yc = jnp.concatenate([gla_out(go_ctx, ctx_sl), rwkv_out(ro_ctx, ctx_sl)], axis=-1).astype(h.dtype) @ w_out
    return y, yc


def swiglu(h, w_gate, w_up, w_down):
    return (jax.nn.silu(h @ w_gate) * (h @ w_up)) @ w_down


def moe_swiglu(h, router, w_gate, w_up, w_down):
    logits = (h @ router).astype(jnp.float32)
    top_val, top_idx = lax.top_k(logits, TOP_K)
    weights = jax.nn.softmax(top_val, axis=-1)
    gates = jnp.sum(jax.nn.one_hot(top_idx, N_EXPERTS, dtype=jnp.float32) * weights[..., None], axis=-2)
    out = jnp.zeros(h.shape, jnp.float32)
    for e in range(N_EXPERTS):
        hidden = jax.nn.silu(h @ w_gate[e]) * (h @ w_up[e])
        out = out + gates[..., e:e + 1] * (hidden @ w_down[e])
    return out.astype(h.dtype)


def setup_inputs(seed: int = 0) -> dict:
    key = jax.random.key(seed)
    keys = jax.random.split(key, 80)
    counter = [0]

    def nk():
        k = keys[counter[0]]
        counter[0] += 1
        return k

    def nrm(shape, scale):
        return jax.random.normal(nk(), shape, jnp.float32) * scale

    def unif(shape, lo, hi):
        return jax.random.uniform(nk(), shape, jnp.float32, lo, hi)

    def gain(n):
        return 1.0 + nrm((n,), 0.05)

    def lin(fan_in, fan_out):
        return nrm((fan_in, fan_out), fan_in ** -0.5)

    D = D_MODEL
    return {
        'x': nrm((BATCH, SEQ, D), 1.0),
        'c': nrm((BATCH, D), 1.0),
        'ctx': nrm((BATCH, CTX_LEN, D), 1.0),
        'c_ctx': nrm((D,), 1.0),
        'hgrn_lb_logits': nrm((N_HGRN_LAYERS + 1, HGRN_K), 0.5),
        'l0_ada_w': nrm((D, 6 * D), 0.5 * D ** -0.5),
        'l0_ada_b': nrm((6 * D,), 0.02),
        'l0_norm_mix_pre': gain(D),
        'l0_norm_mix_post': gain(D),
        'l0_norm_ffn_pre': gain(D),
        'l0_norm_ffn_post': gain(D),
        'l0_w_in': lin(D, EVEN_IN),
        'l0_w_out': lin(EVEN_OUT, D),
        'l0_attn_sink': nrm((ATT_HEADS,), 1.0),
        'l0_hgrn_norm': gain(HGRN_DV),
        'l0_ffn_w_gate': lin(D, D_FF),
        'l0_ffn_w_up': lin(D, D_FF),
        'l0_ffn_w_down': lin(D_FF, D),
        'l1_ada_w': nrm((D, 6 * D), 0.5 * D ** -0.5),
        'l1_ada_b': nrm((6 * D,), 0.02),
        'l1_norm_mix_pre': gain(D),
        'l1_norm_mix_post': gain(D),
        'l1_norm_ffn_pre': gain(D),
        'l1_norm_ffn_post': gain(D),
        'l1_w_in': lin(D, ODD_IN),
        'l1_w_out': lin(ODD_OUT, D),
        'l1_gla_gate_up_f': lin(GLA_GATE_RANK, GLA_K),
        'l1_gla_gate_up_b': lin(GLA_GATE_RANK, GLA_K),
        'l1_gla_gate_bias_f': nrm((GLA_K,), 0.1),
        'l1_gla_gate_bias_b': nrm((GLA_K,), 0.1),
        'l1_gla_norm': gain(GLA_DV),
        'l1_rwkv_mu_prev': unif((RWKV_IN,), 0.0, 0.5),
        'l1_rwkv_mu_next': unif((RWKV_IN,), 0.0, 0.5),
        'l1_rwkv_w0_f': unif((RWKV_C,), -6.0, -1.0),
        'l1_rwkv_w0_b': unif((RWKV_C,), -6.0, -1.0),
        'l1_rwkv_w2_f': nrm((RWKV_DECAY_RANK, RWKV_C), 0.5 * RWKV_DECAY_RANK ** -0.5),
        'l1_rwkv_w2_b': nrm((RWKV_DECAY_RANK, RWKV_C), 0.5 * RWKV_DECAY_RANK ** -0.5),
        'l1_rwkv_a0': nrm((RWKV_C,), 0.5),
        'l1_rwkv_a2': lin(RWKV_A_RANK, RWKV_C),
        'l1_rwkv_g2': lin(RWKV_GATE_RANK, RWKV_C),
        'l1_rwkv_k_k': 0.85 + nrm((RWKV_C,), 0.05),
        'l1_rwkv_k_a': 1.0 + nrm((RWKV_C,), 0.05),
        'l1_rwkv_r_k': nrm((RWKV_HEADS, RWKV_N), 0.1),
        'l1_rwkv_ln_w': gain(RWKV_C),
        'l1_rwkv_ln_b': nrm((RWKV_C,), 0.02),
        'l1_moe_router': lin(D, N_EXPERTS),
        'l1_moe_w_gate': nrm((N_EXPERTS, D, D_FF_EXPERT), D ** -0.5),
        'l1_moe_w_up': nrm((N_EXPERTS, D, D_FF_EXPERT), D ** -0.5),
        'l1_moe_w_down': nrm((N_EXPERTS, D_FF_EXPERT, D), D_FF_EXPERT ** -0.5),
    }


def reference(x, c, ctx, c_ctx, hgrn_lb_logits,
              l0_ada_w, l0_ada_b, l0_norm_mix_pre, l0_norm_mix_post, l0_norm_ffn_pre, l0_norm_ffn_post,
              l0_w_in, l0_w_out, l0_attn_sink, l0_hgrn_norm, l0_ffn_w_gate, l0_ffn_w_up, l0_ffn_w_down,
              l1_ada_w, l1_ada_b, l1_norm_mix_pre, l1_norm_mix_post, l1_norm_ffn_pre, l1_norm_ffn_post,
              l1_w_in, l1_w_out, l1_gla_gate_up_f, l1_gla_gate_up_b, l1_gla_gate_bias_f, l1_gla_gate_bias_b,
              l1_gla_norm, l1_rwkv_mu_prev, l1_rwkv_mu_next, l1_rwkv_w0_f, l1_rwkv_w0_b, l1_rwkv_w2_f,
              l1_rwkv_w2_b, l1_rwkv_a0, l1_rwkv_a2, l1_rwkv_g2, l1_rwkv_k_k, l1_rwkv_k_a, l1_rwkv_r_k,
              l1_rwkv_ln_w, l1_rwkv_ln_b, l1_moe_router, l1_moe_w_gate, l1_moe_w_up, l1_moe_w_down):
    S = x.shape[1]
    L = ctx.shape[1]
    rows = S // GRID_W
    rope_cos, rope_sin = axial_rope_tables(rows)
    hgrn_lb = jnp.cumsum(jax.nn.softmax(hgrn_lb_logits.astype(jnp.float32), axis=0), axis=0)
    layers = [
        dict(ada_w=l0_ada_w, ada_b=l0_ada_b,
             norms=(l0_norm_mix_pre, l0_norm_mix_post, l0_norm_ffn_pre, l0_norm_ffn_post),
             mixer=dict(w_in=l0_w_in, w_out=l0_w_out, attn_sink=l0_attn_sink, hgrn_norm=l0_hgrn_norm),
             ffn=(l0_ffn_w_gate, l0_ffn_w_up, l0_ffn_w_down)),
        dict(ada_w=l1_ada_w, ada_b=l1_ada_b,
             norms=(l1_norm_mix_pre, l1_norm_mix_post, l1_norm_ffn_pre, l1_norm_ffn_post),
             mixer=dict(w_in=l1_w_in, w_out=l1_w_out, gla_gate_up_f=l1_gla_gate_up_f,
                        gla_gate_up_b=l1_gla_gate_up_b, gla_gate_bias_f=l1_gla_gate_bias_f,
                        gla_gate_bias_b=l1_gla_gate_bias_b, gla_norm=l1_gla_norm,
                        rwkv_mu_prev=l1_rwkv_mu_prev, rwkv_mu_next=l1_rwkv_mu_next,
                        rwkv_w0_f=l1_rwkv_w0_f, rwkv_w0_b=l1_rwkv_w0_b, rwkv_w2_f=l1_rwkv_w2_f,
                        rwkv_w2_b=l1_rwkv_w2_b, rwkv_a0=l1_rwkv_a0, rwkv_a2=l1_rwkv_a2, rwkv_g2=l1_rwkv_g2,
                        rwkv_k_k=l1_rwkv_k_k, rwkv_k_a=l1_rwkv_k_a, rwkv_r_k=l1_rwkv_r_k,
                        rwkv_ln_w=l1_rwkv_ln_w, rwkv_ln_b=l1_rwkv_ln_b),
             ffn=(l1_moe_router, l1_moe_w_gate, l1_moe_w_up, l1_moe_w_down)),
    ]
    xc = ctx
    for l in range(DEPTH):
        p = layers[l]
        need_ctx = l < DEPTH - 1
        n_mix_pre, n_mix_post, n_ffn_pre, n_ffn_post = p['norms']
        sh1, sc1, g1, sh2, sc2, g2 = [m[:, None, :] for m in adaln(c, p['ada_w'], p['ada_b'])]
        sh1c, sc1c, g1c, sh2c, sc2c, g2c = adaln(c_ctx, p['ada_w'], p['ada_b'])
        h = rmsnorm(x, n_mix_pre) * (1.0 + sc1) + sh1
        hc = rmsnorm(xc, n_mix_pre) * (1.0 + sc1c) + sh1c
        if l % 2 == 0:
            y, yc = even_mixer(h, hc, hgrn_lb=hgrn_lb[l // 2], rope_cos=rope_cos, rope_sin=rope_sin,
                               need_ctx=need_ctx, **p['mixer'])
            ffn = swiglu
        else:
            y, yc = odd_mixer(h, hc, need_ctx=need_ctx, **p['mixer'])
            ffn = moe_swiglu
        x = x + g1 * rmsnorm(y, n_mix_post)
        h = rmsnorm(x, n_ffn_pre) * (1.0 + sc2) + sh2
        if need_ctx:
            xc = xc + g1c * rmsnorm(yc, n_mix_post)
            hc = rmsnorm(xc, n_ffn_pre) * (1.0 + sc2c) + sh2c
            f = ffn(jnp.concatenate([hc, h], axis=1), *p['ffn'])
            xc = xc + g2c * rmsnorm(f[:, :L], n_ffn_post)
            x = x + g2 * rmsnorm(f[:, L:], n_ffn_post)
        else:
            x = x + g2 * rmsnorm(ffn(h, *p['ffn']), n_ffn_post)
    return x
```

```cpp
#include <hip/hip_runtime.h>
#include <cstdio>
#include <cstdint>

#define LAS __attribute__((address_space(3)))
#define GAS __attribute__((address_space(1)))
typedef unsigned short bf16_t;
typedef short bf16x8 __attribute__((ext_vector_type(8)));
typedef float f32x4 __attribute__((ext_vector_type(4)));
typedef float f32x2 __attribute__((ext_vector_type(2)));
typedef float f32x16 __attribute__((ext_vector_type(16)));
typedef unsigned u32x4 __attribute__((ext_vector_type(4)));
typedef unsigned u32x2 __attribute__((ext_vector_type(2)));

#ifndef N_LAUNCH_MODE
#define N_LAUNCH_MODE 0
#endif

constexpr int D = 2048, SEQ = 16384, CTXL = 256, T = SEQ + CTXL;
constexpr int NWAVES = 8, NTHR = 512;
constexpr float NORM_EPS = 1e-6f;
constexpr int N0 = 6400, P0_QA = 0, P0_KA = 1024, P0_QH = 1280, P0_IH = 2304, P0_FF = 3328, P0_FB = 4352, P0_GH = 5376;
constexpr int N1 = 6912, N1REAL = 6720, G_Q = 0, G_K = 512, G_V = 1024, G_GDF = 2048, G_GDB = 2064, G_GR = 2080;
constexpr int R_R = 3104, R_K = 4128, R_V = 5152, R_WDF = 6176, R_WDB = 6272, R_AD = 6368, R_GD = 6464;
constexpr int FF0 = 5632, FFE = 7168, NE = 8;
constexpr int MOE_ROWS = 2 * SEQ + NE * 256;
constexpr int MOE_MAXPAN = MOE_ROWS / 256;

constexpr size_t MiB = (size_t)1 << 20;
constexpr size_t WS_CTL = 0, CTL_ZERO_BYTES = 1 * MiB;
constexpr size_t WS_MOD = 1 * MiB;
constexpr size_t WS_ROPE = WS_MOD + 256 * 1024;
constexpr size_t WS_BLKCNT = WS_ROPE + 128 * 1024;
constexpr size_t WS_TK = 2 * MiB;
constexpr size_t WS_XC = 4 * MiB;
constexpr size_t WS_W = 8 * MiB;
constexpr size_t W_IN0T = WS_W;
constexpr size_t W_V0T = W_IN0T + 25 * MiB;
constexpr size_t W_OUT0T = W_V0T + 1 * MiB;
constexpr size_t W_GU0T = W_OUT0T + 8 * MiB;
constexpr size_t W_DN0T = W_GU0T + 44 * MiB;
constexpr size_t W_IN1T = W_DN0T + 22 * MiB;
constexpr size_t W_OUT1T = W_IN1T + 27 * MiB;
constexpr size_t W_MGUT = W_OUT1T + 8 * MiB;
constexpr size_t W_MDNT = W_MGUT + 448 * MiB;
constexpr size_t WS_H = W_MDNT + 224 * MiB;
constexpr size_t WS_A = WS_H + 66 * MiB;
constexpr size_t A_PROJ0 = WS_A;
constexpr size_t A_VT = WS_A + 204 * MiB;
constexpr size_t A_MIX0 = WS_A + 213 * MiB;
constexpr size_t A_OF = WS_A + 278 * MiB;
constexpr size_t A_OB = WS_A + 343 * MiB;
constexpr size_t A_Y0 = WS_A + 408 * MiB;
constexpr size_t A_HID0 = WS_A + 538 * MiB;
constexpr size_t A_F0 = WS_A + 717 * MiB;
constexpr size_t A_PROJ1 = WS_A;
constexpr size_t A_RP = WS_A + 220 * MiB;
constexpr size_t A_GOUT = WS_A + 448 * MiB;
constexpr size_t A_GOF = WS_A + 481 * MiB, A_GOB = WS_A + 546 * MiB, A_ROF = WS_A + 611 * MiB, A_ROB = WS_A + 676 * MiB;
constexpr size_t A_MIX1 = WS_A + 741 * MiB;
constexpr size_t A_Y1 = WS_A + 805 * MiB;
constexpr size_t A_SORT = WS_A;
constexpr size_t A_HID1 = WS_A + 136 * MiB;
constexpr size_t A_YDN = WS_A + 612 * MiB;
constexpr size_t WS_END = WS_A + 933 * MiB;
static_assert(A_YDN + (size_t)MOE_ROWS * 2048 * 2 <= A_Y1, "moe overlay");
static_assert(A_HID1 + (size_t)MOE_ROWS * FFE * 2 <= A_YDN, "moe overlay 2");
static_assert(A_F0 + (size_t)T * 2048 * 4 <= WS_END, "arena");
constexpr int CW_BAR = 4096;

constexpr int LDS_BYTES = 147456;
constexpr int MISC_OFF = 131072;
constexpr int MOE_TAB_OFF = MISC_OFF + 64, ECNT_OFF = MISC_OFF + 1024, PREF_OFF = MISC_OFF + 2048;

__device__ __forceinline__ float bf2f(unsigned b) { return __uint_as_float(b << 16); }
__device__ __forceinline__ float bflo(unsigned w) { return __uint_as_float(w << 16); }
__device__ __forceinline__ float bfhi(unsigned w) { return __uint_as_float(w & 0xffff0000u); }
__device__ __forceinline__ unsigned f2bf(float f) { unsigned u = __float_as_uint(f); return (u + 0x7fffu + ((u >> 16) & 1u)) >> 16; }
__device__ __forceinline__ unsigned pk2(float lo, float hi) { return f2bf(lo) | (f2bf(hi) << 16); }
__device__ __forceinline__ float wave_sum(float v) {
#pragma unroll
    for (int o = 1; o < 64; o <<= 1) v += __shfl_xor(v, o);
    return v;
}
__device__ __forceinline__ float fexp2(float x) { return __builtin_amdgcn_exp2f(x); }
__device__ __forceinline__ float fexp(float x) { return __builtin_amdgcn_exp2f(x * 1.4426950408889634f); }
__device__ __forceinline__ float sigmoidf_(float x) { return 1.0f / (1.0f + fexp(-x)); }
__device__ __forceinline__ float siluf_(float x) { return x / (1.0f + fexp(-x)); }
#define LDS_WAIT() asm volatile("s_waitcnt lgkmcnt(0)" ::: "memory")
#define VM_WAIT() asm volatile("s_waitcnt vmcnt(0)" ::: "memory")

#define XB_TMO      128
#define XB_XCNT(j)  (256  + 64 * (j))
#define XB_XSUB(j)  (1280 + 64 * (j))
#define XB_XGEN(j)  (2304 + 64 * (j))
#define XB_TOP      3328
#define XB_TOPGEN   3392
#define XCD_BAR_WORDS 3456
#define XB_SPIN_CAP (1u << 24)
__device__ __forceinline__ unsigned xb_ld(unsigned* p)              { return __hip_atomic_load(p, __ATOMIC_RELAXED, __HIP_MEMORY_SCOPE_AGENT); }
__device__ __forceinline__ unsigned xb_add(unsigned* p, unsigned v) { return __hip_atomic_fetch_add(p, v, __ATOMIC_RELAXED, __HIP_MEMORY_SCOPE_AGENT); }
__device__ __forceinline__ unsigned xb_xcc_id() { return (unsigned)__builtin_amdgcn_s_getreg((3 << 11) | 20) & 0xFu; }
#define XB_SPIN(cond, bar) do { unsigned _sp = 0; while (cond) { __builtin_amdgcn_s_sleep(1); \
    if ((++_sp & 255u) == 0u) { if (xb_ld(&(bar)[XB_TMO])) break; if (_sp > XB_SPIN_CAP) { atomicAdd(&(bar)[XB_TMO], 1u); break; } } } } while (0)
struct XcdBarrier { unsigned* bar; unsigned x; volatile LAS unsigned* st; };
__device__ __forceinline__ XcdBarrier xcd_barrier_post(unsigned* bar, volatile LAS unsigned* st) {
    XcdBarrier b; b.bar = bar; b.x = xb_xcc_id(); b.st = st;
    if (threadIdx.x == 0) (void)xb_add(&bar[XB_XCNT(b.x)], 1u);
    return b;
}
__device__ __forceinline__ void xcd_barrier_complete(unsigned* bar, unsigned x, unsigned& nloc, unsigned& nx) {
    const unsigned G = gridDim.x * gridDim.y * gridDim.z;
    unsigned sum, cnt, mine, sp = 0u;
    for (;;) {
        sum = 0u; cnt = 0u; mine = 0u;
#pragma unroll
        for (unsigned j = 0; j < 16; ++j) { const unsigned c = xb_ld(&bar[XB_XCNT(j)]); sum += c; cnt += (c > 0u) ? 1u : 0u; mine = (j == x) ? c : mine; }
        if (sum == G) break;
        __builtin_amdgcn_s_sleep(1);
        if ((++sp & 255u) == 0u) { if (xb_ld(&bar[XB_TMO])) break; if (sp > XB_SPIN_CAP) { atomicAdd(&bar[XB_TMO], 1u); break; } }
    }
    nloc = mine > 0u ? mine : 1u; nx = cnt > 0u ? cnt : 1u;
}
__device__ __forceinline__ void xcd_barrier(const XcdBarrier& b) {
    asm volatile("s_waitcnt vmcnt(0)" ::: "memory");
    __syncthreads();
    if (threadIdx.x == 0) {
        unsigned* bar = b.bar;
        __builtin_amdgcn_s_waitcnt(0);
        unsigned nloc = b.st[0], nx = b.st[1];
        if (nloc == 0u) { xcd_barrier_complete(bar, b.x, nloc, nx); b.st[0] = nloc; b.st[1] = nx; }
        const unsigned old = xb_add(&bar[XB_XSUB(b.x)], 1u);
        const unsigned gen = old / nloc;
        if (old + 1u == (gen + 1u) * nloc) {
            __builtin_amdgcn_fence(__ATOMIC_RELEASE, "agent");
            asm volatile("s_waitcnt vmcnt(0)" ::: "memory");
            const unsigned og = xb_add(&bar[XB_TOP], 1u);
            const unsigned tg = og / nx;
            if (og + 1u == (tg + 1u) * nx) xb_add(&bar[XB_TOPGEN], 1u);
            else XB_SPIN(xb_ld(&bar[XB_TOPGEN]) == tg, bar);
            __builtin_amdgcn_fence(__ATOMIC_ACQUIRE, "agent");
            xb_add(&bar[XB_XGEN(b.x)], 1u);
            asm volatile("s_waitcnt vmcnt(0)" ::: "memory");
        } else {
            XB_SPIN(xb_ld(&bar[XB_XGEN(b.x)]) == gen, bar);
            __builtin_amdgcn_fence(__ATOMIC_ACQUIRE, "agent");
            asm volatile("s_waitcnt vmcnt(0)" ::: "memory");
        }
    }
    __syncthreads();
}

namespace pg8 {
constexpr int BM = 256, BK = 64, HALF = 128, HTB = HALF * BK * 2, STAGE_BYTES = 8 * HTB, NXCD = 8, WGM = 8;
__host__ __device__ __forceinline__ int lds_byte(int r, int c) { const int st = (r >> 4) * 2 + (c >> 5), rr = r & 15, cc = c & 31, ob = rr * 64 + cc * 2; return st * 1024 + (ob ^ (((ob >> 9) & 1) << 5)); }
__host__ __device__ __forceinline__ void stage_rc(int b, int& R, int& C) { const int st = b / 1024, sb = b % 1024, swz = sb ^ (((sb >> 9) & 1) << 5); R = (st >> 1) * 16 + swz / 64; C = (st & 1) * 32 + (swz % 64) / 2; }
__host__ __device__ __forceinline__ int perm32(int rho) { const int n = rho >> 4, i = rho & 15; return 8 * (i >> 2) + 4 * n + (i & 3); }

struct Unit { int pm, pn; const char* a; const char* b; int aux; };

__device__ __forceinline__ void order_map(int wgid, int nM, int nN, int& pm, int& pn) {
    const int nwg = nM * nN;
    { const int q = nwg / NXCD, r = nwg % NXCD, xcd = wgid % NXCD, off = wgid / NXCD; wgid = (xcd < r ? xcd * (q + 1) : r * (q + 1) + (xcd - r) * q) + off; }
    const int nig = WGM * nN, gid = wgid / nig, fm = gid * WGM, gsz = (nM - fm) < WGM ? (nM - fm) : WGM;
    pm = fm + ((wgid % nig) % gsz); pn = (wgid % nig) / gsz;
}
struct SchedPlain {
    const char* A; const char* Bt; int nM, nN, G, c; size_t tstep; int nextra; const char* A2; const char* B2;
    __device__ __forceinline__ bool next(int i, Unit& u) const {
        const long L = (long)i * G + c; const int nwg = nM * nN;
        if (L >= nwg + nextra) return false;
        if (L >= nwg) { const int j = (int)L - nwg; u.pm = 0; u.pn = j; u.a = A2; u.b = B2 + (size_t)j * tstep; u.aux = 1; return true; }
        int pm, pn; order_map((int)L, nM, nN, pm, pn);
        u.pm = pm; u.pn = pn; u.a = A + (size_t)pm * tstep; u.b = Bt + (size_t)pn * tstep; u.aux = 0; return true;
    }
};
struct SchedMoe {
    const char* A; const char* Wt; size_t wstride; int nM, nN, G, c; size_t tstep; const LAS int* pexp;
    __device__ __forceinline__ bool next(int i, Unit& u) const {
        const long L = (long)i * G + c; const int nwg = nM * nN;
        if (L >= nwg) return false;
        int pm, pn; order_map((int)L, nM, nN, pm, pn);
        const int e = pexp[pm];
        u.pm = pm; u.pn = pn; u.a = A + (size_t)pm * tstep; u.b = Wt + (size_t)e * wstride + (size_t)pn * tstep; u.aux = e; return true;
    }
};

__device__ __forceinline__ unsigned cvt_pk_bf16(float lo, float hi) { unsigned r; asm volatile("v_cvt_pk_bf16_f32 %0, %1, %2" : "=v"(r) : "v"(lo), "v"(hi)); return r; }
struct EpiBf16 {
    static constexpr bool PERM = true;
    bf16_t* O; int ldc; bf16_t* O1; int ldc1;
    __device__ __forceinline__ void operator()(const f32x4 (&acc)[2][2][4][2], const Unit& u, int wr, int wc, int fr, int fq) const {
        bf16_t* base = (u.aux == 1 && O1) ? O1 : O; const int ld = (u.aux == 1 && O1) ? ldc1 : ldc;
        const int row0 = u.pm * BM + wr * 64 + fr, col0 = u.pn * BM + wc * 32 + 8 * fq;
#pragma unroll
        for (int ai = 0; ai < 2; ++ai)
#pragma unroll
            for (int m = 0; m < 4; ++m) { bf16_t* rowp = base + (size_t)(row0 + ai * HALF + m * 16) * ld + col0;
#pragma unroll
                for (int bj = 0; bj < 2; ++bj) { const f32x4 v0 = acc[ai][bj][m][0], v1 = acc[ai][bj][m][1];
                    u32x4 w; w.x = cvt_pk_bf16(v0[0], v0[1]); w.y = cvt_pk_bf16(v0[2], v0[3]); w.z = cvt_pk_bf16(v1[0], v1[1]); w.w = cvt_pk_bf16(v1[2], v1[3]);
                    *(u32x4*)(rowp + bj * HALF) = w; } }
    }
};
struct EpiF32 {
    static constexpr bool PERM = false;
    float* C; int ldc;
    __device__ __forceinline__ void operator()(const f32x4 (&acc)[2][2][4][2], const Unit& u, int wr, int wc, int fr, int fq) const {
        const int row0 = u.pm * BM + wr * 64 + fr, col0 = u.pn * BM + wc * 32 + 4 * fq;
#pragma unroll
        for (int ai = 0; ai < 2; ++ai)
#pragma unroll
            for (int m = 0; m < 4; ++m) { float* rowp = C + (size_t)(row0 + ai * HALF + m * 16) * ldc + col0;
#pragma unroll
                for (int bj = 0; bj < 2; ++bj)
#pragma unroll
                    for (int n = 0; n < 2; ++n) *(f32x4*)(rowp + bj * HALF + n * 16) = acc[ai][bj][m][n]; }
    }
};
struct EpiSwiglu {
    static constexpr bool PERM = true;
    bf16_t* O; int ldc;
    __device__ __forceinline__ void operator()(const f32x4 (&acc)[2][2][4][2], const Unit& u, int wr, int wc, int fr, int fq) const {
        const int row0 = u.pm * BM + wr * 64 + fr, col0 = u.pn * HALF + wc * 32 + 8 * fq;
#pragma unroll
        for (int ai = 0; ai < 2; ++ai)
#pragma unroll
            for (int m = 0; m < 4; ++m) { bf16_t* rowp = O + (size_t)(row0 + ai * HALF + m * 16) * ldc + col0;
                float o[8];
#pragma unroll
                for (int n = 0; n < 2; ++n)
#pragma unroll
                    for (int j = 0; j < 4; ++j) { const float g = acc[ai][0][m][n][j], up = acc[ai][1][m][n][j];
                        o[n * 4 + j] = g * up * __builtin_amdgcn_rcpf(1.0f + __builtin_amdgcn_exp2f(-1.4426950408889634f * g)); }
                u32x4 w; w.x = cvt_pk_bf16(o[0], o[1]); w.y = cvt_pk_bf16(o[2], o[3]); w.z = cvt_pk_bf16(o[4], o[5]); w.w = cvt_pk_bf16(o[6], o[7]);
                *(u32x4*)rowp = w; }
    }
};

template <class Epi, class Sched, bool ALIGN_EPI = true, bool SP2 = true>
__device__ __forceinline__ void gemm_phase(LAS unsigned char* lds, const int K, const Sched& S, const Epi& E) {
    const int tid = threadIdx.x, wid = __builtin_amdgcn_readfirstlane(tid >> 6), lane = tid & 63, wr = wid >> 2, wc = wid & 3, fr = lane & 15, fq = lane >> 4;
    const int nt = K / BK;
    unsigned voffA[2], voffB[2];
#pragma unroll
    for (int i = 0; i < 2; ++i) { int R, C; stage_rc(tid * 16 + i * 8192, R, C); const int Rb = Epi::PERM ? ((R & ~31) + perm32(R & 31)) : R;
        voffA[i] = (unsigned)(R * K + C) * 2u; voffB[i] = (unsigned)(Rb * K + C) * 2u; }
    const size_t kstep = (size_t)(BK * 2);
    const size_t hstep = (size_t)HALF * K * 2;
    const unsigned ldsw = (unsigned)wid * 1024u;
    const int aoff = lds_byte(wr * 64 + fr, fq * 8), boff = lds_byte(wc * 32 + fr, fq * 8);
#define PG8_SA(b, h) (((b) * 2 + (h)) * HTB)
#define PG8_SB(b, h) ((4 + (b) * 2 + (h)) * HTB)
#define PG8_STAGE(bufoff, gbase, voff) do { _Pragma("unroll") for (int _i = 0; _i < 2; ++_i) \
        __builtin_amdgcn_global_load_lds((const unsigned*)((const char*)(gbase) + (voff)[_i]), (LAS unsigned*)(lds + (bufoff) + ldsw + _i * 8192), 16, 0, 0); } while (0)
#define PG8_LDA(dst, b, h) do { _Pragma("unroll") for (int m = 0; m < 4; ++m) _Pragma("unroll") for (int k = 0; k < 2; ++k) dst[m][k] = *(const LAS bf16x8*)(lds + PG8_SA(b, h) + aoff + m * 2048 + k * 1024); } while (0)
#define PG8_LDB(dst, b, h) do { _Pragma("unroll") for (int n = 0; n < 2; ++n) _Pragma("unroll") for (int k = 0; k < 2; ++k) dst[n][k] = *(const LAS bf16x8*)(lds + PG8_SB(b, h) + boff + n * 2048 + k * 1024); } while (0)
#define PG8_MMA(ai, bj, At, Bt) do { __builtin_amdgcn_s_setprio(1); _Pragma("unroll") for (int m = 0; m < 4; ++m) _Pragma("unroll") for (int n = 0; n < 2; ++n) _Pragma("unroll") for (int k = 0; k < 2; ++k) \
        acc[ai][bj][m][n] = __builtin_amdgcn_mfma_f32_16x16x32_bf16(Bt[n][k], At[m][k], acc[ai][bj][m][n], 0, 0, 0); __builtin_amdgcn_s_setprio(0); } while (0)
#define PG8_WAIT_V(n) asm volatile("s_waitcnt vmcnt(" #n ")" ::: "memory")
#define PG8_WAIT_L(n) asm volatile("s_waitcnt lgkmcnt(" #n ")" ::: "memory")
#define PG8_BAR __builtin_amdgcn_s_barrier()
#define PG8_SCHED __builtin_amdgcn_sched_barrier(0)
    Unit cur, nxt; int ui = 0;
    if (!S.next(0, cur)) return;
    f32x4 acc[2][2][4][2];
#pragma unroll
    for (int a = 0; a < 2; ++a)
#pragma unroll
        for (int b = 0; b < 2; ++b)
#pragma unroll
            for (int m = 0; m < 4; ++m)
#pragma unroll
                for (int n = 0; n < 2; ++n) acc[a][b][m][n] = (f32x4){0.f, 0.f, 0.f, 0.f};
    bf16x8 At[4][2], B0[2][2], B1[2][2];
    const char* cA = cur.a; const char* cB = cur.b;
    if constexpr (SP2) {
        PG8_STAGE(PG8_SB(0, 0), cB, voffB); PG8_STAGE(PG8_SB(0, 1), cB + hstep, voffB); PG8_STAGE(PG8_SA(0, 0), cA, voffA); PG8_STAGE(PG8_SA(0, 1), cA + hstep, voffA);
        if (wr == 1) PG8_BAR;
        PG8_WAIT_V(2); PG8_BAR;
        PG8_STAGE(PG8_SB(1, 0), cB + kstep, voffB); PG8_STAGE(PG8_SA(1, 0), cA + kstep, voffA); PG8_STAGE(PG8_SB(1, 1), cB + hstep + kstep, voffB);
        PG8_WAIT_V(6); PG8_BAR;
    } else {
        PG8_STAGE(PG8_SB(0, 0), cB, voffB); PG8_STAGE(PG8_SA(0, 0), cA, voffA); PG8_STAGE(PG8_SB(0, 1), cB + hstep, voffB); PG8_STAGE(PG8_SA(0, 1), cA + hstep, voffA);
        if (wr == 1) PG8_BAR;
        PG8_WAIT_V(4); PG8_BAR;
        PG8_STAGE(PG8_SB(1, 0), cB + kstep, voffB); PG8_STAGE(PG8_SA(1, 0), cA + kstep, voffA); PG8_STAGE(PG8_SB(1, 1), cB + hstep + kstep, voffB);
        PG8_WAIT_V(6); PG8_BAR;
    }
    for (;;) {
        const bool has_next = S.next(ui + 1, nxt);
        const char* nA = has_next ? nxt.a : cA; const char* nB = has_next ? nxt.b : cB;
        for (int t = 0; t < nt; t += 2) {
            const bool last = (t == nt - 2);
            const char* a1 = cA + (size_t)(t + 1) * kstep;
            const char* a2 = last ? nA : cA + (size_t)(t + 2) * kstep; const char* b2 = last ? nB : cB + (size_t)(t + 2) * kstep;
            const char* a3 = a2 + kstep; const char* b3 = b2 + kstep;
            if constexpr (SP2) {
            PG8_LDB(B0, 0, 0); PG8_LDB(B1, 0, 1); PG8_SCHED; PG8_LDA(At, 0, 0); PG8_STAGE(PG8_SA(1, 1), a1 + hstep, voffA);
            PG8_WAIT_V(8); PG8_WAIT_L(0); PG8_BAR; PG8_MMA(0, 0, At, B0); PG8_MMA(0, 1, At, B1); PG8_BAR; PG8_SCHED;
            PG8_LDA(At, 0, 1); PG8_STAGE(PG8_SB(0, 0), b2, voffB); PG8_STAGE(PG8_SB(0, 1), b2 + hstep, voffB); PG8_STAGE(PG8_SA(0, 0), a2, voffA);
            PG8_WAIT_V(8); PG8_WAIT_L(0); PG8_BAR; PG8_MMA(1, 0, At, B0); PG8_MMA(1, 1, At, B1); PG8_BAR; PG8_SCHED;
            PG8_LDB(B0, 1, 0); PG8_LDB(B1, 1, 1); PG8_SCHED; PG8_LDA(At, 1, 0); PG8_STAGE(PG8_SA(0, 1), a2 + hstep, voffA);
            PG8_WAIT_V(8); PG8_WAIT_L(0); PG8_BAR; PG8_MMA(0, 0, At, B0); PG8_MMA(0, 1, At, B1); PG8_BAR; PG8_SCHED;
            PG8_LDA(At, 1, 1); PG8_STAGE(PG8_SB(1, 0), b3, voffB); PG8_STAGE(PG8_SB(1, 1), b3 + hstep, voffB); PG8_STAGE(PG8_SA(1, 0), a3, voffA);
            PG8_WAIT_V(8); PG8_WAIT_L(0); PG8_BAR; PG8_MMA(1, 0, At, B0); PG8_MMA(1, 1, At, B1); PG8_BAR; PG8_SCHED;
            } else {
            PG8_LDB(B0, 0, 0); PG8_SCHED; PG8_LDA(At, 0, 0); PG8_STAGE(PG8_SA(1, 1), a1 + hstep, voffA);
            PG8_WAIT_L(8); PG8_BAR; PG8_WAIT_L(0); PG8_MMA(0, 0, At, B0); PG8_BAR; PG8_SCHED;
            PG8_LDB(B1, 0, 1); PG8_STAGE(PG8_SB(0, 0), b2, voffB);
            PG8_BAR; PG8_WAIT_L(0); PG8_MMA(0, 1, At, B1); PG8_BAR;
            PG8_LDA(At, 0, 1); PG8_STAGE(PG8_SA(0, 0), a2, voffA);
            PG8_BAR; PG8_WAIT_L(0); PG8_MMA(1, 0, At, B0); PG8_BAR; PG8_SCHED;
            PG8_STAGE(PG8_SB(0, 1), b2 + hstep, voffB);
            PG8_WAIT_V(6); PG8_BAR; PG8_MMA(1, 1, At, B1); PG8_BAR;
            PG8_LDB(B0, 1, 0); PG8_SCHED; PG8_LDA(At, 1, 0); PG8_STAGE(PG8_SA(0, 1), a2 + hstep, voffA);
            PG8_WAIT_L(8); PG8_BAR; PG8_WAIT_L(0); PG8_MMA(0, 0, At, B0); PG8_BAR; PG8_SCHED;
            PG8_LDB(B1, 1, 1); PG8_STAGE(PG8_SB(1, 0), b3, voffB);
            PG8_BAR; PG8_WAIT_L(0); PG8_MMA(0, 1, At, B1); PG8_BAR;
            PG8_LDA(At, 1, 1); PG8_STAGE(PG8_SA(1, 0), a3, voffA);
            PG8_BAR; PG8_WAIT_L(0); PG8_MMA(1, 0, At, B0); PG8_BAR; PG8_SCHED;
            PG8_STAGE(PG8_SB(1, 1), b3 + hstep, voffB);
            PG8_WAIT_V(6); PG8_BAR; PG8_MMA(1, 1, At, B1); PG8_BAR;
            }
        }
        if constexpr (ALIGN_EPI) { if (wr == 0) PG8_BAR; }
        E(acc, cur, wr, wc, fr, fq);
        if (!has_next) break;
#pragma unroll
        for (int a = 0; a < 2; ++a)
#pragma unroll
            for (int b = 0; b < 2; ++b)
#pragma unroll
                for (int m = 0; m < 4; ++m)
#pragma unroll
                    for (int n = 0; n < 2; ++n) acc[a][b][m][n] = (f32x4){0.f, 0.f, 0.f, 0.f};
        cur = nxt; cA = nA; cB = nB; ++ui;
        if constexpr (ALIGN_EPI) { if (wr == 1) PG8_BAR; }
    }
    PG8_WAIT_V(0);
    if constexpr (!ALIGN_EPI) { if (wr == 0) PG8_BAR; }
    PG8_BAR;
#undef PG8_SA
#undef PG8_SB
#undef PG8_STAGE
#undef PG8_LDA
#undef PG8_LDB
#undef PG8_MMA
#undef PG8_WAIT_V
#undef PG8_WAIT_L
#undef PG8_BAR
#undef PG8_SCHED
}
}

struct Args { const float* in[49]; float* out; unsigned char* ws; int ph_lo, ph_hi; };
enum { I_X = 0, I_C, I_CTX, I_CCTX, I_LBL, I_ADAW0, I_ADAB0, I_NMIXPRE0, I_NMIXPOST0, I_NFFNPRE0, I_NFFNPOST0, I_WIN0, I_WOUT0, I_SINK, I_HNORM, I_FG0, I_FU0, I_FD0,
       I_ADAW1, I_ADAB1, I_NMIXPRE1, I_NMIXPOST1, I_NFFNPRE1, I_NFFNPOST1, I_WIN1, I_WOUT1, I_GUPF, I_GUPB, I_GBIASF, I_GBIASB, I_GLANORM, I_MUPREV, I_MUNEXT, I_W0F, I_W0B, I_W2F, I_W2B,
       I_A0, I_A2, I_G2, I_KK, I_KA, I_RK, I_LNW, I_LNB, I_ROUTER, I_MG, I_MU, I_MD };

__device__ __forceinline__ void tr_item(const float* W, int K, int ld, int ncol0, bf16_t* WT, int drow0, int mode, int nblk, LAS float* scr, int item, int lane) {
    const int kb = item / nblk, nb = item - kb * nblk, k0 = 64 * kb, n0 = ncol0 + 32 * nb;
    int drow; if (mode == 0) drow = drow0 + 32 * nb; else { const int cc = 32 * nb; drow = (cc >> 7) * 256 + (cc & 127) + (mode == 2 ? 128 : 0); }
#pragma unroll 8
    for (int i = 0; i < 32; ++i) { const int kk = 2 * i + (lane >> 5); scr[kk * 33 + (lane & 31)] = W[(size_t)(k0 + kk) * ld + n0 + (lane & 31)]; }
    LDS_WAIT();
    const int c = lane & 7;
#pragma unroll
    for (int j = 0; j < 4; ++j) { const int n = (lane >> 3) + 8 * j; const LAS float* s = scr + (8 * c) * 33 + n;
        u32x4 o; o.x = pk2(s[0 * 33], s[1 * 33]); o.y = pk2(s[2 * 33], s[3 * 33]); o.z = pk2(s[4 * 33], s[5 * 33]); o.w = pk2(s[6 * 33], s[7 * 33]);
        *(u32x4*)(WT + (size_t)(drow + n) * K + k0 + 8 * c) = o; }
    LDS_WAIT();
}

__device__ __forceinline__ void p0_prologue(const Args& a, LAS unsigned char* lds, int tid, int lane, int wave) {
    unsigned char* ws = a.ws;
    const int G = gridDim.x, bx = blockIdx.x;
    {
        LAS float* sc = (LAS float*)lds;
        LAS float* red = (LAS float*)(lds + 16384);
        for (int i = tid; i < 2 * D; i += NTHR) { const float v = (i < D) ? a.in[I_C][i] : a.in[I_CCTX][i - D]; sc[i] = siluf_(v); }
        __syncthreads();
        float* mod = (float*)(ws + WS_MOD);
        for (int it = bx; it < 384; it += G) {
            const int l = it / 192, cg = it % 192; const float* W = a.in[l ? I_ADAW1 : I_ADAW0]; const float* B = a.in[l ? I_ADAB1 : I_ADAB0];
            const int col = cg * 64 + lane; float a0 = 0.f, a1 = 0.f;
            const float* wp = W + (size_t)(wave * 256) * 12288 + col;
#pragma unroll 8
            for (int k = 0; k < 256; ++k) { const float w = wp[(size_t)k * 12288]; a0 = fmaf(sc[wave * 256 + k], w, a0); a1 = fmaf(sc[D + wave * 256 + k], w, a1); }
            red[(wave * 2 + 0) * 64 + lane] = a0; red[(wave * 2 + 1) * 64 + lane] = a1;
            __syncthreads();
            if (wave < 2) { float s = 0.f;
#pragma unroll
                for (int w = 0; w < 8; ++w) s += red[(w * 2 + wave) * 64 + lane];
                mod[(size_t)(l * 2 + wave) * 12288 + col] = s + B[col]; }
            __syncthreads();
        }
    }
    {
        float* tab = (float*)(ws + WS_ROPE);
        const int gi = bx * NTHR + tid;
        if (gi < 320 * 32) { const int pos = gi >> 5, f = gi & 31; const int p = pos < 256 ? pos : pos - 256;
            const float inv = exp2f(-(float)f * (13.287712379549449f / 32.0f));
            const float ang = (float)p * inv; float sn, cs; sincosf(ang, &sn, &cs);
            tab[2 * gi] = cs; tab[2 * gi + 1] = sn; }
    }
    {
        LAS float* scr = (LAS float*)(lds + wave * 16384);
        const int gw = bx * NWAVES + wave, NGW = G * NWAVES;
        constexpr int S0 = 32 * 40, S1 = 32 * 8, S2 = 32 * 160, S3 = 32 * 64, S4 = 32 * 176, S5 = S4, S6 = 88 * 64, S7 = 32 * 210, S8 = 32 * 64, SE = 32 * 224, SD = 112 * 64;
        constexpr int NIT = S0 + S1 + S2 + S3 + S4 + S5 + S6 + S7 + S8 + 8 * SE * 2 + 8 * SD;
        for (int it = gw; it < NIT; it += NGW) {
            int r = it;
            if (r < S0) { tr_item(a.in[I_WIN0], 2048, 6656, 0, (bf16_t*)(ws + W_IN0T), 0, 0, 40, scr, r, lane); continue; } r -= S0;
            if (r < S1) { tr_item(a.in[I_WIN0], 2048, 6656, 1280, (bf16_t*)(ws + W_V0T), 0, 0, 8, scr, r, lane); continue; } r -= S1;
            if (r < S2) { tr_item(a.in[I_WIN0], 2048, 6656, 1536, (bf16_t*)(ws + W_IN0T), 1280, 0, 160, scr, r, lane); continue; } r -= S2;
            if (r < S3) { tr_item(a.in[I_WOUT0], 2048, 2048, 0, (bf16_t*)(ws + W_OUT0T), 0, 0, 64, scr, r, lane); continue; } r -= S3;
            if (r < S4) { tr_item(a.in[I_FG0], 2048, 5632, 0, (bf16_t*)(ws + W_GU0T), 0, 1, 176, scr, r, lane); continue; } r -= S4;
            if (r < S5) { tr_item(a.in[I_FU0], 2048, 5632, 0, (bf16_t*)(ws + W_GU0T), 0, 2, 176, scr, r, lane); continue; } r -= S5;
            if (r < S6) { tr_item(a.in[I_FD0], 5632, 2048, 0, (bf16_t*)(ws + W_DN0T), 0, 0, 64, scr, r, lane); continue; } r -= S6;
            if (r < S7) { tr_item(a.in[I_WIN1], 2048, 6720, 0, (bf16_t*)(ws + W_IN1T), 0, 0, 210, scr, r, lane); continue; } r -= S7;
            if (r < S8) { tr_item(a.in[I_WOUT1], 2048, 2048, 0, (bf16_t*)(ws + W_OUT1T), 0, 0, 64, scr, r, lane); continue; } r -= S8;
            if (r < 8 * SE) { const int e = r / SE; tr_item(a.in[I_MG] + (size_t)e * 2048 * 7168, 2048, 7168, 0, (bf16_t*)(ws + W_MGUT) + (size_t)e * 14336 * 2048, 0, 1, 224, scr, r - e * SE, lane); continue; } r -= 8 * SE;
            if (r < 8 * SE) { const int e = r / SE; tr_item(a.in[I_MU] + (size_t)e * 2048 * 7168, 2048, 7168, 0, (bf16_t*)(ws + W_MGUT) + (size_t)e * 14336 * 2048, 0, 2, 224, scr, r - e * SE, lane); continue; } r -= 8 * SE;
            { const int e = r / SD; tr_item(a.in[I_MD] + (size_t)e * 7168 * 2048, 7168, 2048, 0, (bf16_t*)(ws + W_MDNT) + (size_t)e * 2048 * 7168, 0, 0, 64, scr, r - e * SD, lane); }
        }
    }
}

__device__ __forceinline__ f32x4 ldp(const float* p, int lane, int j) { return *(const f32x4*)(p + 4 * lane + 256 * j); }
__device__ __forceinline__ void ldrow(const float* p, int lane, f32x4 (&v)[8]) {
#pragma unroll
    for (int j = 0; j < 8; ++j) v[j] = ldp(p, lane, j);
}
__device__ __forceinline__ float rms_scale(const f32x4 (&v)[8]) {
    float s = 0.f;
#pragma unroll
    for (int j = 0; j < 8; ++j) s += (v[j][0] * v[j][0] + v[j][1] * v[j][1]) + (v[j][2] * v[j][2] + v[j][3] * v[j][3]);
    return __builtin_amdgcn_rsqf(wave_sum(s) * (1.0f / D) + NORM_EPS);
}
__device__ __forceinline__ void mod_store(f32x4 (&v)[8], const float* gpre, const float* sc, const float* sh, bf16_t* hrow, int lane) {
    const float rs = rms_scale(v);
#pragma unroll
    for (int j = 0; j < 8; ++j) { const f32x4 g = ldp(gpre, lane, j), s = ldp(sc, lane, j), b = ldp(sh, lane, j);
        v[j] = v[j] * rs * g * (s + 1.0f) + b;
        u32x2 w; w.x = pk2(v[j][0], v[j][1]); w.y = pk2(v[j][2], v[j][3]); *(u32x2*)(hrow + 4 * lane + 256 * j) = w; }
}
__device__ __forceinline__ void add_branch(f32x4 (&v)[8], const f32x4 (&b)[8], const float* gpost, const float* gate, int lane) {
    const float rs = rms_scale(b);
#pragma unroll
    for (int j = 0; j < 8; ++j) { const f32x4 g = ldp(gpost, lane, j), gt = ldp(gate, lane, j); v[j] = v[j] + gt * (b[j] * rs * g); }
}
__device__ __forceinline__ void strow(float* p, int lane, const f32x4 (&v)[8]) {
#pragma unroll
    for (int j = 0; j < 8; ++j) *(f32x4*)(p + 4 * lane + 256 * j) = v[j];
}

constexpr int KST = 272, VST = 136, ATT_V_OFF = 64 * KST;
__device__ __forceinline__ void attn_unit(LAS unsigned char* lds, const bf16_t* proj0, const bf16_t* vT, bf16_t* mix, const float* sinks, const float* ropetab,
                                          int kind, int qb, int g, int tid) {
    const int wave = tid >> 6, lane = tid & 63, c = lane & 31, hh = lane >> 5;
    const int head = g * 4 + (wave >> 1), sub = (wave & 1) * 32;
    const int qrow = (kind == 0 ? CTXL + qb * 64 : qb * 64) + sub + c;
    const float qscale = 0.08838834764831845f * 1.4426950408889634f;
    const float* rowtab = ropetab; const float* coltab = ropetab + 256 * 64;
    bf16x8 qf[8];
    {
        const bf16_t* qp = proj0 + (size_t)qrow * N0 + P0_QA + head * 128;
        const int tl = qrow - CTXL;
#pragma unroll
        for (int ax = 0; ax < 2; ++ax)
#pragma unroll
            for (int sp = 0; sp < 2; ++sp) {
                const int d1 = ax * 64 + sp * 16 + hh * 8;
                const u32x4 c1 = *(const u32x4*)(qp + d1), c2 = *(const u32x4*)(qp + d1 + 32);
                float x1[8], x2[8];
#pragma unroll
                for (int e = 0; e < 4; ++e) { x1[2 * e] = bflo(c1[e]); x1[2 * e + 1] = bfhi(c1[e]); x2[2 * e] = bflo(c2[e]); x2[2 * e + 1] = bfhi(c2[e]); }
                if (kind == 0) {
                    const int pos = ax == 0 ? (tl >> 6) : (tl & 63);
                    const float* tb = (ax == 0 ? rowtab : coltab) + (pos * 32 + sp * 16 + hh * 8) * 2;
#pragma unroll
                    for (int e = 0; e < 8; ++e) { const float cs = tb[2 * e], sn = tb[2 * e + 1]; const float o1 = x1[e] * cs - x2[e] * sn, o2 = x1[e] * sn + x2[e] * cs; x1[e] = o1; x2[e] = o2; }
                }
                u32x4 w1, w2;
#pragma unroll
                for (int e = 0; e < 4; ++e) { w1[e] = pk2(x1[2 * e] * qscale, x1[2 * e + 1] * qscale); w2[e] = pk2(x2[2 * e] * qscale, x2[2 * e + 1] * qscale); }
                qf[ax * 4 + sp] = __builtin_bit_cast(bf16x8, w1); qf[ax * 4 + sp + 2] = __builtin_bit_cast(bf16x8, w2);
            }
    }
    float m = sinks[head] * 1.4426950408889634f, lsum = (hh == 0) ? 1.0f : 0.0f;
    f32x16 o[4];
#pragma unroll
    for (int i = 0; i < 4; ++i)
#pragma unroll
        for (int r = 0; r < 16; ++r) o[i][r] = 0.f;
    const int ntile = (kind == 0) ? 9 : 4;
    for (int ti = 0; ti < ntile; ++ti) {
        int krow0, mode = 0; bool rope = false;
        if (ti < 4) krow0 = 64 * ti;
        else { const int j = ti - 6; const int tl0 = qb * 64 + 64 * j; if (tl0 < 0 || tl0 >= SEQ) continue; krow0 = CTXL + tl0; rope = true; mode = (j == -2) ? 1 : (j == 2 ? 2 : 0); }
        __syncthreads();
        {
            const int key = tid >> 3, p = tid & 7, ax = p >> 2, fc = p & 3; const int krow = krow0 + key;
            const bf16_t* kp = proj0 + (size_t)krow * N0 + P0_KA + g * 128 + ax * 64 + fc * 8;
            u32x4 c1 = *(const u32x4*)kp, c2 = *(const u32x4*)(kp + 32);
            if (rope) {
                const int tl = krow - CTXL; const int pos = ax == 0 ? (tl >> 6) : (tl & 63);
                const float* tb = (ax == 0 ? rowtab : coltab) + (pos * 32 + fc * 8) * 2;
                float x1[8], x2[8];
#pragma unroll
                for (int e = 0; e < 4; ++e) { x1[2 * e] = bflo(c1[e]); x1[2 * e + 1] = bfhi(c1[e]); x2[2 * e] = bflo(c2[e]); x2[2 * e + 1] = bfhi(c2[e]); }
#pragma unroll
                for (int e = 0; e < 8; ++e) { const float cs = tb[2 * e], sn = tb[2 * e + 1]; const float o1 = x1[e] * cs - x2[e] * sn, o2 = x1[e] * sn + x2[e] * cs; x1[e] = o1; x2[e] = o2; }
#pragma unroll
                for (int e = 0; e < 4; ++e) { c1[e] = pk2(x1[2 * e], x1[2 * e + 1]); c2[e] = pk2(x2[2 * e], x2[2 * e + 1]); }
            }
            *(LAS u32x4*)(lds + key * KST + (ax * 64 + fc * 8) * 2) = c1;
            *(LAS u32x4*)(lds + key * KST + (ax * 64 + fc * 8 + 32) * 2) = c2;
        }
#pragma unroll
        for (int i = 0; i < 2; ++i) {
            const int idx = tid + NTHR * i, d = idx >> 3, ch = idx & 7;
            const u32x4 v = *(const u32x4*)(vT + (size_t)(g * 128 + d) * T + krow0 + ch * 8);
            LAS u32x2* dst = (LAS u32x2*)(lds + ATT_V_OFF + d * VST + ch * 16);
            dst[0] = (u32x2){v.x, v.y}; dst[1] = (u32x2){v.z, v.w};
        }
        __syncthreads();
        f32x16 p0, p1;
#pragma unroll
        for (int r = 0; r < 16; ++r) { p0[r] = 0.f; p1[r] = 0.f; }
#pragma unroll
        for (int s = 0; s < 8; ++s) {
            const bf16x8 k0 = *(const LAS bf16x8*)(lds + c * KST + (16 * s + 8 * hh) * 2);
            const bf16x8 k1 = *(const LAS bf16x8*)(lds + (32 + c) * KST + (16 * s + 8 * hh) * 2);
            p0 = __builtin_amdgcn_mfma_f32_32x32x16_bf16(k0, qf[s], p0, 0, 0, 0);
            p1 = __builtin_amdgcn_mfma_f32_32x32x16_bf16(k1, qf[s], p1, 0, 0, 0);
        }
        if (mode != 0) {
            const int ii = sub + c;
#pragma unroll
            for (int r = 0; r < 16; ++r) { const int k0i = (r & 3) + 8 * (r >> 2) + 4 * hh, k1i = k0i + 32;
                const bool bad0 = (mode == 1) ? (k0i < ii) : (k0i > ii), bad1 = (mode == 1) ? (k1i < ii) : (k1i > ii);
                if (bad0) p0[r] = -INFINITY; if (bad1) p1[r] = -INFINITY; }
        }
        float mx = p0[0];
#pragma unroll
        for (int r = 0; r < 16; ++r) { mx = fmaxf(mx, p0[r]); mx = fmaxf(mx, p1[r]); }
        mx = fmaxf(mx, __shfl_xor(mx, 32));
        const float mnew = fmaxf(m, mx), alpha = fexp2(m - mnew); m = mnew;
        float rs = 0.f;
#pragma unroll
        for (int r = 0; r < 16; ++r) { p0[r] = fexp2(p0[r] - mnew); p1[r] = fexp2(p1[r] - mnew); rs += p0[r] + p1[r]; }
        lsum = lsum * alpha + rs;
#pragma unroll
        for (int i = 0; i < 4; ++i)
#pragma unroll
            for (int r = 0; r < 16; ++r) o[i][r] *= alpha;
        bf16x8 pf[2][2];
#pragma unroll
        for (int s2 = 0; s2 < 2; ++s2) {
            u32x4 w0, w1;
#pragma unroll
            for (int e = 0; e < 4; ++e) { w0[e] = pk2(p0[8 * s2 + 2 * e], p0[8 * s2 + 2 * e + 1]); w1[e] = pk2(p1[8 * s2 + 2 * e], p1[8 * s2 + 2 * e + 1]); }
            pf[0][s2] = __builtin_bit_cast(bf16x8, w0); pf[1][s2] = __builtin_bit_cast(bf16x8, w1);
        }
#pragma unroll
        for (int dt = 0; dt < 4; ++dt)
#pragma unroll
            for (int kt = 0; kt < 2; ++kt)
#pragma unroll
                for (int s2 = 0; s2 < 2; ++s2) {
                    const LAS unsigned char* vp = lds + ATT_V_OFF + (32 * dt + c) * VST + (32 * kt + 16 * s2 + 4 * hh) * 2;
                    const u32x2 lo = *(const LAS u32x2*)vp, hi = *(const LAS u32x2*)(vp + 16);
                    const u32x4 vv = (u32x4){lo.x, lo.y, hi.x, hi.y};
                    o[dt] = __builtin_amdgcn_mfma_f32_32x32x16_bf16(__builtin_bit_cast(bf16x8, vv), pf[kt][s2], o[dt], 0, 0, 0);
                }
    }
    const float ltot = lsum + __shfl_xor(lsum, 32), inv = 1.0f / ltot;
    bf16_t* op = mix + (size_t)qrow * D + head * 128;
#pragma unroll
    for (int dt = 0; dt < 4; ++dt)
#pragma unroll
        for (int gq = 0; gq < 4; ++gq) {
            u32x2 w; w.x = pk2(o[dt][4 * gq] * inv, o[dt][4 * gq + 1] * inv); w.y = pk2(o[dt][4 * gq + 2] * inv, o[dt][4 * gq + 3] * inv);
            *(u32x2*)(op + 32 * dt + 8 * gq + 4 * hh) = w;
        }
}

__device__ __forceinline__ int row_of(int dir, int n) { return dir == 0 ? n : (n < CTXL ? CTXL - 1 - n : T + CTXL - 1 - n); }

__device__ __forceinline__ void hgrn_scan(LAS unsigned char* wl, const bf16_t* proj0, const float* lbl, float* of, float* ob, int task, int lane) {
    const int dir = task >> 4, head = (task >> 1) & 7, vh = task & 1;
    LAS float* lq = (LAS float*)wl; LAS float* lf = lq + 8 * 128; LAS float* lv = lf + 8 * 128;
    float lb0, lb1;
    { const int k = head * 128 + 2 * lane; lb0 = 1.0f / (1.0f + fexp(lbl[1024 + k] - lbl[k])); lb1 = 1.0f / (1.0f + fexp(lbl[1024 + k + 1] - lbl[k + 1])); }
    float s[128];
#pragma unroll
    for (int k = 0; k < 128; ++k) s[k] = 0.f;
    float* outp = dir ? ob : of;
    const int foff = dir ? P0_FB : P0_FF;
    for (int n0 = 0; n0 < T; n0 += 8) {
#pragma unroll
        for (int j = 0; j < 8; ++j) {
            const int r = row_of(dir, n0 + j); const bf16_t* pr = proj0 + (size_t)r * N0;
            const unsigned qq = *(const unsigned*)(pr + P0_QH + head * 128 + 2 * lane), ff = *(const unsigned*)(pr + foff + head * 128 + 2 * lane);
            const float iv = bf2f(pr[P0_IH + head * 128 + vh * 64 + lane]);
            *(LAS f32x2*)(lq + j * 128 + 2 * lane) = (f32x2){siluf_(bflo(qq)), siluf_(bfhi(qq))};
            *(LAS f32x2*)(lf + j * 128 + 2 * lane) = (f32x2){lb0 + (1.0f - lb0) * sigmoidf_(bflo(ff)), lb1 + (1.0f - lb1) * sigmoidf_(bfhi(ff))};
            lv[j * 64 + lane] = iv;
        }
        LDS_WAIT();
#pragma unroll 1
        for (int j = 0; j < 8; ++j) {
            const float iv = lv[j * 64 + lane];
            float o0 = 0.f, o1 = 0.f, o2 = 0.f, o3 = 0.f;
#pragma unroll
            for (int k4 = 0; k4 < 32; ++k4) {
                const f32x4 f4 = *(const LAS f32x4*)(lf + j * 128 + 4 * k4), q4 = *(const LAS f32x4*)(lq + j * 128 + 4 * k4);
                s[4 * k4 + 0] = fmaf(f4[0], s[4 * k4 + 0] - iv, iv); o0 = fmaf(q4[0], s[4 * k4 + 0], o0);
                s[4 * k4 + 1] = fmaf(f4[1], s[4 * k4 + 1] - iv, iv); o1 = fmaf(q4[1], s[4 * k4 + 1], o1);
                s[4 * k4 + 2] = fmaf(f4[2], s[4 * k4 + 2] - iv, iv); o2 = fmaf(q4[2], s[4 * k4 + 2], o2);
                s[4 * k4 + 3] = fmaf(f4[3], s[4 * k4 + 3] - iv, iv); o3 = fmaf(q4[3], s[4 * k4 + 3], o3);
            }
            const int r = row_of(dir, n0 + j);
            outp[(size_t)r * 1024 + head * 128 + vh * 64 + lane] = (o0 + o1) + (o2 + o3);
        }
        LDS_WAIT();
    }
}

__device__ __forceinline__ float logsigf_(float x) { return fminf(x, 0.f) - __logf(1.0f + fexp(-fabsf(x))); }

__device__ __forceinline__ void gla_scan(LAS unsigned char* wl, const bf16_t* proj1, const float* upf, const float* upb, const float* biasf, const float* biasb, float* gof, float* gob, int task, int lane) {
    const int dir = task >> 4, head = (task >> 2) & 3, vq = task & 3;
    LAS float* lq = (LAS float*)wl; LAS float* lk = lq + 8 * 128; LAS float* ld_ = lk + 8 * 128; LAS float* lv = ld_ + 8 * 128;
    const float* up = dir ? upb : upf; const float* bias = dir ? biasb : biasf;
    float u0[16], u1[16]; const int ch = head * 128 + 2 * lane;
#pragma unroll
    for (int j = 0; j < 16; ++j) { u0[j] = up[j * 512 + ch]; u1[j] = up[j * 512 + ch + 1]; }
    const float b0 = bias[ch], b1 = bias[ch + 1];
    float s[128];
#pragma unroll
    for (int k = 0; k < 128; ++k) s[k] = 0.f;
    float* outp = dir ? gob : gof;
    const int gdo = dir ? G_GDB : G_GDF;
    for (int n0 = 0; n0 < T; n0 += 8) {
#pragma unroll
        for (int j = 0; j < 8; ++j) {
            const int r = row_of(dir, n0 + j); const bf16_t* pr = proj1 + (size_t)r * N1;
            const unsigned qq = *(const unsigned*)(pr + G_Q + ch), kk = *(const unsigned*)(pr + G_K + ch);
            const u32x4 g0 = *(const u32x4*)(pr + gdo), g1 = *(const u32x4*)(pr + gdo + 8);
            float x0 = b0, x1 = b1;
#pragma unroll
            for (int e = 0; e < 4; ++e) { x0 = fmaf(bflo(g0[e]), u0[2 * e], x0); x0 = fmaf(bfhi(g0[e]), u0[2 * e + 1], x0); x1 = fmaf(bflo(g0[e]), u1[2 * e], x1); x1 = fmaf(bfhi(g0[e]), u1[2 * e + 1], x1);
                x0 = fmaf(bflo(g1[e]), u0[8 + 2 * e], x0); x0 = fmaf(bfhi(g1[e]), u0[8 + 2 * e + 1], x0); x1 = fmaf(bflo(g1[e]), u1[8 + 2 * e], x1); x1 = fmaf(bfhi(g1[e]), u1[8 + 2 * e + 1], x1); }
            const float iv = bf2f(pr[G_V + head * 256 + vq * 64 + lane]);
            *(LAS f32x2*)(lq + j * 128 + 2 * lane) = (f32x2){bflo(qq) * 0.08838834764831845f, bfhi(qq) * 0.08838834764831845f};
            *(LAS f32x2*)(lk + j * 128 + 2 * lane) = (f32x2){bflo(kk), bfhi(kk)};
            *(LAS f32x2*)(ld_ + j * 128 + 2 * lane) = (f32x2){fexp(logsigf_(x0) * 0.0625f), fexp(logsigf_(x1) * 0.0625f)};
            lv[j * 64 + lane] = iv;
        }
        LDS_WAIT();
#pragma unroll 1
        for (int j = 0; j < 8; ++j) {
            const float iv = lv[j * 64 + lane];
            float o0 = 0.f, o1 = 0.f, o2 = 0.f, o3 = 0.f;
#pragma unroll
            for (int k4 = 0; k4 < 32; ++k4) {
                const f32x4 d4 = *(const LAS f32x4*)(ld_ + j * 128 + 4 * k4), q4 = *(const LAS f32x4*)(lq + j * 128 + 4 * k4), kk4 = *(const LAS f32x4*)(lk + j * 128 + 4 * k4);
                s[4 * k4 + 0] = fmaf(d4[0], s[4 * k4 + 0], kk4[0] * iv); o0 = fmaf(q4[0], s[4 * k4 + 0], o0);
                s[4 * k4 + 1] = fmaf(d4[1], s[4 * k4 + 1], kk4[1] * iv); o1 = fmaf(q4[1], s[4 * k4 + 1], o1);
                s[4 * k4 + 2] = fmaf(d4[2], s[4 * k4 + 2], kk4[2] * iv); o2 = fmaf(q4[2], s[4 * k4 + 2], o2);
                s[4 * k4 + 3] = fmaf(d4[3], s[4 * k4 + 3], kk4[3] * iv); o3 = fmaf(q4[3], s[4 * k4 + 3], o3);
            }
            const int r = row_of(dir, n0 + j);
            outp[(size_t)r * 1024 + head * 256 + vq * 64 + lane] = (o0 + o1) + (o2 + o3);
        }
        LDS_WAIT();
    }
}

__device__ __forceinline__ void rwkv_scan(LAS unsigned char* wl, const bf16_t* RP, float* rof, float* rob, int task, int lane) {
    const int dir = task >> 4, head = task & 15;
    LAS float* lr = (LAS float*)wl; LAS float* lw = lr + 8 * 64; LAS float* lk = lw + 8 * 64; LAS float* la = lk + 8 * 64; LAS float* lb = la + 8 * 64; LAS float* lv = lb + 8 * 64;
    float s[64];
#pragma unroll
    for (int k = 0; k < 64; ++k) s[k] = 0.f;
    float* outp = dir ? rob : rof;
    const int c = head * 64 + lane;
    for (int n0 = 0; n0 < T; n0 += 8) {
#pragma unroll
        for (int j = 0; j < 8; ++j) {
            const int r = row_of(dir, n0 + j); const bf16_t* pr = RP + (size_t)r * 7168 + c;
            const float rr = bf2f(pr[0]), km = bf2f(pr[1024]), vv = bf2f(pr[2048]), kk = bf2f(pr[3072]), aa = bf2f(pr[4096]), lwv = bf2f(pr[(5 + dir) * 1024]);
            lr[j * 64 + lane] = rr; lw[j * 64 + lane] = fexp(lwv); lk[j * 64 + lane] = km; la[j * 64 + lane] = -kk; lb[j * 64 + lane] = kk * aa; lv[j * 64 + lane] = vv;
        }
        LDS_WAIT();
#pragma unroll 1
        for (int j = 0; j < 8; ++j) {
            const float iv = lv[j * 64 + lane];
            float a0 = 0.f, a1 = 0.f, a2 = 0.f, a3 = 0.f;
#pragma unroll
            for (int k4 = 0; k4 < 16; ++k4) { const f32x4 x = *(const LAS f32x4*)(la + j * 64 + 4 * k4);
                a0 = fmaf(s[4 * k4], x[0], a0); a1 = fmaf(s[4 * k4 + 1], x[1], a1); a2 = fmaf(s[4 * k4 + 2], x[2], a2); a3 = fmaf(s[4 * k4 + 3], x[3], a3); }
            const float sa = (a0 + a1) + (a2 + a3);
            float o0 = 0.f, o1 = 0.f, o2 = 0.f, o3 = 0.f;
#pragma unroll
            for (int k4 = 0; k4 < 16; ++k4) {
                const f32x4 w4 = *(const LAS f32x4*)(lw + j * 64 + 4 * k4), b4 = *(const LAS f32x4*)(lb + j * 64 + 4 * k4), k4v = *(const LAS f32x4*)(lk + j * 64 + 4 * k4), r4 = *(const LAS f32x4*)(lr + j * 64 + 4 * k4);
                s[4 * k4 + 0] = fmaf(s[4 * k4 + 0], w4[0], fmaf(sa, b4[0], iv * k4v[0])); o0 = fmaf(s[4 * k4 + 0], r4[0], o0);
                s[4 * k4 + 1] = fmaf(s[4 * k4 + 1], w4[1], fmaf(sa, b4[1], iv * k4v[1])); o1 = fmaf(s[4 * k4 + 1], r4[1], o1);
                s[4 * k4 + 2] = fmaf(s[4 * k4 + 2], w4[2], fmaf(sa, b4[2], iv * k4v[2])); o2 = fmaf(s[4 * k4 + 2], r4[2], o2);
                s[4 * k4 + 3] = fmaf(s[4 * k4 + 3], w4[3], fmaf(sa, b4[3], iv * k4v[3])); o3 = fmaf(s[4 * k4 + 3], r4[3], o3);
            }
            const int r = row_of(dir, n0 + j);
            outp[(size_t)r * 1024 + c] = (o0 + o1) + (o2 + o3);
        }
        LDS_WAIT();
    }
}

__device__ __forceinline__ float shifted(const bf16_t* P, int r, int col, const float* mup, const float* mun) {
    const float p = bf2f(P[(size_t)r * N1 + col]);
    const float pv = (r == 0 || r == CTXL) ? 0.f : bf2f(P[(size_t)(r - 1) * N1 + col]);
    const float nx = (r == CTXL - 1 || r == T - 1) ? 0.f : bf2f(P[(size_t)(r + 1) * N1 + col]);
    const int mi = col - R_R;
    return p + mup[mi] * (pv - p) + mun[mi] * (nx - p);
}
__device__ __forceinline__ void rwkv_prep(const Args& a, LAS unsigned char* lds, const bf16_t* P, bf16_t* RP, bf16_t* GOUT, int tid) {
    LAS float* LF = (LAS float*)lds; LAS float* LB = LF + 96 * 16; LAS float* LA = LB + 96 * 16; LAS float* LG = LA + 96 * 16;
    const float* mup = a.in[I_MUPREV]; const float* mun = a.in[I_MUNEXT];
    const float* w2f = a.in[I_W2F]; const float* w2b = a.in[I_W2B]; const float* a2 = a.in[I_A2]; const float* g2 = a.in[I_G2];
    for (int tile = blockIdx.x; tile < T / 16; tile += gridDim.x) {
        const int r0 = tile * 16;
        __syncthreads();
        for (int idx = tid; idx < 16 * 544; idx += NTHR) {
            const int row = idx / 544, cc = idx - row * 544;
            float v = shifted(P, r0 + row, R_WDF + cc, mup, mun);
            if (cc < 192) { v = tanhf(v); if (cc < 96) LF[cc * 16 + row] = v; else LB[(cc - 96) * 16 + row] = v; }
            else if (cc < 288) LA[(cc - 192) * 16 + row] = v;
            else LG[(cc - 288) * 16 + row] = sigmoidf_(v);
        }
        __syncthreads();
#pragma unroll 1
        for (int ci = 0; ci < 2; ++ci) {
            const int c = tid + 512 * ci;
            float af[16], ab[16], aa[16], ag[16];
#pragma unroll
            for (int r = 0; r < 16; ++r) { af[r] = 0.f; ab[r] = 0.f; aa[r] = 0.f; ag[r] = 0.f; }
#pragma unroll 2
            for (int j = 0; j < 96; ++j) {
                const float wf = w2f[j * 1024 + c], wb = w2b[j * 1024 + c], wa = a2[j * 1024 + c];
#pragma unroll
                for (int q = 0; q < 4; ++q) {
                    const f32x4 xf = *(const LAS f32x4*)(LF + j * 16 + 4 * q), xb = *(const LAS f32x4*)(LB + j * 16 + 4 * q), xa = *(const LAS f32x4*)(LA + j * 16 + 4 * q);
#pragma unroll
                    for (int e = 0; e < 4; ++e) { af[4 * q + e] = fmaf(xf[e], wf, af[4 * q + e]); ab[4 * q + e] = fmaf(xb[e], wb, ab[4 * q + e]); aa[4 * q + e] = fmaf(xa[e], wa, aa[4 * q + e]); }
                }
            }
#pragma unroll 2
            for (int j = 0; j < 256; ++j) {
                const float wg = g2[j * 1024 + c];
#pragma unroll
                for (int q = 0; q < 4; ++q) { const f32x4 xg = *(const LAS f32x4*)(LG + j * 16 + 4 * q);
#pragma unroll
                    for (int e = 0; e < 4; ++e) ag[4 * q + e] = fmaf(xg[e], wg, ag[4 * q + e]); }
            }
            const float w0f = a.in[I_W0F][c], w0b = a.in[I_W0B][c], a0 = a.in[I_A0][c], kkc = a.in[I_KK][c], kac = a.in[I_KA][c];
#pragma unroll
            for (int row = 0; row < 16; ++row) {
                const int r = r0 + row;
                const float rr = shifted(P, r, R_R + c, mup, mun), rk = shifted(P, r, R_K + c, mup, mun), rv = shifted(P, r, R_V + c, mup, mun);
                const float lwf = -0.6065306597126334f * sigmoidf_(w0f + af[row]), lwb = -0.6065306597126334f * sigmoidf_(w0b + ab[row]);
                const float av = sigmoidf_(a0 + aa[row]);
                const float kkr = rk * kkc; const float ss = wave_sum(kkr * kkr); const float kk = kkr * __builtin_amdgcn_rsqf(ss + 1e-12f);
                const float km = rk * (1.0f + (av - 1.0f) * kac);
                bf16_t* o = RP + (size_t)r * 7168 + c;
                o[0] = (bf16_t)f2bf(rr); o[1024] = (bf16_t)f2bf(km); o[2048] = (bf16_t)f2bf(rv); o[3072] = (bf16_t)f2bf(kk); o[4096] = (bf16_t)f2bf(av); o[5120] = (bf16_t)f2bf(lwf); o[6144] = (bf16_t)f2bf(lwb);
                GOUT[(size_t)r * 1024 + c] = (bf16_t)f2bf(ag[row]);
            }
        }
    }
}

__device__ __forceinline__ void hgrn_out_row(const float* of, const float* ob, const bf16_t* proj0, const float* hn, bf16_t* mix, int r, int lane) {
    const int head = lane >> 3, part = lane & 7, cb = head * 128 + part * 16;
    float o[16]; float ss = 0.f;
#pragma unroll
    for (int q = 0; q < 4; ++q) { const f32x4 x = *(const f32x4*)(of + (size_t)r * 1024 + cb + 4 * q), y = *(const f32x4*)(ob + (size_t)r * 1024 + cb + 4 * q);
#pragma unroll
        for (int e = 0; e < 4; ++e) { o[4 * q + e] = x[e] + y[e]; ss += o[4 * q + e] * o[4 * q + e]; } }
    ss += __shfl_xor(ss, 1); ss += __shfl_xor(ss, 2); ss += __shfl_xor(ss, 4);
    const float rs = __builtin_amdgcn_rsqf(ss * (1.0f / 128.0f) + NORM_EPS);
    const u32x4 g0 = *(const u32x4*)(proj0 + (size_t)r * N0 + P0_GH + cb), g1 = *(const u32x4*)(proj0 + (size_t)r * N0 + P0_GH + cb + 8);
    float gh[16];
#pragma unroll
    for (int e = 0; e < 4; ++e) { gh[2 * e] = bflo(g0[e]); gh[2 * e + 1] = bfhi(g0[e]); gh[8 + 2 * e] = bflo(g1[e]); gh[8 + 2 * e + 1] = bfhi(g1[e]); }
    u32x4 w0, w1;
#pragma unroll
    for (int e = 0; e < 4; ++e) {
        const int v = part * 16 + 2 * e;
        w0[e] = pk2(o[2 * e] * rs * hn[v] * siluf_(gh[2 * e]), o[2 * e + 1] * rs * hn[v + 1] * siluf_(gh[2 * e + 1]));
        w1[e] = pk2(o[8 + 2 * e] * rs * hn[v + 8] * siluf_(gh[8 + 2 * e]), o[8 + 2 * e + 1] * rs * hn[v + 9] * siluf_(gh[8 + 2 * e + 1]));
    }
    bf16_t* op = mix + (size_t)r * D + 1024 + cb;
    *(u32x4*)op = w0; *(u32x4*)(op + 8) = w1;
}
__device__ __forceinline__ void l1_out_row(const Args& a, const float* gof, const float* gob, const float* rof, const float* rob, const bf16_t* proj1, const bf16_t* RP, const bf16_t* GOUT, bf16_t* mix1, int t, int lane) {
    const int r = t + CTXL;
    const float* gn = a.in[I_GLANORM];
#pragma unroll
    for (int head = 0; head < 4; ++head) {
        const int cb = head * 256 + 4 * lane;
        const f32x4 x = *(const f32x4*)(gof + (size_t)r * 1024 + cb), y = *(const f32x4*)(gob + (size_t)r * 1024 + cb);
        const f32x4 o = x + y; float ss = (o[0] * o[0] + o[1] * o[1]) + (o[2] * o[2] + o[3] * o[3]);
        ss = wave_sum(ss); const float rs = __builtin_amdgcn_rsqf(ss * (1.0f / 256.0f) + NORM_EPS);
        const u32x2 gr = *(const u32x2*)(proj1 + (size_t)r * N1 + G_GR + cb);
        const f32x4 g = *(const f32x4*)(gn + 4 * lane);
        u32x2 w; w.x = pk2(o[0] * rs * g[0] * siluf_(bflo(gr.x)), o[1] * rs * g[1] * siluf_(bfhi(gr.x))); w.y = pk2(o[2] * rs * g[2] * siluf_(bflo(gr.y)), o[3] * rs * g[3] * siluf_(bfhi(gr.y)));
        *(u32x2*)(mix1 + (size_t)t * D + cb) = w;
    }
    {
        const int head = lane >> 2, part = lane & 3, cb = head * 64 + part * 16;
        float o[16]; float sm = 0.f;
#pragma unroll
        for (int q = 0; q < 4; ++q) { const f32x4 x = *(const f32x4*)(rof + (size_t)r * 1024 + cb + 4 * q), y = *(const f32x4*)(rob + (size_t)r * 1024 + cb + 4 * q);
#pragma unroll
            for (int e = 0; e < 4; ++e) { o[4 * q + e] = x[e] + y[e]; sm += o[4 * q + e]; } }
        sm += __shfl_xor(sm, 1); sm += __shfl_xor(sm, 2); const float mu = sm * (1.0f / 64.0f);
        float sv = 0.f;
#pragma unroll
        for (int e = 0; e < 16; ++e) { const float d = o[e] - mu; sv += d * d; }
        sv += __shfl_xor(sv, 1); sv += __shfl_xor(sv, 2);
        const float rs = __builtin_amdgcn_rsqf(sv * (1.0f / 64.0f) + 64e-5f);
        const bf16_t* rp = RP + (size_t)r * 7168 + cb;
        float rr[16], km[16], vv[16], go[16];
#pragma unroll
        for (int h2 = 0; h2 < 2; ++h2) {
            const u32x4 a0 = *(const u32x4*)(rp + 8 * h2), a1 = *(const u32x4*)(rp + 1024 + 8 * h2), a2 = *(const u32x4*)(rp + 2048 + 8 * h2), a3 = *(const u32x4*)(GOUT + (size_t)r * 1024 + cb + 8 * h2);
#pragma unroll
            for (int e = 0; e < 4; ++e) { rr[8 * h2 + 2 * e] = bflo(a0[e]); rr[8 * h2 + 2 * e + 1] = bfhi(a0[e]); km[8 * h2 + 2 * e] = bflo(a1[e]); km[8 * h2 + 2 * e + 1] = bfhi(a1[e]);
                vv[8 * h2 + 2 * e] = bflo(a2[e]); vv[8 * h2 + 2 * e + 1] = bfhi(a2[e]); go[8 * h2 + 2 * e] = bflo(a3[e]); go[8 * h2 + 2 * e + 1] = bfhi(a3[e]); }
        }
        const float* rk = a.in[I_RK] + cb; const float* lw = a.in[I_LNW] + cb; const float* lbv = a.in[I_LNB] + cb;
        float bs = 0.f;
#pragma unroll
        for (int e = 0; e < 16; ++e) bs += rr[e] * km[e] * rk[e];
        bs += __shfl_xor(bs, 1); bs += __shfl_xor(bs, 2);
        u32x4 w0, w1;
        float res[16];
#pragma unroll
        for (int e = 0; e < 16; ++e) res[e] = (((o[e] - mu) * rs) * lw[e] + lbv[e] + bs * vv[e]) * go[e];
#pragma unroll
        for (int e = 0; e < 4; ++e) { w0[e] = pk2(res[2 * e], res[2 * e + 1]); w1[e] = pk2(res[8 + 2 * e], res[8 + 2 * e + 1]); }
        bf16_t* op = mix1 + (size_t)t * D + 1024 + cb;
        *(u32x4*)op = w0; *(u32x4*)(op + 8) = w1;
    }
}

__device__ __forceinline__ void moe_tables(LAS unsigned char* lds, const int* blkcnt, int tid) {
    LAS int* tab = (LAS int*)(lds + MOE_TAB_OFF); LAS int* pref = (LAS int*)(lds + PREF_OFF);
    __syncthreads();
    for (int i = tid; i < 2048; i += NTHR) pref[i] = blkcnt[i];
    __syncthreads();
    if (tid < 8) { int run = 0; for (int b = 0; b < 256; ++b) { const int cnt = pref[b * 8 + tid]; pref[b * 8 + tid] = run; run += cnt; } tab[tid] = run; }
    __syncthreads();
    if (tid == 0) { int off = 0, np = 0; for (int e = 0; e < 8; ++e) { tab[8 + e] = off; const int npe = (tab[e] + 255) >> 8; for (int p = 0; p < npe; ++p) tab[18 + np++] = e; off += npe * 256; } tab[16] = off; tab[17] = np; }
    __syncthreads();
}

constexpr int NPH = 20;
__global__ void __launch_bounds__(NTHR, 2) trunk_fwd(Args a) {
    extern __shared__ __attribute__((aligned(16))) unsigned char lds_raw[];
    LAS unsigned char* lds = (LAS unsigned char*)lds_raw;
    const int tid = threadIdx.x, lane = tid & 63, wave = __builtin_amdgcn_readfirstlane(tid >> 6);
    const int bx = blockIdx.x, G = gridDim.x, gw = bx * NWAVES + wave, NGW = G * NWAVES;
    unsigned char* ws = a.ws;
    for (int u = tid; u < (LDS_BYTES - MISC_OFF) / 4; u += NTHR) ((LAS unsigned*)(lds + MISC_OFF))[u] = 0u;
    __syncthreads();
    const int lo = a.ph_lo, hi = a.ph_hi;
    XcdBarrier bar; bar.bar = (unsigned*)(ws + WS_CTL) + CW_BAR; bar.x = 0; bar.st = (volatile LAS unsigned*)(lds + MISC_OFF);
    if (hi - lo > 1) bar = xcd_barrier_post((unsigned*)(ws + WS_CTL) + CW_BAR, (volatile LAS unsigned*)(lds + MISC_OFF));
#ifdef ONLY_PHASE
#define IN(k) ((k) == ONLY_PHASE && lo <= (k) && (k) < hi)
#else
#define IN(k) (lo <= (k) && (k) < hi)
#endif
#define SEAM(k) do { if (IN(k) && IN((k) + 1)) xcd_barrier(bar); } while (0)
#define MODP(l, vec, which) (mod + (size_t)(((l) * 2 + (vec)) * 6 + (which)) * 2048)
    const float* mod = (const float*)(ws + WS_MOD);
    bf16_t* H = (bf16_t*)(ws + WS_H);
    float* XC = (float*)(ws + WS_XC);
    float* out = a.out;
    const size_t TS2048 = (size_t)256 * 2048 * 2;

    if (IN(0)) { p0_prologue(a, lds, tid, lane, wave); }
    SEAM(0);
    if (IN(1)) {
        for (int r = gw; r < T; r += NGW) {
            const int vec = r < CTXL ? 1 : 0; const float* xin = vec ? a.in[I_CTX] + (size_t)r * D : a.in[I_X] + (size_t)(r - CTXL) * D;
            f32x4 v[8]; ldrow(xin, lane, v);
            mod_store(v, a.in[I_NMIXPRE0], MODP(0, vec, 1), MODP(0, vec, 0), H + (size_t)r * D, lane);
        }
    }
    SEAM(1);
    if (IN(2)) {
        pg8::SchedPlain S{(const char*)H, (const char*)(ws + W_IN0T), 65, 25, G, bx, TS2048, 65, (const char*)(ws + W_V0T), (const char*)H};
        pg8::EpiBf16 E{(bf16_t*)(ws + A_PROJ0), N0, (bf16_t*)(ws + A_VT), T};
        pg8::gemm_phase<pg8::EpiBf16, pg8::SchedPlain>(lds, 2048, S, E);
    }
    SEAM(2);
    if (IN(3)) {
        const float* ropetab = (const float*)(ws + WS_ROPE);
        for (int u = bx; u < 520; u += G) {
            const int kind = u < 512 ? 0 : 1, uu = u < 512 ? u : u - 512;
            attn_unit(lds, (const bf16_t*)(ws + A_PROJ0), (const bf16_t*)(ws + A_VT), (bf16_t*)(ws + A_MIX0), a.in[I_SINK], ropetab, kind, uu >> 1, uu & 1, tid);
        }
        __syncthreads();
        if (wave == 0 && bx < 32) hgrn_scan(lds, (const bf16_t*)(ws + A_PROJ0), a.in[I_LBL], (float*)(ws + A_OF), (float*)(ws + A_OB), bx, lane);
    }
    SEAM(3);
    if (IN(4)) {
        for (int r = gw; r < T; r += NGW) hgrn_out_row((const float*)(ws + A_OF), (const float*)(ws + A_OB), (const bf16_t*)(ws + A_PROJ0), a.in[I_HNORM], (bf16_t*)(ws + A_MIX0), r, lane);
    }
    SEAM(4);
    if (IN(5)) {
        pg8::SchedPlain S{(const char*)(ws + A_MIX0), (const char*)(ws + W_OUT0T), 65, 8, G, bx, TS2048, 0, nullptr, nullptr};
        pg8::EpiF32 E{(float*)(ws + A_Y0), 2048};
        pg8::gemm_phase<pg8::EpiF32, pg8::SchedPlain>(lds, 2048, S, E);
    }
    SEAM(5);
    if (IN(6)) {
        const float* Y0 = (const float*)(ws + A_Y0);
        for (int r = gw; r < T; r += NGW) {
            const int vec = r < CTXL ? 1 : 0; const float* xin = vec ? a.in[I_CTX] + (size_t)r * D : a.in[I_X] + (size_t)(r - CTXL) * D;
            float* xo = vec ? XC + (size_t)r * D : out + (size_t)(r - CTXL) * D;
            f32x4 v[8], b[8]; ldrow(xin, lane, v); ldrow(Y0 + (size_t)r * D, lane, b);
            add_branch(v, b, a.in[I_NMIXPOST0], MODP(0, vec, 2), lane); strow(xo, lane, v);
            mod_store(v, a.in[I_NFFNPRE0], MODP(0, vec, 4), MODP(0, vec, 3), H + (size_t)r * D, lane);
        }
    }
    SEAM(6);
    if (IN(7)) {
        pg8::SchedPlain S{(const char*)H, (const char*)(ws + W_GU0T), 65, 44, G, bx, TS2048, 0, nullptr, nullptr};
        pg8::EpiSwiglu E{(bf16_t*)(ws + A_HID0), FF0};
        pg8::gemm_phase<pg8::EpiSwiglu, pg8::SchedPlain>(lds, 2048, S, E);
    }
    SEAM(7);
    if (IN(8)) {
        pg8::SchedPlain S{(const char*)(ws + A_HID0), (const char*)(ws + W_DN0T), 65, 8, G, bx, (size_t)256 * FF0 * 2, 0, nullptr, nullptr};
        pg8::EpiF32 E{(float*)(ws + A_F0), 2048};
        pg8::gemm_phase<pg8::EpiF32, pg8::SchedPlain>(lds, FF0, S, E);
    }
    SEAM(8);
    if (IN(9)) {
        const float* F0 = (const float*)(ws + A_F0);
        for (int r = gw; r < T; r += NGW) {
            const int vec = r < CTXL ? 1 : 0; float* xo = vec ? XC + (size_t)r * D : out + (size_t)(r - CTXL) * D;
            f32x4 v[8], b[8]; ldrow(xo, lane, v); ldrow(F0 + (size_t)r * D, lane, b);
            add_branch(v, b, a.in[I_NFFNPOST0], MODP(0, vec, 5), lane); strow(xo, lane, v);
            mod_store(v, a.in[I_NMIXPRE1], MODP(1, vec, 1), MODP(1, vec, 0), H + (size_t)r * D, lane);
        }
    }
    SEAM(9);
    if (IN(10)) {
        pg8::SchedPlain S{(const char*)H, (const char*)(ws + W_IN1T), 65, 27, G, bx, TS2048, 0, nullptr, nullptr};
        pg8::EpiBf16 E{(bf16_t*)(ws + A_PROJ1), N1, nullptr, 0};
        pg8::gemm_phase<pg8::EpiBf16, pg8::SchedPlain>(lds, 2048, S, E);
    }
    SEAM(10);
    if (IN(11)) { rwkv_prep(a, lds, (const bf16_t*)(ws + A_PROJ1), (bf16_t*)(ws + A_RP), (bf16_t*)(ws + A_GOUT), tid); }
    SEAM(11);
    if (IN(12)) {
        if (wave == 0 && bx < 32) gla_scan(lds, (const bf16_t*)(ws + A_PROJ1), a.in[I_GUPF], a.in[I_GUPB], a.in[I_GBIASF], a.in[I_GBIASB], (float*)(ws + A_GOF), (float*)(ws + A_GOB), bx, lane);
        else if (wave == 0 && bx < 64) rwkv_scan(lds, (const bf16_t*)(ws + A_RP), (float*)(ws + A_ROF), (float*)(ws + A_ROB), bx - 32, lane);
    }
    SEAM(12);
    if (IN(13)) {
        for (int t = gw; t < SEQ; t += NGW)
            l1_out_row(a, (const float*)(ws + A_GOF), (const float*)(ws + A_GOB), (const float*)(ws + A_ROF), (const float*)(ws + A_ROB), (const bf16_t*)(ws + A_PROJ1), (const bf16_t*)(ws + A_RP), (const bf16_t*)(ws + A_GOUT), (bf16_t*)(ws + A_MIX1), t, lane);
    }
    SEAM(13);
    if (IN(14)) {
        pg8::SchedPlain S{(const char*)(ws + A_MIX1), (const char*)(ws + W_OUT1T), 64, 8, G, bx, TS2048, 0, nullptr, nullptr};
        pg8::EpiF32 E{(float*)(ws + A_Y1), 2048};
        pg8::gemm_phase<pg8::EpiF32, pg8::SchedPlain>(lds, 2048, S, E);
    }
    SEAM(14);
    int* tk_e = (int*)(ws + WS_TK); float* tk_w = (float*)(ws + WS_TK + 128 * 1024); int* tk_lr = (int*)(ws + WS_TK + 256 * 1024); int* tk_pos = (int*)(ws + WS_TK + 384 * 1024);
    int* blkcnt = (int*)(ws + WS_BLKCNT);
    if (IN(15)) {
        LAS int* ecnt = (LAS int*)(lds + ECNT_OFF);
        if (tid < 8) ecnt[tid] = 0;
        __syncthreads();
        const float* Y1 = (const float*)(ws + A_Y1); const float* router = a.in[I_ROUTER];
        for (int t = gw; t < SEQ; t += NGW) {
            f32x4 v[8], b[8]; ldrow(out + (size_t)t * D, lane, v); ldrow(Y1 + (size_t)t * D, lane, b);
            add_branch(v, b, a.in[I_NMIXPOST1], MODP(1, 0, 2), lane); strow(out + (size_t)t * D, lane, v);
            mod_store(v, a.in[I_NFFNPRE1], MODP(1, 0, 4), MODP(1, 0, 3), H + (size_t)t * D, lane);
            float lg[8];
#pragma unroll
            for (int e = 0; e < 8; ++e) lg[e] = 0.f;
#pragma unroll
            for (int j = 0; j < 8; ++j)
#pragma unroll
                for (int q = 0; q < 4; ++q) { const float* rp = router + (size_t)(4 * lane + 256 * j + q) * 8; const f32x4 r0 = *(const f32x4*)rp, r1 = *(const f32x4*)(rp + 4); const float hv = v[j][q];
                    lg[0] = fmaf(hv, r0[0], lg[0]); lg[1] = fmaf(hv, r0[1], lg[1]); lg[2] = fmaf(hv, r0[2], lg[2]); lg[3] = fmaf(hv, r0[3], lg[3]);
                    lg[4] = fmaf(hv, r1[0], lg[4]); lg[5] = fmaf(hv, r1[1], lg[5]); lg[6] = fmaf(hv, r1[2], lg[6]); lg[7] = fmaf(hv, r1[3], lg[7]); }
#pragma unroll
            for (int e = 0; e < 8; ++e) lg[e] = wave_sum(lg[e]);
            int ea = 0; float va = lg[0];
#pragma unroll
            for (int e = 1; e < 8; ++e) if (lg[e] > va) { va = lg[e]; ea = e; }
            int eb = -1; float vb = -INFINITY;
#pragma unroll
            for (int e = 0; e < 8; ++e) if (e != ea && lg[e] > vb) { vb = lg[e]; eb = e; }
            if (eb < 0) eb = (ea + 1) & 7;
            const float wa = 1.0f / (1.0f + fexp(vb - va)), wb = 1.0f - wa;
            if (lane == 0) {
                const int la = __hip_atomic_fetch_add(ecnt + ea, 1, __ATOMIC_RELAXED, __HIP_MEMORY_SCOPE_WORKGROUP);
                const int lb = __hip_atomic_fetch_add(ecnt + eb, 1, __ATOMIC_RELAXED, __HIP_MEMORY_SCOPE_WORKGROUP);
                tk_e[2 * t] = ea; tk_e[2 * t + 1] = eb; tk_w[2 * t] = wa; tk_w[2 * t + 1] = wb; tk_lr[2 * t] = la; tk_lr[2 * t + 1] = lb;
            }
        }
        __syncthreads();
        if (tid < 8) blkcnt[bx * 8 + tid] = ecnt[tid];
    }
    SEAM(15);
    if (IN(16)) {
        moe_tables(lds, blkcnt, tid);
        const LAS int* tab = (const LAS int*)(lds + MOE_TAB_OFF); const LAS int* pref = (const LAS int*)(lds + PREF_OFF);
        bf16_t* SORT = (bf16_t*)(ws + A_SORT);
        for (int t = gw; t < SEQ; t += NGW) {
            const int b = (t % NGW) / NWAVES;
#pragma unroll
            for (int sl = 0; sl < 2; ++sl) {
                const int e = tk_e[2 * t + sl], lr = tk_lr[2 * t + sl];
                const int pos = tab[8 + e] + pref[b * 8 + e] + lr;
                if (lane == 0) tk_pos[2 * t + sl] = pos;
                const u32x4* src = (const u32x4*)(H + (size_t)t * D); u32x4* dst = (u32x4*)(SORT + (size_t)pos * D);
#pragma unroll
                for (int j = 0; j < 4; ++j) dst[lane + 64 * j] = src[lane + 64 * j];
            }
        }
    }
    SEAM(16);
    if (IN(17)) {
        moe_tables(lds, blkcnt, tid);
        const LAS int* tab = (const LAS int*)(lds + MOE_TAB_OFF);
        pg8::SchedMoe S{(const char*)(ws + A_SORT), (const char*)(ws + W_MGUT), (size_t)14336 * 2048 * 2, tab[17], 56, G, bx, TS2048, tab + 18};
        pg8::EpiSwiglu E{(bf16_t*)(ws + A_HID1), FFE};
        pg8::gemm_phase<pg8::EpiSwiglu, pg8::SchedMoe>(lds, 2048, S, E);
    }
    SEAM(17);
    if (IN(18)) {
        moe_tables(lds, blkcnt, tid);
        const LAS int* tab = (const LAS int*)(lds + MOE_TAB_OFF);
        pg8::SchedMoe S{(const char*)(ws + A_HID1), (const char*)(ws + W_MDNT), (size_t)2048 * FFE * 2, tab[17], 8, G, bx, (size_t)256 * FFE * 2, tab + 18};
        pg8::EpiBf16 E{(bf16_t*)(ws + A_YDN), 2048, nullptr, 0};
        pg8::gemm_phase<pg8::EpiBf16, pg8::SchedMoe>(lds, FFE, S, E);
    }
    SEAM(18);
    if (IN(19)) {
        const bf16_t* YDN = (const bf16_t*)(ws + A_YDN);
        for (int t = gw; t < SEQ; t += NGW) {
            f32x4 v[8], b[8]; ldrow(out + (size_t)t * D, lane, v);
            const int pa = tk_pos[2 * t], pb = tk_pos[2 * t + 1]; const float wa = tk_w[2 * t], wb = tk_w[2 * t + 1];
#pragma unroll
            for (int j = 0; j < 8; ++j) { const u32x2 ya = *(const u32x2*)(YDN + (size_t)pa * D + 4 * lane + 256 * j), yb = *(const u32x2*)(YDN + (size_t)pb * D + 4 * lane + 256 * j);
                b[j] = (f32x4){wa * bflo(ya.x) + wb * bflo(yb.x), wa * bfhi(ya.x) + wb * bfhi(yb.x), wa * bflo(ya.y) + wb * bflo(yb.y), wa * bfhi(ya.y) + wb * bfhi(yb.y)}; }
            add_branch(v, b, a.in[I_NFFNPOST1], MODP(1, 0, 5), lane); strow(out + (size_t)t * D, lane, v);
        }
    }
#undef IN
#undef SEAM
#undef MODP
}

extern "C" void kernel_launch(void* const* d_in, const int* in_sizes, int n_in, void* d_out, int out_size, void* d_ws, size_t ws_size, hipStream_t stream) {
    static int state = 0;
    if (state == 0) {
        state = -1;
        if (n_in != 49 || out_size != SEQ * D || ws_size < WS_END) { fprintf(stderr, "kernel_launch: unexpected shapes (n_in %d, out %d, ws %zu, need %zu)\n", n_in, out_size, ws_size, (size_t)WS_END); return; }
        if (hipFuncSetAttribute((const void*)trunk_fwd, hipFuncAttributeMaxDynamicSharedMemorySize, LDS_BYTES) != hipSuccess) { fprintf(stderr, "kernel_launch: hipFuncSetAttribute failed\n"); return; }
        int per_cu = 0; (void)hipOccupancyMaxActiveBlocksPerMultiprocessor(&per_cu, (const void*)trunk_fwd, NTHR, LDS_BYTES); (void)hipGetLastError();
        if (per_cu < 1) fprintf(stderr, "kernel_launch: occupancy query says %d\n", per_cu);
        state = 1;
    }
    if (state < 0) return;
    (void)hipMemsetAsync((char*)d_ws + WS_CTL, 0, CTL_ZERO_BYTES, stream);
    Args a{};
    for (int i = 0; i < 49; ++i) a.in[i] = (const float*)d_in[i];
    a.out = (float*)d_out; a.ws = (unsigned char*)d_ws;
    const int grid = 256;
#if N_LAUNCH_MODE == 0
    for (int ph = 0; ph < NPH; ++ph) { a.ph_lo = ph; a.ph_hi = ph + 1; hipLaunchKernelGGL(trunk_fwd, dim3(grid), dim3(NTHR), LDS_BYTES, stream, a); }
#else
    a.ph_lo = 0; a.ph_hi = NPH; hipLaunchKernelGGL(trunk_fwd, dim3(grid), dim3(NTHR), LDS_BYTES, stream, a);
#endif
}
```

```cpp
#include <hip/hip_runtime.h>
#include <cstdio>
#include <cstdint>

#define LAS __attribute__((address_space(3)))
#define GAS __attribute__((address_space(1)))
typedef unsigned short bf16_t;
typedef short bf16x8 __attribute__((ext_vector_type(8)));
typedef float f32x4 __attribute__((ext_vector_type(4)));
typedef float f32x2 __attribute__((ext_vector_type(2)));
typedef float f32x16 __attribute__((ext_vector_type(16)));
typedef unsigned u32x4 __attribute__((ext_vector_type(4)));
typedef unsigned u32x2 __attribute__((ext_vector_type(2)));

#ifndef REPMASK
#define REPMASK 0u
#endif
#ifndef N_LAUNCH_MODE
#define N_LAUNCH_MODE 1
#endif

constexpr int D = 2048, SEQ = 16384, CTXL = 256, T = SEQ + CTXL;
constexpr int NWAVES = 8, NTHR = 512;
constexpr float NORM_EPS = 1e-6f;
constexpr int N0 = 5376, P0_QA = 0, P0_KA = 1024, P0_QH = 1280, P0_FF = 2304, P0_FB = 3328, P0_GH = 4352;
constexpr int VT_ROWS = 1280;
constexpr int N1 = 5888, G_Q = 0, G_K = 512, G_GDF = 1024, G_GDB = 1040, G_GR = 1056;
constexpr int R_R = 2080, R_K = 3104, R_V = 4128, R_WDF = 5152, R_WDB = 5248, R_AD = 5344, R_GD = 5440;
constexpr int FF0 = 5632, FFE = 7168, NE = 8;
constexpr int MOE_ROWS = 2 * SEQ + NE * 256;
constexpr int MOE_MAXPAN = MOE_ROWS / 256;
constexpr int NCHUNK = T / 32;

constexpr size_t MiB = (size_t)1 << 20;
constexpr size_t WS_CTL = 0, CTL_ZERO_BYTES = 1 * MiB;
constexpr size_t WS_MOD = 1 * MiB;
constexpr size_t WS_ROPE = WS_MOD + 256 * 1024;
constexpr size_t WS_BLKCNT = WS_ROPE + 128 * 1024;
constexpr size_t WS_TK = 2 * MiB;
constexpr size_t WS_XC = 4 * MiB;
constexpr size_t WS_LORA = 6 * MiB;
constexpr size_t WS_QS0 = WS_LORA + 1280 * 1024;
constexpr size_t WS_QSM = WS_QS0 + 64 * 1024;
constexpr size_t WS_QI0 = WS_TK + 512 * 1024;
constexpr size_t WS_QV0 = WS_QI0 + 32 * 1024;
constexpr size_t WS_QI1 = WS_QV0 + 8 * 1024;
constexpr size_t WS_QG1 = WS_QI1 + 32 * 1024;
constexpr size_t WS_LB = WS_QG1 + 8 * 1024;
constexpr size_t WS_HSC = WS_TK + 1024 * 1024;
constexpr size_t WS_SSC = WS_HSC + 128 * 1024;
constexpr size_t WS_W = 8 * MiB;
constexpr size_t W_IN0T = WS_W;
constexpr size_t W_V0T = W_IN0T + 21 * MiB;
constexpr size_t W_OUT0T = W_V0T + 5 * MiB;
constexpr size_t W_GU0T = W_OUT0T + 8 * MiB;
constexpr size_t W_DN0T = W_GU0T + 44 * MiB;
constexpr size_t W_IN1T = W_DN0T + 22 * MiB;
constexpr size_t W_GV1T = W_IN1T + 23 * MiB;
constexpr size_t W_OUT1T = W_GV1T + 4 * MiB;
constexpr size_t W_MGUT = W_OUT1T + 8 * MiB;
constexpr size_t W_MDNT = W_MGUT + 448 * MiB;
constexpr size_t WS_LORA4 = W_GU0T + 22 * MiB;
constexpr size_t WS_XB = W_MGUT + 224 * MiB;
constexpr size_t WS_H = W_MDNT + 224 * MiB;
constexpr size_t WS_A = WS_H + 66 * MiB;
constexpr size_t A_PROJ0 = WS_A;
constexpr size_t A_VT = WS_A + 171 * MiB;
constexpr size_t A_MIX0 = WS_A + 212 * MiB;
constexpr size_t A_KVT0 = WS_A + 277 * MiB;
constexpr size_t A_DEC0 = WS_A + 537 * MiB;
constexpr size_t A_Y0 = WS_A + 542 * MiB;
constexpr size_t A_PY0 = WS_A + 672 * MiB;
constexpr size_t A_PF0 = WS_A + 690 * MiB;
constexpr size_t A_HID0 = WS_A;
constexpr size_t A_F0 = WS_A + 179 * MiB;
static_assert(A_HID0 + (size_t)T * FF0 * 2 <= A_F0 && A_F0 + (size_t)T * 2048 * 4 <= A_Y0, "layer-0 overlays");
constexpr size_t A_PROJ1 = WS_A;
constexpr size_t A_GVT = WS_A + 187 * MiB;
constexpr size_t A_RP = WS_A + 220 * MiB;
constexpr size_t A_KVT1 = WS_A + 448 * MiB;
constexpr size_t A_DEC1 = WS_A + 708 * MiB;
constexpr size_t A_MF = WS_A + 711 * MiB;
constexpr size_t A_XL = A_MF;
constexpr size_t A_NB = WS_A + 841 * MiB;
constexpr size_t A_MIX1 = WS_A + 971 * MiB;
constexpr size_t A_QB = W_IN0T;
constexpr size_t A_GOUT = W_IN0T + 65 * MiB;
constexpr size_t A_OB = WS_H;
constexpr size_t A_Y1 = WS_A;
constexpr size_t A_SORT = WS_A + 128 * MiB;
constexpr size_t A_HID1 = WS_A + 264 * MiB;
constexpr size_t A_YDN = WS_A + 740 * MiB;
constexpr size_t A_PYD = WS_A + 880 * MiB;
constexpr size_t WS_END = WS_A + 1035 * MiB;
static_assert(A_YDN + (size_t)MOE_ROWS * 2048 * 2 <= A_PYD && A_PYD + (size_t)32 * 256 * 2048 * 4 <= A_MIX1, "moe partials");
static_assert(A_SORT + (size_t)MOE_ROWS * 2048 * 2 <= A_HID1 && A_HID1 + (size_t)MOE_ROWS * FFE * 2 <= A_YDN && A_YDN + (size_t)MOE_ROWS * 2048 * 2 <= A_MIX1, "moe overlay");
static_assert(A_PROJ1 + (size_t)T * N1 * 2 <= A_GVT && A_GVT + (size_t)1024 * T * 2 <= A_RP && A_RP + (size_t)T * 7168 * 2 <= A_KVT1 && A_KVT1 + (size_t)2 * 4 * 520 * 256 * 128 * 2 <= A_DEC1, "layer-1 map");
static_assert(A_MF + (size_t)2 * 16 * 520 * 8192 <= A_NB && A_NB + (size_t)2 * 16 * 520 * 8192 <= A_MIX1 && A_MIX1 + (size_t)SEQ * 2048 * 2 <= WS_END, "layer-1 map 2");
static_assert(A_GOUT + (size_t)T * 1024 * 2 <= W_OUT1T && A_QB + (size_t)2 * T * 1024 * 2 <= A_GOUT && A_OB + (size_t)2 * 16 * 520 * 4096 <= WS_A, "overlays on dead weights / h");
static_assert(A_PROJ0 + (size_t)T * N0 * 2 <= A_VT && A_VT + (size_t)VT_ROWS * T * 2 <= A_MIX0 && A_KVT0 + (size_t)2 * 8 * 520 * 128 * 128 * 2 <= A_DEC0, "layer-0 map");
constexpr int CW_BAR = 4096;

constexpr int LDS_BYTES = 147456;
constexpr int MISC_OFF = 135168;
constexpr int MOE_TAB_OFF = MISC_OFF + 64, ECNT_OFF = MISC_OFF + 1024, PREF_OFF = MISC_OFF + 2048;

__device__ __forceinline__ float bf2f(unsigned b) { return __uint_as_float(b << 16); }
__device__ __forceinline__ float bflo(unsigned w) { return __uint_as_float(w << 16); }
__device__ __forceinline__ float bfhi(unsigned w) { return __uint_as_float(w & 0xffff0000u); }
typedef __bf16 bf16x2_t __attribute__((ext_vector_type(2)));
__device__ __forceinline__ unsigned pk2(float lo, float hi) { const f32x2 v = {lo, hi}; const bf16x2_t b = __builtin_convertvector(v, bf16x2_t); return __builtin_bit_cast(unsigned, b); }
__device__ __forceinline__ unsigned f2bf(float f) { return pk2(f, 0.f) & 0xffffu; }
__device__ __forceinline__ float wave_sum(float v) {
#pragma unroll
    for (int o = 1; o < 64; o <<= 1) v += __shfl_xor(v, o);
    return v;
}
__device__ __forceinline__ float fexp2(float x) { return __builtin_amdgcn_exp2f(x); }
__device__ __forceinline__ float fexp(float x) { return __builtin_amdgcn_exp2f(x * 1.4426950408889634f); }
__device__ __forceinline__ float sigmoidf_(float x) { return __builtin_amdgcn_rcpf(1.0f + fexp(-x)); }
__device__ __forceinline__ float siluf_(float x) { return x * __builtin_amdgcn_rcpf(1.0f + fexp(-x)); }
__device__ __forceinline__ float tanhf_(float x) { return 1.0f - 2.0f * __builtin_amdgcn_rcpf(1.0f + fexp(2.0f * x)); }
#define LDS_WAIT() asm volatile("s_waitcnt lgkmcnt(0)" ::: "memory")
#define VM_WAIT() asm volatile("s_waitcnt vmcnt(0)" ::: "memory")

#define XB_TMO      128
#define XB_XCNT(j)  (256  + 64 * (j))
#define XB_XSUB(j)  (1280 + 64 * (j))
#define XB_XGEN(j)  (2304 + 64 * (j))
#define XB_TOP      3328
#define XB_TOPGEN   3392
#define XCD_BAR_WORDS 3456
#define XB_SPIN_CAP (1u << 24)
__device__ __forceinline__ unsigned xb_ld(unsigned* p)              { return __hip_atomic_load(p, __ATOMIC_RELAXED, __HIP_MEMORY_SCOPE_AGENT); }
__device__ __forceinline__ unsigned xb_add(unsigned* p, unsigned v) { return __hip_atomic_fetch_add(p, v, __ATOMIC_RELAXED, __HIP_MEMORY_SCOPE_AGENT); }
__device__ __forceinline__ unsigned xb_xcc_id() { return (unsigned)__builtin_amdgcn_s_getreg((3 << 11) | 20) & 0xFu; }
#define XB_SPIN(cond, bar) do { unsigned _sp = 0; while (cond) { __builtin_amdgcn_s_sleep(1); \
    if ((++_sp & 255u) == 0u) { if (xb_ld(&(bar)[XB_TMO])) break; if (_sp > XB_SPIN_CAP) { atomicAdd(&(bar)[XB_TMO], 1u); break; } } } } while (0)
struct XcdBarrier { unsigned* bar; unsigned x; volatile LAS unsigned* st; };
__device__ __forceinline__ XcdBarrier xcd_barrier_post(unsigned* bar, volatile LAS unsigned* st) {
    XcdBarrier b; b.bar = bar; b.x = xb_xcc_id(); b.st = st;
    if (threadIdx.x == 0) (void)xb_add(&bar[XB_XCNT(b.x)], 1u);
    return b;
}
__device__ __forceinline__ void xcd_barrier_complete(unsigned* bar, unsigned x, unsigned& nloc, unsigned& nx) {
    const unsigned G = gridDim.x * gridDim.y * gridDim.z;
    unsigned sum, cnt, mine, sp = 0u;
    for (;;) {
        sum = 0u; cnt = 0u; mine = 0u;
#pragma unroll
        for (unsigned j = 0; j < 16; ++j) { const unsigned c = xb_ld(&bar[XB_XCNT(j)]); sum += c; cnt += (c > 0u) ? 1u : 0u; mine = (j == x) ? c : mine; }
        if (sum == G) break;
        __builtin_amdgcn_s_sleep(1);
        if ((++sp & 255u) == 0u) { if (xb_ld(&bar[XB_TMO])) break; if (sp > XB_SPIN_CAP) { atomicAdd(&bar[XB_TMO], 1u); break; } }
    }
    nloc = mine > 0u ? mine : 1u; nx = cnt > 0u ? cnt : 1u;
}
__device__ __forceinline__ void xcd_barrier(const XcdBarrier& b) {
    asm volatile("s_waitcnt vmcnt(0)" ::: "memory");
    __syncthreads();
    if (threadIdx.x == 0) {
        unsigned* bar = b.bar;
        __builtin_amdgcn_s_waitcnt(0);
        unsigned nloc = b.st[0], nx = b.st[1];
        if (nloc == 0u) { xcd_barrier_complete(bar, b.x, nloc, nx); b.st[0] = nloc; b.st[1] = nx; }
        const unsigned old = xb_add(&bar[XB_XSUB(b.x)], 1u);
        const unsigned gen = old / nloc;
        if (old + 1u == (gen + 1u) * nloc) {
            __builtin_amdgcn_fence(__ATOMIC_RELEASE, "agent");
            asm volatile("s_waitcnt vmcnt(0)" ::: "memory");
            const unsigned og = xb_add(&bar[XB_TOP], 1u);
            const unsigned tg = og / nx;
            if (og + 1u == (tg + 1u) * nx) xb_add(&bar[XB_TOPGEN], 1u);
            else XB_SPIN(xb_ld(&bar[XB_TOPGEN]) == tg, bar);
            __builtin_amdgcn_fence(__ATOMIC_ACQUIRE, "agent");
            xb_add(&bar[XB_XGEN(b.x)], 1u);
            asm volatile("s_waitcnt vmcnt(0)" ::: "memory");
        } else {
            XB_SPIN(xb_ld(&bar[XB_XGEN(b.x)]) == gen, bar);
            __builtin_amdgcn_fence(__ATOMIC_ACQUIRE, "agent");
            asm volatile("s_waitcnt vmcnt(0)" ::: "memory");
        }
    }
    __syncthreads();
}

namespace pg8 {
constexpr int BM = 256, BK = 64, HALF = 128, HTB = HALF * BK * 2, STAGE_BYTES = 8 * HTB, NXCD = 8, WGM = 8;
__host__ __device__ __forceinline__ int lds_byte(int r, int c) { const int st = (r >> 4) * 2 + (c >> 5), rr = r & 15, cc = c & 31, ob = rr * 64 + cc * 2; return st * 1024 + (ob ^ (((ob >> 9) & 1) << 5)); }
__host__ __device__ __forceinline__ void stage_rc(int b, int& R, int& C) { const int st = b / 1024, sb = b % 1024, swz = sb ^ (((sb >> 9) & 1) << 5); R = (st >> 1) * 16 + swz / 64; C = (st & 1) * 32 + (swz % 64) / 2; }
__host__ __device__ __forceinline__ int perm32(int rho) { const int n = rho >> 4, i = rho & 15; return 8 * (i >> 2) + 4 * n + (i & 3); }

struct Unit { int pm, pn; const char* a; const char* b; int aux; };

__device__ __forceinline__ void order_map(int wgid, int nM, int nN, int& pm, int& pn) {
    const int nwg = nM * nN;
    { const int q = nwg / NXCD, r = nwg % NXCD, xcd = wgid % NXCD, off = wgid / NXCD; wgid = (xcd < r ? xcd * (q + 1) : r * (q + 1) + (xcd - r) * q) + off; }
    const int nig = WGM * nN, gid = wgid / nig, fm = gid * WGM, gsz = (nM - fm) < WGM ? (nM - fm) : WGM;
    pm = fm + ((wgid % nig) % gsz); pn = (wgid % nig) / gsz;
}
struct SchedPlain {
    const char* A; const char* Bt; int nM, nN, G, c; size_t tstep; int nextra; const char* A2; const char* B2; int nN2; int pm0;
    __device__ __forceinline__ bool next(int i, Unit& u) const {
        const long L = (long)i * G + c; const int nwg = nM * nN;
        if (L >= nwg + nextra) return false;
        if (L >= nwg) { const int j = (int)L - nwg, pm2 = j / nN2, pn2 = j - pm2 * nN2; u.pm = pm2; u.pn = pn2; u.a = A2 + (size_t)pm2 * tstep; u.b = B2 + (size_t)pn2 * tstep; u.aux = 1; return true; }
        int pm, pn; order_map((int)L, nM, nN, pm, pn);
        u.pm = pm + pm0; u.pn = pn; u.a = A + (size_t)(pm + pm0) * tstep; u.b = Bt + (size_t)pn * tstep; u.aux = 0; return true;
    }
};
struct SchedSplit {
    const char* A; const char* Bt; int nN, nsplit, G, c; size_t tstep, kslice;
    __device__ __forceinline__ bool next(int i, Unit& u) const {
        const long L = (long)i * G + c; if (L >= (long)nN * nsplit) return false;
        const int pn = (int)L % nN, ks = (int)L / nN;
        u.pm = 0; u.pn = pn; u.a = A + (size_t)ks * kslice; u.b = Bt + (size_t)pn * tstep + (size_t)ks * kslice; u.aux = ks; return true;
    }
};
struct SchedMoe {
    const char* A; const char* Wt; size_t wstride; int nM, nN, G, c; size_t tstep; const LAS int* pexp;
    __device__ __forceinline__ bool next(int i, Unit& u) const {
        const long L = (long)i * G + c; const int nwg = nM * nN;
        if (L >= nwg) return false;
        int pm, pn; order_map((int)L, nM, nN, pm, pn);
        const int e = pexp[pm];
        u.pm = pm; u.pn = pn; u.a = A + (size_t)pm * tstep; u.b = Wt + (size_t)e * wstride + (size_t)pn * tstep; u.aux = e; return true;
    }
};

struct SchedLora {
    const char* X; const char* Wt; size_t plane; int G, c;
    __device__ __forceinline__ bool next(int i, Unit& u) const {
        const long L = (long)i * G + c; if (L >= 65 * 16) return false;
        int pm, pn; order_map((int)L, 65, 16, pm, pn);
        u.pm = pm; u.pn = pn; u.a = X + (size_t)(pn >> 2) * plane + (size_t)pm * 131072; u.b = Wt + (size_t)pn * 131072; u.aux = pn >> 2; return true;
    }
};
struct SchedMoeDown {
    const char* A; const char* Wt; size_t wstride; int nunits, G, c; size_t tstep; const LAS int* pexp; int split, rem, nfull; size_t kslice;
    __device__ __forceinline__ bool next(int i, Unit& u) const {
        const long L = (long)i * G + c; int Lb = 0, ks = 0;
        int pm, pn;
        if (split == 0) { if (L >= nunits) return false; order_map((int)L, nunits >> 3, 8, pm, pn); }
        else { if (L >= (long)rem * split) return false; Lb = nfull + (int)(L % rem); ks = (int)(L / rem); pm = Lb >> 3; pn = Lb & 7; }
        const int e = pexp[pm];
        u.pm = pm; u.pn = pn; u.a = A + (size_t)pm * tstep + (size_t)ks * kslice; u.b = Wt + (size_t)e * wstride + (size_t)pn * tstep + (size_t)ks * kslice;
        u.aux = split == 0 ? -1 : ((pm - (nfull >> 3)) * split + ks); return true;
    }
};
__device__ __forceinline__ unsigned cvt_pk_bf16(float lo, float hi) { unsigned r; asm volatile("v_cvt_pk_bf16_f32 %0, %1, %2" : "=v"(r) : "v"(lo), "v"(hi)); return r; }
struct EpiBf16 {
    static constexpr bool PERM = true;
    struct Pre {}; __device__ __forceinline__ void prefetch(const Unit&, int, int, int, int, Pre&) const {}
    bf16_t* O; int ldc; bf16_t* O1; int ldc1;
    __device__ __forceinline__ void operator()(const f32x4 (&acc)[2][2][4][2], const Unit& u, int wr, int wc, int fr, int fq, const Pre&) const {
        bf16_t* base = (u.aux == 1 && O1) ? O1 : O; const int ld = (u.aux == 1 && O1) ? ldc1 : ldc;
        const int row0 = u.pm * BM + wr * 64 + fr, col0 = u.pn * BM + wc * 32 + 8 * fq;
#pragma unroll
        for (int ai = 0; ai < 2; ++ai)
#pragma unroll
            for (int m = 0; m < 4; ++m) { bf16_t* rowp = base + (size_t)(row0 + ai * HALF + m * 16) * ld + col0;
#pragma unroll
                for (int bj = 0; bj < 2; ++bj) { const f32x4 v0 = acc[ai][bj][m][0], v1 = acc[ai][bj][m][1];
                    u32x4 w; w.x = cvt_pk_bf16(v0[0], v0[1]); w.y = cvt_pk_bf16(v0[2], v0[3]); w.z = cvt_pk_bf16(v1[0], v1[1]); w.w = cvt_pk_bf16(v1[2], v1[3]);
                    *(u32x4*)(rowp + bj * HALF) = w; } }
    }
};
struct EpiLora {
    static constexpr bool PERM = true;
    struct Pre {}; __device__ __forceinline__ void prefetch(const Unit&, int, int, int, int, Pre&) const {}
    bf16_t* RP; long gdelta; const float* bias3;
    __device__ __forceinline__ void operator()(const f32x4 (&acc)[2][2][4][2], const Unit& u, int wr, int wc, int fr, int fq, const Pre&) const {
        const int kind = u.aux, row0 = u.pm * BM + wr * 64 + fr, ch0 = (u.pn & 3) * BM + wc * 32 + 8 * fq;
        const float* bias = bias3 + (kind < 3 ? kind : 0) * 1024;
        const long poff = kind == 3 ? gdelta : (kind == 0 ? 5120 : (kind == 1 ? 6144 : 4096)); const int ld = kind == 3 ? 1024 : 7168;
        bf16_t* base = RP + poff;
        const float sc = kind < 2 ? -0.6065306597126334f : 1.0f;
        f32x4 bv[2][2];
#pragma unroll
        for (int bj = 0; bj < 2; ++bj)
#pragma unroll
            for (int n = 0; n < 2; ++n) { bv[bj][n] = *(const f32x4*)(bias + ch0 + bj * HALF + 4 * n); if (kind == 3) bv[bj][n] = (f32x4){0.f, 0.f, 0.f, 0.f}; }
#pragma unroll
        for (int ai = 0; ai < 2; ++ai)
#pragma unroll
            for (int m = 0; m < 4; ++m) { bf16_t* rowp = base + (size_t)(row0 + ai * HALF + m * 16) * ld + ch0;
#pragma unroll
                for (int bj = 0; bj < 2; ++bj) { f32x4 v0 = acc[ai][bj][m][0] + bv[bj][0], v1 = acc[ai][bj][m][1] + bv[bj][1];
                    if (kind != 3) {
#pragma unroll
                        for (int j = 0; j < 4; ++j) { v0[j] = sc * __builtin_amdgcn_rcpf(1.0f + __builtin_amdgcn_exp2f(-1.4426950408889634f * v0[j])); v1[j] = sc * __builtin_amdgcn_rcpf(1.0f + __builtin_amdgcn_exp2f(-1.4426950408889634f * v1[j])); } }
                    u32x4 w; w.x = cvt_pk_bf16(v0[0], v0[1]); w.y = cvt_pk_bf16(v0[2], v0[3]); w.z = cvt_pk_bf16(v1[0], v1[1]); w.w = cvt_pk_bf16(v1[2], v1[3]);
                    *(u32x4*)(rowp + bj * HALF) = w; } }
    }
};
struct EpiMoeDown {
    static constexpr bool PERM = true;
    struct Pre {}; __device__ __forceinline__ void prefetch(const Unit&, int, int, int, int, Pre&) const {}
    bf16_t* O; float* P;
    __device__ __forceinline__ void operator()(const f32x4 (&acc)[2][2][4][2], const Unit& u, int wr, int wc, int fr, int fq, const Pre&) const {
        const int rin0 = wr * 64 + fr, col0 = u.pn * BM + wc * 32 + 8 * fq;
        if (u.aux < 0) {
            bf16_t* base = O + (size_t)(u.pm * BM + rin0) * 2048 + col0;
#pragma unroll
            for (int ai = 0; ai < 2; ++ai)
#pragma unroll
                for (int m = 0; m < 4; ++m) { bf16_t* rowp = base + (size_t)(ai * HALF + m * 16) * 2048;
#pragma unroll
                    for (int bj = 0; bj < 2; ++bj) { const f32x4 v0 = acc[ai][bj][m][0], v1 = acc[ai][bj][m][1];
                        u32x4 w; w.x = cvt_pk_bf16(v0[0], v0[1]); w.y = cvt_pk_bf16(v0[2], v0[3]); w.z = cvt_pk_bf16(v1[0], v1[1]); w.w = cvt_pk_bf16(v1[2], v1[3]);
                        *(u32x4*)(rowp + bj * HALF) = w; } }
        } else {
            float* base = P + ((size_t)u.aux * 256 + rin0) * 2048 + col0;
#pragma unroll
            for (int ai = 0; ai < 2; ++ai)
#pragma unroll
                for (int m = 0; m < 4; ++m) { float* rowp = base + (size_t)(ai * HALF + m * 16) * 2048;
#pragma unroll
                    for (int bj = 0; bj < 2; ++bj) { *(f32x4*)(rowp + bj * HALF) = acc[ai][bj][m][0]; *(f32x4*)(rowp + bj * HALF + 4) = acc[ai][bj][m][1]; } }
        }
    }
};
struct EpiF32 {
    static constexpr bool PERM = false;
    struct Pre {}; __device__ __forceinline__ void prefetch(const Unit&, int, int, int, int, Pre&) const {}
    float* C; int ldc; size_t astride;
    __device__ __forceinline__ void operator()(const f32x4 (&acc)[2][2][4][2], const Unit& u, int wr, int wc, int fr, int fq, const Pre&) const {
        const int row0 = u.pm * BM + wr * 64 + fr, col0 = u.pn * BM + wc * 32 + 4 * fq; float* C = this->C + (size_t)u.aux * astride;
#pragma unroll
        for (int ai = 0; ai < 2; ++ai)
#pragma unroll
            for (int m = 0; m < 4; ++m) { float* rowp = C + (size_t)(row0 + ai * HALF + m * 16) * ldc + col0;
#pragma unroll
                for (int bj = 0; bj < 2; ++bj)
#pragma unroll
                    for (int n = 0; n < 2; ++n) *(f32x4*)(rowp + bj * HALF + n * 16) = acc[ai][bj][m][n]; }
    }
};
struct EpiSwiglu {
    static constexpr bool PERM = true;
    struct Pre {}; __device__ __forceinline__ void prefetch(const Unit&, int, int, int, int, Pre&) const {}
    bf16_t* O; int ldc;
    __device__ __forceinline__ void operator()(const f32x4 (&acc)[2][2][4][2], const Unit& u, int wr, int wc, int fr, int fq, const Pre&) const {
        const int row0 = u.pm * BM + wr * 64 + fr, col0 = u.pn * HALF + wc * 32 + 8 * fq;
#pragma unroll
        for (int ai = 0; ai < 2; ++ai)
#pragma unroll
            for (int m = 0; m < 4; ++m) { bf16_t* rowp = O + (size_t)(row0 + ai * HALF + m * 16) * ldc + col0;
                float o[8];
#pragma unroll
                for (int n = 0; n < 2; ++n)
#pragma unroll
                    for (int j = 0; j < 4; ++j) { const float g = acc[ai][0][m][n][j], up = acc[ai][1][m][n][j];
                        o[n * 4 + j] = g * up * __builtin_amdgcn_rcpf(1.0f + __builtin_amdgcn_exp2f(-1.4426950408889634f * g)); }
                u32x4 w; w.x = cvt_pk_bf16(o[0], o[1]); w.y = cvt_pk_bf16(o[2], o[3]); w.z = cvt_pk_bf16(o[4], o[5]); w.w = cvt_pk_bf16(o[6], o[7]);
                *(u32x4*)rowp = w; }
    }
};

typedef int i32x4 __attribute__((ext_vector_type(4)));
struct EpiBf16I8 {
    static constexpr bool PERM = true;
    bf16_t* O; int ldc; bf16_t* O1; int ldc1; const float* sr0; const float* sc0; const float* sr1; const float* sc1;
    struct Pre { float rsv[2]; float csv; };
    __device__ __forceinline__ void prefetch(const Unit& u, int wr, int wc, int fr, int fq, Pre& p) const {
        const bool x = (u.aux == 1 && O1); const float* sr = x ? sr1 : sr0; const float* sc = x ? sc1 : sc0; const int lane = fr + 16 * fq;
        p.rsv[0] = sr[u.pm * BM + wr * 64 + lane]; p.rsv[1] = sr[u.pm * BM + HALF + wr * 64 + lane];
        p.csv = sc[u.pn * BM + wc * 32 + (lane & 31) + (lane >> 5) * HALF];
    }
    __device__ __forceinline__ void operator()(const i32x4 (&acc)[2][2][4][2], const Unit& u, int wr, int wc, int fr, int fq, const Pre& p) const {
        const bool x = (u.aux == 1 && O1);
        bf16_t* base = x ? O1 : O; const int ld = x ? ldc1 : ldc;
        const int row0 = u.pm * BM + wr * 64 + fr, col0 = u.pn * BM + wc * 32 + 8 * fq;
        f32x4 cs[2][2];
#pragma unroll
        for (int bj = 0; bj < 2; ++bj)
#pragma unroll
            for (int n = 0; n < 2; ++n)
#pragma unroll
                for (int j = 0; j < 4; ++j) cs[bj][n][j] = __shfl(p.csv, 32 * bj + 8 * fq + 4 * n + j);
#pragma unroll
        for (int ai = 0; ai < 2; ++ai)
#pragma unroll
            for (int m = 0; m < 4; ++m) { const int r = row0 + ai * HALF + m * 16; const float rs = __shfl(p.rsv[ai], m * 16 + fr); bf16_t* rowp = base + (size_t)r * ld + col0;
#pragma unroll
                for (int bj = 0; bj < 2; ++bj) { const i32x4 a0 = acc[ai][bj][m][0], a1 = acc[ai][bj][m][1]; const f32x4 c0 = cs[bj][0] * rs, c1 = cs[bj][1] * rs;
                    u32x4 w; w.x = cvt_pk_bf16((float)a0[0] * c0[0], (float)a0[1] * c0[1]); w.y = cvt_pk_bf16((float)a0[2] * c0[2], (float)a0[3] * c0[3]);
                    w.z = cvt_pk_bf16((float)a1[0] * c1[0], (float)a1[1] * c1[1]); w.w = cvt_pk_bf16((float)a1[2] * c1[2], (float)a1[3] * c1[3]);
                    *(u32x4*)(rowp + bj * HALF) = w; } }
    }
};
struct EpiSwigluI8 {
    static constexpr bool PERM = true;
    bf16_t* O; int ldc; const float* sa; const float* sb; size_t sb_estride;
    struct Pre { float rsv[2]; float csv; };
    __device__ __forceinline__ void prefetch(const Unit& u, int wr, int wc, int fr, int fq, Pre& p) const {
        const int lane = fr + 16 * fq;
        p.rsv[0] = sa[u.pm * BM + wr * 64 + lane]; p.rsv[1] = sa[u.pm * BM + HALF + wr * 64 + lane];
        p.csv = sb[(size_t)u.aux * sb_estride + u.pn * BM + wc * 32 + (lane & 31) + (lane >> 5) * HALF];
    }
    __device__ __forceinline__ void operator()(const i32x4 (&acc)[2][2][4][2], const Unit& u, int wr, int wc, int fr, int fq, const Pre& p) const {
        const int row0 = u.pm * BM + wr * 64 + fr, col0 = u.pn * HALF + wc * 32 + 8 * fq;
        f32x4 sg[2], su[2];
#pragma unroll
        for (int n = 0; n < 2; ++n)
#pragma unroll
            for (int j = 0; j < 4; ++j) { sg[n][j] = __shfl(p.csv, 8 * fq + 4 * n + j); su[n][j] = __shfl(p.csv, 32 + 8 * fq + 4 * n + j); }
#pragma unroll
        for (int ai = 0; ai < 2; ++ai)
#pragma unroll
            for (int m = 0; m < 4; ++m) { const int r = row0 + ai * HALF + m * 16; const float sar = __shfl(p.rsv[ai], m * 16 + fr); bf16_t* rowp = O + (size_t)r * ldc + col0;
                float o[8];
#pragma unroll
                for (int n = 0; n < 2; ++n)
#pragma unroll
                    for (int j = 0; j < 4; ++j) { const float g = (float)acc[ai][0][m][n][j] * (sar * sg[n][j]), up = (float)acc[ai][1][m][n][j] * (sar * su[n][j]);
                        o[n * 4 + j] = g * up * __builtin_amdgcn_rcpf(1.0f + __builtin_amdgcn_exp2f(-1.4426950408889634f * g)); }
                u32x4 w; w.x = cvt_pk_bf16(o[0], o[1]); w.y = cvt_pk_bf16(o[2], o[3]); w.z = cvt_pk_bf16(o[4], o[5]); w.w = cvt_pk_bf16(o[6], o[7]);
                *(u32x4*)rowp = w; }
    }
};
template <bool I8> struct MM;
template <> struct MM<false> { typedef f32x4 acc_t; static __device__ __forceinline__ acc_t zero() { return (f32x4){0.f, 0.f, 0.f, 0.f}; }
    static __device__ __forceinline__ acc_t mma(const bf16x8& b, const bf16x8& a, const acc_t& c) { return __builtin_amdgcn_mfma_f32_16x16x32_bf16(b, a, c, 0, 0, 0); } };
template <> struct MM<true> { typedef i32x4 acc_t; static __device__ __forceinline__ acc_t zero() { return (i32x4){0, 0, 0, 0}; }
    static __device__ __forceinline__ acc_t mma(const bf16x8& b, const bf16x8& a, const acc_t& c) { return __builtin_amdgcn_mfma_i32_16x16x64_i8(__builtin_bit_cast(i32x4, b), __builtin_bit_cast(i32x4, a), c, 0, 0, 0); } };
template <class Epi, class Sched, bool I8 = false, bool ALIGN_EPI = true, bool SP2 = true>
__device__ __forceinline__ void gemm_phase(LAS unsigned char* lds, const int Kb, const Sched& S, const Epi& E, const int Kloop = 0) {
    typedef typename MM<I8>::acc_t acc_t;
    const int tid = threadIdx.x, wid = __builtin_amdgcn_readfirstlane(tid >> 6), lane = tid & 63, wr = wid >> 2, wc = wid & 3, fr = lane & 15, fq = lane >> 4;
    const int nt = (Kloop ? Kloop : Kb) / 128;
    unsigned voffA[2], voffB[2];
#pragma unroll
    for (int i = 0; i < 2; ++i) { int R, C; stage_rc(tid * 16 + i * 8192, R, C); const int Rb = Epi::PERM ? ((R & ~31) + perm32(R & 31)) : R;
        voffA[i] = (unsigned)(R * Kb + C * 2); voffB[i] = (unsigned)(Rb * Kb + C * 2); }
    const size_t kstep = (size_t)(BK * 2);
    const size_t hstep = (size_t)HALF * Kb;
    const unsigned ldsw = (unsigned)wid * 1024u;
    const int aoff = lds_byte(wr * 64 + fr, fq * 8), boff = lds_byte(wc * 32 + fr, fq * 8);
#define PG8_SA(b, h) (((b) * 2 + (h)) * HTB)
#define PG8_SB(b, h) ((4 + (b) * 2 + (h)) * HTB)
#define PG8_STAGE(bufoff, gbase, voff) do { _Pragma("unroll") for (int _i = 0; _i < 2; ++_i) \
        __builtin_amdgcn_global_load_lds((const unsigned*)((const char*)(gbase) + (voff)[_i]), (LAS unsigned*)(lds + (bufoff) + ldsw + _i * 8192), 16, 0, 0); } while (0)
#define PG8_LDA(dst, b, h) do { _Pragma("unroll") for (int m = 0; m < 4; ++m) _Pragma("unroll") for (int k = 0; k < 2; ++k) dst[m][k] = *(const LAS bf16x8*)(lds + PG8_SA(b, h) + aoff + m * 2048 + k * 1024); } while (0)
#define PG8_LDB(dst, b, h) do { _Pragma("unroll") for (int n = 0; n < 2; ++n) _Pragma("unroll") for (int k = 0; k < 2; ++k) dst[n][k] = *(const LAS bf16x8*)(lds + PG8_SB(b, h) + boff + n * 2048 + k * 1024); } while (0)
#define PG8_MMA(ai, bj, At, Bt) do { __builtin_amdgcn_s_setprio(1); _Pragma("unroll") for (int m = 0; m < 4; ++m) _Pragma("unroll") for (int n = 0; n < 2; ++n) _Pragma("unroll") for (int k = 0; k < 2; ++k) \
        acc[ai][bj][m][n] = MM<I8>::mma(Bt[n][k], At[m][k], acc[ai][bj][m][n]); __builtin_amdgcn_s_setprio(0); } while (0)
#define PG8_WAIT_V(n) asm volatile("s_waitcnt vmcnt(" #n ")" ::: "memory")
#define PG8_WAIT_L(n) asm volatile("s_waitcnt lgkmcnt(" #n ")" ::: "memory")
#define PG8_BAR __builtin_amdgcn_s_barrier()
#define PG8_SCHED __builtin_amdgcn_sched_barrier(0)
    Unit cur, nxt; int ui = 0;
    if (!S.next(0, cur)) return;
    acc_t acc[2][2][4][2]; typename Epi::Pre pre;
#pragma unroll
    for (int a = 0; a < 2; ++a)
#pragma unroll
        for (int b = 0; b < 2; ++b)
#pragma unroll
            for (int m = 0; m < 4; ++m)
#pragma unroll
                for (int n = 0; n < 2; ++n) acc[a][b][m][n] = MM<I8>::zero();
    bf16x8 At[4][2], B0[2][2], B1[2][2];
    const char* cA = cur.a; const char* cB = cur.b;
    if constexpr (SP2) {
        PG8_STAGE(PG8_SB(0, 0), cB, voffB); PG8_STAGE(PG8_SB(0, 1), cB + hstep, voffB); PG8_STAGE(PG8_SA(0, 0), cA, voffA); PG8_STAGE(PG8_SA(0, 1), cA + hstep, voffA);
        if (wr == 1) PG8_BAR;
        PG8_WAIT_V(2); PG8_BAR;
        PG8_STAGE(PG8_SB(1, 0), cB + kstep, voffB); PG8_STAGE(PG8_SA(1, 0), cA + kstep, voffA); PG8_STAGE(PG8_SB(1, 1), cB + hstep + kstep, voffB);
        PG8_WAIT_V(6); PG8_BAR;
    } else {
        PG8_STAGE(PG8_SB(0, 0), cB, voffB); PG8_STAGE(PG8_SA(0, 0), cA, voffA); PG8_STAGE(PG8_SB(0, 1), cB + hstep, voffB); PG8_STAGE(PG8_SA(0, 1), cA + hstep, voffA);
        if (wr == 1) PG8_BAR;
        PG8_WAIT_V(4); PG8_BAR;
        PG8_STAGE(PG8_SB(1, 0), cB + kstep, voffB); PG8_STAGE(PG8_SA(1, 0), cA + kstep, voffA); PG8_STAGE(PG8_SB(1, 1), cB + hstep + kstep, voffB);
        PG8_WAIT_V(6); PG8_BAR;
    }
    for (;;) {
        const bool has_next = S.next(ui + 1, nxt);
        const char* nA = has_next ? nxt.a : cA; const char* nB = has_next ? nxt.b : cB;
        for (int t = 0; t < nt; t += 2) {
            const bool last = (t == nt - 2);
            if (last) E.prefetch(cur, wr, wc, fr, fq, pre);
            const char* a1 = cA + (size_t)(t + 1) * kstep;
            const char* a2 = last ? nA : cA + (size_t)(t + 2) * kstep; const char* b2 = last ? nB : cB + (size_t)(t + 2) * kstep;
            const char* a3 = a2 + kstep; const char* b3 = b2 + kstep;
            if constexpr (SP2) {
            PG8_LDB(B0, 0, 0); PG8_LDB(B1, 0, 1); PG8_SCHED; PG8_LDA(At, 0, 0); PG8_STAGE(PG8_SA(1, 1), a1 + hstep, voffA);
            PG8_WAIT_V(8); PG8_WAIT_L(0); PG8_BAR; PG8_MMA(0, 0, At, B0); PG8_MMA(0, 1, At, B1); PG8_BAR; PG8_SCHED;
            PG8_LDA(At, 0, 1); PG8_STAGE(PG8_SB(0, 0), b2, voffB); PG8_STAGE(PG8_SB(0, 1), b2 + hstep, voffB); PG8_STAGE(PG8_SA(0, 0), a2, voffA);
            PG8_WAIT_V(8); PG8_WAIT_L(0); PG8_BAR; PG8_MMA(1, 0, At, B0); PG8_MMA(1, 1, At, B1); PG8_BAR; PG8_SCHED;
            PG8_LDB(B0, 1, 0); PG8_LDB(B1, 1, 1); PG8_SCHED; PG8_LDA(At, 1, 0); PG8_STAGE(PG8_SA(0, 1), a2 + hstep, voffA);
            PG8_WAIT_V(8); PG8_WAIT_L(0); PG8_BAR; PG8_MMA(0, 0, At, B0); PG8_MMA(0, 1, At, B1); PG8_BAR; PG8_SCHED;
            PG8_LDA(At, 1, 1); PG8_STAGE(PG8_SB(1, 0), b3, voffB); PG8_STAGE(PG8_SB(1, 1), b3 + hstep, voffB); PG8_STAGE(PG8_SA(1, 0), a3, voffA);
            PG8_WAIT_V(8); PG8_WAIT_L(0); PG8_BAR; PG8_MMA(1, 0, At, B0); PG8_MMA(1, 1, At, B1); PG8_BAR; PG8_SCHED;
            } else {
            PG8_LDB(B0, 0, 0); PG8_SCHED; PG8_LDA(At, 0, 0); PG8_STAGE(PG8_SA(1, 1), a1 + hstep, voffA);
            PG8_WAIT_L(8); PG8_BAR; PG8_WAIT_L(0); PG8_MMA(0, 0, At, B0); PG8_BAR; PG8_SCHED;
            PG8_LDB(B1, 0, 1); PG8_STAGE(PG8_SB(0, 0), b2, voffB);
            PG8_BAR; PG8_WAIT_L(0); PG8_MMA(0, 1, At, B1); PG8_BAR;
            PG8_LDA(At, 0, 1); PG8_STAGE(PG8_SA(0, 0), a2, voffA);
            PG8_BAR; PG8_WAIT_L(0); PG8_MMA(1, 0, At, B0); PG8_BAR; PG8_SCHED;
            PG8_STAGE(PG8_SB(0, 1), b2 + hstep, voffB);
            PG8_WAIT_V(6); PG8_BAR; PG8_MMA(1, 1, At, B1); PG8_BAR;
            PG8_LDB(B0, 1, 0); PG8_SCHED; PG8_LDA(At, 1, 0); PG8_STAGE(PG8_SA(0, 1), a2 + hstep, voffA);
            PG8_WAIT_L(8); PG8_BAR; PG8_WAIT_L(0); PG8_MMA(0, 0, At, B0); PG8_BAR; PG8_SCHED;
            PG8_LDB(B1, 1, 1); PG8_STAGE(PG8_SB(1, 0), b3, voffB);
            PG8_BAR; PG8_WAIT_L(0); PG8_MMA(0, 1, At, B1); PG8_BAR;
            PG8_LDA(At, 1, 1); PG8_STAGE(PG8_SA(1, 0), a3, voffA);
            PG8_BAR; PG8_WAIT_L(0); PG8_MMA(1, 0, At, B0); PG8_BAR; PG8_SCHED;
            PG8_STAGE(PG8_SB(1, 1), b3 + hstep, voffB);
            PG8_WAIT_V(6); PG8_BAR; PG8_MMA(1, 1, At, B1); PG8_BAR;
            }
        }
        if constexpr (ALIGN_EPI) { if (wr == 0) PG8_BAR; }
        E(acc, cur, wr, wc, fr, fq, pre);
        if constexpr ((REPMASK >> 28) & 1u) E(acc, cur, wr, wc, fr, fq, pre);
        if (!has_next) break;
#pragma unroll
        for (int a = 0; a < 2; ++a)
#pragma unroll
            for (int b = 0; b < 2; ++b)
#pragma unroll
                for (int m = 0; m < 4; ++m)
#pragma unroll
                    for (int n = 0; n < 2; ++n) acc[a][b][m][n] = MM<I8>::zero();
        cur = nxt; cA = nA; cB = nB; ++ui;
        if constexpr (ALIGN_EPI) { if (wr == 1) PG8_BAR; }
    }
    PG8_WAIT_V(0);
    if constexpr (!ALIGN_EPI) { if (wr == 0) PG8_BAR; }
    PG8_BAR;
#undef PG8_SA
#undef PG8_SB
#undef PG8_STAGE
#undef PG8_LDA
#undef PG8_LDB
#undef PG8_MMA
#undef PG8_WAIT_V
#undef PG8_WAIT_L
#undef PG8_BAR
#undef PG8_SCHED
}
}

struct Args { const float* in[49]; float* out; unsigned char* ws; int ph_lo, ph_hi; };
enum { I_X = 0, I_C, I_CTX, I_CCTX, I_LBL, I_ADAW0, I_ADAB0, I_NMIXPRE0, I_NMIXPOST0, I_NFFNPRE0, I_NFFNPOST0, I_WIN0, I_WOUT0, I_SINK, I_HNORM, I_FG0, I_FU0, I_FD0,
       I_ADAW1, I_ADAB1, I_NMIXPRE1, I_NMIXPOST1, I_NFFNPRE1, I_NFFNPOST1, I_WIN1, I_WOUT1, I_GUPF, I_GUPB, I_GBIASF, I_GBIASB, I_GLANORM, I_MUPREV, I_MUNEXT, I_W0F, I_W0B, I_W2F, I_W2B,
       I_A0, I_A2, I_G2, I_KK, I_KA, I_RK, I_LNW, I_LNB, I_ROUTER, I_MG, I_MU, I_MD };

__device__ __forceinline__ void tr_item(const float* W, int K, int ld, int ncol0, bf16_t* WT, int drow0, int mode, int nblk, LAS float* scr, int item, int lane) {
    const int kb = item / nblk, nb = item - kb * nblk, k0 = 64 * kb, n0 = ncol0 + 32 * nb;
    int drow; if (mode == 0) drow = drow0 + 32 * nb; else { const int cc = 32 * nb; drow = (cc >> 7) * 256 + (cc & 127) + (mode == 2 ? 128 : 0); }
#pragma unroll 8
    for (int i = 0; i < 32; ++i) { const int kk = 2 * i + (lane >> 5); scr[kk * 33 + (lane & 31)] = __builtin_nontemporal_load(W + (size_t)(k0 + kk) * ld + n0 + (lane & 31)); }
    LDS_WAIT();
    const int c = lane & 7;
#pragma unroll
    for (int j = 0; j < 4; ++j) { const int n = (lane >> 3) + 8 * j; const LAS float* s = scr + (8 * c) * 33 + n;
        u32x4 o; o.x = pk2(s[0 * 33], s[1 * 33]); o.y = pk2(s[2 * 33], s[3 * 33]); o.z = pk2(s[4 * 33], s[5 * 33]); o.w = pk2(s[6 * 33], s[7 * 33]);
        *(u32x4*)(WT + (size_t)(drow + n) * K + k0 + 8 * c) = o; }
    LDS_WAIT();
}

constexpr int Q8_PITCH = 4100;
__device__ __forceinline__ void q8_strip(const float* W, int ld, int ncol0, signed char* dst, float* sdst, int drow0, LAS unsigned char* lds, int tid) {
    LAS unsigned* cmax = (LAS unsigned*)(lds + 32 * Q8_PITCH);
    const int lane = tid & 63, wave = tid >> 6;
    __syncthreads();
    if (tid < 32) cmax[tid] = 0u;
    __syncthreads();
    const int n4 = tid & 7, kr = tid >> 3;
    float mx[4] = {0.f, 0.f, 0.f, 0.f};
#pragma unroll 4
    for (int it = 0; it < 32; ++it) { const int k = it * 64 + kr; const f32x4 v = __builtin_nontemporal_load((const f32x4*)(W + (size_t)k * ld + ncol0 + 4 * n4));
#pragma unroll
        for (int e = 0; e < 4; ++e) { mx[e] = fmaxf(mx[e], fabsf(v[e])); *(LAS bf16_t*)(lds + (4 * n4 + e) * Q8_PITCH + k * 2) = (bf16_t)f2bf(v[e]); } }
#pragma unroll
    for (int e = 0; e < 4; ++e) __hip_atomic_fetch_max(cmax + 4 * n4 + e, __float_as_uint(mx[e]), __ATOMIC_RELAXED, __HIP_MEMORY_SCOPE_WORKGROUP);
    __syncthreads();
#pragma unroll 1
    for (int q = 0; q < 4; ++q) {
        const int n = 4 * wave + q; const float m = __uint_as_float(cmax[n]); const float inv = m > 0.f ? 127.0f / m : 0.f;
        const LAS unsigned* src = (const LAS unsigned*)(lds + n * Q8_PITCH + lane * 64);
        u32x4 o0, o1;
#pragma unroll
        for (int d = 0; d < 8; ++d) { const unsigned w0 = src[2 * d], w1 = src[2 * d + 1];
            const int q0 = (int)__builtin_rintf(bflo(w0) * inv), q1 = (int)__builtin_rintf(bfhi(w0) * inv), q2 = (int)__builtin_rintf(bflo(w1) * inv), q3 = (int)__builtin_rintf(bfhi(w1) * inv);
            const unsigned pk = (unsigned)(q0 & 0xff) | ((unsigned)(q1 & 0xff) << 8) | ((unsigned)(q2 & 0xff) << 16) | ((unsigned)(q3 & 0xff) << 24);
            if (d < 4) o0[d] = pk; else o1[d - 4] = pk; }
        u32x4* dp = (u32x4*)(dst + (size_t)(drow0 + n) * 2048 + 32 * lane);
        dp[0] = o0; dp[1] = o1;
        if (lane == 0) sdst[drow0 + n] = m > 0.f ? m * (1.0f / 127.0f) : 1.0f;
    }
}

__device__ __forceinline__ void p0_prologue(const Args& a, LAS unsigned char* lds, int tid, int lane, int wave) {
    unsigned char* ws = a.ws;
    const int G = gridDim.x, bx = blockIdx.x;
    {
        LAS float* sc = (LAS float*)lds;
        LAS float* red = (LAS float*)(lds + 16384);
        for (int i = tid; i < 2 * D; i += NTHR) { const float v = (i < D) ? a.in[I_C][i] : a.in[I_CCTX][i - D]; sc[i] = siluf_(v); }
        __syncthreads();
        float* mod = (float*)(ws + WS_MOD);
        for (int it = bx; it < 384; it += G) {
            const int l = it / 192, cg = it % 192; const float* W = a.in[l ? I_ADAW1 : I_ADAW0]; const float* B = a.in[l ? I_ADAB1 : I_ADAB0];
            const int col = cg * 64 + lane; float a0 = 0.f, a1 = 0.f;
            const float* wp = W + (size_t)(wave * 256) * 12288 + col;
#pragma unroll 8
            for (int k = 0; k < 256; ++k) { const float w = __builtin_nontemporal_load(wp + (size_t)k * 12288); a0 = fmaf(sc[wave * 256 + k], w, a0); a1 = fmaf(sc[D + wave * 256 + k], w, a1); }
            red[(wave * 2 + 0) * 64 + lane] = a0; red[(wave * 2 + 1) * 64 + lane] = a1;
            __syncthreads();
            if (wave < 2) { float s = 0.f;
#pragma unroll
                for (int w = 0; w < 8; ++w) s += red[(w * 2 + wave) * 64 + lane];
                mod[(size_t)(l * 2 + wave) * 12288 + col] = s + B[col]; }
            __syncthreads();
        }
    }
    {
        float* tab = (float*)(ws + WS_ROPE);
        const int gi = bx * NTHR + tid;
        if (gi < 320 * 32) { const int pos = gi >> 5, f = gi & 31; const int p = pos < 256 ? pos : pos - 256;
            const float inv = exp2f(-(float)f * (13.287712379549449f / 32.0f));
            const float ang = (float)p * inv; float sn, cs; sincosf(ang, &sn, &cs);
            tab[2 * gi] = cs; tab[2 * gi + 1] = sn; }
    }
    {
        bf16_t* wt = (bf16_t*)(ws + WS_LORA4);
        { float* lb = (float*)(ws + WS_LB); const int e = bx * NTHR + tid; if (e < 3072) lb[e] = e < 1024 ? a.in[I_W0F][e] : (e < 2048 ? a.in[I_W0B][e - 1024] : a.in[I_A0][e - 2048]); }
        for (int e = bx * NTHR + tid; e < 4 * 256 * 1024; e += G * NTHR) {
            const int m = e >> 18, kk = (e >> 10) & 255, n = e & 1023; float v = 0.f;
            if (m == 3) v = a.in[I_G2][kk * 1024 + n];
            else if (kk < 96) v = a.in[m == 0 ? I_W2F : (m == 1 ? I_W2B : I_A2)][kk * 1024 + n];
            wt[((size_t)m * 1024 + n) * 256 + kk] = (bf16_t)f2bf(v);
        }
    }
    {
        LAS float* scr = (LAS float*)(lds + wave * 16384);
        const int gw = bx * NWAVES + wave, NGW = G * NWAVES;
        constexpr int S3 = 32 * 64, S6 = 88 * 64, S8 = 32 * 64, SD = 112 * 64;
        constexpr int NIT = S3 + S6 + S8 + 8 * SD;
        for (int it = gw; it < NIT; it += NGW) {
            int r = it;
            if (r < S3) { tr_item(a.in[I_WOUT0], 2048, 2048, 0, (bf16_t*)(ws + W_OUT0T), 0, 0, 64, scr, r, lane); continue; } r -= S3;
            if (r < S6) { tr_item(a.in[I_FD0], 5632, 2048, 0, (bf16_t*)(ws + W_DN0T), 0, 0, 64, scr, r, lane); continue; } r -= S6;
            if (r < S8) { tr_item(a.in[I_WOUT1], 2048, 2048, 0, (bf16_t*)(ws + W_OUT1T), 0, 0, 64, scr, r, lane); continue; } r -= S8;
            { const int e = r / SD; tr_item(a.in[I_MD] + (size_t)e * 7168 * 2048, 7168, 2048, 0, (bf16_t*)(ws + W_MDNT) + (size_t)e * 2048 * 7168, 0, 0, 64, scr, r - e * SD, lane); }
        }
    }
    {
        constexpr int NS0 = 176, NSE = 224, NI0 = 208, NI1 = 210, NITEM = 2 * NS0 + 16 * NSE + NI0 + NI1;
        for (int it = bx; it < NITEM; it += G) {
            int r = it; const float* W; int ld, cc, up; signed char* dst; float* sd;
            if (r >= 2 * NS0 + 16 * NSE) {
                r -= 2 * NS0 + 16 * NSE; int drow;
                if (r < NI0) { cc = 32 * r; W = a.in[I_WIN0]; ld = 6656;
                    if (cc < 1280) { dst = (signed char*)(ws + W_IN0T); sd = (float*)(ws + WS_QI0); drow = cc; }
                    else if (cc < 1536) { dst = (signed char*)(ws + W_V0T); sd = (float*)(ws + WS_QV0); drow = cc - 1280; }
                    else if (cc < 2560) { dst = (signed char*)(ws + W_IN0T); sd = (float*)(ws + WS_QI0); drow = cc - 1536 + 1280; }
                    else if (cc < 3584) { dst = (signed char*)(ws + W_V0T); sd = (float*)(ws + WS_QV0); drow = cc - 2560 + 256; }
                    else { dst = (signed char*)(ws + W_IN0T); sd = (float*)(ws + WS_QI0); drow = cc - 3584 + 2304; } }
                else { cc = 32 * (r - NI0); W = a.in[I_WIN1]; ld = 6720;
                    if (cc < 1024) { dst = (signed char*)(ws + W_IN1T); sd = (float*)(ws + WS_QI1); drow = cc; }
                    else if (cc < 2048) { dst = (signed char*)(ws + W_GV1T); sd = (float*)(ws + WS_QG1); drow = cc - 1024; }
                    else { dst = (signed char*)(ws + W_IN1T); sd = (float*)(ws + WS_QI1); drow = cc - 2048 + 1024; } }
                q8_strip(W, ld, cc, dst, sd, drow, lds, tid);
                continue;
            }
            if (r < 2 * NS0) { up = r / NS0; cc = 32 * (r - up * NS0); W = a.in[up ? I_FU0 : I_FG0]; ld = 5632; dst = (signed char*)(ws + W_GU0T); sd = (float*)(ws + WS_QS0); }
            else { r -= 2 * NS0; const int e = r / (2 * NSE); r -= e * 2 * NSE; up = r / NSE; cc = 32 * (r - up * NSE); W = a.in[up ? I_MU : I_MG] + (size_t)e * 2048 * 7168; ld = 7168;
                   dst = (signed char*)(ws + W_MGUT) + (size_t)e * 14336 * 2048; sd = (float*)(ws + WS_QSM) + (size_t)e * 14336; }
            q8_strip(W, ld, cc, dst, sd, (cc >> 7) * 256 + (cc & 127) + (up ? 128 : 0), lds, tid);
        }
    }
}

__device__ __forceinline__ f32x4 ldp(const float* p, int lane, int j) { return *(const f32x4*)(p + 4 * lane + 256 * j); }
__device__ __forceinline__ void ldrow(const float* p, int lane, f32x4 (&v)[8]) {
#pragma unroll
    for (int j = 0; j < 8; ++j) v[j] = ldp(p, lane, j);
}
__device__ __forceinline__ void ldrow_bf(const bf16_t* p, int lane, f32x4 (&v)[8]) {
#pragma unroll
    for (int j = 0; j < 8; ++j) { const u32x2 y = *(const u32x2*)(p + 4 * lane + 256 * j); v[j] = (f32x4){bflo(y.x), bfhi(y.x), bflo(y.y), bfhi(y.y)}; }
}
__device__ __forceinline__ float rms_scale(const f32x4 (&v)[8]) {
    float s = 0.f;
#pragma unroll
    for (int j = 0; j < 8; ++j) s += (v[j][0] * v[j][0] + v[j][1] * v[j][1]) + (v[j][2] * v[j][2] + v[j][3] * v[j][3]);
    return __builtin_amdgcn_rsqf(wave_sum(s) * (1.0f / D) + NORM_EPS);
}
__device__ __forceinline__ void mod_store(f32x4 (&v)[8], const float* gpre, const float* sc, const float* sh, bf16_t* hrow, int lane) {
    const float rs = rms_scale(v);
#pragma unroll
    for (int j = 0; j < 8; ++j) { const f32x4 g = ldp(gpre, lane, j), s = ldp(sc, lane, j), b = ldp(sh, lane, j);
        v[j] = v[j] * rs * g * (s + 1.0f) + b;
        u32x2 w; w.x = pk2(v[j][0], v[j][1]); w.y = pk2(v[j][2], v[j][3]); *(u32x2*)(hrow + 4 * lane + 256 * j) = w; }
}
__device__ __forceinline__ void mod_store_i8(f32x4 (&v)[8], const float* gpre, const float* sc, const float* sh, signed char* hrow, float* scale_out, int lane) {
    const float rs = rms_scale(v); float mx = 0.f;
#pragma unroll
    for (int j = 0; j < 8; ++j) { const f32x4 g = ldp(gpre, lane, j), s = ldp(sc, lane, j), b = ldp(sh, lane, j);
        v[j] = v[j] * rs * g * (s + 1.0f) + b;
        mx = fmaxf(fmaxf(mx, fmaxf(fabsf(v[j][0]), fabsf(v[j][1]))), fmaxf(fabsf(v[j][2]), fabsf(v[j][3]))); }
#pragma unroll
    for (int o = 1; o < 64; o <<= 1) mx = fmaxf(mx, __shfl_xor(mx, o));
    const float inv = mx > 0.f ? 127.0f / mx : 0.f;
#pragma unroll
    for (int j = 0; j < 8; ++j) { const int q0 = (int)__builtin_rintf(v[j][0] * inv), q1 = (int)__builtin_rintf(v[j][1] * inv), q2 = (int)__builtin_rintf(v[j][2] * inv), q3 = (int)__builtin_rintf(v[j][3] * inv);
        *(unsigned*)(hrow + 4 * lane + 256 * j) = (unsigned)(q0 & 0xff) | ((unsigned)(q1 & 0xff) << 8) | ((unsigned)(q2 & 0xff) << 16) | ((unsigned)(q3 & 0xff) << 24); }
    if (lane == 0) *scale_out = mx > 0.f ? mx * (1.0f / 127.0f) : 1.0f;
}
__device__ __forceinline__ void add_branch(f32x4 (&v)[8], const f32x4 (&b)[8], const float* gpost, const float* gate, int lane) {
    const float rs = rms_scale(b);
#pragma unroll
    for (int j = 0; j < 8; ++j) { const f32x4 g = ldp(gpost, lane, j), gt = ldp(gate, lane, j); v[j] = v[j] + gt * (b[j] * rs * g); }
}
__device__ __forceinline__ void strow_bf(bf16_t* p, int lane, const f32x4 (&v)[8]) {
#pragma unroll
    for (int j = 0; j < 8; ++j) { u32x2 w; w.x = pk2(v[j][0], v[j][1]); w.y = pk2(v[j][2], v[j][3]); *(u32x2*)(p + 4 * lane + 256 * j) = w; }
}
__device__ __forceinline__ void strow(float* p, int lane, const f32x4 (&v)[8]) {
#pragma unroll
    for (int j = 0; j < 8; ++j) *(f32x4*)(p + 4 * lane + 256 * j) = v[j];
}

constexpr int KST = 272, VST = 136, ATT_V_OFF = 64 * KST;
__device__ __forceinline__ void attn_unit(LAS unsigned char* lds, const bf16_t* proj0, const bf16_t* vT, bf16_t* mix, const float* sinks, const float* ropetab,
                                          int kind, int qb, int g, int tid) {
    const int wave = tid >> 6, lane = tid & 63, c = lane & 31, hh = lane >> 5;
    const int head = g * 4 + (wave >> 1), sub = (wave & 1) * 32;
    const int qrow = (kind == 0 ? CTXL + qb * 64 : qb * 64) + sub + c;
    const float qscale = 0.08838834764831845f * 1.4426950408889634f;
    const float* rowtab = ropetab; const float* coltab = ropetab + 256 * 64;
    bf16x8 qf[8];
    {
        const bf16_t* qp = proj0 + (size_t)qrow * N0 + P0_QA + head * 128;
        const int tl = qrow - CTXL;
#pragma unroll
        for (int ax = 0; ax < 2; ++ax)
#pragma unroll
            for (int sp = 0; sp < 2; ++sp) {
                const int d1 = ax * 64 + sp * 16 + hh * 8;
                const u32x4 c1 = *(const u32x4*)(qp + d1), c2 = *(const u32x4*)(qp + d1 + 32);
                float x1[8], x2[8];
#pragma unroll
                for (int e = 0; e < 4; ++e) { x1[2 * e] = bflo(c1[e]); x1[2 * e + 1] = bfhi(c1[e]); x2[2 * e] = bflo(c2[e]); x2[2 * e + 1] = bfhi(c2[e]); }
                if (kind == 0) {
                    const int pos = ax == 0 ? (tl >> 6) : (tl & 63);
                    const float* tb = (ax == 0 ? rowtab : coltab) + (pos * 32 + sp * 16 + hh * 8) * 2;
#pragma unroll
                    for (int e = 0; e < 8; ++e) { const float cs = tb[2 * e], sn = tb[2 * e + 1]; const float o1 = x1[e] * cs - x2[e] * sn, o2 = x1[e] * sn + x2[e] * cs; x1[e] = o1; x2[e] = o2; }
                }
                u32x4 w1, w2;
#pragma unroll
                for (int e = 0; e < 4; ++e) { w1[e] = pk2(x1[2 * e] * qscale, x1[2 * e + 1] * qscale); w2[e] = pk2(x2[2 * e] * qscale, x2[2 * e + 1] * qscale); }
                qf[ax * 4 + sp] = __builtin_bit_cast(bf16x8, w1); qf[ax * 4 + sp + 2] = __builtin_bit_cast(bf16x8, w2);
            }
    }
    float m = sinks[head] * 1.4426950408889634f, lsum = (hh == 0) ? 1.0f : 0.0f;
    f32x16 o[4];
#pragma unroll
    for (int i = 0; i < 4; ++i)
#pragma unroll
        for (int r = 0; r < 16; ++r) o[i][r] = 0.f;
    const int ntile = (kind == 0) ? 9 : 4;
    for (int ti = 0; ti < ntile; ++ti) {
        int krow0, mode = 0; bool rope = false;
        if (ti < 4) krow0 = 64 * ti;
        else { const int j = ti - 6; const int tl0 = qb * 64 + 64 * j; if (tl0 < 0 || tl0 >= SEQ) continue; krow0 = CTXL + tl0; rope = true; mode = (j == -2) ? 1 : (j == 2 ? 2 : 0); }
        __syncthreads();
        {
            const int key = tid >> 3, p = tid & 7, ax = p >> 2, fc = p & 3; const int krow = krow0 + key;
            const bf16_t* kp = proj0 + (size_t)krow * N0 + P0_KA + g * 128 + ax * 64 + fc * 8;
            u32x4 c1 = *(const u32x4*)kp, c2 = *(const u32x4*)(kp + 32);
            if (rope) {
                const int tl = krow - CTXL; const int pos = ax == 0 ? (tl >> 6) : (tl & 63);
                const float* tb = (ax == 0 ? rowtab : coltab) + (pos * 32 + fc * 8) * 2;
                float x1[8], x2[8];
#pragma unroll
                for (int e = 0; e < 4; ++e) { x1[2 * e] = bflo(c1[e]); x1[2 * e + 1] = bfhi(c1[e]); x2[2 * e] = bflo(c2[e]); x2[2 * e + 1] = bfhi(c2[e]); }
#pragma unroll
                for (int e = 0; e < 8; ++e) { const float cs = tb[2 * e], sn = tb[2 * e + 1]; const float o1 = x1[e] * cs - x2[e] * sn, o2 = x1[e] * sn + x2[e] * cs; x1[e] = o1; x2[e] = o2; }
#pragma unroll
                for (int e = 0; e < 4; ++e) { c1[e] = pk2(x1[2 * e], x1[2 * e + 1]); c2[e] = pk2(x2[2 * e], x2[2 * e + 1]); }
            }
            *(LAS u32x4*)(lds + key * KST + (ax * 64 + fc * 8) * 2) = c1;
            *(LAS u32x4*)(lds + key * KST + (ax * 64 + fc * 8 + 32) * 2) = c2;
        }
#pragma unroll
        for (int i = 0; i < 2; ++i) {
            const int idx = tid + NTHR * i, d = idx >> 3, ch = idx & 7;
            const u32x4 v = *(const u32x4*)(vT + (size_t)(g * 128 + d) * T + krow0 + ch * 8);
            LAS u32x2* dst = (LAS u32x2*)(lds + ATT_V_OFF + d * VST + ch * 16);
            dst[0] = (u32x2){v.x, v.y}; dst[1] = (u32x2){v.z, v.w};
        }
        __syncthreads();
        f32x16 p0, p1;
#pragma unroll
        for (int r = 0; r < 16; ++r) { p0[r] = 0.f; p1[r] = 0.f; }
#pragma unroll
        for (int s = 0; s < 8; ++s) {
            const bf16x8 k0 = *(const LAS bf16x8*)(lds + c * KST + (16 * s + 8 * hh) * 2);
            const bf16x8 k1 = *(const LAS bf16x8*)(lds + (32 + c) * KST + (16 * s + 8 * hh) * 2);
            p0 = __builtin_amdgcn_mfma_f32_32x32x16_bf16(k0, qf[s], p0, 0, 0, 0);
            p1 = __builtin_amdgcn_mfma_f32_32x32x16_bf16(k1, qf[s], p1, 0, 0, 0);
        }
        if (mode != 0) {
            const int ii = sub + c;
#pragma unroll
            for (int r = 0; r < 16; ++r) { const int k0i = (r & 3) + 8 * (r >> 2) + 4 * hh, k1i = k0i + 32;
                const bool bad0 = (mode == 1) ? (k0i < ii) : (k0i > ii), bad1 = (mode == 1) ? (k1i < ii) : (k1i > ii);
                if (bad0) p0[r] = -INFINITY; if (bad1) p1[r] = -INFINITY; }
        }
        float mx = p0[0];
#pragma unroll
        for (int r = 0; r < 16; ++r) { mx = fmaxf(mx, p0[r]); mx = fmaxf(mx, p1[r]); }
        mx = fmaxf(mx, __shfl_xor(mx, 32));
        const float mnew = fmaxf(m, mx), alpha = fexp2(m - mnew); m = mnew;
        float rs = 0.f;
#pragma unroll
        for (int r = 0; r < 16; ++r) { p0[r] = fexp2(p0[r] - mnew); p1[r] = fexp2(p1[r] - mnew); rs += p0[r] + p1[r]; }
        lsum = lsum * alpha + rs;
#pragma unroll
        for (int i = 0; i < 4; ++i)
#pragma unroll
            for (int r = 0; r < 16; ++r) o[i][r] *= alpha;
        bf16x8 pf[2][2];
#pragma unroll
        for (int s2 = 0; s2 < 2; ++s2) {
            u32x4 w0, w1;
#pragma unroll
            for (int e = 0; e < 4; ++e) { w0[e] = pk2(p0[8 * s2 + 2 * e], p0[8 * s2 + 2 * e + 1]); w1[e] = pk2(p1[8 * s2 + 2 * e], p1[8 * s2 + 2 * e + 1]); }
            pf[0][s2] = __builtin_bit_cast(bf16x8, w0); pf[1][s2] = __builtin_bit_cast(bf16x8, w1);
        }
#pragma unroll
        for (int dt = 0; dt < 4; ++dt)
#pragma unroll
            for (int kt = 0; kt < 2; ++kt)
#pragma unroll
                for (int s2 = 0; s2 < 2; ++s2) {
                    const LAS unsigned char* vp = lds + ATT_V_OFF + (32 * dt + c) * VST + (32 * kt + 16 * s2 + 4 * hh) * 2;
                    const u32x2 lo = *(const LAS u32x2*)vp, hi = *(const LAS u32x2*)(vp + 16);
                    const u32x4 vv = (u32x4){lo.x, lo.y, hi.x, hi.y};
                    o[dt] = __builtin_amdgcn_mfma_f32_32x32x16_bf16(__builtin_bit_cast(bf16x8, vv), pf[kt][s2], o[dt], 0, 0, 0);
                }
    }
    const float ltot = lsum + __shfl_xor(lsum, 32), inv = 1.0f / ltot;
    bf16_t* op = mix + (size_t)qrow * D + head * 128;
#pragma unroll
    for (int dt = 0; dt < 4; ++dt)
#pragma unroll
        for (int gq = 0; gq < 4; ++gq) {
            u32x2 w; w.x = pk2(o[dt][4 * gq] * inv, o[dt][4 * gq + 1] * inv); w.y = pk2(o[dt][4 * gq + 2] * inv, o[dt][4 * gq + 3] * inv);
            *(u32x2*)(op + 32 * dt + 8 * gq + 4 * hh) = w;
        }
}

__device__ __forceinline__ int row_of(int dir, int n) { return dir == 0 ? n : (n < CTXL ? CTXL - 1 - n : T + CTXL - 1 - n); }

__device__ __forceinline__ float logsigf_(float x) { return fminf(x, 0.f) - __logf(1.0f + fexp(-fabsf(x))); }


template <int MIX> struct GL { static constexpr int NH = MIX ? 4 : 8, V = MIX ? 256 : 128, NVT = V / 32; };
constexpr int GL_KT_STRIDE = 80;
constexpr int GL_QK_STRIDE = 272;
constexpr int GL_RAW_OFF = 70 * 1024;
constexpr int GL_GD_OFF = 120 * 1024;
constexpr int GL_RED_OFF = 130 * 1024;
static_assert(GL_RED_OFF + 1024 <= MISC_OFF, "GL LDS map");
struct GLArgs { const bf16_t* proj; const bf16_t* vT; bf16_t* kvt; float* dec; bf16_t* mix; const float* lbl; const float* upf; const float* upb; const float* biasf; const float* biasb; const float* gain; };

template <int MIX> __device__ __forceinline__ int gl_scan_chunk(int dir, int step) { return dir == 0 ? step : (step < 8 ? 7 - step : NCHUNK + 7 - step); }

template <int MIX, bool NEEDQ>
__device__ __forceinline__ void gl_stage_raw(const GLArgs& g, LAS unsigned char* lds, int R0, int head, int tid) {
    constexpr int NT = MIX == 0 ? (NEEDQ ? 3 : 2) : (NEEDQ ? 2 : 1);
#pragma unroll
    for (int i = 0; i < 2 * NT; ++i) {
        const int idx = tid + NTHR * i, tile = idx >> 10, rem = idx & 1023, row = rem >> 4, ch = rem & 15;
        int col, slot;
        if constexpr (MIX == 0) { slot = tile; col = (tile == 0 ? P0_FF : (tile == 1 ? P0_FB : P0_QH)) + head * 128 + ch * 8; }
        else { slot = tile == 0 ? 0 : 2; col = (tile == 0 ? G_K : G_Q) + head * 128 + ch * 8; }
        const u32x4 v = *(const u32x4*)(g.proj + (size_t)(R0 + row) * (MIX ? N1 : N0) + col);
        *(LAS u32x4*)(lds + GL_RAW_OFF + slot * 16384 + row * 256 + ch * 16) = v;
    }
}
template <int MIX, bool NEEDQ>
__device__ __forceinline__ void gl_load(const LAS unsigned char* lds, int rloc, int k, int dir, unsigned short& x0, unsigned short& x1) {
    x1 = 0;
    x0 = *(const LAS bf16_t*)(lds + GL_RAW_OFF + (MIX == 0 ? dir : 0) * 16384 + rloc * 256 + k * 2);
    if (NEEDQ) x1 = *(const LAS bf16_t*)(lds + GL_RAW_OFF + 2 * 16384 + rloc * 256 + k * 2);
}
template <int MIX, bool NEEDQ>
__device__ __forceinline__ void gl_comp(unsigned short x0, unsigned short x1, float lbk, const float (&up)[16], float bias, const LAS float* gdrow, float& d, float& kv, float& q) {
    if constexpr (MIX == 0) {
        const float f = lbk + (1.0f - lbk) * sigmoidf_(bf2f(x0));
        d = f; kv = 1.0f - f; if (NEEDQ) q = siluf_(bf2f(x1));
    } else {
        f32x2 xa = {bias, 0.f};
#pragma unroll
        for (int q4 = 0; q4 < 4; ++q4) { const f32x4 gd = *(const LAS f32x4*)(gdrow + 4 * q4);
            xa = __builtin_elementwise_fma((f32x2){gd[0], gd[1]}, (f32x2){up[4 * q4], up[4 * q4 + 1]}, xa);
            xa = __builtin_elementwise_fma((f32x2){gd[2], gd[3]}, (f32x2){up[4 * q4 + 2], up[4 * q4 + 3]}, xa); }
        const float x = xa[0] + xa[1];
        d = fexp(logsigf_(x) * 0.0625f); kv = bf2f(x0); if (NEEDQ) q = bf2f(x1) * 0.08838834764831845f;
    }
}
template <int MIX>
__device__ __forceinline__ void gl_stage_gd(const GLArgs& g, LAS unsigned char* lds, int R0, int tid) {
    if constexpr (MIX == 1) {
        LAS float* gds = (LAS float*)(lds + GL_GD_OFF);
        for (int idx = tid; idx < 2048; idx += NTHR) { const int row = idx >> 5, dj = idx & 31, dir = dj >> 4, j = dj & 15;
            gds[(dir * 64 + row) * 16 + j] = bf2f(g.proj[(size_t)(R0 + row) * N1 + (dir ? G_GDB : G_GDF) + j]); }
    }
}
template <int MIX>
__device__ __forceinline__ void gl_walker_consts(const GLArgs& g, int head, int k, int dir, float& lbk, float (&up)[16], float& bias) {
    lbk = 0.f; bias = 0.f;
#pragma unroll
    for (int j = 0; j < 16; ++j) up[j] = 0.f;
    if constexpr (MIX == 0) { const int kk = head * 128 + k; lbk = 1.0f / (1.0f + fexp(g.lbl[1024 + kk] - g.lbl[kk])); }
    else { const float* upp = dir ? g.upb : g.upf; const int ch = head * 128 + k;
#pragma unroll
        for (int j = 0; j < 16; ++j) up[j] = upp[j * 512 + ch];
        bias = (dir ? g.biasb : g.biasf)[ch]; }
}

template <int MIX>
__device__ __forceinline__ void gl_phaseA(const GLArgs& g, LAS unsigned char* lds, int tid, int bid, int nblk) {
    constexpr int NH = GL<MIX>::NH, V = GL<MIX>::V, NVT = GL<MIX>::NVT;
    const int lane = tid & 63, wave = tid >> 6, c = lane & 31, hh = lane >> 5;
    const int wk = tid & 127, wc2 = (tid >> 7) & 1, wdir = tid >> 8;
    const int dir = wave >> 2, c2 = (wave >> 1) & 1, kh = wave & 1;
    for (int item = bid; item < NH * (T / 64); item += nblk) {
        const int head = item % NH, nb = item / NH, R0 = nb * 64;
        __syncthreads();
        gl_stage_gd<MIX>(g, lds, R0, tid); gl_stage_raw<MIX, false>(g, lds, R0, head, tid);
        const int rbase = R0 + 32 * c2, cr = (R0 >> 5) + c2;
        const bf16_t* vsrc = g.vT + (size_t)((MIX ? 0 : 256) + head * V) * T + rbase;
        bf16x8 bfv[NVT][2];
#pragma unroll
        for (int vt = 0; vt < NVT; ++vt)
#pragma unroll
            for (int s = 0; s < 2; ++s) bfv[vt][s] = *(const bf16x8*)(vsrc + (size_t)(32 * vt + c) * T + 16 * s + 8 * hh);
        float lbk, up[16], bias; gl_walker_consts<MIX>(g, head, wk, wdir, lbk, up, bias);
        __syncthreads();
        {
            float tail = 1.0f;
            LAS bf16_t* kt = (LAS bf16_t*)(lds + (wdir * 2 + wc2) * (128 * GL_KT_STRIDE) + wk * GL_KT_STRIDE);
#pragma unroll 8
            for (int s = 0; s < 32; ++s) {
                const int t = wdir == 0 ? 31 - s : s; unsigned short x0, x1; gl_load<MIX, false>(lds, 32 * wc2 + t, wk, wdir, x0, x1);
                float d, kv, q; gl_comp<MIX, false>(x0, x1, lbk, up, bias, (const LAS float*)(lds + GL_GD_OFF) + (wdir * 64 + 32 * wc2 + t) * 16, d, kv, q);
                kt[t] = (bf16_t)f2bf(kv * tail); tail *= d;
            }
            g.dec[((size_t)(wdir * NH + head) * NCHUNK + (R0 >> 5) + wc2) * 128 + wk] = tail;
        }
        __syncthreads();
        {
            const LAS unsigned char* ktile = lds + (dir * 2 + c2) * (128 * GL_KT_STRIDE);
            bf16x8 af[2][2];
#pragma unroll
            for (int kt2 = 0; kt2 < 2; ++kt2)
#pragma unroll
                for (int s = 0; s < 2; ++s) af[kt2][s] = *(const LAS bf16x8*)(ktile + (32 * (2 * kh + kt2) + c) * GL_KT_STRIDE + (16 * s + 8 * hh) * 2);
            bf16_t* kvo = g.kvt + ((size_t)(dir * NH + head) * NCHUNK + cr) * (V * 128);
#pragma unroll
            for (int pass = 0; pass < NVT / 4; ++pass) {
                f32x16 acc[4][2];
#pragma unroll
                for (int vt = 0; vt < 4; ++vt)
#pragma unroll
                    for (int kt2 = 0; kt2 < 2; ++kt2)
#pragma unroll
                        for (int r = 0; r < 16; ++r) acc[vt][kt2][r] = 0.f;
#pragma unroll
                for (int vt = 0; vt < 4; ++vt)
#pragma unroll
                    for (int s = 0; s < 2; ++s)
#pragma unroll
                        for (int kt2 = 0; kt2 < 2; ++kt2) acc[vt][kt2] = __builtin_amdgcn_mfma_f32_32x32x16_bf16(bfv[4 * pass + vt][s], af[kt2][s], acc[vt][kt2], 0, 0, 0);
#pragma unroll
                for (int vt = 0; vt < 4; ++vt)
#pragma unroll
                    for (int kt2 = 0; kt2 < 2; ++kt2)
#pragma unroll
                        for (int r = 0; r < 16; ++r) {
                            const int v = 32 * (4 * pass + vt) + (r & 3) + 8 * (r >> 2) + 4 * hh;
                            kvo[(size_t)v * 128 + 32 * (2 * kh + kt2) + c] = (bf16_t)f2bf(acc[vt][kt2][r]);
                        }
            }
        }
    }
}

template <int MIX, int KPT>
__device__ __forceinline__ void gl_phaseB(const GLArgs& g, int gidx) {
    constexpr int NH = GL<MIX>::NH, V = GL<MIX>::V, KG = 128 / KPT;
    if (gidx < 0 || gidx >= 2 * NH * V * KG) return;
    const int kq = gidx % KG; int rest = gidx / KG; const int v = rest % V; rest /= V; const int head = rest % NH, dir = rest / NH;
    bf16_t* base = g.kvt + (size_t)(dir * NH + head) * NCHUNK * (V * 128) + (size_t)v * 128 + KPT * kq;
    const float* dbase = g.dec + (size_t)(dir * NH + head) * NCHUNK * 128 + KPT * kq;
    float st[KPT];
#pragma unroll
    for (int e = 0; e < KPT; ++e) st[e] = 0.f;
    constexpr int UB = 10;
    unsigned kv[UB][KPT / 2], kvn[UB][KPT / 2]; float dd[UB][KPT], ddn[UB][KPT];
#define GLB_LOAD(KV, DD, ST0) do { _Pragma("unroll") for (int u = 0; u < UB; ++u) { const int cr_ = gl_scan_chunk<MIX>(dir, (ST0) + u); \
        if constexpr (KPT == 4) { const u32x2 k_ = *(const u32x2*)(base + (size_t)cr_ * (V * 128)); KV[u][0] = k_.x; KV[u][1] = k_.y; const f32x4 d_ = *(const f32x4*)(dbase + (size_t)cr_ * 128); DD[u][0] = d_[0]; DD[u][1] = d_[1]; DD[u][2] = d_[2]; DD[u][3] = d_[3]; } \
        else { _Pragma("unroll") for (int e = 0; e < KPT / 2; ++e) KV[u][e] = *((const unsigned*)(base + (size_t)cr_ * (V * 128)) + e); \
        _Pragma("unroll") for (int e = 0; e < KPT; ++e) DD[u][e] = dbase[(size_t)cr_ * 128 + e]; } } } while (0)
    GLB_LOAD(kv, dd, 0);
    for (int st0 = 0; st0 < NCHUNK; st0 += UB) {
        if (st0 + UB < NCHUNK) GLB_LOAD(kvn, ddn, st0 + UB);
#pragma unroll
        for (int u = 0; u < UB; ++u) { const int cr = gl_scan_chunk<MIX>(dir, st0 + u);
            if constexpr (KPT == 4) { *(u32x2*)(base + (size_t)cr * (V * 128)) = (u32x2){pk2(st[0], st[1]), pk2(st[2], st[3])}; }
#pragma unroll
            for (int e = 0; e < KPT / 2; ++e) { if constexpr (KPT != 4) *((unsigned*)(base + (size_t)cr * (V * 128)) + e) = pk2(st[2 * e], st[2 * e + 1]);
                st[2 * e] = fmaf(dd[u][2 * e], st[2 * e], bflo(kv[u][e])); st[2 * e + 1] = fmaf(dd[u][2 * e + 1], st[2 * e + 1], bfhi(kv[u][e])); } }
#pragma unroll
        for (int u = 0; u < UB; ++u) {
#pragma unroll
            for (int e = 0; e < KPT / 2; ++e) kv[u][e] = kvn[u][e];
#pragma unroll
            for (int e = 0; e < KPT; ++e) dd[u][e] = ddn[u][e]; }
    }
#undef GLB_LOAD
}

template <int MIX>
__device__ __forceinline__ void gl_phaseC(const GLArgs& g, LAS unsigned char* lds, int tid, int bid, int nblk) {
    constexpr int NH = GL<MIX>::NH, V = GL<MIX>::V, NVT = GL<MIX>::NVT, NP = NVT / 4;
    const int lane = tid & 63, wave = tid >> 6, c = lane & 31, hh = lane >> 5;
    const int wk = tid & 127, wc2 = (tid >> 7) & 1, wdir = tid >> 8;
    constexpr int TILE = 32 * GL_QK_STRIDE;
    for (int item = bid; item < NH * (T / 64); item += nblk) {
        const int head = item % NH, nb = item / NH, R0 = nb * 64;
        if (MIX == 1 && R0 < CTXL) continue;
        __syncthreads();
        gl_stage_gd<MIX>(g, lds, R0, tid); gl_stage_raw<MIX, true>(g, lds, R0, head, tid);
        const int c2 = wave >> 2, vg = wave & 3, rbase = R0 + 32 * c2, cr = (R0 >> 5) + c2;
        bf16x8 sf2[2][8]; u32x4 vf2[2][NP][2];
#pragma unroll
        for (int dir = 0; dir < 2; ++dir) {
            const bf16_t* sb_ = g.kvt + ((size_t)(dir * NH + head) * NCHUNK + cr) * (V * 128);
#pragma unroll
            for (int p = 0; p < NP; ++p) {
                const int vrow = 32 * (vg + 4 * p) + c;
                const bf16_t* vp = g.vT + (size_t)((MIX ? 0 : 256) + head * V + vrow) * T + rbase;
#pragma unroll
                for (int s2 = 0; s2 < 2; ++s2) { const u32x2 lo = *(const u32x2*)(vp + 16 * s2 + 4 * hh), hi = *(const u32x2*)(vp + 16 * s2 + 8 + 4 * hh); vf2[dir][p][s2] = (u32x4){lo.x, lo.y, hi.x, hi.y}; }
            }
#pragma unroll
            for (int s = 0; s < 8; ++s) sf2[dir][s] = *(const bf16x8*)(sb_ + (size_t)(32 * vg + c) * 128 + 16 * s + 8 * hh);
        }
        float lbk, up[16], bias; gl_walker_consts<MIX>(g, head, wk, wdir, lbk, up, bias);
        __syncthreads();
        {
            const int rbase = R0 + 32 * wc2; float P = 1.0f;
            LAS unsigned char* qt = lds + ((wdir * 2 + wc2) * 2) * TILE; LAS unsigned char* kt = qt + TILE;
#pragma unroll 8
            for (int s = 0; s < 32; ++s) {
                const int t = wdir == 0 ? s : 31 - s; unsigned short x0, x1; gl_load<MIX, true>(lds, 32 * wc2 + t, wk, wdir, x0, x1);
                float d, kv, q; gl_comp<MIX, true>(x0, x1, lbk, up, bias, (const LAS float*)(lds + GL_GD_OFF) + (wdir * 64 + 32 * wc2 + t) * 16, d, kv, q);
                P *= d;
                *(LAS bf16_t*)(qt + t * GL_QK_STRIDE + wk * 2) = (bf16_t)f2bf(q * P);
                *(LAS bf16_t*)(kt + t * GL_QK_STRIDE + wk * 2) = (bf16_t)f2bf(kv * fminf(__builtin_amdgcn_rcpf(P), 1e30f));
            }
        }
        __syncthreads();
        f32x16 o[NP];
#pragma unroll
        for (int p = 0; p < NP; ++p)
#pragma unroll
            for (int r = 0; r < 16; ++r) o[p][r] = 0.f;
        __builtin_amdgcn_sched_barrier(0);
#pragma unroll
        for (int dir = 0; dir < 2; ++dir) {
            const LAS unsigned char* qt = lds + ((dir * 2 + c2) * 2) * TILE; const LAS unsigned char* kt = qt + TILE;
            const bf16_t* sbase = g.kvt + ((size_t)(dir * NH + head) * NCHUNK + cr) * (V * 128);
            bf16x8 sf[8]; u32x4 vf[NP][2];
#pragma unroll
            for (int s = 0; s < 8; ++s) sf[s] = sf2[dir][s];
#pragma unroll
            for (int p = 0; p < NP; ++p) { vf[p][0] = vf2[dir][p][0]; vf[p][1] = vf2[dir][p][1]; }
            bf16x8 qf[8];
            f32x16 x;
#pragma unroll
            for (int r = 0; r < 16; ++r) x[r] = 0.f;
#pragma unroll
            for (int s = 0; s < 8; ++s) { qf[s] = *(const LAS bf16x8*)(qt + c * GL_QK_STRIDE + (16 * s + 8 * hh) * 2);
                const bf16x8 kf = *(const LAS bf16x8*)(kt + c * GL_QK_STRIDE + (16 * s + 8 * hh) * 2);
                x = __builtin_amdgcn_mfma_f32_32x32x16_bf16(kf, qf[s], x, 0, 0, 0); }
#pragma unroll
            for (int r = 0; r < 16; ++r) { const int j = (r & 3) + 8 * (r >> 2) + 4 * hh; const bool keep = dir == 0 ? (j <= c) : (j >= c); if (!keep) x[r] = 0.f; }
            bf16x8 xf[2];
#pragma unroll
            for (int s2 = 0; s2 < 2; ++s2) { u32x4 w;
#pragma unroll
                for (int e = 0; e < 4; ++e) w[e] = pk2(x[8 * s2 + 2 * e], x[8 * s2 + 2 * e + 1]);
                xf[s2] = __builtin_bit_cast(bf16x8, w); }
#pragma unroll
            for (int p = 0; p < NP; ++p) {
                bf16x8 sn[8];
                if (p + 1 < NP) {
#pragma unroll
                    for (int s = 0; s < 8; ++s) sn[s] = *(const bf16x8*)(sbase + (size_t)(32 * (vg + 4 * (p + 1)) + c) * 128 + 16 * s + 8 * hh);
                }
                __builtin_amdgcn_sched_barrier(0);
#pragma unroll
                for (int s2 = 0; s2 < 2; ++s2) o[p] = __builtin_amdgcn_mfma_f32_32x32x16_bf16(__builtin_bit_cast(bf16x8, vf[p][s2]), xf[s2], o[p], 0, 0, 0);
#pragma unroll
                for (int s = 0; s < 8; ++s) o[p] = __builtin_amdgcn_mfma_f32_32x32x16_bf16(sf[s], qf[s], o[p], 0, 0, 0);
                if (p + 1 < NP) {
#pragma unroll
                    for (int s = 0; s < 8; ++s) sf[s] = sn[s];
                }
            }
        }
        float ss = 0.f;
#pragma unroll
        for (int p = 0; p < NP; ++p)
#pragma unroll
            for (int r = 0; r < 16; ++r) ss += o[p][r] * o[p][r];
        ss += __shfl_xor(ss, 32);
        LAS float* red = (LAS float*)(lds + GL_RED_OFF);
        if (hh == 0) red[(c2 * 4 + vg) * 32 + c] = ss;
        __syncthreads();
        const float tot = (red[(c2 * 4 + 0) * 32 + c] + red[(c2 * 4 + 1) * 32 + c]) + (red[(c2 * 4 + 2) * 32 + c] + red[(c2 * 4 + 3) * 32 + c]);
        const float rs = __builtin_amdgcn_rsqf(tot * (1.0f / V) + NORM_EPS);
        const int r = rbase + c;
#pragma unroll
        for (int p = 0; p < NP; ++p)
#pragma unroll
            for (int gq = 0; gq < 4; ++gq) {
                const int v0 = 32 * (vg + 4 * p) + 8 * gq + 4 * hh;
                const f32x4 gn = *(const f32x4*)(g.gain + v0);
                const u32x2 gt = *(const u32x2*)(g.proj + (size_t)r * (MIX ? N1 : N0) + (MIX ? G_GR : P0_GH) + head * V + v0);
                u32x2 w; w.x = pk2(o[p][4 * gq] * rs * gn[0] * siluf_(bflo(gt.x)), o[p][4 * gq + 1] * rs * gn[1] * siluf_(bfhi(gt.x)));
                w.y = pk2(o[p][4 * gq + 2] * rs * gn[2] * siluf_(bflo(gt.y)), o[p][4 * gq + 3] * rs * gn[3] * siluf_(bfhi(gt.y)));
                bf16_t* op = MIX ? g.mix + (size_t)(r - CTXL) * D + head * V + v0 : g.mix + (size_t)r * D + 1024 + head * V + v0;
                *(u32x2*)op = w;
            }
    }
}

constexpr int RW_TS = 144, RW_TILE = 32 * RW_TS, RW_WAVE_LDS = 14336;
__host__ __device__ constexpr int rw_tri(int t) { return t <= 0 ? 0 : ((t - 1) / 4 + 1) * (2 * ((t - 1) / 4) + (t - 1) % 4); }
constexpr int RW_TRI_BYTES = 16 * rw_tri(32);
#ifndef RW_LB
#define RW_LB 2
#endif
static_assert(RW_TRI_BYTES + 2048 <= RW_TILE, "triangle rows + the parked fragments must fit the third tile slot");
struct RWArgs { const bf16_t* RP; const bf16_t* GOUT; bf16_t* MF; bf16_t* NB; bf16_t* QB; bf16_t* OB; bf16_t* mix; const float* rk; const float* lnw; const float* lnb; const float* ka; };
__device__ __forceinline__ int rw_scan_chunk(int dir, int cs) { return dir == 0 ? cs : (cs < 8 ? 7 - cs : NCHUNK + 7 - cs); }
__device__ __forceinline__ float rdlane(float v, int l) { return __int_as_float(__builtin_amdgcn_readlane(__float_as_int(v), l)); }
template <bool PERM>
__device__ __forceinline__ void rw_pack(const float (&x)[32], int hh, u32x4 (&f)[2][2]) {
#pragma unroll
    for (int s2 = 0; s2 < 2; ++s2)
#pragma unroll
        for (int e = 0; e < 4; ++e) {
            const int t0 = PERM ? 16 * s2 + 8 * ((2 * e) >> 2) + ((2 * e) & 3) : 16 * s2 + 2 * e;
            const int t1 = PERM ? t0 + 4 : t0 + 8;
            const unsigned p0 = pk2(x[t0], x[t0 + 1]), p1 = pk2(x[t1], x[t1 + 1]);
            const auto rr = __builtin_amdgcn_permlane32_swap(p0, p1, false, false);
            f[0][s2][e] = rr[0]; f[1][s2][e] = rr[1];
        }
    (void)hh;
}
__device__ __forceinline__ void rw_pack_pairs(const unsigned (&xp)[16], int hh, u32x4 (&f)[2][2]) {
#pragma unroll
    for (int s2 = 0; s2 < 2; ++s2)
#pragma unroll
        for (int e = 0; e < 4; ++e) { const auto rr = __builtin_amdgcn_permlane32_swap(xp[8 * s2 + e], xp[8 * s2 + 4 + e], false, false); f[0][s2][e] = rr[0]; f[1][s2][e] = rr[1]; }
    (void)hh;
}
__device__ __forceinline__ void rw_pack_pairs_perm(const unsigned (&xp)[16], int hh, u32x4 (&f)[2][2]) {
#pragma unroll
    for (int s2 = 0; s2 < 2; ++s2)
#pragma unroll
        for (int e = 0; e < 4; ++e) { const int t0 = 16 * s2 + 8 * (e >> 1) + 2 * (e & 1);
            const auto rr = __builtin_amdgcn_permlane32_swap(xp[t0 >> 1], xp[(t0 + 4) >> 1], false, false); f[0][s2][e] = rr[0]; f[1][s2][e] = rr[1]; }
    (void)hh;
}
__device__ __forceinline__ bf16x8 acc_frag(const f32x16& x, int s2) {
    u32x4 w;
#pragma unroll
    for (int e = 0; e < 4; ++e) w[e] = pk2(x[8 * s2 + 2 * e], x[8 * s2 + 2 * e + 1]);
    return __builtin_bit_cast(bf16x8, w);
}
#define MFMA32(A, B, C) __builtin_amdgcn_mfma_f32_32x32x16_bf16(A, B, C, 0, 0, 0)

__device__ __forceinline__ void rwkv_stageA(const RWArgs& g, LAS unsigned char* wl, int item, int lane) {
    __builtin_assume(item >= 0 && item < 2 * 16 * NCHUNK);
    const int dir = item / (16 * NCHUNK), rem = item - dir * 16 * NCHUNK, head = rem / NCHUNK, cs = rem - head * NCHUNK;
    const int cr = rw_scan_chunk(dir, cs), rbase = 32 * cr, c = lane & 31, hh = lane >> 5;
    LAS unsigned char* s0 = wl; LAS unsigned char* s1 = wl + RW_TILE; LAS unsigned char* s2p = wl + 2 * RW_TILE; LAS float* gam = (LAS float*)(wl + 3 * RW_TILE);
    unsigned vp[16], bp[16], kp[16];
    {
        float gprev = 1.0f; const bf16_t* rp0 = g.RP + head * 64; unsigned vo0 = (unsigned)lane * 2u, vo2 = vo0 + 4096u, vo4 = vo0 + 8192u, vo5 = vo0 + (unsigned)(5 + dir) * 2048u; asm volatile("" : "+v"(vo2), "+v"(vo4), "+v"(vo5)); const float kac = g.ka[head * 64 + lane];
#pragma unroll
        for (int sb = 0; sb < 32; sb += 16) {
            unsigned short raw[16][6];
#pragma unroll
            for (int u = 0; u < 16; ++u) { const int s = sb + u; const int r = rbase + (dir ? 31 - s : s); const char* pb = (const char*)(rp0 + (size_t)r * 7168);
                raw[u][0] = *(const bf16_t*)(pb + vo0); raw[u][1] = *(const bf16_t*)(pb + 2048 + vo0); raw[u][2] = *(const bf16_t*)(pb + vo2); raw[u][3] = *(const bf16_t*)(pb + 2048 + vo2);
                raw[u][4] = *(const bf16_t*)(pb + vo4); raw[u][5] = *(const bf16_t*)(pb + vo5); }
#pragma unroll
            for (int u = 0; u < 16; ++u) { const int s = sb + u;
                const float rr = bf2f(raw[u][0]), kk = bf2f(raw[u][3]), aa = bf2f(raw[u][4]), lw = bf2f(raw[u][5]);
                const float km = bf2f(raw[u][1]) * (1.0f + (aa - 1.0f) * kac);
                const float gcur = gprev * fexp(lw), ginv = __builtin_amdgcn_rcpf(gcur);
                const unsigned bt = f2bf(kk * aa * ginv), kt = f2bf(km * ginv);
                *(LAS bf16_t*)(s0 + s * RW_TS + lane * 2) = (bf16_t)f2bf(-kk * gprev);
                *(LAS bf16_t*)(s1 + s * RW_TS + lane * 2) = (bf16_t)f2bf(rr * gcur);
                *(LAS bf16_t*)(s2p + s * RW_TS + lane * 2) = (bf16_t)kt;
                if (s & 1) { bp[s >> 1] |= bt << 16; kp[s >> 1] |= kt << 16; vp[s >> 1] |= (unsigned)raw[u][2] << 16; } else { bp[s >> 1] = bt; kp[s >> 1] = kt; vp[s >> 1] = raw[u][2]; }
                gprev = gcur;
            }
        }
        gam[lane] = gprev;
    }
    LDS_WAIT();
    f32x16 g1, g2, g3, g4;
#pragma unroll
    for (int r = 0; r < 16; ++r) { g1[r] = 0.f; g2[r] = 0.f; g3[r] = 0.f; g4[r] = 0.f; }
    {
        bf16x8 fa[4], fr[4], fk[4];
#pragma unroll
        for (int ks = 0; ks < 4; ++ks) { fa[ks] = *(const LAS bf16x8*)(s0 + c * RW_TS + (16 * ks + 8 * hh) * 2); fr[ks] = *(const LAS bf16x8*)(s1 + c * RW_TS + (16 * ks + 8 * hh) * 2);
            fk[ks] = *(const LAS bf16x8*)(s2p + c * RW_TS + (16 * ks + 8 * hh) * 2); }
        LDS_WAIT();
#pragma unroll
        for (int s = 0; s < 32; ++s) *(LAS bf16_t*)(s2p + s * RW_TS + lane * 2) = (bf16_t)((s & 1) ? (bp[s >> 1] >> 16) : (bp[s >> 1] & 0xffffu));
        LDS_WAIT();
#pragma unroll
        for (int ks = 0; ks < 4; ++ks) {
            const bf16x8 fb = *(const LAS bf16x8*)(s2p + c * RW_TS + (16 * ks + 8 * hh) * 2);
            g1 = MFMA32(fb, fa[ks], g1); g2 = MFMA32(fk[ks], fa[ks], g2); g3 = MFMA32(fb, fr[ks], g3); g4 = MFMA32(fk[ks], fr[ks], g4);
        }
    }
#pragma unroll
    for (int r = 0; r < 16; ++r) { const int i = (r & 3) + 8 * (r >> 2) + 4 * hh; if (i > c) { g3[r] = 0.f; g4[r] = 0.f; } }
    const bf16x8 b3[2] = {acc_frag(g3, 0), acc_frag(g3, 1)}, b4[2] = {acc_frag(g4, 0), acc_frag(g4, 1)};
    LDS_WAIT();
    {
        int toff = 4 * rw_tri(c); asm volatile("" : "+v"(toff));
#pragma unroll
        for (int gq = 0; gq < 4; ++gq) { const int i0 = 8 * gq + 4 * hh;
            if (i0 < c) *(LAS f32x4*)(s2p + (toff + i0) * 4) = (f32x4){g1[4 * gq], g1[4 * gq + 1], g1[4 * gq + 2], g1[4 * gq + 3]}; }
        *(LAS bf16x8*)(s2p + RW_TRI_BYTES + lane * 16) = b4[0]; *(LAS bf16x8*)(s2p + RW_TRI_BYTES + 1024 + lane * 16) = b4[1];
    }
    f32x16 wxA, wxB;
    {
#pragma unroll
        for (int r = 0; r < 16; ++r) { const int i = (r & 3) + 8 * (r >> 2) + 4 * hh; if (i >= c) g2[r] = 0.f; }
        const bf16x8 a2[2] = {acc_frag(g2, 0), acc_frag(g2, 1)};
        u32x4 fVq[2][2]; rw_pack_pairs_perm(vp, hh, fVq);
        f32x16 x0, x1;
#pragma unroll
        for (int r = 0; r < 16; ++r) { x0[r] = 0.f; x1[r] = 0.f; }
#pragma unroll
        for (int q = 0; q < 2; ++q) { x0 = MFMA32(a2[q], __builtin_bit_cast(bf16x8, fVq[0][q]), x0); x1 = MFMA32(a2[q], __builtin_bit_cast(bf16x8, fVq[1][q]), x1); }
#pragma unroll
        for (int r = 0; r < 16; ++r) { const auto rr = __builtin_amdgcn_permlane32_swap(__float_as_uint(x0[r]), __float_as_uint(x1[r]), false, false); wxA[r] = __uint_as_float(rr[0]); wxB[r] = __uint_as_float(rr[1]); }
    }
    LDS_WAIT();
    float p[32], w[32];
    {
        f32x2 pw[32];
#pragma unroll
        for (int t = 0; t < 32; ++t) {
            f32x2 acc = {bf2f(*(const LAS bf16_t*)(s0 + t * RW_TS + lane * 2)), ((t >> 2) & 1) ? wxB[(t & 3) + 4 * (t >> 3)] : wxA[(t & 3) + 4 * (t >> 3)]};
#pragma unroll
            for (int ib = 0; ib < (t + 3) / 4; ib += RW_LB) {
                f32x4 lab[RW_LB];
#pragma unroll
                for (int b = 0; b < RW_LB; ++b) if (ib + b < (t + 3) / 4) lab[b] = *(const LAS f32x4*)(s2p + (4 * rw_tri(t) + 4 * (ib + b)) * 4);
#pragma unroll
                for (int b = 0; b < RW_LB; ++b) if (ib + b < (t + 3) / 4) {
                    const f32x2 l01 = {lab[b][0], lab[b][1]}, l23 = {lab[b][2], lab[b][3]};
                    const int i0 = 4 * (ib + b), n = t - i0;
#define RW_F0 "v_pk_fma_f32 %0, %1, %3, %0 op_sel_hi:[0,1,1]"
#define RW_F1 "\n\tv_pk_fma_f32 %0, %1, %4, %0 op_sel:[1,0,0] op_sel_hi:[1,1,1]"
#define RW_F2 "\n\tv_pk_fma_f32 %0, %2, %5, %0 op_sel_hi:[0,1,1]"
#define RW_F3 "\n\tv_pk_fma_f32 %0, %2, %6, %0 op_sel:[1,0,0] op_sel_hi:[1,1,1]"
                    if (n >= 4)      asm(RW_F0 RW_F1 RW_F2 RW_F3 : "+v"(acc) : "v"(l01), "v"(l23), "v"(pw[i0]), "v"(pw[i0 + 1]), "v"(pw[i0 + 2]), "v"(pw[i0 + 3]));
                    else if (n == 3) asm(RW_F0 RW_F1 RW_F2       : "+v"(acc) : "v"(l01), "v"(l23), "v"(pw[i0]), "v"(pw[i0 + 1]), "v"(pw[i0 + 2]));
                    else if (n == 2) asm(RW_F0 RW_F1             : "+v"(acc) : "v"(l01), "v"(l23), "v"(pw[i0]), "v"(pw[i0 + 1]));
                    else             asm(RW_F0                   : "+v"(acc) : "v"(l01), "v"(l23), "v"(pw[i0]));
#undef RW_F0
#undef RW_F1
#undef RW_F2
#undef RW_F3
                }
            }
            pw[t] = acc;
        }
#pragma unroll
        for (int t = 0; t < 32; ++t) { p[t] = pw[t][0]; w[t] = pw[t][1]; }
    }
#define BF(x) __builtin_bit_cast(bf16x8, x)
    u32x4 fBn[2][2], fKn[2][2];
    rw_pack_pairs(bp, hh, fBn); rw_pack_pairs(kp, hh, fKn);
    {
        u32x4 fPn[2][2], fPp[2][2];
        rw_pack<false>(p, hh, fPn); rw_pack<true>(p, hh, fPp);
        bf16_t* mf = g.MF + (size_t)item * 4096;
#pragma unroll
        for (int n = 0; n < 2; ++n) {
            const float gk = gam[32 * n + c];
#pragma unroll
            for (int mp = 0; mp < 2; ++mp) {
                f32x16 x;
#pragma unroll
                for (int r = 0; r < 16; ++r) x[r] = 0.f;
#pragma unroll
                for (int q = 0; q < 2; ++q) x = MFMA32(BF(fPn[mp][q]), BF(fBn[n][q]), x);
#pragma unroll
                for (int r = 0; r < 16; ++r) { const int kprime = (r & 3) + 8 * (r >> 2) + 4 * hh; x[r] = gk * (x[r] + ((mp == n && kprime == c) ? 1.0f : 0.0f)); }
#pragma unroll
                for (int q = 0; q < 2; ++q) *(bf16x8*)(mf + (size_t)(((n * 2 + mp) * 2 + q) * 64 + lane) * 8) = acc_frag(x, q);
            }
        }
        const int r = rbase + (dir ? 31 - c : c);
        bf16_t* qrow = g.QB + ((size_t)dir * T + r) * 1024 + head * 64;
#pragma unroll
        for (int mp = 0; mp < 2; ++mp) {
            f32x16 x;
#pragma unroll
            for (int rr = 0; rr < 16; ++rr) x[rr] = 0.f;
#pragma unroll
            for (int q = 0; q < 2; ++q) x = MFMA32(BF(fPp[mp][q]), b3[q], x);
#pragma unroll
            for (int gq = 0; gq < 4; ++gq) { const int k0 = 32 * mp + 8 * gq + 4 * hh; const u32x2 rt = *(const LAS u32x2*)(s1 + c * RW_TS + k0 * 2);
                u32x2 o; o.x = pk2(x[4 * gq] + bflo(rt.x), x[4 * gq + 1] + bfhi(rt.x)); o.y = pk2(x[4 * gq + 2] + bflo(rt.y), x[4 * gq + 3] + bfhi(rt.y));
                *(u32x2*)(qrow + k0) = o; }
        }
    }
    asm volatile("" ::: "memory");
    {
        u32x4 fWn[2][2], fVn[2][2], fWp[2][2], fVp[2][2];
        rw_pack<false>(w, hh, fWn); rw_pack_pairs(vp, hh, fVn); rw_pack<true>(w, hh, fWp); rw_pack_pairs_perm(vp, hh, fVp);
        bf16_t* nb = g.NB + (size_t)item * 4096;
#pragma unroll
        for (int n = 0; n < 2; ++n)
#pragma unroll
            for (int m = 0; m < 2; ++m) {
                f32x16 x;
#pragma unroll
                for (int r = 0; r < 16; ++r) x[r] = 0.f;
#pragma unroll
                for (int q = 0; q < 2; ++q) { x = MFMA32(BF(fBn[m][q]), BF(fWn[n][q]), x); x = MFMA32(BF(fKn[m][q]), BF(fVn[n][q]), x); }
                u32x4 o0, o1;
#pragma unroll
                for (int gq = 0; gq < 4; ++gq) { const f32x4 gg = *(const LAS f32x4*)(gam + 32 * m + 8 * gq + 4 * hh);
                    const unsigned a0 = pk2(x[4 * gq] * gg[0], x[4 * gq + 1] * gg[1]), a1 = pk2(x[4 * gq + 2] * gg[2], x[4 * gq + 3] * gg[3]);
                    if (gq < 2) { o0[2 * gq] = a0; o0[2 * gq + 1] = a1; } else { o1[2 * (gq - 2)] = a0; o1[2 * (gq - 2) + 1] = a1; } }
                u32x4* dst = (u32x4*)(nb + (size_t)((n * 2 + m) * 64 + lane) * 16);
                dst[0] = o0; dst[1] = o1;
            }
        const int lrow = (dir ? 31 - c : c) + 32 * hh;
        bf16_t* ob = g.OB + ((size_t)((dir * 16 + head) * NCHUNK + cr)) * 2048;
#pragma unroll
        for (int n = 0; n < 2; ++n) {
            f32x16 x;
#pragma unroll
            for (int rr = 0; rr < 16; ++rr) x[rr] = 0.f;
#pragma unroll
            for (int q = 0; q < 2; ++q) { x = MFMA32(BF(fWp[n][q]), b3[q], x); x = MFMA32(BF(fVp[n][q]), *(const LAS bf16x8*)(s2p + RW_TRI_BYTES + q * 1024 + lane * 16), x); }
            u32x4 o0, o1;
#pragma unroll
            for (int e = 0; e < 4; ++e) { o0[e] = pk2(x[2 * e], x[2 * e + 1]); o1[e] = pk2(x[8 + 2 * e], x[8 + 2 * e + 1]); }
            u32x4* dst = (u32x4*)(ob + (size_t)(n * 64 + lrow) * 16);
            dst[0] = o0; dst[1] = o1;
        }
    }
    LDS_WAIT();
}

constexpr int RWB_SLOT = 12288, RWB_FLAGS = MISC_OFF + 1536;
__device__ __forceinline__ void rwkv_stageB(const RWArgs& g, LAS unsigned char* lds, int tk, int wave, int lane) {
    const int n = tk & 1, dh = tk >> 1;
    const bf16_t* mfb = g.MF + (size_t)dh * NCHUNK * 4096; bf16_t* nbb = g.NB + (size_t)dh * NCHUNK * 4096 + (size_t)n * 2048;
    volatile LAS unsigned* flags = (volatile LAS unsigned*)(lds + RWB_FLAGS);
    if (wave != 0) {
        const int sl = wave - 1; LAS unsigned char* slot = lds + sl * RWB_SLOT;
        for (int cs = sl; cs < NCHUNK; cs += 7) {
            u32x4 v[12];
            const u32x4* mp_ = (const u32x4*)(mfb + (size_t)cs * 4096); const u32x4* np_ = (const u32x4*)(nbb + (size_t)cs * 4096);
#pragma unroll
            for (int q = 0; q < 8; ++q) v[q] = mp_[q * 64 + lane];
#pragma unroll
            for (int q = 0; q < 4; ++q) v[8 + q] = np_[q * 64 + lane];
            unsigned sp = 0; while ((int)flags[8] + 7 <= cs) { __builtin_amdgcn_s_sleep(1); if (++sp > (1u << 26)) break; }
#pragma unroll
            for (int q = 0; q < 12; ++q) *(LAS u32x4*)(slot + q * 1024 + lane * 16) = v[q];
            LDS_WAIT();
            if (lane == 0) flags[sl] = (unsigned)(cs + 1);
        }
        return;
    }
    f32x16 H[2];
#pragma unroll
    for (int m = 0; m < 2; ++m)
#pragma unroll
        for (int r = 0; r < 16; ++r) H[m][r] = 0.f;
    for (int cs = 0; cs < NCHUNK; ++cs) {
        const int sl = cs % 7; const LAS unsigned char* slot = lds + sl * RWB_SLOT;
        { unsigned sp = 0; while (flags[sl] != (unsigned)(cs + 1)) { __builtin_amdgcn_s_sleep(1); if (++sp > (1u << 26)) break; } }
        bf16x8 cm[2][2][2]; u32x4 cn[2][2];
#pragma unroll
        for (int m = 0; m < 2; ++m) {
#pragma unroll
            for (int mp = 0; mp < 2; ++mp)
#pragma unroll
                for (int q = 0; q < 2; ++q) cm[m][mp][q] = *(const LAS bf16x8*)(slot + ((m * 2 + mp) * 2 + q) * 1024 + lane * 16);
            cn[m][0] = *(const LAS u32x4*)(slot + 8192 + (m * 64 + lane) * 32); cn[m][1] = *(const LAS u32x4*)(slot + 8192 + (m * 64 + lane) * 32 + 16);
        }
        LDS_WAIT();
        if (lane == 0) flags[8] = (unsigned)(cs + 1);
        bf16x8 hb[2][2];
#pragma unroll
        for (int mp = 0; mp < 2; ++mp)
#pragma unroll
            for (int q = 0; q < 2; ++q) hb[mp][q] = acc_frag(H[mp], q);
        bf16_t* hf = nbb + (size_t)cs * 4096;
#pragma unroll
        for (int mp = 0; mp < 2; ++mp)
#pragma unroll
            for (int q = 0; q < 2; ++q) *(bf16x8*)(hf + (size_t)((mp * 2 + q) * 64 + lane) * 8) = hb[mp][q];
        f32x16 Hn[2];
#pragma unroll
        for (int m = 0; m < 2; ++m) {
#pragma unroll
            for (int e = 0; e < 4; ++e) { Hn[m][2 * e] = bflo(cn[m][0][e]); Hn[m][2 * e + 1] = bfhi(cn[m][0][e]); Hn[m][8 + 2 * e] = bflo(cn[m][1][e]); Hn[m][8 + 2 * e + 1] = bfhi(cn[m][1][e]); }
#pragma unroll
            for (int mp = 0; mp < 2; ++mp)
#pragma unroll
                for (int q = 0; q < 2; ++q) Hn[m] = MFMA32(cm[m][mp][q], hb[mp][q], Hn[m]);
        }
        H[0] = Hn[0]; H[1] = Hn[1];
    }
}

__device__ __forceinline__ void rwkv_stageC(const RWArgs& g, int head, int cr, int lane) {
    const int c = lane & 31, hh = lane >> 5, r = 32 * cr + c, t = r - CTXL;
    f32x16 o[2];
#pragma unroll
    for (int n = 0; n < 2; ++n)
#pragma unroll
        for (int q = 0; q < 16; ++q) o[n][q] = 0.f;
    bf16x8 qf[2][2][2], hf[2][2][2][2]; u32x4 ov[2][2][2];
#pragma unroll
    for (int dir = 0; dir < 2; ++dir) {
        const int cs = rw_scan_chunk(dir, cr);
        const bf16_t* qrow = g.QB + ((size_t)dir * T + r) * 1024 + head * 64;
        const bf16_t* hfb = g.NB + ((size_t)(dir * 16 + head) * NCHUNK + cs) * 4096;
        const bf16_t* ob = g.OB + ((size_t)((dir * 16 + head) * NCHUNK + cr)) * 2048;
#pragma unroll
        for (int mp = 0; mp < 2; ++mp)
#pragma unroll
            for (int q = 0; q < 2; ++q) { const u32x2 lo = *(const u32x2*)(qrow + 32 * mp + 16 * q + 4 * hh), hi = *(const u32x2*)(qrow + 32 * mp + 16 * q + 8 + 4 * hh);
                qf[dir][mp][q] = __builtin_bit_cast(bf16x8, ((u32x4){lo.x, lo.y, hi.x, hi.y})); }
#pragma unroll
        for (int n = 0; n < 2; ++n) {
            const u32x4* src = (const u32x4*)(ob + (size_t)(n * 64 + lane) * 16); ov[dir][n][0] = src[0]; ov[dir][n][1] = src[1];
#pragma unroll
            for (int mp = 0; mp < 2; ++mp)
#pragma unroll
                for (int q = 0; q < 2; ++q) hf[dir][n][mp][q] = *(const bf16x8*)(hfb + (size_t)n * 2048 + (size_t)((mp * 2 + q) * 64 + lane) * 8);
        }
    }
    const bf16_t* rp = g.RP + (size_t)r * 7168 + head * 64;
    u32x4 ra[4], ka[4], aa4[4];
#pragma unroll
    for (int q4 = 0; q4 < 4; ++q4) { ra[q4] = *(const u32x4*)(rp + 32 * hh + 8 * q4); ka[q4] = *(const u32x4*)(rp + 1024 + 32 * hh + 8 * q4); aa4[q4] = *(const u32x4*)(rp + 4096 + 32 * hh + 8 * q4); }
    __builtin_amdgcn_sched_barrier(0);
#pragma unroll
    for (int dir = 0; dir < 2; ++dir)
#pragma unroll
        for (int n = 0; n < 2; ++n) {
#pragma unroll
            for (int e = 0; e < 4; ++e) { o[n][2 * e] += bflo(ov[dir][n][0][e]); o[n][2 * e + 1] += bfhi(ov[dir][n][0][e]); o[n][8 + 2 * e] += bflo(ov[dir][n][1][e]); o[n][8 + 2 * e + 1] += bfhi(ov[dir][n][1][e]); }
#pragma unroll
            for (int mp = 0; mp < 2; ++mp)
#pragma unroll
                for (int q = 0; q < 2; ++q) o[n] = MFMA32(hf[dir][n][mp][q], qf[dir][mp][q], o[n]);
        }
    float sm = 0.f;
#pragma unroll
    for (int n = 0; n < 2; ++n)
#pragma unroll
        for (int q = 0; q < 16; ++q) sm += o[n][q];
    sm += __shfl_xor(sm, 32); const float mu = sm * (1.0f / 64.0f);
    float sv = 0.f;
#pragma unroll
    for (int n = 0; n < 2; ++n)
#pragma unroll
        for (int q = 0; q < 16; ++q) { const float d = o[n][q] - mu; sv += d * d; }
    sv += __shfl_xor(sv, 32); const float rs = __builtin_amdgcn_rsqf(sv * (1.0f / 64.0f) + 64e-5f);
    float bs = 0.f;
#pragma unroll
    for (int q4 = 0; q4 < 4; ++q4) { const float* rk = g.rk + head * 64 + 32 * hh + 8 * q4; const float* kac = g.ka + head * 64 + 32 * hh + 8 * q4;
#pragma unroll
        for (int e = 0; e < 4; ++e) { const float km0 = bflo(ka[q4][e]) * (1.0f + (bflo(aa4[q4][e]) - 1.0f) * kac[2 * e]), km1 = bfhi(ka[q4][e]) * (1.0f + (bfhi(aa4[q4][e]) - 1.0f) * kac[2 * e + 1]);
            bs = fmaf(bflo(ra[q4][e]) * km0, rk[2 * e], bs); bs = fmaf(bfhi(ra[q4][e]) * km1, rk[2 * e + 1], bs); } }
    bs += __shfl_xor(bs, 32);
#pragma unroll
    for (int n = 0; n < 2; ++n)
#pragma unroll
        for (int gq = 0; gq < 4; ++gq) {
            const int v0 = 32 * n + 8 * gq + 4 * hh, ch = head * 64 + v0;
            const u32x2 vv = *(const u32x2*)(rp + 2048 + v0), go = *(const u32x2*)(g.GOUT + (size_t)r * 1024 + ch);
            const f32x4 lw = *(const f32x4*)(g.lnw + ch), lb = *(const f32x4*)(g.lnb + ch);
            const float e0 = ((o[n][4 * gq] - mu) * rs * lw[0] + lb[0] + bs * bflo(vv.x)) * bflo(go.x), e1 = ((o[n][4 * gq + 1] - mu) * rs * lw[1] + lb[1] + bs * bfhi(vv.x)) * bfhi(go.x);
            const float e2 = ((o[n][4 * gq + 2] - mu) * rs * lw[2] + lb[2] + bs * bflo(vv.y)) * bflo(go.y), e3 = ((o[n][4 * gq + 3] - mu) * rs * lw[3] + lb[3] + bs * bfhi(vv.y)) * bfhi(go.y);
            u32x2 w; w.x = pk2(e0, e1); w.y = pk2(e2, e3);
            *(u32x2*)(g.mix + (size_t)t * D + 1024 + ch) = w;
        }
}
#undef BF

__device__ __forceinline__ void shifted4(const bf16_t* P, int r, int col, const float* mup, const float* mun, float (&o)[4]) {
    const u32x2 p = *(const u32x2*)(P + (size_t)r * N1 + col);
    u32x2 pv = (u32x2){0u, 0u}, nx = (u32x2){0u, 0u};
    if (!(r == 0 || r == CTXL)) pv = *(const u32x2*)(P + (size_t)(r - 1) * N1 + col);
    if (!(r == CTXL - 1 || r == T - 1)) nx = *(const u32x2*)(P + (size_t)(r + 1) * N1 + col);
    const f32x4 mp = *(const f32x4*)(mup + col - R_R), mn = *(const f32x4*)(mun + col - R_R);
    const float pc[4] = {bflo(p.x), bfhi(p.x), bflo(p.y), bfhi(p.y)}, pp[4] = {bflo(pv.x), bfhi(pv.x), bflo(pv.y), bfhi(pv.y)}, pn[4] = {bflo(nx.x), bfhi(nx.x), bflo(nx.y), bfhi(nx.y)};
#pragma unroll
    for (int e = 0; e < 4; ++e) o[e] = pc[e] + mp[e] * (pp[e] - pc[e]) + mn[e] * (pn[e] - pc[e]);
}
__device__ __forceinline__ void st4bf(bf16_t* p, float a0, float a1, float a2, float a3) { u32x2 w; w.x = pk2(a0, a1); w.y = pk2(a2, a3); *(u32x2*)p = w; }
__device__ __forceinline__ void rwkv_xfill(const Args& a, const bf16_t* P, bf16_t* XL, int gtid, int gthreads) {
    const float* mup = a.in[I_MUPREV]; const float* mun = a.in[I_MUNEXT];
    for (int idx = gtid; idx < T * 256; idx += gthreads) {
        const int row = idx >> 8, q = idx & 255, plane = q >> 6, col = (q & 63) * 4;
        float v[4] = {0.f, 0.f, 0.f, 0.f};
        if (plane == 3 || col < 96) {
            shifted4(P, row, R_WDF + (plane == 3 ? 288 : plane * 96) + col, mup, mun, v);
            if (plane < 2) { for (int e = 0; e < 4; ++e) v[e] = tanhf_(v[e]); }
            else if (plane == 3) { for (int e = 0; e < 4; ++e) v[e] = sigmoidf_(v[e]); }
        }
        st4bf(XL + ((size_t)plane * T + row) * 256 + col, v[0], v[1], v[2], v[3]);
    }
}
__device__ __forceinline__ void rwkv_rkv(const Args& a, const bf16_t* P, bf16_t* RP, int gw, int ngw, int lane) {
    const float* mup = a.in[I_MUPREV]; const float* mun = a.in[I_MUNEXT];
    for (int it = gw; it < T * 4; it += ngw) {
        const int r = it >> 2, ch = (it & 3) * 256 + 4 * lane;
        float x[4], k[4], y[4];
        shifted4(P, r, R_R + ch, mup, mun, x); shifted4(P, r, R_K + ch, mup, mun, k); shifted4(P, r, R_V + ch, mup, mun, y);
        bf16_t* rp = RP + (size_t)r * 7168;
        const f32x4 kkc = *(const f32x4*)(a.in[I_KK] + ch);
        float kq[4], ss = 0.f;
#pragma unroll
        for (int e = 0; e < 4; ++e) { kq[e] = k[e] * kkc[e]; ss += kq[e] * kq[e]; }
        ss += __shfl_xor(ss, 1); ss += __shfl_xor(ss, 2); ss += __shfl_xor(ss, 4); ss += __shfl_xor(ss, 8);
        const float rn = __builtin_amdgcn_rsqf(ss + 1e-12f);
        st4bf(rp + ch, x[0], x[1], x[2], x[3]);
        st4bf(rp + 1024 + ch, k[0], k[1], k[2], k[3]);
        st4bf(rp + 2048 + ch, y[0], y[1], y[2], y[3]);
        st4bf(rp + 3072 + ch, kq[0] * rn, kq[1] * rn, kq[2] * rn, kq[3] * rn);
    }
}

__device__ __forceinline__ void moe_tables(LAS unsigned char* lds, const int* blkcnt, int tid) {
    LAS int* tab = (LAS int*)(lds + MOE_TAB_OFF); LAS int* pref = (LAS int*)(lds + PREF_OFF);
    const int lane = tid & 63, e = tid >> 6;
    __syncthreads();
    int cnt[4], run = 0;
#pragma unroll
    for (int i = 0; i < 4; ++i) { cnt[i] = blkcnt[(4 * lane + i) * 8 + e]; run += cnt[i]; }
    int inc = run;
#pragma unroll
    for (int o = 1; o < 64; o <<= 1) { const int v = __shfl_up(inc, o); if (lane >= o) inc += v; }
    int ex = inc - run;
#pragma unroll
    for (int i = 0; i < 4; ++i) { pref[(4 * lane + i) * 8 + e] = ex; ex += cnt[i]; }
    if (lane == 63) tab[e] = inc;
    __syncthreads();
    int off = 0, np = 0, mye = -1;
#pragma unroll
    for (int x = 0; x < 8; ++x) { const int npe = (tab[x] + 255) >> 8; if (tid == 0) tab[8 + x] = off; if (tid >= np && tid < np + npe) mye = x; off += npe * 256; np += npe; }
    if (mye >= 0) tab[18 + tid] = mye;
    if (tid == 0) { tab[16] = off; tab[17] = np; }
    __syncthreads();
}

constexpr int NPH = 23;
__global__ void __launch_bounds__(NTHR, 2) trunk_fwd(Args a) {
    extern __shared__ __attribute__((aligned(16))) unsigned char lds_raw[];
    LAS unsigned char* lds = (LAS unsigned char*)lds_raw;
    const int tid = threadIdx.x, lane = tid & 63, wave = __builtin_amdgcn_readfirstlane(tid >> 6);
    const int bx = blockIdx.x, G = gridDim.x, gw = bx * NWAVES + wave, NGW = G * NWAVES;
    unsigned char* ws = a.ws;
    for (int u = tid; u < (LDS_BYTES - MISC_OFF) / 4; u += NTHR) ((LAS unsigned*)(lds + MISC_OFF))[u] = 0u;
    __syncthreads();
    const int lo = a.ph_lo, hi = a.ph_hi;
    XcdBarrier bar; bar.bar = (unsigned*)(ws + WS_CTL) + CW_BAR; bar.x = 0; bar.st = (volatile LAS unsigned*)(lds + MISC_OFF);
    if (hi - lo > 1) bar = xcd_barrier_post((unsigned*)(ws + WS_CTL) + CW_BAR, (volatile LAS unsigned*)(lds + MISC_OFF));
#ifdef ONLY_PHASE
#define IN(k) ((k) == ONLY_PHASE && lo <= (k) && (k) < hi)
#else
#define IN(k) (lo <= (k) && (k) < hi)
#endif
#define SEAM(k) do { if (IN(k) && IN((k) + 1)) xcd_barrier(bar); } while (0)
#define MODP(l, vec, which) (mod + (size_t)(((l) * 2 + (vec)) * 6 + (which)) * 2048)
    const float* mod = (const float*)(ws + WS_MOD);
    bf16_t* H = (bf16_t*)(ws + WS_H);
    bf16_t* XB = (bf16_t*)(ws + WS_XB);
    float* out = a.out;
    const size_t TS2048 = (size_t)256 * 2048 * 2;

    if (IN(0)) for (int rep_ = 0; rep_ <= (int)((REPMASK >> 0) & 1u); ++rep_) { if (rep_) __syncthreads(); p0_prologue(a, lds, tid, lane, wave); }
    SEAM(0);
    if (IN(1)) for (int rep_ = 0; rep_ <= (int)((REPMASK >> 1) & 1u); ++rep_) { if (rep_) __syncthreads();
        for (int r = gw; r < T; r += NGW) {
            const int vec = r < CTXL ? 1 : 0; const float* xin = vec ? a.in[I_CTX] + (size_t)r * D : a.in[I_X] + (size_t)(r - CTXL) * D;
            f32x4 v[8]; ldrow(xin, lane, v);
            mod_store_i8(v, a.in[I_NMIXPRE0], MODP(0, vec, 1), MODP(0, vec, 0), (signed char*)(ws + WS_H) + (size_t)r * D, (float*)(ws + WS_HSC) + r, lane);
        }
    }
    SEAM(1);
    if (IN(2)) for (int rep_ = 0; rep_ <= (int)((REPMASK >> 2) & 1u); ++rep_) { if (rep_) __syncthreads();
        pg8::SchedPlain S{(const char*)(ws + WS_H), (const char*)(ws + W_IN0T), 65, 21, G, bx, (size_t)256 * 2048, 5 * 65, (const char*)(ws + W_V0T), (const char*)(ws + WS_H), 65, 0};
        pg8::EpiBf16I8 E{(bf16_t*)(ws + A_PROJ0), N0, (bf16_t*)(ws + A_VT), T, (const float*)(ws + WS_HSC), (const float*)(ws + WS_QI0), (const float*)(ws + WS_QV0), (const float*)(ws + WS_HSC)};
        pg8::gemm_phase<pg8::EpiBf16I8, pg8::SchedPlain, true>(lds, 2048, S, E);
    }
    SEAM(2);
    const GLArgs g0{(const bf16_t*)(ws + A_PROJ0), (const bf16_t*)(ws + A_VT), (bf16_t*)(ws + A_KVT0), (float*)(ws + A_DEC0), (bf16_t*)(ws + A_MIX0), a.in[I_LBL], nullptr, nullptr, nullptr, nullptr, a.in[I_HNORM]};
    if (IN(3)) for (int rep_ = 0; rep_ <= (int)((REPMASK >> 3) & 1u); ++rep_) { if (rep_) __syncthreads();
        const float* ropetab = (const float*)(ws + WS_ROPE);
        for (int rq_ = 0; rq_ <= (int)((REPMASK >> 24) & 1u); ++rq_)
        for (int u = bx; u < 520; u += G) {
            const int kind = u < 512 ? 0 : 1, uu = u < 512 ? u : u - 512;
            attn_unit(lds, (const bf16_t*)(ws + A_PROJ0), (const bf16_t*)(ws + A_VT), (bf16_t*)(ws + A_MIX0), a.in[I_SINK], ropetab, kind, uu >> 1, uu & 1, tid);
        }
        for (int rq_ = 0; rq_ <= (int)((REPMASK >> 25) & 1u); ++rq_) gl_phaseA<0>(g0, lds, tid, bx, G);
    }
    SEAM(3);
    if (IN(4)) { gl_phaseB<0, 4>(g0, tid < 256 ? bx * 256 + tid : -1);
        if ((REPMASK >> 23) & 1u) { GLArgs gx = g0; gx.kvt = (bf16_t*)(ws + WS_A + 700 * MiB); gx.dec = (float*)(ws + WS_A + 965 * MiB); gl_phaseB<0, 4>(gx, tid < 256 ? bx * 256 + tid : -1); } }
    SEAM(4);
    if (IN(5)) for (int rep_ = 0; rep_ <= (int)((REPMASK >> 5) & 1u); ++rep_) { if (rep_) __syncthreads(); gl_phaseC<0>(g0, lds, tid, bx, G); }
    SEAM(5);
    if (IN(6)) for (int rep_ = 0; rep_ <= (int)((REPMASK >> 6) & 1u); ++rep_) { if (rep_) __syncthreads();
        pg8::SchedPlain S{(const char*)(ws + A_MIX0), (const char*)(ws + W_OUT0T), 64, 8, G, bx, TS2048, 0, nullptr, nullptr, 1, 1};
        pg8::EpiBf16 E{(bf16_t*)(ws + A_Y0), 2048, nullptr, 0};
        pg8::gemm_phase<pg8::EpiBf16, pg8::SchedPlain>(lds, 4096, S, E);
        pg8::SchedSplit S2{(const char*)(ws + A_MIX0), (const char*)(ws + W_OUT0T), 8, 8, G, bx, TS2048, (size_t)512};
        pg8::EpiF32 E2{(float*)(ws + A_PY0), 2048, (size_t)256 * 2048};
        pg8::gemm_phase<pg8::EpiF32, pg8::SchedSplit>(lds, 4096, S2, E2, 512 + (lo >> 20));
    }
    SEAM(6);
    if (IN(7)) for (int rep_ = 0; rep_ <= (int)((REPMASK >> 7) & 1u); ++rep_) { if (rep_) __syncthreads();
        const bf16_t* Y0 = (const bf16_t*)(ws + A_Y0);
        for (int r = gw; r < T; r += NGW) {
            const int vec = r < CTXL ? 1 : 0; const float* xin = vec ? a.in[I_CTX] + (size_t)r * D : a.in[I_X] + (size_t)(r - CTXL) * D;
            bf16_t* xo = XB + (size_t)r * D;
            f32x4 v[8], b[8]; ldrow(xin, lane, v);
            if (vec) { const float* pp = (const float*)(ws + A_PY0) + (size_t)r * D; ldrow(pp, lane, b);
                for (int ks = 1; ks < 8; ++ks) { f32x4 t2[8]; ldrow(pp + (size_t)ks * 256 * 2048, lane, t2);
#pragma unroll
                    for (int j = 0; j < 8; ++j) b[j] += t2[j]; } }
            else ldrow_bf(Y0 + (size_t)r * D, lane, b);
            add_branch(v, b, a.in[I_NMIXPOST0], MODP(0, vec, 2), lane); strow_bf(xo, lane, v);
            mod_store_i8(v, a.in[I_NFFNPRE0], MODP(0, vec, 4), MODP(0, vec, 3), (signed char*)(ws + WS_H) + (size_t)r * D, (float*)(ws + WS_HSC) + r, lane);
        }
    }
    SEAM(7);
    if (IN(8)) for (int rep_ = 0; rep_ <= (int)((REPMASK >> 8) & 1u); ++rep_) { if (rep_) __syncthreads();
        pg8::SchedPlain S{(const char*)(ws + WS_H), (const char*)(ws + W_GU0T), 65, 44, G, bx, (size_t)256 * 2048, 0, nullptr, nullptr, 1, 0};
        pg8::EpiSwigluI8 E{(bf16_t*)(ws + A_HID0), FF0, (const float*)(ws + WS_HSC), (const float*)(ws + WS_QS0), 0};
        pg8::gemm_phase<pg8::EpiSwigluI8, pg8::SchedPlain, true>(lds, 2048, S, E);
    }
    SEAM(8);
    if (IN(9)) for (int rep_ = 0; rep_ <= (int)((REPMASK >> 9) & 1u); ++rep_) { if (rep_) __syncthreads();
        pg8::SchedPlain S{(const char*)(ws + A_HID0), (const char*)(ws + W_DN0T), 64, 8, G, bx, (size_t)256 * FF0 * 2, 0, nullptr, nullptr, 1, 1};
        pg8::EpiBf16 E{(bf16_t*)(ws + A_F0), 2048, nullptr, 0};
        pg8::gemm_phase<pg8::EpiBf16, pg8::SchedPlain>(lds, 2 * FF0, S, E);
        pg8::SchedSplit S2{(const char*)(ws + A_HID0), (const char*)(ws + W_DN0T), 8, 22, G, bx, (size_t)256 * FF0 * 2, (size_t)512};
        pg8::EpiF32 E2{(float*)(ws + A_PF0), 2048, (size_t)256 * 2048};
        pg8::gemm_phase<pg8::EpiF32, pg8::SchedSplit>(lds, 2 * FF0, S2, E2, 512 + (lo >> 20));
    }
    SEAM(9);
    if (IN(10)) {
        const bf16_t* F0 = (const bf16_t*)(ws + A_F0);
        for (int r = gw; r < T; r += NGW) {
            const int vec = r < CTXL ? 1 : 0; bf16_t* xo = XB + (size_t)r * D;
            f32x4 v[8], b[8]; ldrow_bf(xo, lane, v);
            if (vec) { const float* pp = (const float*)(ws + A_PF0) + (size_t)r * D; ldrow(pp, lane, b);
                for (int ks = 1; ks < 22; ++ks) { f32x4 t2[8]; ldrow(pp + (size_t)ks * 256 * 2048, lane, t2);
#pragma unroll
                    for (int j = 0; j < 8; ++j) b[j] += t2[j]; } }
            else ldrow_bf(F0 + (size_t)r * D, lane, b);
            add_branch(v, b, a.in[I_NFFNPOST0], MODP(0, vec, 5), lane); strow_bf(xo, lane, v);
            mod_store_i8(v, a.in[I_NMIXPRE1], MODP(1, vec, 1), MODP(1, vec, 0), (signed char*)(ws + WS_H) + (size_t)r * D, (float*)(ws + WS_HSC) + r, lane);
        }
    }
    SEAM(10);
    if (IN(11)) for (int rep_ = 0; rep_ <= (int)((REPMASK >> 11) & 1u); ++rep_) { if (rep_) __syncthreads();
        pg8::SchedPlain S{(const char*)(ws + WS_H), (const char*)(ws + W_IN1T), 65, 23, G, bx, (size_t)256 * 2048, 4 * 65, (const char*)(ws + W_GV1T), (const char*)(ws + WS_H), 65, 0};
        pg8::EpiBf16I8 E{(bf16_t*)(ws + A_PROJ1), N1, (bf16_t*)(ws + A_GVT), T, (const float*)(ws + WS_HSC), (const float*)(ws + WS_QI1), (const float*)(ws + WS_QG1), (const float*)(ws + WS_HSC)};
        pg8::gemm_phase<pg8::EpiBf16I8, pg8::SchedPlain, true>(lds, 2048, S, E);
    }
    SEAM(11);
    const GLArgs g1{(const bf16_t*)(ws + A_PROJ1), (const bf16_t*)(ws + A_GVT), (bf16_t*)(ws + A_KVT1), (float*)(ws + A_DEC1), (bf16_t*)(ws + A_MIX1), nullptr, a.in[I_GUPF], a.in[I_GUPB], a.in[I_GBIASF], a.in[I_GBIASB], a.in[I_GLANORM]};
    const RWArgs rwa{(const bf16_t*)(ws + A_RP), (const bf16_t*)(ws + A_GOUT), (bf16_t*)(ws + A_MF), (bf16_t*)(ws + A_NB), (bf16_t*)(ws + A_QB), (bf16_t*)(ws + A_OB), (bf16_t*)(ws + A_MIX1), a.in[I_RK], a.in[I_LNW], a.in[I_LNB], a.in[I_KA]};
    if (IN(12)) for (int rep_ = 0; rep_ <= (int)((REPMASK >> 12) & 1u); ++rep_) { if (rep_) __syncthreads();
        rwkv_xfill(a, (const bf16_t*)(ws + A_PROJ1), (bf16_t*)(ws + A_XL), bx * NTHR + tid, G * NTHR);
        rwkv_rkv(a, (const bf16_t*)(ws + A_PROJ1), (bf16_t*)(ws + A_RP), gw, NGW, lane);
        gl_phaseA<1>(g1, lds, tid, bx, G);
    }
    SEAM(12);
    if (IN(13)) {
        pg8::SchedLora S{(const char*)(ws + A_XL), (const char*)(ws + WS_LORA4), (size_t)T * 512, G, bx};
        pg8::EpiLora E{(bf16_t*)(ws + A_RP), ((long)A_GOUT - (long)A_RP) / 2, (const float*)(ws + WS_LB)};
        pg8::gemm_phase<pg8::EpiLora, pg8::SchedLora>(lds, 512 + (lo >> 20), S, E);
    }
    SEAM(13);
    if (IN(14)) {
        volatile LAS int* ictr = (volatile LAS int*)(lds + MISC_OFF + 1600);
        if (tid == 0) *ictr = 0;
        __syncthreads();
        if (wave >= 4) gl_phaseB<1, 4>(g1, bx * 256 + (tid - 256));
        {
            const int nw = wave < 4 ? (wave == 0 ? 11 : 10) : 6, jb = wave < 4 ? wave : 40 + (wave - 4);
            for (int i = 0; i < nw; ++i) { const int j = (wave == 0 && i == 10) ? 64 : jb + 4 * i; rwkv_stageA(rwa, lds + wave * RW_WAVE_LDS, bx + 256 * j, lane); }
        }
    }
    SEAM(14);
    if (IN(15)) {
        if (bx < 64) rwkv_stageB(rwa, lds, bx, wave, lane);
        else for (int rq_ = 0; rq_ <= (int)((REPMASK >> 29) & 1u); ++rq_) gl_phaseC<1>(g1, lds, tid, bx - 64, G - 64);
    }
    SEAM(15);
    if (IN(16)) for (int rep_ = 0; rep_ <= (int)((REPMASK >> 15) & 1u); ++rep_) { if (rep_) __syncthreads();
        for (int it = gw; it < 16 * (NCHUNK - 8); it += NGW) rwkv_stageC(rwa, it & 15, 8 + (it >> 4), lane);
    }
    SEAM(16);
    if (IN(17)) for (int rep_ = 0; rep_ <= (int)((REPMASK >> 18) & 1u); ++rep_) { if (rep_) __syncthreads();
        pg8::SchedPlain S{(const char*)(ws + A_MIX1), (const char*)(ws + W_OUT1T), 64, 8, G, bx, TS2048, 0, nullptr, nullptr, 1, 0};
        pg8::EpiBf16 E{(bf16_t*)(ws + A_Y1), 2048, nullptr, 0};
        pg8::gemm_phase<pg8::EpiBf16, pg8::SchedPlain>(lds, 4096, S, E);
    }
    SEAM(17);
    int* tk_e = (int*)(ws + WS_TK); float* tk_w = (float*)(ws + WS_TK + 128 * 1024); int* tk_lr = (int*)(ws + WS_TK + 256 * 1024); int* tk_pos = (int*)(ws + WS_TK + 384 * 1024);
    int* blkcnt = (int*)(ws + WS_BLKCNT);
    if (IN(18)) {
        LAS int* ecnt = (LAS int*)(lds + ECNT_OFF);
        if (tid < 8) ecnt[tid] = 0;
        __syncthreads();
        const bf16_t* Y1 = (const bf16_t*)(ws + A_Y1); const float* router = a.in[I_ROUTER];
        for (int t = gw; t < SEQ; t += NGW) {
            f32x4 v[8], b[8]; ldrow_bf(XB + (size_t)(t + CTXL) * D, lane, v); ldrow_bf(Y1 + (size_t)t * D, lane, b);
            add_branch(v, b, a.in[I_NMIXPOST1], MODP(1, 0, 2), lane); strow_bf(XB + (size_t)(t + CTXL) * D, lane, v);
            mod_store(v, a.in[I_NFFNPRE1], MODP(1, 0, 4), MODP(1, 0, 3), H + (size_t)t * D, lane);
            float lg[8];
#pragma unroll
            for (int e = 0; e < 8; ++e) lg[e] = 0.f;
#pragma unroll
            for (int j = 0; j < 8; ++j)
#pragma unroll
                for (int q = 0; q < 4; ++q) { const float* rp = router + (size_t)(4 * lane + 256 * j + q) * 8; const f32x4 r0 = *(const f32x4*)rp, r1 = *(const f32x4*)(rp + 4); const float hv = v[j][q];
                    lg[0] = fmaf(hv, r0[0], lg[0]); lg[1] = fmaf(hv, r0[1], lg[1]); lg[2] = fmaf(hv, r0[2], lg[2]); lg[3] = fmaf(hv, r0[3], lg[3]);
                    lg[4] = fmaf(hv, r1[0], lg[4]); lg[5] = fmaf(hv, r1[1], lg[5]); lg[6] = fmaf(hv, r1[2], lg[6]); lg[7] = fmaf(hv, r1[3], lg[7]); }
#pragma unroll
            for (int e = 0; e < 8; ++e) lg[e] = wave_sum(lg[e]);
            int ea = 0; float va = lg[0];
#pragma unroll
            for (int e = 1; e < 8; ++e) if (lg[e] > va) { va = lg[e]; ea = e; }
            int eb = -1; float vb = -INFINITY;
#pragma unroll
            for (int e = 0; e < 8; ++e) if (e != ea && lg[e] > vb) { vb = lg[e]; eb = e; }
            if (eb < 0) eb = (ea + 1) & 7;
            const float wa = 1.0f / (1.0f + fexp(vb - va)), wb = 1.0f - wa;
            if (lane == 0) {
                const int la = __hip_atomic_fetch_add(ecnt + ea, 1, __ATOMIC_RELAXED, __HIP_MEMORY_SCOPE_WORKGROUP);
                const int lb = __hip_atomic_fetch_add(ecnt + eb, 1, __ATOMIC_RELAXED, __HIP_MEMORY_SCOPE_WORKGROUP);
                tk_e[2 * t] = ea; tk_e[2 * t + 1] = eb; tk_w[2 * t] = wa; tk_w[2 * t + 1] = wb; tk_lr[2 * t] = la; tk_lr[2 * t + 1] = lb;
            }
        }
        __syncthreads();
        if (tid < 8) blkcnt[bx * 8 + tid] = ecnt[tid];
    }
    SEAM(18);
    if (IN(19)) for (int rep_ = 0; rep_ <= (int)((REPMASK >> 20) & 1u); ++rep_) { if (rep_) __syncthreads();
        moe_tables(lds, blkcnt, tid);
        const LAS int* tab = (const LAS int*)(lds + MOE_TAB_OFF); const LAS int* pref = (const LAS int*)(lds + PREF_OFF);
        signed char* SORT = (signed char*)(ws + A_SORT); float* ssc = (float*)(ws + WS_SSC);
        for (int t = gw; t < SEQ; t += NGW) {
            const int b = (t % NGW) / NWAVES;
            const u32x4* src = (const u32x4*)(H + (size_t)t * D); u32x4 hv[4]; float mx = 0.f;
#pragma unroll
            for (int j = 0; j < 4; ++j) { hv[j] = src[lane + 64 * j];
#pragma unroll
                for (int e = 0; e < 4; ++e) mx = fmaxf(mx, fmaxf(fabsf(bflo(hv[j][e])), fabsf(bfhi(hv[j][e])))); }
#pragma unroll
            for (int o = 1; o < 64; o <<= 1) mx = fmaxf(mx, __shfl_xor(mx, o));
            const float inv = mx > 0.f ? 127.0f / mx : 0.f, scl = mx > 0.f ? mx * (1.0f / 127.0f) : 1.0f;
            u32x2 qv[4];
#pragma unroll
            for (int j = 0; j < 4; ++j) { unsigned pk[2];
#pragma unroll
                for (int hq = 0; hq < 2; ++hq) { const unsigned w0 = hv[j][2 * hq], w1 = hv[j][2 * hq + 1];
                    const int q0 = (int)__builtin_rintf(bflo(w0) * inv), q1 = (int)__builtin_rintf(bfhi(w0) * inv), q2 = (int)__builtin_rintf(bflo(w1) * inv), q3 = (int)__builtin_rintf(bfhi(w1) * inv);
                    pk[hq] = (unsigned)(q0 & 0xff) | ((unsigned)(q1 & 0xff) << 8) | ((unsigned)(q2 & 0xff) << 16) | ((unsigned)(q3 & 0xff) << 24); }
                qv[j] = (u32x2){pk[0], pk[1]}; }
#pragma unroll
            for (int sl = 0; sl < 2; ++sl) {
                const int e = tk_e[2 * t + sl], lr = tk_lr[2 * t + sl];
                const int pos = tab[8 + e] + pref[b * 8 + e] + lr;
                if (lane == 0) { tk_pos[2 * t + sl] = pos; ssc[pos] = scl; }
                u32x2* dst = (u32x2*)(SORT + (size_t)pos * D);
#pragma unroll
                for (int j = 0; j < 4; ++j) dst[lane + 64 * j] = qv[j];
            }
        }
    }
    SEAM(19);
    if (IN(20)) for (int rep_ = 0; rep_ <= (int)((REPMASK >> 21) & 1u); ++rep_) { if (rep_) __syncthreads();
        moe_tables(lds, blkcnt, tid);
        const LAS int* tab = (const LAS int*)(lds + MOE_TAB_OFF);
        pg8::SchedMoe S{(const char*)(ws + A_SORT), (const char*)(ws + W_MGUT), (size_t)14336 * 2048, tab[17], 56, G, bx, (size_t)256 * 2048, tab + 18};
        pg8::EpiSwigluI8 E{(bf16_t*)(ws + A_HID1), FFE, (const float*)(ws + WS_SSC), (const float*)(ws + WS_QSM), 14336};
        pg8::gemm_phase<pg8::EpiSwigluI8, pg8::SchedMoe, true>(lds, 2048, S, E);
    }
    SEAM(20);
    if (IN(21)) for (int rep_ = 0; rep_ <= (int)((REPMASK >> 22) & 1u); ++rep_) { if (rep_) __syncthreads();
        moe_tables(lds, blkcnt, tid);
        const LAS int* tab = (const LAS int*)(lds + MOE_TAB_OFF);
        const int nwg = tab[17] * 8, nfull = (nwg >> 8) << 8, rem = nwg - nfull;
        const int split = rem == 0 ? 1 : (rem * 8 <= 256 ? 8 : (rem * 4 <= 256 ? 4 : (rem * 2 <= 256 ? 2 : 1)));
        const size_t kslice = (size_t)(2 * FFE) / split;
        pg8::SchedMoeDown S{(const char*)(ws + A_HID1), (const char*)(ws + W_MDNT), (size_t)2048 * FFE * 2, split > 1 ? nfull : nwg, G, bx, (size_t)256 * FFE * 2, tab + 18, 0, 0, nfull, 0};
        pg8::EpiMoeDown E{(bf16_t*)(ws + A_YDN), (float*)(ws + A_PYD)};
        pg8::gemm_phase<pg8::EpiMoeDown, pg8::SchedMoeDown>(lds, 2 * FFE, S, E);
        if (split > 1) {
            pg8::SchedMoeDown S2{(const char*)(ws + A_HID1), (const char*)(ws + W_MDNT), (size_t)2048 * FFE * 2, 0, G, bx, (size_t)256 * FFE * 2, tab + 18, split, rem, nfull, kslice};
            pg8::gemm_phase<pg8::EpiMoeDown, pg8::SchedMoeDown>(lds, 2 * FFE, S2, E, (int)kslice);
        }
    }
    SEAM(21);
    if (IN(22)) {
        const bf16_t* YDN = (const bf16_t*)(ws + A_YDN); const float* PYD = (const float*)(ws + A_PYD);
        moe_tables(lds, blkcnt, tid);
        const LAS int* tab = (const LAS int*)(lds + MOE_TAB_OFF);
        const int nwg = tab[17] * 8, nfull = (nwg >> 8) << 8, rem = nwg - nfull, pfull = nfull >> 3;
        const int split = rem == 0 ? 1 : (rem * 8 <= 256 ? 8 : (rem * 4 <= 256 ? 4 : (rem * 2 <= 256 ? 2 : 1)));
        for (int t = gw; t < SEQ; t += NGW) {
            f32x4 v[8], b[8]; ldrow_bf(XB + (size_t)(t + CTXL) * D, lane, v);
            const int pa = tk_pos[2 * t], pb = tk_pos[2 * t + 1]; const float wa = tk_w[2 * t], wb = tk_w[2 * t + 1];
            if (split > 1 && ((pa >> 8) >= pfull || (pb >> 8) >= pfull)) {
#pragma unroll
                for (int j = 0; j < 8; ++j) b[j] = (f32x4){0.f, 0.f, 0.f, 0.f};
#pragma unroll 1
                for (int sl = 0; sl < 2; ++sl) { const int pos = sl ? pb : pa; const float w = sl ? wb : wa;
                    if ((pos >> 8) >= pfull) { for (int ks = 0; ks < split; ++ks) { f32x4 t2[8]; ldrow(PYD + ((size_t)(((pos >> 8) - pfull) * split + ks) * 256 + (pos & 255)) * 2048, lane, t2);
#pragma unroll
                            for (int j = 0; j < 8; ++j) b[j] += t2[j] * w; } }
                    else {
#pragma unroll
                        for (int j = 0; j < 8; ++j) { const u32x2 y = *(const u32x2*)(YDN + (size_t)pos * D + 4 * lane + 256 * j); b[j] += (f32x4){bflo(y.x), bfhi(y.x), bflo(y.y), bfhi(y.y)} * w; } } }
                add_branch(v, b, a.in[I_NFFNPOST1], MODP(1, 0, 5), lane); strow(out + (size_t)t * D, lane, v);
                continue;
            }
#pragma unroll
            for (int j = 0; j < 8; ++j) { const u32x2 ya = *(const u32x2*)(YDN + (size_t)pa * D + 4 * lane + 256 * j), yb = *(const u32x2*)(YDN + (size_t)pb * D + 4 * lane + 256 * j);
                b[j] = (f32x4){wa * bflo(ya.x) + wb * bflo(yb.x), wa * bfhi(ya.x) + wb * bfhi(yb.x), wa * bflo(ya.y) + wb * bflo(yb.y), wa * bfhi(ya.y) + wb * bfhi(yb.y)}; }
            add_branch(v, b, a.in[I_NFFNPOST1], MODP(1, 0, 5), lane); strow(out + (size_t)t * D, lane, v);
        }
    }
#undef IN
#undef SEAM
#undef MODP
}

extern "C" void kernel_launch(void* const* d_in, const int* in_sizes, int n_in, void* d_out, int out_size, void* d_ws, size_t ws_size, hipStream_t stream) {
    static int state = 0;
    if (state == 0) {
        state = -1;
        if (n_in != 49 || out_size != SEQ * D || ws_size < WS_END) { fprintf(stderr, "kernel_launch: unexpected shapes (n_in %d, out %d, ws %zu, need %zu)\n", n_in, out_size, ws_size, (size_t)WS_END); return; }
        if (hipFuncSetAttribute((const void*)trunk_fwd, hipFuncAttributeMaxDynamicSharedMemorySize, LDS_BYTES) != hipSuccess) { fprintf(stderr, "kernel_launch: hipFuncSetAttribute failed\n"); return; }
        int per_cu = 0; (void)hipOccupancyMaxActiveBlocksPerMultiprocessor(&per_cu, (const void*)trunk_fwd, NTHR, LDS_BYTES); (void)hipGetLastError();
        if (per_cu < 1) fprintf(stderr, "kernel_launch: occupancy query says %d\n", per_cu);
        state = 1;
    }
    if (state < 0) return;
    (void)hipMemsetAsync((char*)d_ws + WS_CTL, 0, CTL_ZERO_BYTES, stream);
    Args a{};
    for (int i = 0; i < 49; ++i) a.in[i] = (const float*)d_in[i];
    a.out = (float*)d_out; a.ws = (unsigned char*)d_ws;
    const int grid = 256;
#if N_LAUNCH_MODE == 0
    for (int ph = 0; ph < NPH; ++ph) { a.ph_lo = ph; a.ph_hi = ph + 1; hipLaunchKernelGGL(trunk_fwd, dim3(grid), dim3(NTHR), LDS_BYTES, stream, a); }
#else
    a.ph_lo = 0; a.ph_hi = NPH; hipLaunchKernelGGL(trunk_fwd, dim3(grid), dim3(NTHR), LDS_BYTES, stream, a);
#endif
}
```

```cpp
#include <hip/hip_runtime.h>
#include <cstdio>
#include <cstdint>

#define LAS __attribute__((address_space(3)))
#define GAS __attribute__((address_space(1)))
typedef unsigned short bf16_t;
typedef short bf16x8 __attribute__((ext_vector_type(8)));
typedef float f32x4 __attribute__((ext_vector_type(4)));
typedef float f32x2 __attribute__((ext_vector_type(2)));
typedef float f32x16 __attribute__((ext_vector_type(16)));
typedef unsigned u32x4 __attribute__((ext_vector_type(4)));
typedef unsigned u32x2 __attribute__((ext_vector_type(2)));

#ifndef REPMASK
#define REPMASK 0u
#endif
#ifndef N_LAUNCH_MODE
#define N_LAUNCH_MODE 1
#endif

constexpr int D = 2048, SEQ = 16384, CTXL = 256, T = SEQ + CTXL;
constexpr int NWAVES = 8, NTHR = 512;
constexpr float NORM_EPS = 1e-6f;
constexpr int N0 = 5376, P0_QA = 0, P0_KA = 1024, P0_QH = 1280, P0_FF = 2304, P0_FB = 3328, P0_GH = 4352;
constexpr int VT_ROWS = 1280;
constexpr int N1 = 5888, G_Q = 0, G_K = 512, G_GDF = 1024, G_GDB = 1040, G_GR = 1056;
constexpr int R_R = 2080, R_K = 3104, R_V = 4128, R_WDF = 5152, R_WDB = 5248, R_AD = 5344, R_GD = 5440;
constexpr int FF0 = 5632, FFE = 7168, NE = 8;
constexpr int MOE_ROWS = 2 * SEQ + NE * 256;
constexpr int MOE_MAXPAN = MOE_ROWS / 256;
constexpr int NCHUNK = T / 32;

constexpr size_t MiB = (size_t)1 << 20;
constexpr size_t WS_CTL = 0, CTL_ZERO_BYTES = 1 * MiB;
constexpr size_t WS_MOD = 1 * MiB;
constexpr size_t WS_ROPE = WS_MOD + 256 * 1024;
constexpr size_t WS_BLKCNT = WS_ROPE + 128 * 1024;
constexpr size_t WS_TK = 2 * MiB;
constexpr size_t WS_XC = 4 * MiB;
constexpr size_t WS_LORA = 6 * MiB;
constexpr size_t WS_QS0 = WS_LORA + 1280 * 1024;
constexpr size_t WS_QSM = WS_QS0 + 64 * 1024;
constexpr size_t WS_QI0 = WS_TK + 512 * 1024;
constexpr size_t WS_QV0 = WS_QI0 + 32 * 1024;
constexpr size_t WS_QI1 = WS_QV0 + 8 * 1024;
constexpr size_t WS_QG1 = WS_QI1 + 32 * 1024;
constexpr size_t WS_LB = WS_QG1 + 8 * 1024;
constexpr size_t WS_HSC = WS_TK + 1024 * 1024;
constexpr size_t WS_SSC = WS_HSC + 128 * 1024;
constexpr size_t WS_W = 8 * MiB;
constexpr size_t W_IN0T = WS_W;
constexpr size_t W_V0T = W_IN0T + 21 * MiB;
constexpr size_t W_OUT0T = W_V0T + 5 * MiB;
constexpr size_t W_GU0T = W_OUT0T + 8 * MiB;
constexpr size_t W_DN0T = W_GU0T + 44 * MiB;
constexpr size_t W_IN1T = W_DN0T + 22 * MiB;
constexpr size_t W_GV1T = W_IN1T + 23 * MiB;
constexpr size_t W_OUT1T = W_GV1T + 4 * MiB;
constexpr size_t W_MGUT = W_OUT1T + 8 * MiB;
constexpr size_t W_MDNT = W_MGUT + 448 * MiB;
constexpr size_t WS_LORA4 = W_GU0T + 22 * MiB;
constexpr size_t WS_XB = W_MGUT + 224 * MiB;
constexpr size_t WS_H = W_MDNT + 224 * MiB;
constexpr size_t WS_A = WS_H + 66 * MiB;
constexpr size_t A_PROJ0 = WS_A;
constexpr size_t A_VT = WS_A + 171 * MiB;
constexpr size_t A_MIX0 = WS_A + 212 * MiB;
constexpr size_t A_KVT0 = WS_A + 277 * MiB;
constexpr size_t A_DEC0 = WS_A + 537 * MiB;
constexpr size_t A_Y0 = WS_A + 542 * MiB;
constexpr size_t A_PY0 = WS_A + 672 * MiB;
constexpr size_t A_PF0 = WS_A + 690 * MiB;
constexpr size_t A_HID0 = WS_A;
constexpr size_t A_F0 = WS_A + 179 * MiB;
static_assert(A_HID0 + (size_t)T * FF0 * 2 <= A_F0 && A_F0 + (size_t)T * 2048 * 4 <= A_Y0, "layer-0 overlays");
constexpr size_t A_PROJ1 = WS_A;
constexpr size_t A_GVT = WS_A + 187 * MiB;
constexpr size_t A_RP = WS_A + 220 * MiB;
constexpr size_t A_KVT1 = WS_A + 448 * MiB;
constexpr size_t A_DEC1 = WS_A + 708 * MiB;
constexpr size_t A_MF = WS_A + 711 * MiB;
constexpr size_t A_XL = A_MF;
constexpr size_t A_NB = WS_A + 841 * MiB;
constexpr size_t A_MIX1 = WS_A + 971 * MiB;
constexpr size_t A_QB = W_IN0T;
constexpr size_t A_GOUT = W_IN0T + 65 * MiB;
constexpr size_t A_OB = WS_H;
constexpr size_t A_Y1 = WS_A;
constexpr size_t A_SORT = WS_A + 128 * MiB;
constexpr size_t A_HID1 = WS_A + 264 * MiB;
constexpr size_t A_YDN = WS_A + 740 * MiB;
constexpr size_t A_PYD = WS_A + 880 * MiB;
constexpr size_t WS_END = WS_A + 1035 * MiB;
static_assert(A_YDN + (size_t)MOE_ROWS * 2048 * 2 <= A_PYD && A_PYD + (size_t)32 * 256 * 2048 * 4 <= A_MIX1, "moe partials");
static_assert(A_SORT + (size_t)MOE_ROWS * 2048 * 2 <= A_HID1 && A_HID1 + (size_t)MOE_ROWS * FFE * 2 <= A_YDN && A_YDN + (size_t)MOE_ROWS * 2048 * 2 <= A_MIX1, "moe overlay");
static_assert(A_PROJ1 + (size_t)T * N1 * 2 <= A_GVT && A_GVT + (size_t)1024 * T * 2 <= A_RP && A_RP + (size_t)T * 7168 * 2 <= A_KVT1 && A_KVT1 + (size_t)2 * 4 * 520 * 256 * 128 * 2 <= A_DEC1, "layer-1 map");
static_assert(A_MF + (size_t)2 * 16 * 520 * 8192 <= A_NB && A_NB + (size_t)2 * 16 * 520 * 8192 <= A_MIX1 && A_MIX1 + (size_t)SEQ * 2048 * 2 <= WS_END, "layer-1 map 2");
static_assert(A_GOUT + (size_t)T * 1024 * 2 <= W_OUT1T && A_QB + (size_t)2 * T * 1024 * 2 <= A_GOUT && A_OB + (size_t)2 * 16 * 520 * 4096 <= WS_A, "overlays on dead weights / h");
static_assert(A_PROJ0 + (size_t)T * N0 * 2 <= A_VT && A_VT + (size_t)VT_ROWS * T * 2 <= A_MIX0 && A_KVT0 + (size_t)2 * 8 * 520 * 128 * 128 * 2 <= A_DEC0, "layer-0 map");
constexpr int CW_BAR = 4096;

constexpr int LDS_BYTES = 147456;
constexpr int MISC_OFF = 135168;
constexpr int MOE_TAB_OFF = MISC_OFF + 64, ECNT_OFF = MISC_OFF + 1024, PREF_OFF = MISC_OFF + 2048;

__device__ __forceinline__ float bf2f(unsigned b) { return __uint_as_float(b << 16); }
__device__ __forceinline__ float bflo(unsigned w) { return __uint_as_float(w << 16); }
__device__ __forceinline__ float bfhi(unsigned w) { return __uint_as_float(w & 0xffff0000u); }
typedef __bf16 bf16x2_t __attribute__((ext_vector_type(2)));
__device__ __forceinline__ unsigned pk2(float lo, float hi) { const f32x2 v = {lo, hi}; const bf16x2_t b = __builtin_convertvector(v, bf16x2_t); return __builtin_bit_cast(unsigned, b); }
__device__ __forceinline__ unsigned f2bf(float f) { return pk2(f, 0.f) & 0xffffu; }
__device__ __forceinline__ float wave_sum(float v) {
#pragma unroll
    for (int o = 1; o < 64; o <<= 1) v += __shfl_xor(v, o);
    return v;
}
__device__ __forceinline__ float fexp2(float x) { return __builtin_amdgcn_exp2f(x); }
__device__ __forceinline__ float fexp(float x) { return __builtin_amdgcn_exp2f(x * 1.4426950408889634f); }
__device__ __forceinline__ float sigmoidf_(float x) { return __builtin_amdgcn_rcpf(1.0f + fexp(-x)); }
__device__ __forceinline__ float siluf_(float x) { return x * __builtin_amdgcn_rcpf(1.0f + fexp(-x)); }
__device__ __forceinline__ float tanhf_(float x) { return 1.0f - 2.0f * __builtin_amdgcn_rcpf(1.0f + fexp(2.0f * x)); }
#define LDS_WAIT() asm volatile("s_waitcnt lgkmcnt(0)" ::: "memory")
#define VM_WAIT() asm volatile("s_waitcnt vmcnt(0)" ::: "memory")

#define XB_TMO      128
#define XB_XCNT(j)  (256  + 64 * (j))
#define XB_XSUB(j)  (1280 + 64 * (j))
#define XB_XGEN(j)  (2304 + 64 * (j))
#define XB_TOP      3328
#define XB_TOPGEN   3392
#define XCD_BAR_WORDS 3456
#define XB_SPIN_CAP (1u << 24)
__device__ __forceinline__ unsigned xb_ld(unsigned* p)              { return __hip_atomic_load(p, __ATOMIC_RELAXED, __HIP_MEMORY_SCOPE_AGENT); }
__device__ __forceinline__ unsigned xb_add(unsigned* p, unsigned v) { return __hip_atomic_fetch_add(p, v, __ATOMIC_RELAXED, __HIP_MEMORY_SCOPE_AGENT); }
__device__ __forceinline__ unsigned xb_xcc_id() { return (unsigned)__builtin_amdgcn_s_getreg((3 << 11) | 20) & 0xFu; }
#define XB_SPIN(cond, bar) do { unsigned _sp = 0; while (cond) { __builtin_amdgcn_s_sleep(1); \
    if ((++_sp & 255u) == 0u) { if (xb_ld(&(bar)[XB_TMO])) break; if (_sp > XB_SPIN_CAP) { atomicAdd(&(bar)[XB_TMO], 1u); break; } } } } while (0)
struct XcdBarrier { unsigned* bar; unsigned x; volatile LAS unsigned* st; };
__device__ __forceinline__ XcdBarrier xcd_barrier_post(unsigned* bar, volatile LAS unsigned* st) {
    XcdBarrier b; b.bar = bar; b.x = xb_xcc_id(); b.st = st;
    if (threadIdx.x == 0) (void)xb_add(&bar[XB_XCNT(b.x)], 1u);
    return b;
}
__device__ __forceinline__ void xcd_barrier_complete(unsigned* bar, unsigned x, unsigned& nloc, unsigned& nx) {
    const unsigned G = gridDim.x * gridDim.y * gridDim.z;
    unsigned sum, cnt, mine, sp = 0u;
    for (;;) {
        sum = 0u; cnt = 0u; mine = 0u;
#pragma unroll
        for (unsigned j = 0; j < 16; ++j) { const unsigned c = xb_ld(&bar[XB_XCNT(j)]); sum += c; cnt += (c > 0u) ? 1u : 0u; mine = (j == x) ? c : mine; }
        if (sum == G) break;
        __builtin_amdgcn_s_sleep(1);
        if ((++sp & 255u) == 0u) { if (xb_ld(&bar[XB_TMO])) break; if (sp > XB_SPIN_CAP) { atomicAdd(&bar[XB_TMO], 1u); break; } }
    }
    nloc = mine > 0u ? mine : 1u; nx = cnt > 0u ? cnt : 1u;
}
__device__ __forceinline__ void xcd_barrier(const XcdBarrier& b) {
    asm volatile("s_waitcnt vmcnt(0)" ::: "memory");
    __syncthreads();
    if (threadIdx.x == 0) {
        unsigned* bar = b.bar;
        __builtin_amdgcn_s_waitcnt(0);
        unsigned nloc = b.st[0], nx = b.st[1];
        if (nloc == 0u) { xcd_barrier_complete(bar, b.x, nloc, nx); b.st[0] = nloc; b.st[1] = nx; }
        const unsigned old = xb_add(&bar[XB_XSUB(b.x)], 1u);
        const unsigned gen = old / nloc;
        if (old + 1u == (gen + 1u) * nloc) {
            __builtin_amdgcn_fence(__ATOMIC_RELEASE, "agent");
            asm volatile("s_waitcnt vmcnt(0)" ::: "memory");
            const unsigned og = xb_add(&bar[XB_TOP], 1u);
            const unsigned tg = og / nx;
            if (og + 1u == (tg + 1u) * nx) xb_add(&bar[XB_TOPGEN], 1u);
            else XB_SPIN(xb_ld(&bar[XB_TOPGEN]) == tg, bar);
            __builtin_amdgcn_fence(__ATOMIC_ACQUIRE, "agent");
            xb_add(&bar[XB_XGEN(b.x)], 1u);
            asm volatile("s_waitcnt vmcnt(0)" ::: "memory");
        } else {
            XB_SPIN(xb_ld(&bar[XB_XGEN(b.x)]) == gen, bar);
            __builtin_amdgcn_fence(__ATOMIC_ACQUIRE, "agent");
            asm volatile("s_waitcnt vmcnt(0)" ::: "memory");
        }
    }
    __syncthreads();
}

namespace pg8 {
constexpr int BM = 256, BK = 64, HALF = 128, HTB = HALF * BK * 2, STAGE_BYTES = 8 * HTB, NXCD = 8, WGM = 8;
__host__ __device__ __forceinline__ int lds_byte(int r, int c) { const int st = (r >> 4) * 2 + (c >> 5), rr = r & 15, cc = c & 31, ob = rr * 64 + cc * 2; return st * 1024 + (ob ^ (((ob >> 9) & 1) << 5)); }
__host__ __device__ __forceinline__ void stage_rc(int b, int& R, int& C) { const int st = b / 1024, sb = b % 1024, swz = sb ^ (((sb >> 9) & 1) << 5); R = (st >> 1) * 16 + swz / 64; C = (st & 1) * 32 + (swz % 64) / 2; }
__host__ __device__ __forceinline__ int perm32(int rho) { const int n = rho >> 4, i = rho & 15; return 8 * (i >> 2) + 4 * n + (i & 3); }

struct Unit { int pm, pn; const char* a; const char* b; int aux; };

__device__ __forceinline__ void order_map(int wgid, int nM, int nN, int& pm, int& pn) {
    const int nwg = nM * nN;
    { const int q = nwg / NXCD, r = nwg % NXCD, xcd = wgid % NXCD, off = wgid / NXCD; wgid = (xcd < r ? xcd * (q + 1) : r * (q + 1) + (xcd - r) * q) + off; }
    const int nig = WGM * nN, gid = wgid / nig, fm = gid * WGM, gsz = (nM - fm) < WGM ? (nM - fm) : WGM;
    pm = fm + ((wgid % nig) % gsz); pn = (wgid % nig) / gsz;
}
struct SchedPlain {
    const char* A; const char* Bt; int nM, nN, G, c; size_t tstep; int nextra; const char* A2; const char* B2; int nN2; int pm0;
    __device__ __forceinline__ bool next(int i, Unit& u) const {
        const long L = (long)i * G + c; const int nwg = nM * nN;
        if (L >= nwg + nextra) return false;
        if (L >= nwg) { const int j = (int)L - nwg, pm2 = j / nN2, pn2 = j - pm2 * nN2; u.pm = pm2; u.pn = pn2; u.a = A2 + (size_t)pm2 * tstep; u.b = B2 + (size_t)pn2 * tstep; u.aux = 1; return true; }
        int pm, pn; order_map((int)L, nM, nN, pm, pn);
        u.pm = pm + pm0; u.pn = pn; u.a = A + (size_t)(pm + pm0) * tstep; u.b = Bt + (size_t)pn * tstep; u.aux = 0; return true;
    }
};
struct SchedSplit {
    const char* A; const char* Bt; int nN, nsplit, G, c; size_t tstep, kslice;
    __device__ __forceinline__ bool next(int i, Unit& u) const {
        const long L = (long)i * G + c; if (L >= (long)nN * nsplit) return false;
        const int pn = (int)L % nN, ks = (int)L / nN;
        u.pm = 0; u.pn = pn; u.a = A + (size_t)ks * kslice; u.b = Bt + (size_t)pn * tstep + (size_t)ks * kslice; u.aux = ks; return true;
    }
};
struct SchedMoe {
    const char* A; const char* Wt; size_t wstride; int nM, nN, G, c; size_t tstep; const LAS int* pexp;
    __device__ __forceinline__ bool next(int i, Unit& u) const {
        const long L = (long)i * G + c; const int nwg = nM * nN;
        if (L >= nwg) return false;
        int pm, pn; order_map((int)L, nM, nN, pm, pn);
        const int e = pexp[pm];
        u.pm = pm; u.pn = pn; u.a = A + (size_t)pm * tstep; u.b = Wt + (size_t)e * wstride + (size_t)pn * tstep; u.aux = e; return true;
    }
};

struct SchedLora {
    const char* X; const char* Wt; size_t plane; int G, c;
    __device__ __forceinline__ bool next(int i, Unit& u) const {
        const long L = (long)i * G + c; if (L >= 65 * 16) return false;
        int pm, pn; order_map((int)L, 65, 16, pm, pn);
        u.pm = pm; u.pn = pn; u.a = X + (size_t)(pn >> 2) * plane + (size_t)pm * 131072; u.b = Wt + (size_t)pn * 131072; u.aux = pn >> 2; return true;
    }
};
struct SchedMoeDown {
    const char* A; const char* Wt; size_t wstride; int nunits, G, c; size_t tstep; const LAS int* pexp; int split, rem, nfull; size_t kslice;
    __device__ __forceinline__ bool next(int i, Unit& u) const {
        const long L = (long)i * G + c; int Lb = 0, ks = 0;
        int pm, pn;
        if (split == 0) { if (L >= nunits) return false; order_map((int)L, nunits >> 3, 8, pm, pn); }
        else { if (L >= (long)rem * split) return false; Lb = nfull + (int)(L % rem); ks = (int)(L / rem); pm = Lb >> 3; pn = Lb & 7; }
        const int e = pexp[pm];
        u.pm = pm; u.pn = pn; u.a = A + (size_t)pm * tstep + (size_t)ks * kslice; u.b = Wt + (size_t)e * wstride + (size_t)pn * tstep + (size_t)ks * kslice;
        u.aux = split == 0 ? -1 : ((pm - (nfull >> 3)) * split + ks); return true;
    }
};
__device__ __forceinline__ unsigned cvt_pk_bf16(float lo, float hi) { unsigned r; asm volatile("v_cvt_pk_bf16_f32 %0, %1, %2" : "=v"(r) : "v"(lo), "v"(hi)); return r; }
struct EpiBf16 {
    static constexpr bool PERM = true;
    struct Pre {}; __device__ __forceinline__ void prefetch(const Unit&, int, int, int, int, Pre&) const {}
    bf16_t* O; int ldc; bf16_t* O1; int ldc1;
    __device__ __forceinline__ void operator()(const f32x4 (&acc)[2][2][4][2], const Unit& u, int wr, int wc, int fr, int fq, const Pre&) const {
        bf16_t* base = (u.aux == 1 && O1) ? O1 : O; const int ld = (u.aux == 1 && O1) ? ldc1 : ldc;
        const int row0 = u.pm * BM + wr * 64 + fr, col0 = u.pn * BM + wc * 32 + 8 * fq;
#pragma unroll
        for (int ai = 0; ai < 2; ++ai)
#pragma unroll
            for (int m = 0; m < 4; ++m) { bf16_t* rowp = base + (size_t)(row0 + ai * HALF + m * 16) * ld + col0;
#pragma unroll
                for (int bj = 0; bj < 2; ++bj) { const f32x4 v0 = acc[ai][bj][m][0], v1 = acc[ai][bj][m][1];
                    u32x4 w; w.x = cvt_pk_bf16(v0[0], v0[1]); w.y = cvt_pk_bf16(v0[2], v0[3]); w.z = cvt_pk_bf16(v1[0], v1[1]); w.w = cvt_pk_bf16(v1[2], v1[3]);
                    *(u32x4*)(rowp + bj * HALF) = w; } }
    }
};
struct EpiLora {
    static constexpr bool PERM = true;
    struct Pre {}; __device__ __forceinline__ void prefetch(const Unit&, int, int, int, int, Pre&) const {}
    bf16_t* RP; long gdelta; const float* bias3;
    __device__ __forceinline__ void operator()(const f32x4 (&acc)[2][2][4][2], const Unit& u, int wr, int wc, int fr, int fq, const Pre&) const {
        const int kind = u.aux, row0 = u.pm * BM + wr * 64 + fr, ch0 = (u.pn & 3) * BM + wc * 32 + 8 * fq;
        const float* bias = bias3 + (kind < 3 ? kind : 0) * 1024;
        const long poff = kind == 3 ? gdelta : (kind == 0 ? 5120 : (kind == 1 ? 6144 : 4096)); const int ld = kind == 3 ? 1024 : 7168;
        bf16_t* base = RP + poff;
        const float sc = kind < 2 ? -0.6065306597126334f : 1.0f;
        f32x4 bv[2][2];
#pragma unroll
        for (int bj = 0; bj < 2; ++bj)
#pragma unroll
            for (int n = 0; n < 2; ++n) { bv[bj][n] = *(const f32x4*)(bias + ch0 + bj * HALF + 4 * n); if (kind == 3) bv[bj][n] = (f32x4){0.f, 0.f, 0.f, 0.f}; }
#pragma unroll
        for (int ai = 0; ai < 2; ++ai)
#pragma unroll
            for (int m = 0; m < 4; ++m) { bf16_t* rowp = base + (size_t)(row0 + ai * HALF + m * 16) * ld + ch0;
#pragma unroll
                for (int bj = 0; bj < 2; ++bj) { f32x4 v0 = acc[ai][bj][m][0] + bv[bj][0], v1 = acc[ai][bj][m][1] + bv[bj][1];
                    if (kind != 3) {
#pragma unroll
                        for (int j = 0; j < 4; ++j) { v0[j] = sc * __builtin_amdgcn_rcpf(1.0f + __builtin_amdgcn_exp2f(-1.4426950408889634f * v0[j])); v1[j] = sc * __builtin_amdgcn_rcpf(1.0f + __builtin_amdgcn_exp2f(-1.4426950408889634f * v1[j])); } }
                    u32x4 w; w.x = cvt_pk_bf16(v0[0], v0[1]); w.y = cvt_pk_bf16(v0[2], v0[3]); w.z = cvt_pk_bf16(v1[0], v1[1]); w.w = cvt_pk_bf16(v1[2], v1[3]);
                    *(u32x4*)(rowp + bj * HALF) = w; } }
    }
};
struct EpiMoeDown {
    static constexpr bool PERM = true;
    struct Pre {}; __device__ __forceinline__ void prefetch(const Unit&, int, int, int, int, Pre&) const {}
    bf16_t* O; float* P;
    __device__ __forceinline__ void operator()(const f32x4 (&acc)[2][2][4][2], const Unit& u, int wr, int wc, int fr, int fq, const Pre&) const {
        const int rin0 = wr * 64 + fr, col0 = u.pn * BM + wc * 32 + 8 * fq;
        if (u.aux < 0) {
            bf16_t* base = O + (size_t)(u.pm * BM + rin0) * 2048 + col0;
#pragma unroll
            for (int ai = 0; ai < 2; ++ai)
#pragma unroll
                for (int m = 0; m < 4; ++m) { bf16_t* rowp = base + (size_t)(ai * HALF + m * 16) * 2048;
#pragma unroll
                    for (int bj = 0; bj < 2; ++bj) { const f32x4 v0 = acc[ai][bj][m][0], v1 = acc[ai][bj][m][1];
                        u32x4 w; w.x = cvt_pk_bf16(v0[0], v0[1]); w.y = cvt_pk_bf16(v0[2], v0[3]); w.z = cvt_pk_bf16(v1[0], v1[1]); w.w = cvt_pk_bf16(v1[2], v1[3]);
                        *(u32x4*)(rowp + bj * HALF) = w; } }
        } else {
            float* base = P + ((size_t)u.aux * 256 + rin0) * 2048 + col0;
#pragma unroll
            for (int ai = 0; ai < 2; ++ai)
#pragma unroll
                for (int m = 0; m < 4; ++m) { float* rowp = base + (size_t)(ai * HALF + m * 16) * 2048;
#pragma unroll
                    for (int bj = 0; bj < 2; ++bj) { *(f32x4*)(rowp + bj * HALF) = acc[ai][bj][m][0]; *(f32x4*)(rowp + bj * HALF + 4) = acc[ai][bj][m][1]; } }
        }
    }
};
struct EpiF32 {
    static constexpr bool PERM = false;
    struct Pre {}; __device__ __forceinline__ void prefetch(const Unit&, int, int, int, int, Pre&) const {}
    float* C; int ldc; size_t astride;
    __device__ __forceinline__ void operator()(const f32x4 (&acc)[2][2][4][2], const Unit& u, int wr, int wc, int fr, int fq, const Pre&) const {
        const int row0 = u.pm * BM + wr * 64 + fr, col0 = u.pn * BM + wc * 32 + 4 * fq; float* C = this->C + (size_t)u.aux * astride;
#pragma unroll
        for (int ai = 0; ai < 2; ++ai)
#pragma unroll
            for (int m = 0; m < 4; ++m) { float* rowp = C + (size_t)(row0 + ai * HALF + m * 16) * ldc + col0;
#pragma unroll
                for (int bj = 0; bj < 2; ++bj)
#pragma unroll
                    for (int n = 0; n < 2; ++n) *(f32x4*)(rowp + bj * HALF + n * 16) = acc[ai][bj][m][n]; }
    }
};
struct EpiSwiglu {
    static constexpr bool PERM = true;
    struct Pre {}; __device__ __forceinline__ void prefetch(const Unit&, int, int, int, int, Pre&) const {}
    bf16_t* O; int ldc;
    __device__ __forceinline__ void operator()(const f32x4 (&acc)[2][2][4][2], const Unit& u, int wr, int wc, int fr, int fq, const Pre&) const {
        const int row0 = u.pm * BM + wr * 64 + fr, col0 = u.pn * HALF + wc * 32 + 8 * fq;
#pragma unroll
        for (int ai = 0; ai < 2; ++ai)
#pragma unroll
            for (int m = 0; m < 4; ++m) { bf16_t* rowp = O + (size_t)(row0 + ai * HALF + m * 16) * ldc + col0;
                float o[8];
#pragma unroll
                for (int n = 0; n < 2; ++n)
#pragma unroll
                    for (int j = 0; j < 4; ++j) { const float g = acc[ai][0][m][n][j], up = acc[ai][1][m][n][j];
                        o[n * 4 + j] = g * up * __builtin_amdgcn_rcpf(1.0f + __builtin_amdgcn_exp2f(-1.4426950408889634f * g)); }
                u32x4 w; w.x = cvt_pk_bf16(o[0], o[1]); w.y = cvt_pk_bf16(o[2], o[3]); w.z = cvt_pk_bf16(o[4], o[5]); w.w = cvt_pk_bf16(o[6], o[7]);
                *(u32x4*)rowp = w; }
    }
};

typedef int i32x4 __attribute__((ext_vector_type(4)));
struct EpiBf16I8 {
    static constexpr bool PERM = true;
    bf16_t* O; int ldc; bf16_t* O1; int ldc1; const float* sr0; const float* sc0; const float* sr1; const float* sc1;
    struct Pre { float rsv[2]; float csv; };
    __device__ __forceinline__ void prefetch(const Unit& u, int wr, int wc, int fr, int fq, Pre& p) const {
        const bool x = (u.aux == 1 && O1); const float* sr = x ? sr1 : sr0; const float* sc = x ? sc1 : sc0; const int lane = fr + 16 * fq;
        p.rsv[0] = sr[u.pm * BM + wr * 64 + lane]; p.rsv[1] = sr[u.pm * BM + HALF + wr * 64 + lane];
        p.csv = sc[u.pn * BM + wc * 32 + (lane & 31) + (lane >> 5) * HALF];
    }
    __device__ __forceinline__ void operator()(const i32x4 (&acc)[2][2][4][2], const Unit& u, int wr, int wc, int fr, int fq, const Pre& p) const {
        const bool x = (u.aux == 1 && O1);
        bf16_t* base = x ? O1 : O; const int ld = x ? ldc1 : ldc;
        const int row0 = u.pm * BM + wr * 64 + fr, col0 = u.pn * BM + wc * 32 + 8 * fq;
        f32x4 cs[2][2];
#pragma unroll
        for (int bj = 0; bj < 2; ++bj)
#pragma unroll
            for (int n = 0; n < 2; ++n)
#pragma unroll
                for (int j = 0; j < 4; ++j) cs[bj][n][j] = __shfl(p.csv, 32 * bj + 8 * fq + 4 * n + j);
#pragma unroll
        for (int ai = 0; ai < 2; ++ai)
#pragma unroll
            for (int m = 0; m < 4; ++m) { const int r = row0 + ai * HALF + m * 16; const float rs = __shfl(p.rsv[ai], m * 16 + fr); bf16_t* rowp = base + (size_t)r * ld + col0;
#pragma unroll
                for (int bj = 0; bj < 2; ++bj) { const i32x4 a0 = acc[ai][bj][m][0], a1 = acc[ai][bj][m][1]; const f32x4 c0 = cs[bj][0] * rs, c1 = cs[bj][1] * rs;
                    u32x4 w; w.x = cvt_pk_bf16((float)a0[0] * c0[0], (float)a0[1] * c0[1]); w.y = cvt_pk_bf16((float)a0[2] * c0[2], (float)a0[3] * c0[3]);
                    w.z = cvt_pk_bf16((float)a1[0] * c1[0], (float)a1[1] * c1[1]); w.w = cvt_pk_bf16((float)a1[2] * c1[2], (float)a1[3] * c1[3]);
                    *(u32x4*)(rowp + bj * HALF) = w; } }
    }
};
struct EpiSwigluI8 {
    static constexpr bool PERM = true;
    bf16_t* O; int ldc; const float* sa; const float* sb; size_t sb_estride;
    struct Pre { float rsv[2]; float csv; };
    __device__ __forceinline__ void prefetch(const Unit& u, int wr, int wc, int fr, int fq, Pre& p) const {
        const int lane = fr + 16 * fq;
        p.rsv[0] = sa[u.pm * BM + wr * 64 + lane]; p.rsv[1] = sa[u.pm * BM + HALF + wr * 64 + lane];
        p.csv = sb[(size_t)u.aux * sb_estride + u.pn * BM + wc * 32 + (lane & 31) + (lane >> 5) * HALF];
    }
    __device__ __forceinline__ void operator()(const i32x4 (&acc)[2][2][4][2], const Unit& u, int wr, int wc, int fr, int fq, const Pre& p) const {
        const int row0 = u.pm * BM + wr * 64 + fr, col0 = u.pn * HALF + wc * 32 + 8 * fq;
        f32x4 sg[2], su[2];
#pragma unroll
        for (int n = 0; n < 2; ++n)
#pragma unroll
            for (int j = 0; j < 4; ++j) { sg[n][j] = __shfl(p.csv, 8 * fq + 4 * n + j); su[n][j] = __shfl(p.csv, 32 + 8 * fq + 4 * n + j); }
#pragma unroll
        for (int ai = 0; ai < 2; ++ai)
#pragma unroll
            for (int m = 0; m < 4; ++m) { const int r = row0 + ai * HALF + m * 16; const float sar = __shfl(p.rsv[ai], m * 16 + fr); bf16_t* rowp = O + (size_t)r * ldc + col0;
                f32x2 o[4];
#pragma unroll
                for (int n = 0; n < 2; ++n)
#pragma unroll
                    for (int jp = 0; jp < 2; ++jp) {
                        const f32x2 cg = {(float)acc[ai][0][m][n][2 * jp], (float)acc[ai][0][m][n][2 * jp + 1]}, cu = {(float)acc[ai][1][m][n][2 * jp], (float)acc[ai][1][m][n][2 * jp + 1]};
                        const f32x2 sgp = {sg[n][2 * jp], sg[n][2 * jp + 1]}, sup = {su[n][2 * jp], su[n][2 * jp + 1]};
                        const f32x2 g = cg * (sgp * sar), up = cu * (sup * sar);
                        const f32x2 t = g * -1.4426950408889634f;
                        const f32x2 d = (f32x2){__builtin_amdgcn_exp2f(t[0]), __builtin_amdgcn_exp2f(t[1])} + 1.0f;
                        const f32x2 rc = {__builtin_amdgcn_rcpf(d[0]), __builtin_amdgcn_rcpf(d[1])};
                        o[n * 2 + jp] = g * up * rc; }
                u32x4 w; w.x = cvt_pk_bf16(o[0][0], o[0][1]); w.y = cvt_pk_bf16(o[1][0], o[1][1]); w.z = cvt_pk_bf16(o[2][0], o[2][1]); w.w = cvt_pk_bf16(o[3][0], o[3][1]);
                *(u32x4*)rowp = w; }
    }
};
template <bool I8> struct MM;
template <> struct MM<false> { typedef f32x4 acc_t; static __device__ __forceinline__ acc_t zero() { return (f32x4){0.f, 0.f, 0.f, 0.f}; }
    static __device__ __forceinline__ acc_t mma(const bf16x8& b, const bf16x8& a, const acc_t& c) { return __builtin_amdgcn_mfma_f32_16x16x32_bf16(b, a, c, 0, 0, 0); } };
template <> struct MM<true> { typedef i32x4 acc_t; static __device__ __forceinline__ acc_t zero() { return (i32x4){0, 0, 0, 0}; }
    static __device__ __forceinline__ acc_t mma(const bf16x8& b, const bf16x8& a, const acc_t& c) { return __builtin_amdgcn_mfma_i32_16x16x64_i8(__builtin_bit_cast(i32x4, b), __builtin_bit_cast(i32x4, a), c, 0, 0, 0); } };
template <class Epi, class Sched, bool I8 = false, bool ALIGN_EPI = true, bool SP2 = true>
__device__ __forceinline__ void gemm_phase(LAS unsigned char* lds, const int Kb, const Sched& S, const Epi& E, const int Kloop = 0) {
    typedef typename MM<I8>::acc_t acc_t;
    const int tid = threadIdx.x, wid = __builtin_amdgcn_readfirstlane(tid >> 6), lane = tid & 63, wr = wid >> 2, wc = wid & 3, fr = lane & 15, fq = lane >> 4;
    const int nt = (Kloop ? Kloop : Kb) / 128;
    unsigned voffA[2], voffB[2];
#pragma unroll
    for (int i = 0; i < 2; ++i) { int R, C; stage_rc(tid * 16 + i * 8192, R, C); const int Rb = Epi::PERM ? ((R & ~31) + perm32(R & 31)) : R;
        voffA[i] = (unsigned)(R * Kb + C * 2); voffB[i] = (unsigned)(Rb * Kb + C * 2); }
    const size_t kstep = (size_t)(BK * 2);
    const size_t hstep = (size_t)HALF * Kb;
    const unsigned ldsw = (unsigned)wid * 1024u;
    const int aoff = lds_byte(wr * 64 + fr, fq * 8), boff = lds_byte(wc * 32 + fr, fq * 8);
#define PG8_SA(b, h) (((b) * 2 + (h)) * HTB)
#define PG8_SB(b, h) ((4 + (b) * 2 + (h)) * HTB)
#define PG8_STAGE(bufoff, gbase, voff) do { _Pragma("unroll") for (int _i = 0; _i < 2; ++_i) \
        __builtin_amdgcn_global_load_lds((const unsigned*)((const char*)(gbase) + (voff)[_i]), (LAS unsigned*)(lds + (bufoff) + ldsw + _i * 8192), 16, 0, 0); } while (0)
#define PG8_LDA(dst, b, h) do { _Pragma("unroll") for (int m = 0; m < 4; ++m) _Pragma("unroll") for (int k = 0; k < 2; ++k) dst[m][k] = *(const LAS bf16x8*)(lds + PG8_SA(b, h) + aoff + m * 2048 + k * 1024); } while (0)
#define PG8_LDB(dst, b, h) do { _Pragma("unroll") for (int n = 0; n < 2; ++n) _Pragma("unroll") for (int k = 0; k < 2; ++k) dst[n][k] = *(const LAS bf16x8*)(lds + PG8_SB(b, h) + boff + n * 2048 + k * 1024); } while (0)
#define PG8_MMA(ai, bj, At, Bt) do { __builtin_amdgcn_s_setprio(1); _Pragma("unroll") for (int m = 0; m < 4; ++m) _Pragma("unroll") for (int n = 0; n < 2; ++n) _Pragma("unroll") for (int k = 0; k < 2; ++k) \
        acc[ai][bj][m][n] = MM<I8>::mma(Bt[n][k], At[m][k], acc[ai][bj][m][n]); __builtin_amdgcn_s_setprio(0); } while (0)
#define PG8_WAIT_V(n) asm volatile("s_waitcnt vmcnt(" #n ")" ::: "memory")
#define PG8_WAIT_L(n) asm volatile("s_waitcnt lgkmcnt(" #n ")" ::: "memory")
#define PG8_BAR __builtin_amdgcn_s_barrier()
#define PG8_SCHED __builtin_amdgcn_sched_barrier(0)
    Unit cur, nxt; int ui = 0;
    if (!S.next(0, cur)) return;
    acc_t acc[2][2][4][2]; typename Epi::Pre pre;
#pragma unroll
    for (int a = 0; a < 2; ++a)
#pragma unroll
        for (int b = 0; b < 2; ++b)
#pragma unroll
            for (int m = 0; m < 4; ++m)
#pragma unroll
                for (int n = 0; n < 2; ++n) acc[a][b][m][n] = MM<I8>::zero();
    bf16x8 At[4][2], B0[2][2], B1[2][2];
    const char* cA = cur.a; const char* cB = cur.b;
    if constexpr (SP2) {
        PG8_STAGE(PG8_SB(0, 0), cB, voffB); PG8_STAGE(PG8_SB(0, 1), cB + hstep, voffB); PG8_STAGE(PG8_SA(0, 0), cA, voffA); PG8_STAGE(PG8_SA(0, 1), cA + hstep, voffA);
        if (wr == 1) PG8_BAR;
        PG8_WAIT_V(2); PG8_BAR;
        PG8_STAGE(PG8_SB(1, 0), cB + kstep, voffB); PG8_STAGE(PG8_SA(1, 0), cA + kstep, voffA); PG8_STAGE(PG8_SB(1, 1), cB + hstep + kstep, voffB);
        PG8_WAIT_V(6); PG8_BAR;
    } else {
        PG8_STAGE(PG8_SB(0, 0), cB, voffB); PG8_STAGE(PG8_SA(0, 0), cA, voffA); PG8_STAGE(PG8_SB(0, 1), cB + hstep, voffB); PG8_STAGE(PG8_SA(0, 1), cA + hstep, voffA);
        if (wr == 1) PG8_BAR;
        PG8_WAIT_V(4); PG8_BAR;
        PG8_STAGE(PG8_SB(1, 0), cB + kstep, voffB); PG8_STAGE(PG8_SA(1, 0), cA + kstep, voffA); PG8_STAGE(PG8_SB(1, 1), cB + hstep + kstep, voffB);
        PG8_WAIT_V(6); PG8_BAR;
    }
    for (;;) {
        const bool has_next = S.next(ui + 1, nxt);
        const char* nA = has_next ? nxt.a : cA; const char* nB = has_next ? nxt.b : cB;
        for (int t = 0; t < nt; t += 2) {
            const bool last = (t == nt - 2);
            if (last) E.prefetch(cur, wr, wc, fr, fq, pre);
            const char* a1 = cA + (size_t)(t + 1) * kstep;
            const char* a2 = last ? nA : cA + (size_t)(t + 2) * kstep; const char* b2 = last ? nB : cB + (size_t)(t + 2) * kstep;
            const char* a3 = a2 + kstep; const char* b3 = b2 + kstep;
            if constexpr (SP2) {
            PG8_LDB(B0, 0, 0); PG8_LDB(B1, 0, 1); PG8_SCHED; PG8_LDA(At, 0, 0); PG8_STAGE(PG8_SA(1, 1), a1 + hstep, voffA);
            PG8_WAIT_V(8); PG8_WAIT_L(0); PG8_BAR; PG8_MMA(0, 0, At, B0); PG8_MMA(0, 1, At, B1); PG8_BAR; PG8_SCHED;
            PG8_LDA(At, 0, 1); PG8_STAGE(PG8_SB(0, 0), b2, voffB); PG8_STAGE(PG8_SB(0, 1), b2 + hstep, voffB); PG8_STAGE(PG8_SA(0, 0), a2, voffA);
            PG8_WAIT_V(8); PG8_WAIT_L(0); PG8_BAR; PG8_MMA(1, 0, At, B0); PG8_MMA(1, 1, At, B1); PG8_BAR; PG8_SCHED;
            PG8_LDB(B0, 1, 0); PG8_LDB(B1, 1, 1); PG8_SCHED; PG8_LDA(At, 1, 0); PG8_STAGE(PG8_SA(0, 1), a2 + hstep, voffA);
            PG8_WAIT_V(8); PG8_WAIT_L(0); PG8_BAR; PG8_MMA(0, 0, At, B0); PG8_MMA(0, 1, At, B1); PG8_BAR; PG8_SCHED;
            PG8_LDA(At, 1, 1); PG8_STAGE(PG8_SB(1, 0), b3, voffB); PG8_STAGE(PG8_SB(1, 1), b3 + hstep, voffB); PG8_STAGE(PG8_SA(1, 0), a3, voffA);
            PG8_WAIT_V(8); PG8_WAIT_L(0); PG8_BAR; PG8_MMA(1, 0, At, B0); PG8_MMA(1, 1, At, B1); PG8_BAR; PG8_SCHED;
            } else {
            PG8_LDB(B0, 0, 0); PG8_SCHED; PG8_LDA(At, 0, 0); PG8_STAGE(PG8_SA(1, 1), a1 + hstep, voffA);
            PG8_WAIT_L(8); PG8_BAR; PG8_WAIT_L(0); PG8_MMA(0, 0, At, B0); PG8_BAR; PG8_SCHED;
            PG8_LDB(B1, 0, 1); PG8_STAGE(PG8_SB(0, 0), b2, voffB);
            PG8_BAR; PG8_WAIT_L(0); PG8_MMA(0, 1, At, B1); PG8_BAR;
            PG8_LDA(At, 0, 1); PG8_STAGE(PG8_SA(0, 0), a2, voffA);
            PG8_BAR; PG8_WAIT_L(0); PG8_MMA(1, 0, At, B0); PG8_BAR; PG8_SCHED;
            PG8_STAGE(PG8_SB(0, 1), b2 + hstep, voffB);
            PG8_WAIT_V(6); PG8_BAR; PG8_MMA(1, 1, At, B1); PG8_BAR;
            PG8_LDB(B0, 1, 0); PG8_SCHED; PG8_LDA(At, 1, 0); PG8_STAGE(PG8_SA(0, 1), a2 + hstep, voffA);
            PG8_WAIT_L(8); PG8_BAR; PG8_WAIT_L(0); PG8_MMA(0, 0, At, B0); PG8_BAR; PG8_SCHED;
            PG8_LDB(B1, 1, 1); PG8_STAGE(PG8_SB(1, 0), b3, voffB);
            PG8_BAR; PG8_WAIT_L(0); PG8_MMA(0, 1, At, B1); PG8_BAR;
            PG8_LDA(At, 1, 1); PG8_STAGE(PG8_SA(1, 0), a3, voffA);
            PG8_BAR; PG8_WAIT_L(0); PG8_MMA(1, 0, At, B0); PG8_BAR; PG8_SCHED;
            PG8_STAGE(PG8_SB(1, 1), b3 + hstep, voffB);
            PG8_WAIT_V(6); PG8_BAR; PG8_MMA(1, 1, At, B1); PG8_BAR;
            }
        }
        if constexpr (ALIGN_EPI) { if (wr == 0) PG8_BAR; }
        E(acc, cur, wr, wc, fr, fq, pre);
        if constexpr ((REPMASK >> 28) & 1u) E(acc, cur, wr, wc, fr, fq, pre);
        if (!has_next) break;
#pragma unroll
        for (int a = 0; a < 2; ++a)
#pragma unroll
            for (int b = 0; b < 2; ++b)
#pragma unroll
                for (int m = 0; m < 4; ++m)
#pragma unroll
                    for (int n = 0; n < 2; ++n) acc[a][b][m][n] = MM<I8>::zero();
        cur = nxt; cA = nA; cB = nB; ++ui;
        if constexpr (ALIGN_EPI) { if (wr == 1) PG8_BAR; }
    }
    PG8_WAIT_V(0);
    if constexpr (!ALIGN_EPI) { if (wr == 0) PG8_BAR; }
    PG8_BAR;
#undef PG8_SA
#undef PG8_SB
#undef PG8_STAGE
#undef PG8_LDA
#undef PG8_LDB
#undef PG8_MMA
#undef PG8_WAIT_V
#undef PG8_WAIT_L
#undef PG8_BAR
#undef PG8_SCHED
}
}

struct Args { const float* in[49]; float* out; unsigned char* ws; int ph_lo, ph_hi; };
enum { I_X = 0, I_C, I_CTX, I_CCTX, I_LBL, I_ADAW0, I_ADAB0, I_NMIXPRE0, I_NMIXPOST0, I_NFFNPRE0, I_NFFNPOST0, I_WIN0, I_WOUT0, I_SINK, I_HNORM, I_FG0, I_FU0, I_FD0,
       I_ADAW1, I_ADAB1, I_NMIXPRE1, I_NMIXPOST1, I_NFFNPRE1, I_NFFNPOST1, I_WIN1, I_WOUT1, I_GUPF, I_GUPB, I_GBIASF, I_GBIASB, I_GLANORM, I_MUPREV, I_MUNEXT, I_W0F, I_W0B, I_W2F, I_W2B,
       I_A0, I_A2, I_G2, I_KK, I_KA, I_RK, I_LNW, I_LNB, I_ROUTER, I_MG, I_MU, I_MD };

__device__ __forceinline__ void tr_item(const float* W, int K, int ld, int ncol0, bf16_t* WT, int drow0, int mode, int nblk, LAS float* scr, int item, int lane) {
    const int kb = item / nblk, nb = item - kb * nblk, k0 = 64 * kb, n0 = ncol0 + 32 * nb;
    int drow; if (mode == 0) drow = drow0 + 32 * nb; else { const int cc = 32 * nb; drow = (cc >> 7) * 256 + (cc & 127) + (mode == 2 ? 128 : 0); }
#pragma unroll 8
    for (int i = 0; i < 32; ++i) { const int kk = 2 * i + (lane >> 5); scr[kk * 33 + (lane & 31)] = __builtin_nontemporal_load(W + (size_t)(k0 + kk) * ld + n0 + (lane & 31)); }
    LDS_WAIT();
    const int c = lane & 7;
#pragma unroll
    for (int j = 0; j < 4; ++j) { const int n = (lane >> 3) + 8 * j; const LAS float* s = scr + (8 * c) * 33 + n;
        u32x4 o; o.x = pk2(s[0 * 33], s[1 * 33]); o.y = pk2(s[2 * 33], s[3 * 33]); o.z = pk2(s[4 * 33], s[5 * 33]); o.w = pk2(s[6 * 33], s[7 * 33]);
        *(u32x4*)(WT + (size_t)(drow + n) * K + k0 + 8 * c) = o; }
    LDS_WAIT();
}

constexpr int Q8_PITCH = 4100;
__device__ __forceinline__ void q8_strip(const float* W, int ld, int ncol0, signed char* dst, float* sdst, int drow0, LAS unsigned char* lds, int tid) {
    LAS unsigned* cmax = (LAS unsigned*)(lds + 32 * Q8_PITCH);
    const int lane = tid & 63, wave = tid >> 6;
    __syncthreads();
    if (tid < 32) cmax[tid] = 0u;
    __syncthreads();
    const int n4 = tid & 7, kr = tid >> 3;
    float mx[4] = {0.f, 0.f, 0.f, 0.f};
#pragma unroll 4
    for (int it = 0; it < 32; ++it) { const int k = it * 64 + kr; const f32x4 v = __builtin_nontemporal_load((const f32x4*)(W + (size_t)k * ld + ncol0 + 4 * n4));
#pragma unroll
        for (int e = 0; e < 4; ++e) { mx[e] = fmaxf(mx[e], fabsf(v[e])); *(LAS bf16_t*)(lds + (4 * n4 + e) * Q8_PITCH + k * 2) = (bf16_t)f2bf(v[e]); } }
#pragma unroll
    for (int e = 0; e < 4; ++e) __hip_atomic_fetch_max(cmax + 4 * n4 + e, __float_as_uint(mx[e]), __ATOMIC_RELAXED, __HIP_MEMORY_SCOPE_WORKGROUP);
    __syncthreads();
#pragma unroll 1
    for (int q = 0; q < 4; ++q) {
        const int n = 4 * wave + q; const float m = __uint_as_float(cmax[n]); const float inv = m > 0.f ? 127.0f / m : 0.f;
        const LAS unsigned* src = (const LAS unsigned*)(lds + n * Q8_PITCH + lane * 64);
        u32x4 o0, o1;
#pragma unroll
        for (int d = 0; d < 8; ++d) { const unsigned w0 = src[2 * d], w1 = src[2 * d + 1];
            const int q0 = (int)__builtin_rintf(bflo(w0) * inv), q1 = (int)__builtin_rintf(bfhi(w0) * inv), q2 = (int)__builtin_rintf(bflo(w1) * inv), q3 = (int)__builtin_rintf(bfhi(w1) * inv);
            const unsigned pk = (unsigned)(q0 & 0xff) | ((unsigned)(q1 & 0xff) << 8) | ((unsigned)(q2 & 0xff) << 16) | ((unsigned)(q3 & 0xff) << 24);
            if (d < 4) o0[d] = pk; else o1[d - 4] = pk; }
        u32x4* dp = (u32x4*)(dst + (size_t)(drow0 + n) * 2048 + 32 * lane);
        dp[0] = o0; dp[1] = o1;
        if (lane == 0) sdst[drow0 + n] = m > 0.f ? m * (1.0f / 127.0f) : 1.0f;
    }
}

__device__ __forceinline__ void p0_prologue(const Args& a, LAS unsigned char* lds, int tid, int lane, int wave) {
    unsigned char* ws = a.ws;
    const int G = gridDim.x, bx = blockIdx.x;
    {
        LAS float* sc = (LAS float*)lds;
        LAS float* red = (LAS float*)(lds + 16384);
        for (int i = tid; i < 2 * D; i += NTHR) { const float v = (i < D) ? a.in[I_C][i] : a.in[I_CCTX][i - D]; sc[i] = siluf_(v); }
        __syncthreads();
        float* mod = (float*)(ws + WS_MOD);
        for (int it = bx; it < 384; it += G) {
            const int l = it / 192, cg = it % 192; const float* W = a.in[l ? I_ADAW1 : I_ADAW0]; const float* B = a.in[l ? I_ADAB1 : I_ADAB0];
            const int col = cg * 64 + lane; float a0 = 0.f, a1 = 0.f;
            const float* wp = W + (size_t)(wave * 256) * 12288 + col;
#pragma unroll 8
            for (int k = 0; k < 256; ++k) { const float w = __builtin_nontemporal_load(wp + (size_t)k * 12288); a0 = fmaf(sc[wave * 256 + k], w, a0); a1 = fmaf(sc[D + wave * 256 + k], w, a1); }
            red[(wave * 2 + 0) * 64 + lane] = a0; red[(wave * 2 + 1) * 64 + lane] = a1;
            __syncthreads();
            if (wave < 2) { float s = 0.f;
#pragma unroll
                for (int w = 0; w < 8; ++w) s += red[(w * 2 + wave) * 64 + lane];
                mod[(size_t)(l * 2 + wave) * 12288 + col] = s + B[col]; }
            __syncthreads();
        }
    }
    {
        float* tab = (float*)(ws + WS_ROPE);
        const int gi = bx * NTHR + tid;
        if (gi < 320 * 32) { const int pos = gi >> 5, f = gi & 31; const int p = pos < 256 ? pos : pos - 256;
            const float inv = exp2f(-(float)f * (13.287712379549449f / 32.0f));
            const float ang = (float)p * inv; float sn, cs; sincosf(ang, &sn, &cs);
            tab[2 * gi] = cs; tab[2 * gi + 1] = sn; }
    }
    {
        bf16_t* wt = (bf16_t*)(ws + WS_LORA4);
        { float* lb = (float*)(ws + WS_LB); const int e = bx * NTHR + tid; if (e < 3072) lb[e] = e < 1024 ? a.in[I_W0F][e] : (e < 2048 ? a.in[I_W0B][e - 1024] : a.in[I_A0][e - 2048]); }
        for (int e = bx * NTHR + tid; e < 4 * 256 * 1024; e += G * NTHR) {
            const int m = e >> 18, kk = (e >> 10) & 255, n = e & 1023; float v = 0.f;
            if (m == 3) v = a.in[I_G2][kk * 1024 + n];
            else if (kk < 96) v = a.in[m == 0 ? I_W2F : (m == 1 ? I_W2B : I_A2)][kk * 1024 + n];
            wt[((size_t)m * 1024 + n) * 256 + kk] = (bf16_t)f2bf(v);
        }
    }
    {
        LAS float* scr = (LAS float*)(lds + wave * 16384);
        const int gw = bx * NWAVES + wave, NGW = G * NWAVES;
        constexpr int S3 = 32 * 64, S6 = 88 * 64, S8 = 32 * 64, SD = 112 * 64;
        constexpr int NIT = S3 + S6 + S8 + 8 * SD;
        for (int it = gw; it < NIT; it += NGW) {
            int r = it;
            if (r < S3) { tr_item(a.in[I_WOUT0], 2048, 2048, 0, (bf16_t*)(ws + W_OUT0T), 0, 0, 64, scr, r, lane); continue; } r -= S3;
            if (r < S6) { tr_item(a.in[I_FD0], 5632, 2048, 0, (bf16_t*)(ws + W_DN0T), 0, 0, 64, scr, r, lane); continue; } r -= S6;
            if (r < S8) { tr_item(a.in[I_WOUT1], 2048, 2048, 0, (bf16_t*)(ws + W_OUT1T), 0, 0, 64, scr, r, lane); continue; } r -= S8;
            { const int e = r / SD; tr_item(a.in[I_MD] + (size_t)e * 7168 * 2048, 7168, 2048, 0, (bf16_t*)(ws + W_MDNT) + (size_t)e * 2048 * 7168, 0, 0, 64, scr, r - e * SD, lane); }
        }
    }
    {
        constexpr int NS0 = 176, NSE = 224, NI0 = 208, NI1 = 210, NITEM = 2 * NS0 + 16 * NSE + NI0 + NI1;
        for (int it = bx; it < NITEM; it += G) {
            int r = it; const float* W; int ld, cc, up; signed char* dst; float* sd;
            if (r >= 2 * NS0 + 16 * NSE) {
                r -= 2 * NS0 + 16 * NSE; int drow;
                if (r < NI0) { cc = 32 * r; W = a.in[I_WIN0]; ld = 6656;
                    if (cc < 1280) { dst = (signed char*)(ws + W_IN0T); sd = (float*)(ws + WS_QI0); drow = cc; }
                    else if (cc < 1536) { dst = (signed char*)(ws + W_V0T); sd = (float*)(ws + WS_QV0); drow = cc - 1280; }
                    else if (cc < 2560) { dst = (signed char*)(ws + W_IN0T); sd = (float*)(ws + WS_QI0); drow = cc - 1536 + 1280; }
                    else if (cc < 3584) { dst = (signed char*)(ws + W_V0T); sd = (float*)(ws + WS_QV0); drow = cc - 2560 + 256; }
                    else { dst = (signed char*)(ws + W_IN0T); sd = (float*)(ws + WS_QI0); drow = cc - 3584 + 2304; } }
                else { cc = 32 * (r - NI0); W = a.in[I_WIN1]; ld = 6720;
                    if (cc < 1024) { dst = (signed char*)(ws + W_IN1T); sd = (float*)(ws + WS_QI1); drow = cc; }
                    else if (cc < 2048) { dst = (signed char*)(ws + W_GV1T); sd = (float*)(ws + WS_QG1); drow = cc - 1024; }
                    else { dst = (signed char*)(ws + W_IN1T); sd = (float*)(ws + WS_QI1); drow = cc - 2048 + 1024; } }
                q8_strip(W, ld, cc, dst, sd, drow, lds, tid);
                continue;
            }
            if (r < 2 * NS0) { up = r / NS0; cc = 32 * (r - up * NS0); W = a.in[up ? I_FU0 : I_FG0]; ld = 5632; dst = (signed char*)(ws + W_GU0T); sd = (float*)(ws + WS_QS0); }
            else { r -= 2 * NS0; const int e = r / (2 * NSE); r -= e * 2 * NSE; up = r / NSE; cc = 32 * (r - up * NSE); W = a.in[up ? I_MU : I_MG] + (size_t)e * 2048 * 7168; ld = 7168;
                   dst = (signed char*)(ws + W_MGUT) + (size_t)e * 14336 * 2048; sd = (float*)(ws + WS_QSM) + (size_t)e * 14336; }
            q8_strip(W, ld, cc, dst, sd, (cc >> 7) * 256 + (cc & 127) + (up ? 128 : 0), lds, tid);
        }
    }
}

__device__ __forceinline__ f32x4 ldp(const float* p, int lane, int j) { return *(const f32x4*)(p + 4 * lane + 256 * j); }
__device__ __forceinline__ void ldrow(const float* p, int lane, f32x4 (&v)[8]) {
#pragma unroll
    for (int j = 0; j < 8; ++j) v[j] = ldp(p, lane, j);
}
__device__ __forceinline__ void ldrow_bf(const bf16_t* p, int lane, f32x4 (&v)[8]) {
#pragma unroll
    for (int j = 0; j < 8; ++j) { const u32x2 y = *(const u32x2*)(p + 4 * lane + 256 * j); v[j] = (f32x4){bflo(y.x), bfhi(y.x), bflo(y.y), bfhi(y.y)}; }
}
__device__ __forceinline__ float rms_scale(const f32x4 (&v)[8]) {
    float s = 0.f;
#pragma unroll
    for (int j = 0; j < 8; ++j) s += (v[j][0] * v[j][0] + v[j][1] * v[j][1]) + (v[j][2] * v[j][2] + v[j][3] * v[j][3]);
    return __builtin_amdgcn_rsqf(wave_sum(s) * (1.0f / D) + NORM_EPS);
}
__device__ __forceinline__ void mod_store(f32x4 (&v)[8], const float* gpre, const float* sc, const float* sh, bf16_t* hrow, int lane) {
    const float rs = rms_scale(v);
#pragma unroll
    for (int j = 0; j < 8; ++j) { const f32x4 g = ldp(gpre, lane, j), s = ldp(sc, lane, j), b = ldp(sh, lane, j);
        v[j] = v[j] * rs * g * (s + 1.0f) + b;
        u32x2 w; w.x = pk2(v[j][0], v[j][1]); w.y = pk2(v[j][2], v[j][3]); *(u32x2*)(hrow + 4 * lane + 256 * j) = w; }
}
__device__ __forceinline__ void mod_store_i8(f32x4 (&v)[8], const float* gpre, const float* sc, const float* sh, signed char* hrow, float* scale_out, int lane) {
    const float rs = rms_scale(v); float mx = 0.f;
#pragma unroll
    for (int j = 0; j < 8; ++j) { const f32x4 g = ldp(gpre, lane, j), s = ldp(sc, lane, j), b = ldp(sh, lane, j);
        v[j] = v[j] * rs * g * (s + 1.0f) + b;
        mx = fmaxf(fmaxf(mx, fmaxf(fabsf(v[j][0]), fabsf(v[j][1]))), fmaxf(fabsf(v[j][2]), fabsf(v[j][3]))); }
#pragma unroll
    for (int o = 1; o < 64; o <<= 1) mx = fmaxf(mx, __shfl_xor(mx, o));
    const float inv = mx > 0.f ? 127.0f / mx : 0.f;
#pragma unroll
    for (int j = 0; j < 8; ++j) { const int q0 = (int)__builtin_rintf(v[j][0] * inv), q1 = (int)__builtin_rintf(v[j][1] * inv), q2 = (int)__builtin_rintf(v[j][2] * inv), q3 = (int)__builtin_rintf(v[j][3] * inv);
        *(unsigned*)(hrow + 4 * lane + 256 * j) = (unsigned)(q0 & 0xff) | ((unsigned)(q1 & 0xff) << 8) | ((unsigned)(q2 & 0xff) << 16) | ((unsigned)(q3 & 0xff) << 24); }
    if (lane == 0) *scale_out = mx > 0.f ? mx * (1.0f / 127.0f) : 1.0f;
}
__device__ __forceinline__ void add_branch(f32x4 (&v)[8], const f32x4 (&b)[8], const float* gpost, const float* gate, int lane) {
    const float rs = rms_scale(b);
#pragma unroll
    for (int j = 0; j < 8; ++j) { const f32x4 g = ldp(gpost, lane, j), gt = ldp(gate, lane, j); v[j] = v[j] + gt * (b[j] * rs * g); }
}
__device__ __forceinline__ void strow_bf(bf16_t* p, int lane, const f32x4 (&v)[8]) {
#pragma unroll
    for (int j = 0; j < 8; ++j) { u32x2 w; w.x = pk2(v[j][0], v[j][1]); w.y = pk2(v[j][2], v[j][3]); *(u32x2*)(p + 4 * lane + 256 * j) = w; }
}
__device__ __forceinline__ void strow(float* p, int lane, const f32x4 (&v)[8]) {
#pragma unroll
    for (int j = 0; j < 8; ++j) *(f32x4*)(p + 4 * lane + 256 * j) = v[j];
}

constexpr int KST = 272, VST = 136, ATT_V_OFF = 64 * KST;
__device__ __forceinline__ void attn_unit(LAS unsigned char* lds, const bf16_t* proj0, const bf16_t* vT, bf16_t* mix, const float* sinks, const float* ropetab,
                                          int kind, int qb, int g, int tid) {
    const int wave = tid >> 6, lane = tid & 63, c = lane & 31, hh = lane >> 5;
    const int head = g * 4 + (wave >> 1), sub = (wave & 1) * 32;
    const int qrow = (kind == 0 ? CTXL + qb * 64 : qb * 64) + sub + c;
    const float qscale = 0.08838834764831845f * 1.4426950408889634f;
    const float* rowtab = ropetab; const float* coltab = ropetab + 256 * 64;
    bf16x8 qf[8];
    {
        const bf16_t* qp = proj0 + (size_t)qrow * N0 + P0_QA + head * 128;
        const int tl = qrow - CTXL;
#pragma unroll
        for (int ax = 0; ax < 2; ++ax)
#pragma unroll
            for (int sp = 0; sp < 2; ++sp) {
                const int d1 = ax * 64 + sp * 16 + hh * 8;
                const u32x4 c1 = *(const u32x4*)(qp + d1), c2 = *(const u32x4*)(qp + d1 + 32);
                float x1[8], x2[8];
#pragma unroll
                for (int e = 0; e < 4; ++e) { x1[2 * e] = bflo(c1[e]); x1[2 * e + 1] = bfhi(c1[e]); x2[2 * e] = bflo(c2[e]); x2[2 * e + 1] = bfhi(c2[e]); }
                if (kind == 0) {
                    const int pos = ax == 0 ? (tl >> 6) : (tl & 63);
                    const float* tb = (ax == 0 ? rowtab : coltab) + (pos * 32 + sp * 16 + hh * 8) * 2;
#pragma unroll
                    for (int e = 0; e < 8; ++e) { const float cs = tb[2 * e], sn = tb[2 * e + 1]; const float o1 = x1[e] * cs - x2[e] * sn, o2 = x1[e] * sn + x2[e] * cs; x1[e] = o1; x2[e] = o2; }
                }
                u32x4 w1, w2;
#pragma unroll
                for (int e = 0; e < 4; ++e) { w1[e] = pk2(x1[2 * e] * qscale, x1[2 * e + 1] * qscale); w2[e] = pk2(x2[2 * e] * qscale, x2[2 * e + 1] * qscale); }
                qf[ax * 4 + sp] = __builtin_bit_cast(bf16x8, w1); qf[ax * 4 + sp + 2] = __builtin_bit_cast(bf16x8, w2);
            }
    }
    float m = sinks[head] * 1.4426950408889634f, lsum = (hh == 0) ? 1.0f : 0.0f;
    f32x16 o[4];
#pragma unroll
    for (int i = 0; i < 4; ++i)
#pragma unroll
        for (int r = 0; r < 16; ++r) o[i][r] = 0.f;
    const int ntile = (kind == 0) ? 9 : 4;
    for (int ti = 0; ti < ntile; ++ti) {
        int krow0, mode = 0; bool rope = false;
        if (ti < 4) krow0 = 64 * ti;
        else { const int j = ti - 6; const int tl0 = qb * 64 + 64 * j; if (tl0 < 0 || tl0 >= SEQ) continue; krow0 = CTXL + tl0; rope = true; mode = (j == -2) ? 1 : (j == 2 ? 2 : 0); }
        __syncthreads();
        {
            const int key = tid >> 3, p = tid & 7, ax = p >> 2, fc = p & 3; const int krow = krow0 + key;
            const bf16_t* kp = proj0 + (size_t)krow * N0 + P0_KA + g * 128 + ax * 64 + fc * 8;
            u32x4 c1 = *(const u32x4*)kp, c2 = *(const u32x4*)(kp + 32);
            if (rope) {
                const int tl = krow - CTXL; const int pos = ax == 0 ? (tl >> 6) : (tl & 63);
                const float* tb = (ax == 0 ? rowtab : coltab) + (pos * 32 + fc * 8) * 2;
                float x1[8], x2[8];
#pragma unroll
                for (int e = 0; e < 4; ++e) { x1[2 * e] = bflo(c1[e]); x1[2 * e + 1] = bfhi(c1[e]); x2[2 * e] = bflo(c2[e]); x2[2 * e + 1] = bfhi(c2[e]); }
#pragma unroll
                for (int e = 0; e < 8; ++e) { const float cs = tb[2 * e], sn = tb[2 * e + 1]; const float o1 = x1[e] * cs - x2[e] * sn, o2 = x1[e] * sn + x2[e] * cs; x1[e] = o1; x2[e] = o2; }
#pragma unroll
                for (int e = 0; e < 4; ++e) { c1[e] = pk2(x1[2 * e], x1[2 * e + 1]); c2[e] = pk2(x2[2 * e], x2[2 * e + 1]); }
            }
            *(LAS u32x4*)(lds + key * KST + (ax * 64 + fc * 8) * 2) = c1;
            *(LAS u32x4*)(lds + key * KST + (ax * 64 + fc * 8 + 32) * 2) = c2;
        }
#pragma unroll
        for (int i = 0; i < 2; ++i) {
            const int idx = tid + NTHR * i, d = idx >> 3, ch = idx & 7;
            const u32x4 v = *(const u32x4*)(vT + (size_t)(g * 128 + d) * T + krow0 + ch * 8);
            LAS u32x2* dst = (LAS u32x2*)(lds + ATT_V_OFF + d * VST + ch * 16);
            dst[0] = (u32x2){v.x, v.y}; dst[1] = (u32x2){v.z, v.w};
        }
        __syncthreads();
        f32x16 p0, p1;
#pragma unroll
        for (int r = 0; r < 16; ++r) { p0[r] = 0.f; p1[r] = 0.f; }
#pragma unroll
        for (int s = 0; s < 8; ++s) {
            const bf16x8 k0 = *(const LAS bf16x8*)(lds + c * KST + (16 * s + 8 * hh) * 2);
            const bf16x8 k1 = *(const LAS bf16x8*)(lds + (32 + c) * KST + (16 * s + 8 * hh) * 2);
            p0 = __builtin_amdgcn_mfma_f32_32x32x16_bf16(k0, qf[s], p0, 0, 0, 0);
            p1 = __builtin_amdgcn_mfma_f32_32x32x16_bf16(k1, qf[s], p1, 0, 0, 0);
        }
        if (mode != 0) {
            const int ii = sub + c;
#pragma unroll
            for (int r = 0; r < 16; ++r) { const int k0i = (r & 3) + 8 * (r >> 2) + 4 * hh, k1i = k0i + 32;
                const bool bad0 = (mode == 1) ? (k0i < ii) : (k0i > ii), bad1 = (mode == 1) ? (k1i < ii) : (k1i > ii);
                if (bad0) p0[r] = -INFINITY; if (bad1) p1[r] = -INFINITY; }
        }
        float mx = p0[0];
#pragma unroll
        for (int r = 0; r < 16; ++r) { mx = fmaxf(mx, p0[r]); mx = fmaxf(mx, p1[r]); }
        mx = fmaxf(mx, __shfl_xor(mx, 32));
        const float mnew = fmaxf(m, mx), alpha = fexp2(m - mnew); m = mnew;
        float rs = 0.f;
#pragma unroll
        for (int r = 0; r < 16; ++r) { p0[r] = fexp2(p0[r] - mnew); p1[r] = fexp2(p1[r] - mnew); rs += p0[r] + p1[r]; }
        lsum = lsum * alpha + rs;
#pragma unroll
        for (int i = 0; i < 4; ++i)
#pragma unroll
            for (int r = 0; r < 16; ++r) o[i][r] *= alpha;
        bf16x8 pf[2][2];
#pragma unroll
        for (int s2 = 0; s2 < 2; ++s2) {
            u32x4 w0, w1;
#pragma unroll
            for (int e = 0; e < 4; ++e) { w0[e] = pk2(p0[8 * s2 + 2 * e], p0[8 * s2 + 2 * e + 1]); w1[e] = pk2(p1[8 * s2 + 2 * e], p1[8 * s2 + 2 * e + 1]); }
            pf[0][s2] = __builtin_bit_cast(bf16x8, w0); pf[1][s2] = __builtin_bit_cast(bf16x8, w1);
        }
#pragma unroll
        for (int dt = 0; dt < 4; ++dt)
#pragma unroll
            for (int kt = 0; kt < 2; ++kt)
#pragma unroll
                for (int s2 = 0; s2 < 2; ++s2) {
                    const LAS unsigned char* vp = lds + ATT_V_OFF + (32 * dt + c) * VST + (32 * kt + 16 * s2 + 4 * hh) * 2;
                    const u32x2 lo = *(const LAS u32x2*)vp, hi = *(const LAS u32x2*)(vp + 16);
                    const u32x4 vv = (u32x4){lo.x, lo.y, hi.x, hi.y};
                    o[dt] = __builtin_amdgcn_mfma_f32_32x32x16_bf16(__builtin_bit_cast(bf16x8, vv), pf[kt][s2], o[dt], 0, 0, 0);
                }
    }
    const float ltot = lsum + __shfl_xor(lsum, 32), inv = 1.0f / ltot;
    bf16_t* op = mix + (size_t)qrow * D + head * 128;
#pragma unroll
    for (int dt = 0; dt < 4; ++dt)
#pragma unroll
        for (int gq = 0; gq < 4; ++gq) {
            u32x2 w; w.x = pk2(o[dt][4 * gq] * inv, o[dt][4 * gq + 1] * inv); w.y = pk2(o[dt][4 * gq + 2] * inv, o[dt][4 * gq + 3] * inv);
            *(u32x2*)(op + 32 * dt + 8 * gq + 4 * hh) = w;
        }
}

__device__ __forceinline__ int row_of(int dir, int n) { return dir == 0 ? n : (n < CTXL ? CTXL - 1 - n : T + CTXL - 1 - n); }

__device__ __forceinline__ float logsigf_(float x) { return fminf(x, 0.f) - __logf(1.0f + fexp(-fabsf(x))); }


template <int MIX> struct GL { static constexpr int NH = MIX ? 4 : 8, V = MIX ? 256 : 128, NVT = V / 32; };
constexpr int GL_KT_STRIDE = 80;
constexpr int GL_QK_STRIDE = 272;
constexpr int GL_RAW_OFF = 70 * 1024;
constexpr int GL_GD_OFF = 120 * 1024;
constexpr int GL_RED_OFF = 130 * 1024;
static_assert(GL_RED_OFF + 1024 <= MISC_OFF, "GL LDS map");
struct GLArgs { const bf16_t* proj; const bf16_t* vT; bf16_t* kvt; float* dec; bf16_t* mix; const float* lbl; const float* upf; const float* upb; const float* biasf; const float* biasb; const float* gain; };

template <int MIX> __device__ __forceinline__ int gl_scan_chunk(int dir, int step) { return dir == 0 ? step : (step < 8 ? 7 - step : NCHUNK + 7 - step); }

template <int MIX, bool NEEDQ>
__device__ __forceinline__ void gl_stage_raw(const GLArgs& g, LAS unsigned char* lds, int R0, int head, int tid) {
    constexpr int NT = MIX == 0 ? (NEEDQ ? 3 : 2) : (NEEDQ ? 2 : 1);
#pragma unroll
    for (int i = 0; i < 2 * NT; ++i) {
        const int idx = tid + NTHR * i, tile = idx >> 10, rem = idx & 1023, row = rem >> 4, ch = rem & 15;
        int col, slot;
        if constexpr (MIX == 0) { slot = tile; col = (tile == 0 ? P0_FF : (tile == 1 ? P0_FB : P0_QH)) + head * 128 + ch * 8; }
        else { slot = tile == 0 ? 0 : 2; col = (tile == 0 ? G_K : G_Q) + head * 128 + ch * 8; }
        const u32x4 v = *(const u32x4*)(g.proj + (size_t)(R0 + row) * (MIX ? N1 : N0) + col);
        *(LAS u32x4*)(lds + GL_RAW_OFF + slot * 16384 + row * 256 + ch * 16) = v;
    }
}
template <int MIX, bool NEEDQ>
__device__ __forceinline__ void gl_load(const LAS unsigned char* lds, int rloc, int k, int dir, unsigned short& x0, unsigned short& x1) {
    x1 = 0;
    x0 = *(const LAS bf16_t*)(lds + GL_RAW_OFF + (MIX == 0 ? dir : 0) * 16384 + rloc * 256 + k * 2);
    if (NEEDQ) x1 = *(const LAS bf16_t*)(lds + GL_RAW_OFF + 2 * 16384 + rloc * 256 + k * 2);
}
template <int MIX, bool NEEDQ>
__device__ __forceinline__ void gl_comp(unsigned short x0, unsigned short x1, float lbk, const float (&up)[16], float bias, const LAS float* gdrow, float& d, float& kv, float& q) {
    if constexpr (MIX == 0) {
        const float f = lbk + (1.0f - lbk) * sigmoidf_(bf2f(x0));
        d = f; kv = 1.0f - f; if (NEEDQ) q = siluf_(bf2f(x1));
    } else {
        f32x2 xa = {bias, 0.f};
#pragma unroll
        for (int q4 = 0; q4 < 4; ++q4) { const f32x4 gd = *(const LAS f32x4*)(gdrow + 4 * q4);
            xa = __builtin_elementwise_fma((f32x2){gd[0], gd[1]}, (f32x2){up[4 * q4], up[4 * q4 + 1]}, xa);
            xa = __builtin_elementwise_fma((f32x2){gd[2], gd[3]}, (f32x2){up[4 * q4 + 2], up[4 * q4 + 3]}, xa); }
        const float x = xa[0] + xa[1];
        d = fexp(logsigf_(x) * 0.0625f); kv = bf2f(x0); if (NEEDQ) q = bf2f(x1) * 0.08838834764831845f;
    }
}
template <int MIX>
__device__ __forceinline__ void gl_stage_gd(const GLArgs& g, LAS unsigned char* lds, int R0, int tid) {
    if constexpr (MIX == 1) {
        LAS float* gds = (LAS float*)(lds + GL_GD_OFF);
        for (int idx = tid; idx < 2048; idx += NTHR) { const int row = idx >> 5, dj = idx & 31, dir = dj >> 4, j = dj & 15;
            gds[(dir * 64 + row) * 16 + j] = bf2f(g.proj[(size_t)(R0 + row) * N1 + (dir ? G_GDB : G_GDF) + j]); }
    }
}
template <int MIX>
__device__ __forceinline__ void gl_walker_consts(const GLArgs& g, int head, int k, int dir, float& lbk, float (&up)[16], float& bias) {
    lbk = 0.f; bias = 0.f;
#pragma unroll
    for (int j = 0; j < 16; ++j) up[j] = 0.f;
    if constexpr (MIX == 0) { const int kk = head * 128 + k; lbk = 1.0f / (1.0f + fexp(g.lbl[1024 + kk] - g.lbl[kk])); }
    else { const float* upp = dir ? g.upb : g.upf; const int ch = head * 128 + k;
#pragma unroll
        for (int j = 0; j < 16; ++j) up[j] = upp[j * 512 + ch];
        bias = (dir ? g.biasb : g.biasf)[ch]; }
}

template <int MIX>
__device__ __forceinline__ void gl_phaseA(const GLArgs& g, LAS unsigned char* lds, int tid, int bid, int nblk) {
    constexpr int NH = GL<MIX>::NH, V = GL<MIX>::V, NVT = GL<MIX>::NVT;
    const int lane = tid & 63, wave = tid >> 6, c = lane & 31, hh = lane >> 5;
    const int wk = tid & 127, wc2 = (tid >> 7) & 1, wdir = tid >> 8;
    const int dir = wave >> 2, c2 = (wave >> 1) & 1, kh = wave & 1;
    for (int item = bid; item < NH * (T / 64); item += nblk) {
        const int head = item % NH, nb = item / NH, R0 = nb * 64;
        __syncthreads();
        gl_stage_gd<MIX>(g, lds, R0, tid); gl_stage_raw<MIX, false>(g, lds, R0, head, tid);
        const int rbase = R0 + 32 * c2, cr = (R0 >> 5) + c2;
        const bf16_t* vsrc = g.vT + (size_t)((MIX ? 0 : 256) + head * V) * T + rbase;
        bf16x8 bfv[NVT][2];
#pragma unroll
        for (int vt = 0; vt < NVT; ++vt)
#pragma unroll
            for (int s = 0; s < 2; ++s) bfv[vt][s] = *(const bf16x8*)(vsrc + (size_t)(32 * vt + c) * T + 16 * s + 8 * hh);
        float lbk, up[16], bias; gl_walker_consts<MIX>(g, head, wk, wdir, lbk, up, bias);
        __syncthreads();
        {
            float tail = 1.0f;
            LAS bf16_t* kt = (LAS bf16_t*)(lds + (wdir * 2 + wc2) * (128 * GL_KT_STRIDE) + wk * GL_KT_STRIDE);
#pragma unroll 8
            for (int s = 0; s < 32; ++s) {
                const int t = wdir == 0 ? 31 - s : s; unsigned short x0, x1; gl_load<MIX, false>(lds, 32 * wc2 + t, wk, wdir, x0, x1);
                float d, kv, q; gl_comp<MIX, false>(x0, x1, lbk, up, bias, (const LAS float*)(lds + GL_GD_OFF) + (wdir * 64 + 32 * wc2 + t) * 16, d, kv, q);
                kt[t] = (bf16_t)f2bf(kv * tail); tail *= d;
            }
            g.dec[((size_t)(wdir * NH + head) * NCHUNK + (R0 >> 5) + wc2) * 128 + wk] = tail;
        }
        __syncthreads();
        {
            const LAS unsigned char* ktile = lds + (dir * 2 + c2) * (128 * GL_KT_STRIDE);
            bf16x8 af[2][2];
#pragma unroll
            for (int kt2 = 0; kt2 < 2; ++kt2)
#pragma unroll
                for (int s = 0; s < 2; ++s) af[kt2][s] = *(const LAS bf16x8*)(ktile + (32 * (2 * kh + kt2) + c) * GL_KT_STRIDE + (16 * s + 8 * hh) * 2);
            bf16_t* kvo = g.kvt + ((size_t)(dir * NH + head) * NCHUNK + cr) * (V * 128);
#pragma unroll
            for (int pass = 0; pass < NVT / 4; ++pass) {
                f32x16 acc[4][2];
#pragma unroll
                for (int vt = 0; vt < 4; ++vt)
#pragma unroll
                    for (int kt2 = 0; kt2 < 2; ++kt2)
#pragma unroll
                        for (int r = 0; r < 16; ++r) acc[vt][kt2][r] = 0.f;
#pragma unroll
                for (int vt = 0; vt < 4; ++vt)
#pragma unroll
                    for (int s = 0; s < 2; ++s)
#pragma unroll
                        for (int kt2 = 0; kt2 < 2; ++kt2) acc[vt][kt2] = __builtin_amdgcn_mfma_f32_32x32x16_bf16(bfv[4 * pass + vt][s], af[kt2][s], acc[vt][kt2], 0, 0, 0);
#pragma unroll
                for (int vt = 0; vt < 4; ++vt)
#pragma unroll
                    for (int kt2 = 0; kt2 < 2; ++kt2)
#pragma unroll
                        for (int r = 0; r < 16; ++r) {
                            const int v = 32 * (4 * pass + vt) + (r & 3) + 8 * (r >> 2) + 4 * hh;
                            kvo[(size_t)v * 128 + 32 * (2 * kh + kt2) + c] = (bf16_t)f2bf(acc[vt][kt2][r]);
                        }
            }
        }
    }
}

template <int MIX, int KPT>
__device__ __forceinline__ void gl_phaseB(const GLArgs& g, int gidx) {
    constexpr int NH = GL<MIX>::NH, V = GL<MIX>::V, KG = 128 / KPT;
    if (gidx < 0 || gidx >= 2 * NH * V * KG) return;
    const int kq = gidx % KG; int rest = gidx / KG; const int v = rest % V; rest /= V; const int head = rest % NH, dir = rest / NH;
    bf16_t* base = g.kvt + (size_t)(dir * NH + head) * NCHUNK * (V * 128) + (size_t)v * 128 + KPT * kq;
    const float* dbase = g.dec + (size_t)(dir * NH + head) * NCHUNK * 128 + KPT * kq;
    float st[KPT];
#pragma unroll
    for (int e = 0; e < KPT; ++e) st[e] = 0.f;
    constexpr int UB = 10;
    unsigned kv[UB][KPT / 2], kvn[UB][KPT / 2]; float dd[UB][KPT], ddn[UB][KPT];
#define GLB_LOAD(KV, DD, ST0) do { _Pragma("unroll") for (int u = 0; u < UB; ++u) { const int cr_ = gl_scan_chunk<MIX>(dir, (ST0) + u); \
        if constexpr (KPT == 4) { const u32x2 k_ = *(const u32x2*)(base + (size_t)cr_ * (V * 128)); KV[u][0] = k_.x; KV[u][1] = k_.y; const f32x4 d_ = *(const f32x4*)(dbase + (size_t)cr_ * 128); DD[u][0] = d_[0]; DD[u][1] = d_[1]; DD[u][2] = d_[2]; DD[u][3] = d_[3]; } \
        else { _Pragma("unroll") for (int e = 0; e < KPT / 2; ++e) KV[u][e] = *((const unsigned*)(base + (size_t)cr_ * (V * 128)) + e); \
        _Pragma("unroll") for (int e = 0; e < KPT; ++e) DD[u][e] = dbase[(size_t)cr_ * 128 + e]; } } } while (0)
    GLB_LOAD(kv, dd, 0);
    for (int st0 = 0; st0 < NCHUNK; st0 += UB) {
        if (st0 + UB < NCHUNK) GLB_LOAD(kvn, ddn, st0 + UB);
#pragma unroll
        for (int u = 0; u < UB; ++u) { const int cr = gl_scan_chunk<MIX>(dir, st0 + u);
            if constexpr (KPT == 4) { *(u32x2*)(base + (size_t)cr * (V * 128)) = (u32x2){pk2(st[0], st[1]), pk2(st[2], st[3])}; }
#pragma unroll
            for (int e = 0; e < KPT / 2; ++e) { if constexpr (KPT != 4) *((unsigned*)(base + (size_t)cr * (V * 128)) + e) = pk2(st[2 * e], st[2 * e + 1]);
                st[2 * e] = fmaf(dd[u][2 * e], st[2 * e], bflo(kv[u][e])); st[2 * e + 1] = fmaf(dd[u][2 * e + 1], st[2 * e + 1], bfhi(kv[u][e])); } }
#pragma unroll
        for (int u = 0; u < UB; ++u) {
#pragma unroll
            for (int e = 0; e < KPT / 2; ++e) kv[u][e] = kvn[u][e];
#pragma unroll
            for (int e = 0; e < KPT; ++e) dd[u][e] = ddn[u][e]; }
    }
#undef GLB_LOAD
}

template <int MIX>
__device__ __forceinline__ void gl_phaseC(const GLArgs& g, LAS unsigned char* lds, int tid, int bid, int nblk) {
    constexpr int NH = GL<MIX>::NH, V = GL<MIX>::V, NVT = GL<MIX>::NVT, NP = NVT / 4;
    const int lane = tid & 63, wave = tid >> 6, c = lane & 31, hh = lane >> 5;
    const int wk = tid & 127, wc2 = (tid >> 7) & 1, wdir = tid >> 8;
    constexpr int TILE = 32 * GL_QK_STRIDE;
    for (int item = bid; item < NH * (T / 64); item += nblk) {
        const int head = item % NH, nb = item / NH, R0 = nb * 64;
        if (MIX == 1 && R0 < CTXL) continue;
        __syncthreads();
        gl_stage_gd<MIX>(g, lds, R0, tid); gl_stage_raw<MIX, true>(g, lds, R0, head, tid);
        const int c2 = wave >> 2, vg = wave & 3, rbase = R0 + 32 * c2, cr = (R0 >> 5) + c2;
        bf16x8 sf2[2][8]; u32x4 vf2[2][NP][2];
#pragma unroll
        for (int dir = 0; dir < 2; ++dir) {
            const bf16_t* sb_ = g.kvt + ((size_t)(dir * NH + head) * NCHUNK + cr) * (V * 128);
#pragma unroll
            for (int p = 0; p < NP; ++p) {
                const int vrow = 32 * (vg + 4 * p) + c;
                const bf16_t* vp = g.vT + (size_t)((MIX ? 0 : 256) + head * V + vrow) * T + rbase;
#pragma unroll
                for (int s2 = 0; s2 < 2; ++s2) { const u32x2 lo = *(const u32x2*)(vp + 16 * s2 + 4 * hh), hi = *(const u32x2*)(vp + 16 * s2 + 8 + 4 * hh); vf2[dir][p][s2] = (u32x4){lo.x, lo.y, hi.x, hi.y}; }
            }
#pragma unroll
            for (int s = 0; s < 8; ++s) sf2[dir][s] = *(const bf16x8*)(sb_ + (size_t)(32 * vg + c) * 128 + 16 * s + 8 * hh);
        }
        float lbk, up[16], bias; gl_walker_consts<MIX>(g, head, wk, wdir, lbk, up, bias);
        __syncthreads();
        {
            const int rbase = R0 + 32 * wc2; float P = 1.0f;
            LAS unsigned char* qt = lds + ((wdir * 2 + wc2) * 2) * TILE; LAS unsigned char* kt = qt + TILE;
#pragma unroll 8
            for (int s = 0; s < 32; ++s) {
                const int t = wdir == 0 ? s : 31 - s; unsigned short x0, x1; gl_load<MIX, true>(lds, 32 * wc2 + t, wk, wdir, x0, x1);
                float d, kv, q; gl_comp<MIX, true>(x0, x1, lbk, up, bias, (const LAS float*)(lds + GL_GD_OFF) + (wdir * 64 + 32 * wc2 + t) * 16, d, kv, q);
                P *= d;
                *(LAS bf16_t*)(qt + t * GL_QK_STRIDE + wk * 2) = (bf16_t)f2bf(q * P);
                *(LAS bf16_t*)(kt + t * GL_QK_STRIDE + wk * 2) = (bf16_t)f2bf(kv * fminf(__builtin_amdgcn_rcpf(P), 1e30f));
            }
        }
        __syncthreads();
        f32x16 o[NP];
#pragma unroll
        for (int p = 0; p < NP; ++p)
#pragma unroll
            for (int r = 0; r < 16; ++r) o[p][r] = 0.f;
        __builtin_amdgcn_sched_barrier(0);
#pragma unroll
        for (int dir = 0; dir < 2; ++dir) {
            const LAS unsigned char* qt = lds + ((dir * 2 + c2) * 2) * TILE; const LAS unsigned char* kt = qt + TILE;
            const bf16_t* sbase = g.kvt + ((size_t)(dir * NH + head) * NCHUNK + cr) * (V * 128);
            bf16x8 sf[8]; u32x4 vf[NP][2];
#pragma unroll
            for (int s = 0; s < 8; ++s) sf[s] = sf2[dir][s];
#pragma unroll
            for (int p = 0; p < NP; ++p) { vf[p][0] = vf2[dir][p][0]; vf[p][1] = vf2[dir][p][1]; }
            bf16x8 qf[8];
            f32x16 x;
#pragma unroll
            for (int r = 0; r < 16; ++r) x[r] = 0.f;
#pragma unroll
            for (int s = 0; s < 8; ++s) { qf[s] = *(const LAS bf16x8*)(qt + c * GL_QK_STRIDE + (16 * s + 8 * hh) * 2);
                const bf16x8 kf = *(const LAS bf16x8*)(kt + c * GL_QK_STRIDE + (16 * s + 8 * hh) * 2);
                x = __builtin_amdgcn_mfma_f32_32x32x16_bf16(kf, qf[s], x, 0, 0, 0); }
#pragma unroll
            for (int r = 0; r < 16; ++r) { const int j = (r & 3) + 8 * (r >> 2) + 4 * hh; const bool keep = dir == 0 ? (j <= c) : (j >= c); if (!keep) x[r] = 0.f; }
            bf16x8 xf[2];
#pragma unroll
            for (int s2 = 0; s2 < 2; ++s2) { u32x4 w;
#pragma unroll
                for (int e = 0; e < 4; ++e) w[e] = pk2(x[8 * s2 + 2 * e], x[8 * s2 + 2 * e + 1]);
                xf[s2] = __builtin_bit_cast(bf16x8, w); }
#pragma unroll
            for (int p = 0; p < NP; ++p) {
                bf16x8 sn[8];
                if (p + 1 < NP) {
#pragma unroll
                    for (int s = 0; s < 8; ++s) sn[s] = *(const bf16x8*)(sbase + (size_t)(32 * (vg + 4 * (p + 1)) + c) * 128 + 16 * s + 8 * hh);
                }
                __builtin_amdgcn_sched_barrier(0);
#pragma unroll
                for (int s2 = 0; s2 < 2; ++s2) o[p] = __builtin_amdgcn_mfma_f32_32x32x16_bf16(__builtin_bit_cast(bf16x8, vf[p][s2]), xf[s2], o[p], 0, 0, 0);
#pragma unroll
                for (int s = 0; s < 8; ++s) o[p] = __builtin_amdgcn_mfma_f32_32x32x16_bf16(sf[s], qf[s], o[p], 0, 0, 0);
                if (p + 1 < NP) {
#pragma unroll
                    for (int s = 0; s < 8; ++s) sf[s] = sn[s];
                }
            }
        }
        float ss = 0.f;
#pragma unroll
        for (int p = 0; p < NP; ++p)
#pragma unroll
            for (int r = 0; r < 16; ++r) ss += o[p][r] * o[p][r];
        ss += __shfl_xor(ss, 32);
        LAS float* red = (LAS float*)(lds + GL_RED_OFF);
        if (hh == 0) red[(c2 * 4 + vg) * 32 + c] = ss;
        __syncthreads();
        const float tot = (red[(c2 * 4 + 0) * 32 + c] + red[(c2 * 4 + 1) * 32 + c]) + (red[(c2 * 4 + 2) * 32 + c] + red[(c2 * 4 + 3) * 32 + c]);
        const float rs = __builtin_amdgcn_rsqf(tot * (1.0f / V) + NORM_EPS);
        const int r = rbase + c;
#pragma unroll
        for (int p = 0; p < NP; ++p)
#pragma unroll
            for (int gq = 0; gq < 4; ++gq) {
                const int v0 = 32 * (vg + 4 * p) + 8 * gq + 4 * hh;
                const f32x4 gn = *(const f32x4*)(g.gain + v0);
                const u32x2 gt = *(const u32x2*)(g.proj + (size_t)r * (MIX ? N1 : N0) + (MIX ? G_GR : P0_GH) + head * V + v0);
                u32x2 w; w.x = pk2(o[p][4 * gq] * rs * gn[0] * siluf_(bflo(gt.x)), o[p][4 * gq + 1] * rs * gn[1] * siluf_(bfhi(gt.x)));
                w.y = pk2(o[p][4 * gq + 2] * rs * gn[2] * siluf_(bflo(gt.y)), o[p][4 * gq + 3] * rs * gn[3] * siluf_(bfhi(gt.y)));
                bf16_t* op = MIX ? g.mix + (size_t)(r - CTXL) * D + head * V + v0 : g.mix + (size_t)r * D + 1024 + head * V + v0;
                *(u32x2*)op = w;
            }
    }
}

constexpr int RW_TS = 144, RW_TILE = 32 * RW_TS, RW_WAVE_LDS = 14336;
__host__ __device__ constexpr int rw_tri(int t) { return t <= 0 ? 0 : ((t - 1) / 4 + 1) * (2 * ((t - 1) / 4) + (t - 1) % 4); }
constexpr int RW_TRI_BYTES = 16 * rw_tri(32);
#ifndef RW_LB
#define RW_LB 2
#endif
static_assert(RW_TRI_BYTES + 2048 <= RW_TILE, "triangle rows + the parked fragments must fit the third tile slot");
struct RWArgs { const bf16_t* RP; const bf16_t* GOUT; bf16_t* MF; bf16_t* NB; bf16_t* QB; bf16_t* OB; bf16_t* mix; const float* rk; const float* lnw; const float* lnb; const float* ka; };
__device__ __forceinline__ int rw_scan_chunk(int dir, int cs) { return dir == 0 ? cs : (cs < 8 ? 7 - cs : NCHUNK + 7 - cs); }
__device__ __forceinline__ float rdlane(float v, int l) { return __int_as_float(__builtin_amdgcn_readlane(__float_as_int(v), l)); }
template <bool PERM>
__device__ __forceinline__ void rw_pack(const float (&x)[32], int hh, u32x4 (&f)[2][2]) {
#pragma unroll
    for (int s2 = 0; s2 < 2; ++s2)
#pragma unroll
        for (int e = 0; e < 4; ++e) {
            const int t0 = PERM ? 16 * s2 + 8 * ((2 * e) >> 2) + ((2 * e) & 3) : 16 * s2 + 2 * e;
            const int t1 = PERM ? t0 + 4 : t0 + 8;
            const unsigned p0 = pk2(x[t0], x[t0 + 1]), p1 = pk2(x[t1], x[t1 + 1]);
            const auto rr = __builtin_amdgcn_permlane32_swap(p0, p1, false, false);
            f[0][s2][e] = rr[0]; f[1][s2][e] = rr[1];
        }
    (void)hh;
}
__device__ __forceinline__ void rw_pack_pairs(const unsigned (&xp)[16], int hh, u32x4 (&f)[2][2]) {
#pragma unroll
    for (int s2 = 0; s2 < 2; ++s2)
#pragma unroll
        for (int e = 0; e < 4; ++e) { const auto rr = __builtin_amdgcn_permlane32_swap(xp[8 * s2 + e], xp[8 * s2 + 4 + e], false, false); f[0][s2][e] = rr[0]; f[1][s2][e] = rr[1]; }
    (void)hh;
}
__device__ __forceinline__ void rw_pack_pairs_perm(const unsigned (&xp)[16], int hh, u32x4 (&f)[2][2]) {
#pragma unroll
    for (int s2 = 0; s2 < 2; ++s2)
#pragma unroll
        for (int e = 0; e < 4; ++e) { const int t0 = 16 * s2 + 8 * (e >> 1) + 2 * (e & 1);
            const auto rr = __builtin_amdgcn_permlane32_swap(xp[t0 >> 1], xp[(t0 + 4) >> 1], false, false); f[0][s2][e] = rr[0]; f[1][s2][e] = rr[1]; }
    (void)hh;
}
__device__ __forceinline__ bf16x8 acc_frag(const f32x16& x, int s2) {
    u32x4 w;
#pragma unroll
    for (int e = 0; e < 4; ++e) w[e] = pk2(x[8 * s2 + 2 * e], x[8 * s2 + 2 * e + 1]);
    return __builtin_bit_cast(bf16x8, w);
}
#define MFMA32(A, B, C) __builtin_amdgcn_mfma_f32_32x32x16_bf16(A, B, C, 0, 0, 0)

__device__ __forceinline__ void rwkv_stageA(const RWArgs& g, LAS unsigned char* wl, int item, int lane) {
    __builtin_assume(item >= 0 && item < 2 * 16 * NCHUNK);
    const int dir = item / (16 * NCHUNK), rem = item - dir * 16 * NCHUNK, head = rem / NCHUNK, cs = rem - head * NCHUNK;
    const int cr = rw_scan_chunk(dir, cs), rbase = 32 * cr, c = lane & 31, hh = lane >> 5;
    LAS unsigned char* s0 = wl; LAS unsigned char* s1 = wl + RW_TILE; LAS unsigned char* s2p = wl + 2 * RW_TILE; LAS float* gam = (LAS float*)(wl + 3 * RW_TILE);
    unsigned vp[16], bp[16], kp[16];
    {
        float gprev = 1.0f; const bf16_t* rp0 = g.RP + head * 64; unsigned vo0 = (unsigned)lane * 2u, vo2 = vo0 + 4096u, vo4 = vo0 + 8192u, vo5 = vo0 + (unsigned)(5 + dir) * 2048u; asm volatile("" : "+v"(vo2), "+v"(vo4), "+v"(vo5)); const float kac = g.ka[head * 64 + lane];
#pragma unroll
        for (int sb = 0; sb < 32; sb += 16) {
            unsigned short raw[16][6];
#pragma unroll
            for (int u = 0; u < 16; ++u) { const int s = sb + u; const int r = rbase + (dir ? 31 - s : s); const char* pb = (const char*)(rp0 + (size_t)r * 7168);
                raw[u][0] = *(const bf16_t*)(pb + vo0); raw[u][1] = *(const bf16_t*)(pb + 2048 + vo0); raw[u][2] = *(const bf16_t*)(pb + vo2); raw[u][3] = *(const bf16_t*)(pb + 2048 + vo2);
                raw[u][4] = *(const bf16_t*)(pb + vo4); raw[u][5] = *(const bf16_t*)(pb + vo5); }
#pragma unroll
            for (int u = 0; u < 16; ++u) { const int s = sb + u;
                const float rr = bf2f(raw[u][0]), kk = bf2f(raw[u][3]), aa = bf2f(raw[u][4]), lw = bf2f(raw[u][5]);
                const float km = bf2f(raw[u][1]) * (1.0f + (aa - 1.0f) * kac);
                const float gcur = gprev * fexp(lw), ginv = __builtin_amdgcn_rcpf(gcur);
                const unsigned bt = f2bf(kk * aa * ginv), kt = f2bf(km * ginv);
                *(LAS bf16_t*)(s0 + s * RW_TS + lane * 2) = (bf16_t)f2bf(-kk * gprev);
                *(LAS bf16_t*)(s1 + s * RW_TS + lane * 2) = (bf16_t)f2bf(rr * gcur);
                *(LAS bf16_t*)(s2p + s * RW_TS + lane * 2) = (bf16_t)kt;
                if (s & 1) { bp[s >> 1] |= bt << 16; kp[s >> 1] |= kt << 16; vp[s >> 1] |= (unsigned)raw[u][2] << 16; } else { bp[s >> 1] = bt; kp[s >> 1] = kt; vp[s >> 1] = raw[u][2]; }
                gprev = gcur;
            }
        }
        gam[lane] = gprev;
    }
    LDS_WAIT();
    f32x16 g1, g2, g3, g4;
#pragma unroll
    for (int r = 0; r < 16; ++r) { g1[r] = 0.f; g2[r] = 0.f; g3[r] = 0.f; g4[r] = 0.f; }
    {
        bf16x8 fa[4], fr[4], fk[4];
#pragma unroll
        for (int ks = 0; ks < 4; ++ks) { fa[ks] = *(const LAS bf16x8*)(s0 + c * RW_TS + (16 * ks + 8 * hh) * 2); fr[ks] = *(const LAS bf16x8*)(s1 + c * RW_TS + (16 * ks + 8 * hh) * 2);
            fk[ks] = *(const LAS bf16x8*)(s2p + c * RW_TS + (16 * ks + 8 * hh) * 2); }
        LDS_WAIT();
#pragma unroll
        for (int s = 0; s < 32; ++s) *(LAS bf16_t*)(s2p + s * RW_TS + lane * 2) = (bf16_t)((s & 1) ? (bp[s >> 1] >> 16) : (bp[s >> 1] & 0xffffu));
        LDS_WAIT();
#pragma unroll
        for (int ks = 0; ks < 4; ++ks) {
            const bf16x8 fb = *(const LAS bf16x8*)(s2p + c * RW_TS + (16 * ks + 8 * hh) * 2);
            g1 = MFMA32(fb, fa[ks], g1); g2 = MFMA32(fk[ks], fa[ks], g2); g3 = MFMA32(fb, fr[ks], g3); g4 = MFMA32(fk[ks], fr[ks], g4);
        }
    }
#pragma unroll
    for (int r = 0; r < 16; ++r) { const int i = (r & 3) + 8 * (r >> 2) + 4 * hh; if (i > c) { g3[r] = 0.f; g4[r] = 0.f; } }
    const bf16x8 b3[2] = {acc_frag(g3, 0), acc_frag(g3, 1)}, b4[2] = {acc_frag(g4, 0), acc_frag(g4, 1)};
    LDS_WAIT();
    {
        int toff = 4 * rw_tri(c); asm volatile("" : "+v"(toff));
#pragma unroll
        for (int gq = 0; gq < 4; ++gq) { const int i0 = 8 * gq + 4 * hh;
            if (i0 < c) *(LAS f32x4*)(s2p + (toff + i0) * 4) = (f32x4){g1[4 * gq], g1[4 * gq + 1], g1[4 * gq + 2], g1[4 * gq + 3]}; }
        *(LAS bf16x8*)(s2p + RW_TRI_BYTES + lane * 16) = b4[0]; *(LAS bf16x8*)(s2p + RW_TRI_BYTES + 1024 + lane * 16) = b4[1];
    }
    f32x16 wxA, wxB;
    {
#pragma unroll
        for (int r = 0; r < 16; ++r) { const int i = (r & 3) + 8 * (r >> 2) + 4 * hh; if (i >= c) g2[r] = 0.f; }
        const bf16x8 a2[2] = {acc_frag(g2, 0), acc_frag(g2, 1)};
        u32x4 fVq[2][2]; rw_pack_pairs_perm(vp, hh, fVq);
        f32x16 x0, x1;
#pragma unroll
        for (int r = 0; r < 16; ++r) { x0[r] = 0.f; x1[r] = 0.f; }
#pragma unroll
        for (int q = 0; q < 2; ++q) { x0 = MFMA32(a2[q], __builtin_bit_cast(bf16x8, fVq[0][q]), x0); x1 = MFMA32(a2[q], __builtin_bit_cast(bf16x8, fVq[1][q]), x1); }
#pragma unroll
        for (int r = 0; r < 16; ++r) { const auto rr = __builtin_amdgcn_permlane32_swap(__float_as_uint(x0[r]), __float_as_uint(x1[r]), false, false); wxA[r] = __uint_as_float(rr[0]); wxB[r] = __uint_as_float(rr[1]); }
    }
    LDS_WAIT();
    float p[32], w[32];
    {
        f32x2 pw[32];
#pragma unroll
        for (int t = 0; t < 32; ++t) {
            f32x2 acc = {bf2f(*(const LAS bf16_t*)(s0 + t * RW_TS + lane * 2)), ((t >> 2) & 1) ? wxB[(t & 3) + 4 * (t >> 3)] : wxA[(t & 3) + 4 * (t >> 3)]};
#pragma unroll
            for (int ib = 0; ib < (t + 3) / 4; ib += RW_LB) {
                f32x4 lab[RW_LB];
#pragma unroll
                for (int b = 0; b < RW_LB; ++b) if (ib + b < (t + 3) / 4) lab[b] = *(const LAS f32x4*)(s2p + (4 * rw_tri(t) + 4 * (ib + b)) * 4);
#pragma unroll
                for (int b = 0; b < RW_LB; ++b) if (ib + b < (t + 3) / 4) {
                    const f32x2 l01 = {lab[b][0], lab[b][1]}, l23 = {lab[b][2], lab[b][3]};
                    const int i0 = 4 * (ib + b), n = t - i0;
#define RW_F0 "v_pk_fma_f32 %0, %1, %3, %0 op_sel_hi:[0,1,1]"
#define RW_F1 "\n\tv_pk_fma_f32 %0, %1, %4, %0 op_sel:[1,0,0] op_sel_hi:[1,1,1]"
#define RW_F2 "\n\tv_pk_fma_f32 %0, %2, %5, %0 op_sel_hi:[0,1,1]"
#define RW_F3 "\n\tv_pk_fma_f32 %0, %2, %6, %0 op_sel:[1,0,0] op_sel_hi:[1,1,1]"
                    if (n >= 4)      asm(RW_F0 RW_F1 RW_F2 RW_F3 : "+v"(acc) : "v"(l01), "v"(l23), "v"(pw[i0]), "v"(pw[i0 + 1]), "v"(pw[i0 + 2]), "v"(pw[i0 + 3]));
                    else if (n == 3) asm(RW_F0 RW_F1 RW_F2       : "+v"(acc) : "v"(l01), "v"(l23), "v"(pw[i0]), "v"(pw[i0 + 1]), "v"(pw[i0 + 2]));
                    else if (n == 2) asm(RW_F0 RW_F1             : "+v"(acc) : "v"(l01), "v"(l23), "v"(pw[i0]), "v"(pw[i0 + 1]));
                    else             asm(RW_F0                   : "+v"(acc) : "v"(l01), "v"(l23), "v"(pw[i0]));
#undef RW_F0
#undef RW_F1
#undef RW_F2
#undef RW_F3
                }
            }
            pw[t] = acc;
        }
#pragma unroll
        for (int t = 0; t < 32; ++t) { p[t] = pw[t][0]; w[t] = pw[t][1]; }
    }
#define BF(x) __builtin_bit_cast(bf16x8, x)
    u32x4 fBn[2][2], fKn[2][2];
    rw_pack_pairs(bp, hh, fBn); rw_pack_pairs(kp, hh, fKn);
    {
        u32x4 fPn[2][2], fPp[2][2];
        rw_pack<false>(p, hh, fPn); rw_pack<true>(p, hh, fPp);
        bf16_t* mf = g.MF + (size_t)item * 4096;
#pragma unroll
        for (int n = 0; n < 2; ++n) {
            const float gk = gam[32 * n + c];
#pragma unroll
            for (int mp = 0; mp < 2; ++mp) {
                f32x16 x;
#pragma unroll
                for (int r = 0; r < 16; ++r) x[r] = 0.f;
#pragma unroll
                for (int q = 0; q < 2; ++q) x = MFMA32(BF(fPn[mp][q]), BF(fBn[n][q]), x);
#pragma unroll
                for (int r = 0; r < 16; ++r) { const int kprime = (r & 3) + 8 * (r >> 2) + 4 * hh; x[r] = gk * (x[r] + ((mp == n && kprime == c) ? 1.0f : 0.0f)); }
#pragma unroll
                for (int q = 0; q < 2; ++q) *(bf16x8*)(mf + (size_t)(((n * 2 + mp) * 2 + q) * 64 + lane) * 8) = acc_frag(x, q);
            }
        }
        const int r = rbase + (dir ? 31 - c : c);
        bf16_t* qrow = g.QB + ((size_t)dir * T + r) * 1024 + head * 64;
#pragma unroll
        for (int mp = 0; mp < 2; ++mp) {
            f32x16 x;
#pragma unroll
            for (int rr = 0; rr < 16; ++rr) x[rr] = 0.f;
#pragma unroll
            for (int q = 0; q < 2; ++q) x = MFMA32(BF(fPp[mp][q]), b3[q], x);
#pragma unroll
            for (int gq = 0; gq < 4; ++gq) { const int k0 = 32 * mp + 8 * gq + 4 * hh; const u32x2 rt = *(const LAS u32x2*)(s1 + c * RW_TS + k0 * 2);
                u32x2 o; o.x = pk2(x[4 * gq] + bflo(rt.x), x[4 * gq + 1] + bfhi(rt.x)); o.y = pk2(x[4 * gq + 2] + bflo(rt.y), x[4 * gq + 3] + bfhi(rt.y));
                *(u32x2*)(qrow + k0) = o; }
        }
    }
    asm volatile("" ::: "memory");
    {
        u32x4 fWn[2][2], fVn[2][2], fWp[2][2], fVp[2][2];
        rw_pack<false>(w, hh, fWn); rw_pack_pairs(vp, hh, fVn); rw_pack<true>(w, hh, fWp); rw_pack_pairs_perm(vp, hh, fVp);
        bf16_t* nb = g.NB + (size_t)item * 4096;
#pragma unroll
        for (int n = 0; n < 2; ++n)
#pragma unroll
            for (int m = 0; m < 2; ++m) {
                f32x16 x;
#pragma unroll
                for (int r = 0; r < 16; ++r) x[r] = 0.f;
#pragma unroll
                for (int q = 0; q < 2; ++q) { x = MFMA32(BF(fBn[m][q]), BF(fWn[n][q]), x); x = MFMA32(BF(fKn[m][q]), BF(fVn[n][q]), x); }
                u32x4 o0, o1;
#pragma unroll
                for (int gq = 0; gq < 4; ++gq) { const f32x4 gg = *(const LAS f32x4*)(gam + 32 * m + 8 * gq + 4 * hh);
                    const unsigned a0 = pk2(x[4 * gq] * gg[0], x[4 * gq + 1] * gg[1]), a1 = pk2(x[4 * gq + 2] * gg[2], x[4 * gq + 3] * gg[3]);
                    if (gq < 2) { o0[2 * gq] = a0; o0[2 * gq + 1] = a1; } else { o1[2 * (gq - 2)] = a0; o1[2 * (gq - 2) + 1] = a1; } }
                u32x4* dst = (u32x4*)(nb + (size_t)((n * 2 + m) * 64 + lane) * 16);
                dst[0] = o0; dst[1] = o1;
            }
        const int lrow = (dir ? 31 - c : c) + 32 * hh;
        bf16_t* ob = g.OB + ((size_t)((dir * 16 + head) * NCHUNK + cr)) * 2048;
#pragma unroll
        for (int n = 0; n < 2; ++n) {
            f32x16 x;
#pragma unroll
            for (int rr = 0; rr < 16; ++rr) x[rr] = 0.f;
#pragma unroll
            for (int q = 0; q < 2; ++q) { x = MFMA32(BF(fWp[n][q]), b3[q], x); x = MFMA32(BF(fVp[n][q]), *(const LAS bf16x8*)(s2p + RW_TRI_BYTES + q * 1024 + lane * 16), x); }
            u32x4 o0, o1;
#pragma unroll
            for (int e = 0; e < 4; ++e) { o0[e] = pk2(x[2 * e], x[2 * e + 1]); o1[e] = pk2(x[8 + 2 * e], x[8 + 2 * e + 1]); }
            u32x4* dst = (u32x4*)(ob + (size_t)(n * 64 + lrow) * 16);
            dst[0] = o0; dst[1] = o1;
        }
    }
    LDS_WAIT();
}

constexpr int RWB_SLOT = 12288, RWB_FLAGS = MISC_OFF + 1536;
__device__ __forceinline__ void rwkv_stageB(const RWArgs& g, LAS unsigned char* lds, int tk, int wave, int lane) {
    const int n = tk & 1, dh = tk >> 1;
    const bf16_t* mfb = g.MF + (size_t)dh * NCHUNK * 4096; bf16_t* nbb = g.NB + (size_t)dh * NCHUNK * 4096 + (size_t)n * 2048;
    volatile LAS unsigned* flags = (volatile LAS unsigned*)(lds + RWB_FLAGS);
    if (wave != 0) {
        const int sl = wave - 1; LAS unsigned char* slot = lds + sl * RWB_SLOT;
        for (int cs = sl; cs < NCHUNK; cs += 7) {
            u32x4 v[12];
            const u32x4* mp_ = (const u32x4*)(mfb + (size_t)cs * 4096); const u32x4* np_ = (const u32x4*)(nbb + (size_t)cs * 4096);
#pragma unroll
            for (int q = 0; q < 8; ++q) v[q] = mp_[q * 64 + lane];
#pragma unroll
            for (int q = 0; q < 4; ++q) v[8 + q] = np_[q * 64 + lane];
            unsigned sp = 0; while ((int)flags[8] + 7 <= cs) { __builtin_amdgcn_s_sleep(1); if (++sp > (1u << 26)) break; }
#pragma unroll
            for (int q = 0; q < 12; ++q) *(LAS u32x4*)(slot + q * 1024 + lane * 16) = v[q];
            LDS_WAIT();
            if (lane == 0) flags[sl] = (unsigned)(cs + 1);
        }
        return;
    }
    f32x16 H[2];
#pragma unroll
    for (int m = 0; m < 2; ++m)
#pragma unroll
        for (int r = 0; r < 16; ++r) H[m][r] = 0.f;
    for (int cs = 0; cs < NCHUNK; ++cs) {
        const int sl = cs % 7; const LAS unsigned char* slot = lds + sl * RWB_SLOT;
        { unsigned sp = 0; while (flags[sl] != (unsigned)(cs + 1)) { __builtin_amdgcn_s_sleep(1); if (++sp > (1u << 26)) break; } }
        bf16x8 cm[2][2][2]; u32x4 cn[2][2];
#pragma unroll
        for (int m = 0; m < 2; ++m) {
#pragma unroll
            for (int mp = 0; mp < 2; ++mp)
#pragma unroll
                for (int q = 0; q < 2; ++q) cm[m][mp][q] = *(const LAS bf16x8*)(slot + ((m * 2 + mp) * 2 + q) * 1024 + lane * 16);
            cn[m][0] = *(const LAS u32x4*)(slot + 8192 + (m * 64 + lane) * 32); cn[m][1] = *(const LAS u32x4*)(slot + 8192 + (m * 64 + lane) * 32 + 16);
        }
        LDS_WAIT();
        if (lane == 0) flags[8] = (unsigned)(cs + 1);
        bf16x8 hb[2][2];
#pragma unroll
        for (int mp = 0; mp < 2; ++mp)
#pragma unroll
            for (int q = 0; q < 2; ++q) hb[mp][q] = acc_frag(H[mp], q);
        bf16_t* hf = nbb + (size_t)cs * 4096;
#pragma unroll
        for (int mp = 0; mp < 2; ++mp)
#pragma unroll
            for (int q = 0; q < 2; ++q) *(bf16x8*)(hf + (size_t)((mp * 2 + q) * 64 + lane) * 8) = hb[mp][q];
        f32x16 Hn[2];
#pragma unroll
        for (int m = 0; m < 2; ++m) {
#pragma unroll
            for (int e = 0; e < 4; ++e) { Hn[m][2 * e] = bflo(cn[m][0][e]); Hn[m][2 * e + 1] = bfhi(cn[m][0][e]); Hn[m][8 + 2 * e] = bflo(cn[m][1][e]); Hn[m][8 + 2 * e + 1] = bfhi(cn[m][1][e]); }
#pragma unroll
            for (int mp = 0; mp < 2; ++mp)
#pragma unroll
                for (int q = 0; q < 2; ++q) Hn[m] = MFMA32(cm[m][mp][q], hb[mp][q], Hn[m]);
        }
        H[0] = Hn[0]; H[1] = Hn[1];
    }
}

__device__ __forceinline__ void rwkv_stageC(const RWArgs& g, int head, int cr, int lane) {
    const int c = lane & 31, hh = lane >> 5, r = 32 * cr + c, t = r - CTXL;
    f32x16 o[2];
#pragma unroll
    for (int n = 0; n < 2; ++n)
#pragma unroll
        for (int q = 0; q < 16; ++q) o[n][q] = 0.f;
    bf16x8 qf[2][2][2], hf[2][2][2][2]; u32x4 ov[2][2][2];
#pragma unroll
    for (int dir = 0; dir < 2; ++dir) {
        const int cs = rw_scan_chunk(dir, cr);
        const bf16_t* qrow = g.QB + ((size_t)dir * T + r) * 1024 + head * 64;
        const bf16_t* hfb = g.NB + ((size_t)(dir * 16 + head) * NCHUNK + cs) * 4096;
        const bf16_t* ob = g.OB + ((size_t)((dir * 16 + head) * NCHUNK + cr)) * 2048;
#pragma unroll
        for (int mp = 0; mp < 2; ++mp)
#pragma unroll
            for (int q = 0; q < 2; ++q) { const u32x2 lo = *(const u32x2*)(qrow + 32 * mp + 16 * q + 4 * hh), hi = *(const u32x2*)(qrow + 32 * mp + 16 * q + 8 + 4 * hh);
                qf[dir][mp][q] = __builtin_bit_cast(bf16x8, ((u32x4){lo.x, lo.y, hi.x, hi.y})); }
#pragma unroll
        for (int n = 0; n < 2; ++n) {
            const u32x4* src = (const u32x4*)(ob + (size_t)(n * 64 + lane) * 16); ov[dir][n][0] = src[0]; ov[dir][n][1] = src[1];
#pragma unroll
            for (int mp = 0; mp < 2; ++mp)
#pragma unroll
                for (int q = 0; q < 2; ++q) hf[dir][n][mp][q] = *(const bf16x8*)(hfb + (size_t)n * 2048 + (size_t)((mp * 2 + q) * 64 + lane) * 8);
        }
    }
    const bf16_t* rp = g.RP + (size_t)r * 7168 + head * 64;
    u32x4 ra[4], ka[4], aa4[4];
#pragma unroll
    for (int q4 = 0; q4 < 4; ++q4) { ra[q4] = *(const u32x4*)(rp + 32 * hh + 8 * q4); ka[q4] = *(const u32x4*)(rp + 1024 + 32 * hh + 8 * q4); aa4[q4] = *(const u32x4*)(rp + 4096 + 32 * hh + 8 * q4); }
    __builtin_amdgcn_sched_barrier(0);
#pragma unroll
    for (int dir = 0; dir < 2; ++dir)
#pragma unroll
        for (int n = 0; n < 2; ++n) {
#pragma unroll
            for (int e = 0; e < 4; ++e) { o[n][2 * e] += bflo(ov[dir][n][0][e]); o[n][2 * e + 1] += bfhi(ov[dir][n][0][e]); o[n][8 + 2 * e] += bflo(ov[dir][n][1][e]); o[n][8 + 2 * e + 1] += bfhi(ov[dir][n][1][e]); }
#pragma unroll
            for (int mp = 0; mp < 2; ++mp)
#pragma unroll
                for (int q = 0; q < 2; ++q) o[n] = MFMA32(hf[dir][n][mp][q], qf[dir][mp][q], o[n]);
        }
    float sm = 0.f;
#pragma unroll
    for (int n = 0; n < 2; ++n)
#pragma unroll
        for (int q = 0; q < 16; ++q) sm += o[n][q];
    sm += __shfl_xor(sm, 32); const float mu = sm * (1.0f / 64.0f);
    float sv = 0.f;
#pragma unroll
    for (int n = 0; n < 2; ++n)
#pragma unroll
        for (int q = 0; q < 16; ++q) { const float d = o[n][q] - mu; sv += d * d; }
    sv += __shfl_xor(sv, 32); const float rs = __builtin_amdgcn_rsqf(sv * (1.0f / 64.0f) + 64e-5f);
    float bs = 0.f;
#pragma unroll
    for (int q4 = 0; q4 < 4; ++q4) { const float* rk = g.rk + head * 64 + 32 * hh + 8 * q4; const float* kac = g.ka + head * 64 + 32 * hh + 8 * q4;
#pragma unroll
        for (int e = 0; e < 4; ++e) { const float km0 = bflo(ka[q4][e]) * (1.0f + (bflo(aa4[q4][e]) - 1.0f) * kac[2 * e]), km1 = bfhi(ka[q4][e]) * (1.0f + (bfhi(aa4[q4][e]) - 1.0f) * kac[2 * e + 1]);
            bs = fmaf(bflo(ra[q4][e]) * km0, rk[2 * e], bs); bs = fmaf(bfhi(ra[q4][e]) * km1, rk[2 * e + 1], bs); } }
    bs += __shfl_xor(bs, 32);
#pragma unroll
    for (int n = 0; n < 2; ++n)
#pragma unroll
        for (int gq = 0; gq < 4; ++gq) {
            const int v0 = 32 * n + 8 * gq + 4 * hh, ch = head * 64 + v0;
            const u32x2 vv = *(const u32x2*)(rp + 2048 + v0), go = *(const u32x2*)(g.GOUT + (size_t)r * 1024 + ch);
            const f32x4 lw = *(const f32x4*)(g.lnw + ch), lb = *(const f32x4*)(g.lnb + ch);
            const float e0 = ((o[n][4 * gq] - mu) * rs * lw[0] + lb[0] + bs * bflo(vv.x)) * bflo(go.x), e1 = ((o[n][4 * gq + 1] - mu) * rs * lw[1] + lb[1] + bs * bfhi(vv.x)) * bfhi(go.x);
            const float e2 = ((o[n][4 * gq + 2] - mu) * rs * lw[2] + lb[2] + bs * bflo(vv.y)) * bflo(go.y), e3 = ((o[n][4 * gq + 3] - mu) * rs * lw[3] + lb[3] + bs * bfhi(vv.y)) * bfhi(go.y);
            u32x2 w; w.x = pk2(e0, e1); w.y = pk2(e2, e3);
            *(u32x2*)(g.mix + (size_t)t * D + 1024 + ch) = w;
        }
}
#undef BF

__device__ __forceinline__ void shifted4(const bf16_t* P, int r, int col, const float* mup, const float* mun, float (&o)[4]) {
    const u32x2 p = *(const u32x2*)(P + (size_t)r * N1 + col);
    u32x2 pv = (u32x2){0u, 0u}, nx = (u32x2){0u, 0u};
    if (!(r == 0 || r == CTXL)) pv = *(const u32x2*)(P + (size_t)(r - 1) * N1 + col);
    if (!(r == CTXL - 1 || r == T - 1)) nx = *(const u32x2*)(P + (size_t)(r + 1) * N1 + col);
    const f32x4 mp = *(const f32x4*)(mup + col - R_R), mn = *(const f32x4*)(mun + col - R_R);
    const float pc[4] = {bflo(p.x), bfhi(p.x), bflo(p.y), bfhi(p.y)}, pp[4] = {bflo(pv.x), bfhi(pv.x), bflo(pv.y), bfhi(pv.y)}, pn[4] = {bflo(nx.x), bfhi(nx.x), bflo(nx.y), bfhi(nx.y)};
#pragma unroll
    for (int e = 0; e < 4; ++e) o[e] = pc[e] + mp[e] * (pp[e] - pc[e]) + mn[e] * (pn[e] - pc[e]);
}
__device__ __forceinline__ void st4bf(bf16_t* p, float a0, float a1, float a2, float a3) { u32x2 w; w.x = pk2(a0, a1); w.y = pk2(a2, a3); *(u32x2*)p = w; }
__device__ __forceinline__ void rwkv_xfill(const Args& a, const bf16_t* P, bf16_t* XL, int gtid, int gthreads) {
    const float* mup = a.in[I_MUPREV]; const float* mun = a.in[I_MUNEXT];
    for (int idx = gtid; idx < T * 256; idx += gthreads) {
        const int row = idx >> 8, q = idx & 255, plane = q >> 6, col = (q & 63) * 4;
        float v[4] = {0.f, 0.f, 0.f, 0.f};
        if (plane == 3 || col < 96) {
            shifted4(P, row, R_WDF + (plane == 3 ? 288 : plane * 96) + col, mup, mun, v);
            if (plane < 2) { for (int e = 0; e < 4; ++e) v[e] = tanhf_(v[e]); }
            else if (plane == 3) { for (int e = 0; e < 4; ++e) v[e] = sigmoidf_(v[e]); }
        }
        st4bf(XL + ((size_t)plane * T + row) * 256 + col, v[0], v[1], v[2], v[3]);
    }
}
__device__ __forceinline__ void rwkv_rkv(const Args& a, const bf16_t* P, bf16_t* RP, int gw, int ngw, int lane) {
    const float* mup = a.in[I_MUPREV]; const float* mun = a.in[I_MUNEXT];
    for (int it = gw; it < T * 4; it += ngw) {
        const int r = it >> 2, ch = (it & 3) * 256 + 4 * lane;
        float x[4], k[4], y[4];
        shifted4(P, r, R_R + ch, mup, mun, x); shifted4(P, r, R_K + ch, mup, mun, k); shifted4(P, r, R_V + ch, mup, mun, y);
        bf16_t* rp = RP + (size_t)r * 7168;
        const f32x4 kkc = *(const f32x4*)(a.in[I_KK] + ch);
        float kq[4], ss = 0.f;
#pragma unroll
        for (int e = 0; e < 4; ++e) { kq[e] = k[e] * kkc[e]; ss += kq[e] * kq[e]; }
        ss += __shfl_xor(ss, 1); ss += __shfl_xor(ss, 2); ss += __shfl_xor(ss, 4); ss += __shfl_xor(ss, 8);
        const float rn = __builtin_amdgcn_rsqf(ss + 1e-12f);
        st4bf(rp + ch, x[0], x[1], x[2], x[3]);
        st4bf(rp + 1024 + ch, k[0], k[1], k[2], k[3]);
        st4bf(rp + 2048 + ch, y[0], y[1], y[2], y[3]);
        st4bf(rp + 3072 + ch, kq[0] * rn, kq[1] * rn, kq[2] * rn, kq[3] * rn);
    }
}

__device__ __forceinline__ void moe_tables(LAS unsigned char* lds, const int* blkcnt, int tid) {
    LAS int* tab = (LAS int*)(lds + MOE_TAB_OFF); LAS int* pref = (LAS int*)(lds + PREF_OFF);
    const int lane = tid & 63, e = tid >> 6;
    __syncthreads();
    int cnt[4], run = 0;
#pragma unroll
    for (int i = 0; i < 4; ++i) { cnt[i] = blkcnt[(4 * lane + i) * 8 + e]; run += cnt[i]; }
    int inc = run;
#pragma unroll
    for (int o = 1; o < 64; o <<= 1) { const int v = __shfl_up(inc, o); if (lane >= o) inc += v; }
    int ex = inc - run;
#pragma unroll
    for (int i = 0; i < 4; ++i) { pref[(4 * lane + i) * 8 + e] = ex; ex += cnt[i]; }
    if (lane == 63) tab[e] = inc;
    __syncthreads();
    int off = 0, np = 0, mye = -1;
#pragma unroll
    for (int x = 0; x < 8; ++x) { const int npe = (tab[x] + 255) >> 8; if (tid == 0) tab[8 + x] = off; if (tid >= np && tid < np + npe) mye = x; off += npe * 256; np += npe; }
    if (mye >= 0) tab[18 + tid] = mye;
    if (tid == 0) { tab[16] = off; tab[17] = np; }
    __syncthreads();
}

constexpr int NPH = 23;
__global__ void __launch_bounds__(NTHR, 2) trunk_fwd(Args a) {
    extern __shared__ __attribute__((aligned(16))) unsigned char lds_raw[];
    LAS unsigned char* lds = (LAS unsigned char*)lds_raw;
    const int tid = threadIdx.x, lane = tid & 63, wave = __builtin_amdgcn_readfirstlane(tid >> 6);
    const int bx = blockIdx.x, G = gridDim.x, gw = bx * NWAVES + wave, NGW = G * NWAVES;
    unsigned char* ws = a.ws;
    for (int u = tid; u < (LDS_BYTES - MISC_OFF) / 4; u += NTHR) ((LAS unsigned*)(lds + MISC_OFF))[u] = 0u;
    __syncthreads();
    const int lo = a.ph_lo, hi = a.ph_hi;
    XcdBarrier bar; bar.bar = (unsigned*)(ws + WS_CTL) + CW_BAR; bar.x = 0; bar.st = (volatile LAS unsigned*)(lds + MISC_OFF);
    if (hi - lo > 1) bar = xcd_barrier_post((unsigned*)(ws + WS_CTL) + CW_BAR, (volatile LAS unsigned*)(lds + MISC_OFF));
#ifdef ONLY_PHASE
#define IN(k) ((k) == ONLY_PHASE && lo <= (k) && (k) < hi)
#else
#define IN(k) (lo <= (k) && (k) < hi)
#endif
#define SEAM(k) do { if (IN(k) && IN((k) + 1)) xcd_barrier(bar); } while (0)
#define MODP(l, vec, which) (mod + (size_t)(((l) * 2 + (vec)) * 6 + (which)) * 2048)
    const float* mod = (const float*)(ws + WS_MOD);
    bf16_t* H = (bf16_t*)(ws + WS_H);
    bf16_t* XB = (bf16_t*)(ws + WS_XB);
    float* out = a.out;
    const size_t TS2048 = (size_t)256 * 2048 * 2;

    if (IN(0)) for (int rep_ = 0; rep_ <= (int)((REPMASK >> 0) & 1u); ++rep_) { if (rep_) __syncthreads(); p0_prologue(a, lds, tid, lane, wave); }
    SEAM(0);
    if (IN(1)) for (int rep_ = 0; rep_ <= (int)((REPMASK >> 1) & 1u); ++rep_) { if (rep_) __syncthreads();
        for (int r = gw; r < T; r += NGW) {
            const int vec = r < CTXL ? 1 : 0; const float* xin = vec ? a.in[I_CTX] + (size_t)r * D : a.in[I_X] + (size_t)(r - CTXL) * D;
            f32x4 v[8]; ldrow(xin, lane, v);
            mod_store_i8(v, a.in[I_NMIXPRE0], MODP(0, vec, 1), MODP(0, vec, 0), (signed char*)(ws + WS_H) + (size_t)r * D, (float*)(ws + WS_HSC) + r, lane);
        }
    }
    SEAM(1);
    if (IN(2)) for (int rep_ = 0; rep_ <= (int)((REPMASK >> 2) & 1u); ++rep_) { if (rep_) __syncthreads();
        pg8::SchedPlain S{(const char*)(ws + WS_H), (const char*)(ws + W_IN0T), 65, 21, G, bx, (size_t)256 * 2048, 5 * 65, (const char*)(ws + W_V0T), (const char*)(ws + WS_H), 65, 0};
        pg8::EpiBf16I8 E{(bf16_t*)(ws + A_PROJ0), N0, (bf16_t*)(ws + A_VT), T, (const float*)(ws + WS_HSC), (const float*)(ws + WS_QI0), (const float*)(ws + WS_QV0), (const float*)(ws + WS_HSC)};
        pg8::gemm_phase<pg8::EpiBf16I8, pg8::SchedPlain, true>(lds, 2048, S, E);
    }
    SEAM(2);
    const GLArgs g0{(const bf16_t*)(ws + A_PROJ0), (const bf16_t*)(ws + A_VT), (bf16_t*)(ws + A_KVT0), (float*)(ws + A_DEC0), (bf16_t*)(ws + A_MIX0), a.in[I_LBL], nullptr, nullptr, nullptr, nullptr, a.in[I_HNORM]};
    if (IN(3)) for (int rep_ = 0; rep_ <= (int)((REPMASK >> 3) & 1u); ++rep_) { if (rep_) __syncthreads();
        const float* ropetab = (const float*)(ws + WS_ROPE);
        for (int rq_ = 0; rq_ <= (int)((REPMASK >> 24) & 1u); ++rq_)
        for (int u = bx; u < 520; u += G) {
            const int kind = u < 512 ? 0 : 1, uu = u < 512 ? u : u - 512;
            attn_unit(lds, (const bf16_t*)(ws + A_PROJ0), (const bf16_t*)(ws + A_VT), (bf16_t*)(ws + A_MIX0), a.in[I_SINK], ropetab, kind, uu >> 1, uu & 1, tid);
        }
        for (int rq_ = 0; rq_ <= (int)((REPMASK >> 25) & 1u); ++rq_) gl_phaseA<0>(g0, lds, tid, bx, G);
    }
    SEAM(3);
    if (IN(4)) { gl_phaseB<0, 4>(g0, tid < 256 ? bx * 256 + tid : -1);
        if ((REPMASK >> 23) & 1u) { GLArgs gx = g0; gx.kvt = (bf16_t*)(ws + WS_A + 700 * MiB); gx.dec = (float*)(ws + WS_A + 965 * MiB); gl_phaseB<0, 4>(gx, tid < 256 ? bx * 256 + tid : -1); } }
    SEAM(4);
    if (IN(5)) for (int rep_ = 0; rep_ <= (int)((REPMASK >> 5) & 1u); ++rep_) { if (rep_) __syncthreads(); gl_phaseC<0>(g0, lds, tid, bx, G); }
    SEAM(5);
    if (IN(6)) for (int rep_ = 0; rep_ <= (int)((REPMASK >> 6) & 1u); ++rep_) { if (rep_) __syncthreads();
        pg8::SchedPlain S{(const char*)(ws + A_MIX0), (const char*)(ws + W_OUT0T), 64, 8, G, bx, TS2048, 0, nullptr, nullptr, 1, 1};
        pg8::EpiBf16 E{(bf16_t*)(ws + A_Y0), 2048, nullptr, 0};
        pg8::gemm_phase<pg8::EpiBf16, pg8::SchedPlain>(lds, 4096, S, E);
        pg8::SchedSplit S2{(const char*)(ws + A_MIX0), (const char*)(ws + W_OUT0T), 8, 8, G, bx, TS2048, (size_t)512};
        pg8::EpiF32 E2{(float*)(ws + A_PY0), 2048, (size_t)256 * 2048};
        pg8::gemm_phase<pg8::EpiF32, pg8::SchedSplit>(lds, 4096, S2, E2, 512 + (lo >> 20));
    }
    SEAM(6);
    if (IN(7)) for (int rep_ = 0; rep_ <= (int)((REPMASK >> 7) & 1u); ++rep_) { if (rep_) __syncthreads();
        const bf16_t* Y0 = (const bf16_t*)(ws + A_Y0);
        for (int r = gw; r < T; r += NGW) {
            const int vec = r < CTXL ? 1 : 0; const float* xin = vec ? a.in[I_CTX] + (size_t)r * D : a.in[I_X] + (size_t)(r - CTXL) * D;
            bf16_t* xo = XB + (size_t)r * D;
            f32x4 v[8], b[8]; ldrow(xin, lane, v);
            if (vec) { const float* pp = (const float*)(ws + A_PY0) + (size_t)r * D; ldrow(pp, lane, b);
                for (int ks = 1; ks < 8; ++ks) { f32x4 t2[8]; ldrow(pp + (size_t)ks * 256 * 2048, lane, t2);
#pragma unroll
                    for (int j = 0; j < 8; ++j) b[j] += t2[j]; } }
            else ldrow_bf(Y0 + (size_t)r * D, lane, b);
            add_branch(v, b, a.in[I_NMIXPOST0], MODP(0, vec, 2), lane); strow_bf(xo, lane, v);
            mod_store_i8(v, a.in[I_NFFNPRE0], MODP(0, vec, 4), MODP(0, vec, 3), (signed char*)(ws + WS_H) + (size_t)r * D, (float*)(ws + WS_HSC) + r, lane);
        }
    }
    SEAM(7);
    if (IN(8)) for (int rep_ = 0; rep_ <= (int)((REPMASK >> 8) & 1u); ++rep_) { if (rep_) __syncthreads();
        pg8::SchedPlain S{(const char*)(ws + WS_H), (const char*)(ws + W_GU0T), 65, 44, G, bx, (size_t)256 * 2048, 0, nullptr, nullptr, 1, 0};
        pg8::EpiSwigluI8 E{(bf16_t*)(ws + A_HID0), FF0, (const float*)(ws + WS_HSC), (const float*)(ws + WS_QS0), 0};
        pg8::gemm_phase<pg8::EpiSwigluI8, pg8::SchedPlain, true>(lds, 2048, S, E);
    }
    SEAM(8);
    if (IN(9)) for (int rep_ = 0; rep_ <= (int)((REPMASK >> 9) & 1u); ++rep_) { if (rep_) __syncthreads();
        pg8::SchedPlain S{(const char*)(ws + A_HID0), (const char*)(ws + W_DN0T), 64, 8, G, bx, (size_t)256 * FF0 * 2, 0, nullptr, nullptr, 1, 1};
        pg8::EpiBf16 E{(bf16_t*)(ws + A_F0), 2048, nullptr, 0};
        pg8::gemm_phase<pg8::EpiBf16, pg8::SchedPlain>(lds, 2 * FF0, S, E);
        pg8::SchedSplit S2{(const char*)(ws + A_HID0), (const char*)(ws + W_DN0T), 8, 22, G, bx, (size_t)256 * FF0 * 2, (size_t)512};
        pg8::EpiF32 E2{(float*)(ws + A_PF0), 2048, (size_t)256 * 2048};
        pg8::gemm_phase<pg8::EpiF32, pg8::SchedSplit>(lds, 2 * FF0, S2, E2, 512 + (lo >> 20));
    }
    SEAM(9);
    if (IN(10)) {
        const bf16_t* F0 = (const bf16_t*)(ws + A_F0);
        for (int r = gw; r < T; r += NGW) {
            const int vec = r < CTXL ? 1 : 0; bf16_t* xo = XB + (size_t)r * D;
            f32x4 v[8], b[8]; ldrow_bf(xo, lane, v);
            if (vec) { const float* pp = (const float*)(ws + A_PF0) + (size_t)r * D; ldrow(pp, lane, b);
                for (int ks = 1; ks < 22; ++ks) { f32x4 t2[8]; ldrow(pp + (size_t)ks * 256 * 2048, lane, t2);
#pragma unroll
                    for (int j = 0; j < 8; ++j) b[j] += t2[j]; } }
            else ldrow_bf(F0 + (size_t)r * D, lane, b);
            add_branch(v, b, a.in[I_NFFNPOST0], MODP(0, vec, 5), lane); strow_bf(xo, lane, v);
            mod_store_i8(v, a.in[I_NMIXPRE1], MODP(1, vec, 1), MODP(1, vec, 0), (signed char*)(ws + WS_H) + (size_t)r * D, (float*)(ws + WS_HSC) + r, lane);
        }
    }
    SEAM(10);
    if (IN(11)) for (int rep_ = 0; rep_ <= (int)((REPMASK >> 11) & 1u); ++rep_) { if (rep_) __syncthreads();
        pg8::SchedPlain S{(const char*)(ws + WS_H), (const char*)(ws + W_IN1T), 65, 23, G, bx, (size_t)256 * 2048, 4 * 65, (const char*)(ws + W_GV1T), (const char*)(ws + WS_H), 65, 0};
        pg8::EpiBf16I8 E{(bf16_t*)(ws + A_PROJ1), N1, (bf16_t*)(ws + A_GVT), T, (const float*)(ws + WS_HSC), (const float*)(ws + WS_QI1), (const float*)(ws + WS_QG1), (const float*)(ws + WS_HSC)};
        pg8::gemm_phase<pg8::EpiBf16I8, pg8::SchedPlain, true>(lds, 2048, S, E);
    }
    SEAM(11);
    const GLArgs g1{(const bf16_t*)(ws + A_PROJ1), (const bf16_t*)(ws + A_GVT), (bf16_t*)(ws + A_KVT1), (float*)(ws + A_DEC1), (bf16_t*)(ws + A_MIX1), nullptr, a.in[I_GUPF], a.in[I_GUPB], a.in[I_GBIASF], a.in[I_GBIASB], a.in[I_GLANORM]};
    const RWArgs rwa{(const bf16_t*)(ws + A_RP), (const bf16_t*)(ws + A_GOUT), (bf16_t*)(ws + A_MF), (bf16_t*)(ws + A_NB), (bf16_t*)(ws + A_QB), (bf16_t*)(ws + A_OB), (bf16_t*)(ws + A_MIX1), a.in[I_RK], a.in[I_LNW], a.in[I_LNB], a.in[I_KA]};
    if (IN(12)) for (int rep_ = 0; rep_ <= (int)((REPMASK >> 12) & 1u); ++rep_) { if (rep_) __syncthreads();
        rwkv_xfill(a, (const bf16_t*)(ws + A_PROJ1), (bf16_t*)(ws + A_XL), bx * NTHR + tid, G * NTHR);
        rwkv_rkv(a, (const bf16_t*)(ws + A_PROJ1), (bf16_t*)(ws + A_RP), gw, NGW, lane);
        gl_phaseA<1>(g1, lds, tid, bx, G);
    }
    SEAM(12);
    if (IN(13)) {
        pg8::SchedLora S{(const char*)(ws + A_XL), (const char*)(ws + WS_LORA4), (size_t)T * 512, G, bx};
        pg8::EpiLora E{(bf16_t*)(ws + A_RP), ((long)A_GOUT - (long)A_RP) / 2, (const float*)(ws + WS_LB)};
        pg8::gemm_phase<pg8::EpiLora, pg8::SchedLora>(lds, 512 + (lo >> 20), S, E);
    }
    SEAM(13);
    if (IN(14)) {
        volatile LAS int* ictr = (volatile LAS int*)(lds + MISC_OFF + 1600);
        if (tid == 0) *ictr = 0;
        __syncthreads();
        if (wave >= 4) gl_phaseB<1, 4>(g1, bx * 256 + (tid - 256));
        {
            const int nw = wave < 4 ? (wave == 0 ? 11 : 10) : 6, jb = wave < 4 ? wave : 40 + (wave - 4);
            for (int i = 0; i < nw; ++i) { const int j = (wave == 0 && i == 10) ? 64 : jb + 4 * i; rwkv_stageA(rwa, lds + wave * RW_WAVE_LDS, bx + 256 * j, lane); }
        }
    }
    SEAM(14);
    if (IN(15)) {
        if (bx < 64) rwkv_stageB(rwa, lds, bx, wave, lane);
        else for (int rq_ = 0; rq_ <= (int)((REPMASK >> 29) & 1u); ++rq_) gl_phaseC<1>(g1, lds, tid, bx - 64, G - 64);
    }
    SEAM(15);
    if (IN(16)) for (int rep_ = 0; rep_ <= (int)((REPMASK >> 15) & 1u); ++rep_) { if (rep_) __syncthreads();
        for (int it = gw; it < 16 * (NCHUNK - 8); it += NGW) rwkv_stageC(rwa, it & 15, 8 + (it >> 4), lane);
    }
    SEAM(16);
    if (IN(17)) for (int rep_ = 0; rep_ <= (int)((REPMASK >> 18) & 1u); ++rep_) { if (rep_) __syncthreads();
        pg8::SchedPlain S{(const char*)(ws + A_MIX1), (const char*)(ws + W_OUT1T), 64, 8, G, bx, TS2048, 0, nullptr, nullptr, 1, 0};
        pg8::EpiBf16 E{(bf16_t*)(ws + A_Y1), 2048, nullptr, 0};
        pg8::gemm_phase<pg8::EpiBf16, pg8::SchedPlain>(lds, 4096, S, E);
    }
    SEAM(17);
    int* tk_e = (int*)(ws + WS_TK); float* tk_w = (float*)(ws + WS_TK + 128 * 1024); int* tk_lr = (int*)(ws + WS_TK + 256 * 1024); int* tk_pos = (int*)(ws + WS_TK + 384 * 1024);
    int* blkcnt = (int*)(ws + WS_BLKCNT);
    if (IN(18)) {
        LAS int* ecnt = (LAS int*)(lds + ECNT_OFF);
        if (tid < 8) ecnt[tid] = 0;
        __syncthreads();
        const bf16_t* Y1 = (const bf16_t*)(ws + A_Y1); const float* router = a.in[I_ROUTER];
        for (int t = gw; t < SEQ; t += NGW) {
            f32x4 v[8], b[8]; ldrow_bf(XB + (size_t)(t + CTXL) * D, lane, v); ldrow_bf(Y1 + (size_t)t * D, lane, b);
            add_branch(v, b, a.in[I_NMIXPOST1], MODP(1, 0, 2), lane); strow_bf(XB + (size_t)(t + CTXL) * D, lane, v);
            mod_store(v, a.in[I_NFFNPRE1], MODP(1, 0, 4), MODP(1, 0, 3), H + (size_t)t * D, lane);
            float lg[8];
#pragma unroll
            for (int e = 0; e < 8; ++e) lg[e] = 0.f;
#pragma unroll
            for (int j = 0; j < 8; ++j)
#pragma unroll
                for (int q = 0; q < 4; ++q) { const float* rp = router + (size_t)(4 * lane + 256 * j + q) * 8; const f32x4 r0 = *(const f32x4*)rp, r1 = *(const f32x4*)(rp + 4); const float hv = v[j][q];
                    lg[0] = fmaf(hv, r0[0], lg[0]); lg[1] = fmaf(hv, r0[1], lg[1]); lg[2] = fmaf(hv, r0[2], lg[2]); lg[3] = fmaf(hv, r0[3], lg[3]);
                    lg[4] = fmaf(hv, r1[0], lg[4]); lg[5] = fmaf(hv, r1[1], lg[5]); lg[6] = fmaf(hv, r1[2], lg[6]); lg[7] = fmaf(hv, r1[3], lg[7]); }
#pragma unroll
            for (int e = 0; e < 8; ++e) lg[e] = wave_sum(lg[e]);
            int ea = 0; float va = lg[0];
#pragma unroll
            for (int e = 1; e < 8; ++e) if (lg[e] > va) { va = lg[e]; ea = e; }
            int eb = -1; float vb = -INFINITY;
#pragma unroll
            for (int e = 0; e < 8; ++e) if (e != ea && lg[e] > vb) { vb = lg[e]; eb = e; }
            if (eb < 0) eb = (ea + 1) & 7;
            const float wa = 1.0f / (1.0f + fexp(vb - va)), wb = 1.0f - wa;
            if (lane == 0) {
                const int la = __hip_atomic_fetch_add(ecnt + ea, 1, __ATOMIC_RELAXED, __HIP_MEMORY_SCOPE_WORKGROUP);
                const int lb = __hip_atomic_fetch_add(ecnt + eb, 1, __ATOMIC_RELAXED, __HIP_MEMORY_SCOPE_WORKGROUP);
                tk_e[2 * t] = ea; tk_e[2 * t + 1] = eb; tk_w[2 * t] = wa; tk_w[2 * t + 1] = wb; tk_lr[2 * t] = la; tk_lr[2 * t + 1] = lb;
            }
        }
        __syncthreads();
        if (tid < 8) blkcnt[bx * 8 + tid] = ecnt[tid];
    }
    SEAM(18);
    if (IN(19)) for (int rep_ = 0; rep_ <= (int)((REPMASK >> 20) & 1u); ++rep_) { if (rep_) __syncthreads();
        moe_tables(lds, blkcnt, tid);
        const LAS int* tab = (const LAS int*)(lds + MOE_TAB_OFF); const LAS int* pref = (const LAS int*)(lds + PREF_OFF);
        signed char* SORT = (signed char*)(ws + A_SORT); float* ssc = (float*)(ws + WS_SSC);
        for (int t = gw; t < SEQ; t += NGW) {
            const int b = (t % NGW) / NWAVES;
            const u32x4* src = (const u32x4*)(H + (size_t)t * D); u32x4 hv[4]; float mx = 0.f;
#pragma unroll
            for (int j = 0; j < 4; ++j) { hv[j] = src[lane + 64 * j];
#pragma unroll
                for (int e = 0; e < 4; ++e) mx = fmaxf(mx, fmaxf(fabsf(bflo(hv[j][e])), fabsf(bfhi(hv[j][e])))); }
#pragma unroll
            for (int o = 1; o < 64; o <<= 1) mx = fmaxf(mx, __shfl_xor(mx, o));
            const float inv = mx > 0.f ? 127.0f / mx : 0.f, scl = mx > 0.f ? mx * (1.0f / 127.0f) : 1.0f;
            u32x2 qv[4];
#pragma unroll
            for (int j = 0; j < 4; ++j) { unsigned pk[2];
#pragma unroll
                for (int hq = 0; hq < 2; ++hq) { const unsigned w0 = hv[j][2 * hq], w1 = hv[j][2 * hq + 1];
                    const int q0 = (int)__builtin_rintf(bflo(w0) * inv), q1 = (int)__builtin_rintf(bfhi(w0) * inv), q2 = (int)__builtin_rintf(bflo(w1) * inv), q3 = (int)__builtin_rintf(bfhi(w1) * inv);
                    pk[hq] = (unsigned)(q0 & 0xff) | ((unsigned)(q1 & 0xff) << 8) | ((unsigned)(q2 & 0xff) << 16) | ((unsigned)(q3 & 0xff) << 24); }
                qv[j] = (u32x2){pk[0], pk[1]}; }
#pragma unroll
            for (int sl = 0; sl < 2; ++sl) {
                const int e = tk_e[2 * t + sl], lr = tk_lr[2 * t + sl];
                const int pos = tab[8 + e] + pref[b * 8 + e] + lr;
                if (lane == 0) { tk_pos[2 * t + sl] = pos; ssc[pos] = scl; }
                u32x2* dst = (u32x2*)(SORT + (size_t)pos * D);
#pragma unroll
                for (int j = 0; j < 4; ++j) dst[lane + 64 * j] = qv[j];
            }
        }
    }
    SEAM(19);
    if (IN(20)) for (int rep_ = 0; rep_ <= (int)((REPMASK >> 21) & 1u); ++rep_) { if (rep_) __syncthreads();
        moe_tables(lds, blkcnt, tid);
        const LAS int* tab = (const LAS int*)(lds + MOE_TAB_OFF);
        pg8::SchedMoe S{(const char*)(ws + A_SORT), (const char*)(ws + W_MGUT), (size_t)14336 * 2048, tab[17], 56, G, bx, (size_t)256 * 2048, tab + 18};
        pg8::EpiSwigluI8 E{(bf16_t*)(ws + A_HID1), FFE, (const float*)(ws + WS_SSC), (const float*)(ws + WS_QSM), 14336};
        pg8::gemm_phase<pg8::EpiSwigluI8, pg8::SchedMoe, true>(lds, 2048, S, E);
    }
    SEAM(20);
    if (IN(21)) for (int rep_ = 0; rep_ <= (int)((REPMASK >> 22) & 1u); ++rep_) { if (rep_) __syncthreads();
        moe_tables(lds, blkcnt, tid);
        const LAS int* tab = (const LAS int*)(lds + MOE_TAB_OFF);
        const int nwg = tab[17] * 8, nfull = (nwg >> 8) << 8, rem = nwg - nfull;
        const int split = rem == 0 ? 1 : (rem * 8 <= 256 ? 8 : (rem * 4 <= 256 ? 4 : (rem * 2 <= 256 ? 2 : 1)));
        const size_t kslice = (size_t)(2 * FFE) / split;
        pg8::SchedMoeDown S{(const char*)(ws + A_HID1), (const char*)(ws + W_MDNT), (size_t)2048 * FFE * 2, split > 1 ? nfull : nwg, G, bx, (size_t)256 * FFE * 2, tab + 18, 0, 0, nfull, 0};
        pg8::EpiMoeDown E{(bf16_t*)(ws + A_YDN), (float*)(ws + A_PYD)};
        pg8::gemm_phase<pg8::EpiMoeDown, pg8::SchedMoeDown>(lds, 2 * FFE, S, E);
        if (split > 1) {
            pg8::SchedMoeDown S2{(const char*)(ws + A_HID1), (const char*)(ws + W_MDNT), (size_t)2048 * FFE * 2, 0, G, bx, (size_t)256 * FFE * 2, tab + 18, split, rem, nfull, kslice};
            pg8::gemm_phase<pg8::EpiMoeDown, pg8::SchedMoeDown>(lds, 2 * FFE, S2, E, (int)kslice);
        }
    }
    SEAM(21);
    if (IN(22)) {
        const bf16_t* YDN = (const bf16_t*)(ws + A_YDN); const float* PYD = (const float*)(ws + A_PYD);
        moe_tables(lds, blkcnt, tid);
        const LAS int* tab = (const LAS int*)(lds + MOE_TAB_OFF);
        const int nwg = tab[17] * 8, nfull = (nwg >> 8) << 8, rem = nwg - nfull, pfull = nfull >> 3;
        const int split = rem == 0 ? 1 : (rem * 8 <= 256 ? 8 : (rem * 4 <= 256 ? 4 : (rem * 2 <= 256 ? 2 : 1)));
        for (int t = gw; t < SEQ; t += NGW) {
            f32x4 v[8], b[8]; ldrow_bf(XB + (size_t)(t + CTXL) * D, lane, v);
            const int pa = tk_pos[2 * t], pb = tk_pos[2 * t + 1]; const float wa = tk_w[2 * t], wb = tk_w[2 * t + 1];
            if (split > 1 && ((pa >> 8) >= pfull || (pb >> 8) >= pfull)) {
#pragma unroll
                for (int j = 0; j < 8; ++j) b[j] = (f32x4){0.f, 0.f, 0.f, 0.f};
#pragma unroll 1
                for (int sl = 0; sl < 2; ++sl) { const int pos = sl ? pb : pa; const float w = sl ? wb : wa;
                    if ((pos >> 8) >= pfull) { for (int ks = 0; ks < split; ++ks) { f32x4 t2[8]; ldrow(PYD + ((size_t)(((pos >> 8) - pfull) * split + ks) * 256 + (pos & 255)) * 2048, lane, t2);
#pragma unroll
                            for (int j = 0; j < 8; ++j) b[j] += t2[j] * w; } }
                    else {
#pragma unroll
                        for (int j = 0; j < 8; ++j) { const u32x2 y = *(const u32x2*)(YDN + (size_t)pos * D + 4 * lane + 256 * j); b[j] += (f32x4){bflo(y.x), bfhi(y.x), bflo(y.y), bfhi(y.y)} * w; } } }
                add_branch(v, b, a.in[I_NFFNPOST1], MODP(1, 0, 5), lane); strow(out + (size_t)t * D, lane, v);
                continue;
            }
#pragma unroll
            for (int j = 0; j < 8; ++j) { const u32x2 ya = *(const u32x2*)(YDN + (size_t)pa * D + 4 * lane + 256 * j), yb = *(const u32x2*)(YDN + (size_t)pb * D + 4 * lane + 256 * j);
                b[j] = (f32x4){wa * bflo(ya.x) + wb * bflo(yb.x), wa * bfhi(ya.x) + wb * bfhi(yb.x), wa * bflo(ya.y) + wb * bflo(yb.y), wa * bfhi(ya.y) + wb * bfhi(yb.y)}; }
            add_branch(v, b, a.in[I_NFFNPOST1], MODP(1, 0, 5), lane); strow(out + (size_t)t * D, lane, v);
        }
    }
#undef IN
#undef SEAM
#undef MODP
}

extern "C" void kernel_launch(void* const* d_in, const int* in_sizes, int n_in, void* d_out, int out_size, void* d_ws, size_t ws_size, hipStream_t stream) {
    static int state = 0;
    if (state == 0) {
        state = -1;
        if (n_in != 49 || out_size != SEQ * D || ws_size < WS_END) { fprintf(stderr, "kernel_launch: unexpected shapes (n_in %d, out %d, ws %zu, need %zu)\n", n_in, out_size, ws_size, (size_t)WS_END); return; }
        if (hipFuncSetAttribute((const void*)trunk_fwd, hipFuncAttributeMaxDynamicSharedMemorySize, LDS_BYTES) != hipSuccess) { fprintf(stderr, "kernel_launch: hipFuncSetAttribute failed\n"); return; }
        int per_cu = 0; (void)hipOccupancyMaxActiveBlocksPerMultiprocessor(&per_cu, (const void*)trunk_fwd, NTHR, LDS_BYTES); (void)hipGetLastError();
        if (per_cu < 1) fprintf(stderr, "kernel_launch: occupancy query says %d\n", per_cu);
        state = 1;
    }
    if (state < 0) return;
    (void)hipMemsetAsync((char*)d_ws + WS_CTL, 0, CTL_ZERO_BYTES, stream);
    Args a{};
    for (int i = 0; i < 49; ++i) a.in[i] = (const float*)d_in[i];
    a.out = (float*)d_out; a.ws = (unsigned char*)d_ws;
    const int grid = 256;
#if N_LAUNCH_MODE == 0
    for (int ph = 0; ph < NPH; ++ph) { a.ph_lo = ph; a.ph_hi = ph + 1; hipLaunchKernelGGL(trunk_fwd, dim3(grid), dim3(NTHR), LDS_BYTES, stream, a); }
#else
    a.ph_lo = 0; a.ph_hi = NPH; hipLaunchKernelGGL(trunk_fwd, dim3(grid), dim3(NTHR), LDS_BYTES, stream, a);
#endif
}
```

```cpp
#include <hip/hip_runtime.h>
#include <cstdio>
#include <cstdint>

#define LAS __attribute__((address_space(3)))
#define GAS __attribute__((address_space(1)))
typedef unsigned short bf16_t;
typedef short bf16x8 __attribute__((ext_vector_type(8)));
typedef float f32x4 __attribute__((ext_vector_type(4)));
typedef float f32x2 __attribute__((ext_vector_type(2)));
typedef float f32x16 __attribute__((ext_vector_type(16)));
typedef unsigned u32x4 __attribute__((ext_vector_type(4)));
typedef unsigned u32x2 __attribute__((ext_vector_type(2)));

#ifndef REPMASK
#define REPMASK 0u
#endif
#ifndef N_LAUNCH_MODE
#define N_LAUNCH_MODE 1
#endif

constexpr int D = 2048, SEQ = 16384, CTXL = 256, T = SEQ + CTXL;
constexpr int NWAVES = 8, NTHR = 512;
constexpr float NORM_EPS = 1e-6f;
constexpr int N0 = 5376, P0_QA = 0, P0_KA = 1024, P0_QH = 1280, P0_FF = 2304, P0_FB = 3328, P0_GH = 4352;
constexpr int VT_ROWS = 1280;
constexpr int N1 = 5888, G_Q = 0, G_K = 512, G_GDF = 1024, G_GDB = 1040, G_GR = 1056;
constexpr int R_R = 2080, R_K = 3104, R_V = 4128, R_WDF = 5152, R_WDB = 5248, R_AD = 5344, R_GD = 5440;
constexpr int FF0 = 5632, FFE = 7168, NE = 8;
constexpr int MOE_ROWS = 2 * SEQ + NE * 256;
constexpr int MOE_MAXPAN = MOE_ROWS / 256;
constexpr int NCHUNK = T / 32;

constexpr size_t MiB = (size_t)1 << 20;
constexpr size_t WS_CTL = 0, CTL_ZERO_BYTES = 1 * MiB;
constexpr size_t WS_MOD = 1 * MiB;
constexpr size_t WS_ROPE = WS_MOD + 256 * 1024;
constexpr size_t WS_BLKCNT = WS_ROPE + 128 * 1024;
constexpr size_t WS_TK = 2 * MiB;
constexpr size_t WS_XC = 4 * MiB;
constexpr size_t WS_LORA = 6 * MiB;
constexpr size_t WS_QS0 = WS_LORA + 1280 * 1024;
constexpr size_t WS_QSM = WS_QS0 + 64 * 1024;
constexpr size_t WS_QI0 = WS_TK + 512 * 1024;
constexpr size_t WS_QV0 = WS_QI0 + 32 * 1024;
constexpr size_t WS_QI1 = WS_QV0 + 8 * 1024;
constexpr size_t WS_QG1 = WS_QI1 + 32 * 1024;
constexpr size_t WS_LB = WS_QG1 + 8 * 1024;
constexpr size_t WS_HSC = WS_TK + 1024 * 1024;
constexpr size_t WS_SSC = WS_HSC + 128 * 1024;
constexpr size_t WS_W = 8 * MiB;
constexpr size_t W_IN0T = WS_W;
constexpr size_t W_V0T = W_IN0T + 21 * MiB;
constexpr size_t W_OUT0T = W_V0T + 5 * MiB;
constexpr size_t W_GU0T = W_OUT0T + 8 * MiB;
constexpr size_t W_DN0T = W_GU0T + 44 * MiB;
constexpr size_t W_IN1T = W_DN0T + 22 * MiB;
constexpr size_t W_GV1T = W_IN1T + 23 * MiB;
constexpr size_t W_OUT1T = W_GV1T + 4 * MiB;
constexpr size_t W_MGUT = W_OUT1T + 8 * MiB;
constexpr size_t W_MDNT = W_MGUT + 448 * MiB;
constexpr size_t WS_LORA4 = W_GU0T + 22 * MiB;
constexpr size_t WS_XB = W_MGUT + 224 * MiB;
constexpr size_t WS_H = W_MDNT + 224 * MiB;
constexpr size_t WS_A = WS_H + 66 * MiB;
constexpr size_t A_PROJ0 = WS_A;
constexpr size_t A_VT = WS_A + 171 * MiB;
constexpr size_t A_MIX0 = WS_A + 212 * MiB;
constexpr size_t A_KVT0 = WS_A + 277 * MiB;
constexpr size_t A_DEC0 = WS_A + 537 * MiB;
constexpr size_t A_Y0 = WS_A + 542 * MiB;
constexpr size_t A_PY0 = WS_A + 672 * MiB;
constexpr size_t A_PF0 = WS_A + 690 * MiB;
constexpr size_t A_HID0 = WS_A;
constexpr size_t A_F0 = WS_A + 179 * MiB;
static_assert(A_HID0 + (size_t)T * FF0 * 2 <= A_F0 && A_F0 + (size_t)T * 2048 * 4 <= A_Y0, "layer-0 overlays");
constexpr size_t A_PROJ1 = WS_A;
constexpr size_t A_GVT = WS_A + 187 * MiB;
constexpr size_t A_RP = WS_A + 220 * MiB;
constexpr size_t A_KVT1 = WS_A + 448 * MiB;
constexpr size_t A_DEC1 = WS_A + 708 * MiB;
constexpr size_t A_MF = WS_A + 711 * MiB;
constexpr size_t A_XL = A_MF;
constexpr size_t A_NB = WS_A + 841 * MiB;
constexpr size_t A_MIX1 = WS_A + 971 * MiB;
constexpr size_t A_QB = W_IN0T;
constexpr size_t A_GOUT = W_IN0T + 65 * MiB;
constexpr size_t A_OB = WS_H;
constexpr size_t A_Y1 = WS_A;
constexpr size_t A_SORT = WS_A + 128 * MiB;
constexpr size_t A_HID1 = WS_A + 264 * MiB;
constexpr size_t A_YDN = WS_A + 740 * MiB;
constexpr size_t A_PYD = WS_A + 880 * MiB;
constexpr size_t WS_END = WS_A + 1035 * MiB;
static_assert(A_YDN + (size_t)MOE_ROWS * 2048 * 2 <= A_PYD && A_PYD + (size_t)32 * 256 * 2048 * 4 <= A_MIX1, "moe partials");
static_assert(A_SORT + (size_t)MOE_ROWS * 2048 * 2 <= A_HID1 && A_HID1 + (size_t)MOE_ROWS * FFE * 2 <= A_YDN && A_YDN + (size_t)MOE_ROWS * 2048 * 2 <= A_MIX1, "moe overlay");
static_assert(A_PROJ1 + (size_t)T * N1 * 2 <= A_GVT && A_GVT + (size_t)1024 * T * 2 <= A_RP && A_RP + (size_t)T * 7168 * 2 <= A_KVT1 && A_KVT1 + (size_t)2 * 4 * 520 * 256 * 128 * 2 <= A_DEC1, "layer-1 map");
static_assert(A_MF + (size_t)2 * 16 * 520 * 8192 <= A_NB && A_NB + (size_t)2 * 16 * 520 * 8192 <= A_MIX1 && A_MIX1 + (size_t)SEQ * 2048 * 2 <= WS_END, "layer-1 map 2");
static_assert(A_GOUT + (size_t)T * 1024 * 2 <= W_OUT1T && A_QB + (size_t)2 * T * 1024 * 2 <= A_GOUT && A_OB + (size_t)2 * 16 * 520 * 4096 <= WS_A, "overlays on dead weights / h");
static_assert(A_PROJ0 + (size_t)T * N0 * 2 <= A_VT && A_VT + (size_t)VT_ROWS * T * 2 <= A_MIX0 && A_KVT0 + (size_t)2 * 8 * 520 * 128 * 128 * 2 <= A_DEC0, "layer-0 map");
constexpr int CW_BAR = 4096;

constexpr int LDS_BYTES = 147456;
constexpr int MISC_OFF = 135168;
constexpr int MOE_TAB_OFF = MISC_OFF + 64, ECNT_OFF = MISC_OFF + 1024, PREF_OFF = MISC_OFF + 2048;

__device__ __forceinline__ float bf2f(unsigned b) { return __uint_as_float(b << 16); }
__device__ __forceinline__ float bflo(unsigned w) { return __uint_as_float(w << 16); }
__device__ __forceinline__ float bfhi(unsigned w) { return __uint_as_float(w & 0xffff0000u); }
typedef __bf16 bf16x2_t __attribute__((ext_vector_type(2)));
__device__ __forceinline__ unsigned pk2(float lo, float hi) { const f32x2 v = {lo, hi}; const bf16x2_t b = __builtin_convertvector(v, bf16x2_t); return __builtin_bit_cast(unsigned, b); }
__device__ __forceinline__ unsigned f2bf(float f) { return pk2(f, 0.f) & 0xffffu; }
__device__ __forceinline__ float wave_sum(float v) {
#pragma unroll
    for (int o = 1; o < 64; o <<= 1) v += __shfl_xor(v, o);
    return v;
}
__device__ __forceinline__ float fexp2(float x) { return __builtin_amdgcn_exp2f(x); }
__device__ __forceinline__ float fexp(float x) { return __builtin_amdgcn_exp2f(x * 1.4426950408889634f); }
__device__ __forceinline__ float sigmoidf_(float x) { return __builtin_amdgcn_rcpf(1.0f + fexp(-x)); }
__device__ __forceinline__ float siluf_(float x) { return x * __builtin_amdgcn_rcpf(1.0f + fexp(-x)); }
__device__ __forceinline__ float tanhf_(float x) { return 1.0f - 2.0f * __builtin_amdgcn_rcpf(1.0f + fexp(2.0f * x)); }
#define LDS_WAIT() asm volatile("s_waitcnt lgkmcnt(0)" ::: "memory")
#define VM_WAIT() asm volatile("s_waitcnt vmcnt(0)" ::: "memory")

#define XB_TMO      128
#define XB_XCNT(j)  (256  + 64 * (j))
#define XB_XSUB(j)  (1280 + 64 * (j))
#define XB_XGEN(j)  (2304 + 64 * (j))
#define XB_TOP      3328
#define XB_TOPGEN   3392
#define XCD_BAR_WORDS 3456
#define XB_SPIN_CAP (1u << 24)
__device__ __forceinline__ unsigned xb_ld(unsigned* p)              { return __hip_atomic_load(p, __ATOMIC_RELAXED, __HIP_MEMORY_SCOPE_AGENT); }
__device__ __forceinline__ unsigned xb_add(unsigned* p, unsigned v) { return __hip_atomic_fetch_add(p, v, __ATOMIC_RELAXED, __HIP_MEMORY_SCOPE_AGENT); }
__device__ __forceinline__ unsigned xb_xcc_id() { return (unsigned)__builtin_amdgcn_s_getreg((3 << 11) | 20) & 0xFu; }
#define XB_SPIN(cond, bar) do { unsigned _sp = 0; while (cond) { __builtin_amdgcn_s_sleep(1); \
    if ((++_sp & 255u) == 0u) { if (xb_ld(&(bar)[XB_TMO])) break; if (_sp > XB_SPIN_CAP) { atomicAdd(&(bar)[XB_TMO], 1u); break; } } } } while (0)
struct XcdBarrier { unsigned* bar; unsigned x; volatile LAS unsigned* st; };
__device__ __forceinline__ XcdBarrier xcd_barrier_post(unsigned* bar, volatile LAS unsigned* st) {
    XcdBarrier b; b.bar = bar; b.x = xb_xcc_id(); b.st = st;
    if (threadIdx.x == 0) (void)xb_add(&bar[XB_XCNT(b.x)], 1u);
    return b;
}
__device__ __forceinline__ void xcd_barrier_complete(unsigned* bar, unsigned x, unsigned& nloc, unsigned& nx) {
    const unsigned G = gridDim.x * gridDim.y * gridDim.z;
    unsigned sum, cnt, mine, sp = 0u;
    for (;;) {
        sum = 0u; cnt = 0u; mine = 0u;
#pragma unroll
        for (unsigned j = 0; j < 16; ++j) { const unsigned c = xb_ld(&bar[XB_XCNT(j)]); sum += c; cnt += (c > 0u) ? 1u : 0u; mine = (j == x) ? c : mine; }
        if (sum == G) break;
        __builtin_amdgcn_s_sleep(1);
        if ((++sp & 255u) == 0u) { if (xb_ld(&bar[XB_TMO])) break; if (sp > XB_SPIN_CAP) { atomicAdd(&bar[XB_TMO], 1u); break; } }
    }
    nloc = mine > 0u ? mine : 1u; nx = cnt > 0u ? cnt : 1u;
}
__device__ __forceinline__ void xcd_barrier(const XcdBarrier& b) {
    asm volatile("s_waitcnt vmcnt(0)" ::: "memory");
    __syncthreads();
    if (threadIdx.x == 0) {
        unsigned* bar = b.bar;
        __builtin_amdgcn_s_waitcnt(0);
        unsigned nloc = b.st[0], nx = b.st[1];
        if (nloc == 0u) { xcd_barrier_complete(bar, b.x, nloc, nx); b.st[0] = nloc; b.st[1] = nx; }
        const unsigned old = xb_add(&bar[XB_XSUB(b.x)], 1u);
        const unsigned gen = old / nloc;
        if (old + 1u == (gen + 1u) * nloc) {
            __builtin_amdgcn_fence(__ATOMIC_RELEASE, "agent");
            asm volatile("s_waitcnt vmcnt(0)" ::: "memory");
            const unsigned og = xb_add(&bar[XB_TOP], 1u);
            const unsigned tg = og / nx;
            if (og + 1u == (tg + 1u) * nx) xb_add(&bar[XB_TOPGEN], 1u);
            else XB_SPIN(xb_ld(&bar[XB_TOPGEN]) == tg, bar);
            __builtin_amdgcn_fence(__ATOMIC_ACQUIRE, "agent");
            xb_add(&bar[XB_XGEN(b.x)], 1u);
            asm volatile("s_waitcnt vmcnt(0)" ::: "memory");
        } else {
            XB_SPIN(xb_ld(&bar[XB_XGEN(b.x)]) == gen, bar);
            __builtin_amdgcn_fence(__ATOMIC_ACQUIRE, "agent");
            asm volatile("s_waitcnt vmcnt(0)" ::: "memory");
        }
    }
    __syncthreads();
}

namespace pg8 {
constexpr int BM = 256, BK = 64, HALF = 128, HTB = HALF * BK * 2, STAGE_BYTES = 8 * HTB, NXCD = 8, WGM = 8;
__host__ __device__ __forceinline__ int lds_byte(int r, int c) { const int st = (r >> 4) * 2 + (c >> 5), rr = r & 15, cc = c & 31, ob = rr * 64 + cc * 2; return st * 1024 + (ob ^ (((ob >> 9) & 1) << 5)); }
__host__ __device__ __forceinline__ void stage_rc(int b, int& R, int& C) { const int st = b / 1024, sb = b % 1024, swz = sb ^ (((sb >> 9) & 1) << 5); R = (st >> 1) * 16 + swz / 64; C = (st & 1) * 32 + (swz % 64) / 2; }
__host__ __device__ __forceinline__ int perm32(int rho) { const int n = rho >> 4, i = rho & 15; return 8 * (i >> 2) + 4 * n + (i & 3); }

struct Unit { int pm, pn; const char* a; const char* b; int aux; };

__device__ __forceinline__ void order_map(int wgid, int nM, int nN, int& pm, int& pn) {
    const int nwg = nM * nN;
    { const int q = nwg / NXCD, r = nwg % NXCD, xcd = wgid % NXCD, off = wgid / NXCD; wgid = (xcd < r ? xcd * (q + 1) : r * (q + 1) + (xcd - r) * q) + off; }
    const int nig = WGM * nN, gid = wgid / nig, fm = gid * WGM, gsz = (nM - fm) < WGM ? (nM - fm) : WGM;
    pm = fm + ((wgid % nig) % gsz); pn = (wgid % nig) / gsz;
}
struct SchedPlain {
    const char* A; const char* Bt; int nM, nN, G, c; size_t tstep; int nextra; const char* A2; const char* B2; int nN2; int pm0;
    __device__ __forceinline__ bool next(int i, Unit& u) const {
        const long L = (long)i * G + c; const int nwg = nM * nN;
        if (L >= nwg + nextra) return false;
        if (L >= nwg) { const int j = (int)L - nwg, pm2 = j / nN2, pn2 = j - pm2 * nN2; u.pm = pm2; u.pn = pn2; u.a = A2 + (size_t)pm2 * tstep; u.b = B2 + (size_t)pn2 * tstep; u.aux = 1; return true; }
        int pm, pn; order_map((int)L, nM, nN, pm, pn);
        u.pm = pm + pm0; u.pn = pn; u.a = A + (size_t)(pm + pm0) * tstep; u.b = Bt + (size_t)pn * tstep; u.aux = 0; return true;
    }
};
struct SchedSplit {
    const char* A; const char* Bt; int nN, nsplit, G, c; size_t tstep, kslice;
    __device__ __forceinline__ bool next(int i, Unit& u) const {
        const long L = (long)i * G + c; if (L >= (long)nN * nsplit) return false;
        const int pn = (int)L % nN, ks = (int)L / nN;
        u.pm = 0; u.pn = pn; u.a = A + (size_t)ks * kslice; u.b = Bt + (size_t)pn * tstep + (size_t)ks * kslice; u.aux = ks; return true;
    }
};
struct SchedMoe {
    const char* A; const char* Wt; size_t wstride; int nM, nN, G, c; size_t tstep; const LAS int* pexp;
    __device__ __forceinline__ bool next(int i, Unit& u) const {
        const long L = (long)i * G + c; const int nwg = nM * nN;
        if (L >= nwg) return false;
        int pm, pn; order_map((int)L, nM, nN, pm, pn);
        const int e = pexp[pm];
        u.pm = pm; u.pn = pn; u.a = A + (size_t)pm * tstep; u.b = Wt + (size_t)e * wstride + (size_t)pn * tstep; u.aux = e; return true;
    }
};

struct SchedLora {
    const char* X; const char* Wt; size_t plane; int G, c;
    __device__ __forceinline__ bool next(int i, Unit& u) const {
        const long L = (long)i * G + c; if (L >= 65 * 16) return false;
        int pm, pn; order_map((int)L, 65, 16, pm, pn);
        u.pm = pm; u.pn = pn; u.a = X + (size_t)(pn >> 2) * plane + (size_t)pm * 131072; u.b = Wt + (size_t)pn * 131072; u.aux = pn >> 2; return true;
    }
};
struct SchedMoeDown {
    const char* A; const char* Wt; size_t wstride; int nunits, G, c; size_t tstep; const LAS int* pexp; int split, rem, nfull; size_t kslice;
    __device__ __forceinline__ bool next(int i, Unit& u) const {
        const long L = (long)i * G + c; int Lb = 0, ks = 0;
        int pm, pn;
        if (split == 0) { if (L >= nunits) return false; order_map((int)L, nunits >> 3, 8, pm, pn); }
        else { if (L >= (long)rem * split) return false; Lb = nfull + (int)(L % rem); ks = (int)(L / rem); pm = Lb >> 3; pn = Lb & 7; }
        const int e = pexp[pm];
        u.pm = pm; u.pn = pn; u.a = A + (size_t)pm * tstep + (size_t)ks * kslice; u.b = Wt + (size_t)e * wstride + (size_t)pn * tstep + (size_t)ks * kslice;
        u.aux = split == 0 ? -1 : ((pm - (nfull >> 3)) * split + ks); return true;
    }
};
__device__ __forceinline__ unsigned cvt_pk_bf16(float lo, float hi) { unsigned r; asm volatile("v_cvt_pk_bf16_f32 %0, %1, %2" : "=v"(r) : "v"(lo), "v"(hi)); return r; }
struct EpiBf16 {
    static constexpr bool PERM = true;
    struct Pre {}; __device__ __forceinline__ void prefetch(const Unit&, int, int, int, int, Pre&) const {}
    bf16_t* O; int ldc; bf16_t* O1; int ldc1;
    __device__ __forceinline__ void operator()(const f32x4 (&acc)[2][2][4][2], const Unit& u, int wr, int wc, int fr, int fq, const Pre&) const {
        bf16_t* base = (u.aux == 1 && O1) ? O1 : O; const int ld = (u.aux == 1 && O1) ? ldc1 : ldc;
        const int row0 = u.pm * BM + wr * 64 + fr, col0 = u.pn * BM + wc * 32 + 8 * fq;
#pragma unroll
        for (int ai = 0; ai < 2; ++ai)
#pragma unroll
            for (int m = 0; m < 4; ++m) { bf16_t* rowp = base + (size_t)(row0 + ai * HALF + m * 16) * ld + col0;
#pragma unroll
                for (int bj = 0; bj < 2; ++bj) { const f32x4 v0 = acc[ai][bj][m][0], v1 = acc[ai][bj][m][1];
                    u32x4 w; w.x = cvt_pk_bf16(v0[0], v0[1]); w.y = cvt_pk_bf16(v0[2], v0[3]); w.z = cvt_pk_bf16(v1[0], v1[1]); w.w = cvt_pk_bf16(v1[2], v1[3]);
                    *(u32x4*)(rowp + bj * HALF) = w; } }
    }
};
struct EpiLora {
    static constexpr bool PERM = true;
    struct Pre {}; __device__ __forceinline__ void prefetch(const Unit&, int, int, int, int, Pre&) const {}
    bf16_t* RP; long gdelta; const float* bias3;
    __device__ __forceinline__ void operator()(const f32x4 (&acc)[2][2][4][2], const Unit& u, int wr, int wc, int fr, int fq, const Pre&) const {
        const int kind = u.aux, row0 = u.pm * BM + wr * 64 + fr, ch0 = (u.pn & 3) * BM + wc * 32 + 8 * fq;
        const float* bias = bias3 + (kind < 3 ? kind : 0) * 1024;
        const long poff = kind == 3 ? gdelta : (kind == 0 ? 5120 : (kind == 1 ? 6144 : 4096)); const int ld = kind == 3 ? 1024 : 7168;
        bf16_t* base = RP + poff;
        const float sc = kind < 2 ? -0.6065306597126334f : 1.0f;
        f32x4 bv[2][2];
#pragma unroll
        for (int bj = 0; bj < 2; ++bj)
#pragma unroll
            for (int n = 0; n < 2; ++n) { bv[bj][n] = *(const f32x4*)(bias + ch0 + bj * HALF + 4 * n); if (kind == 3) bv[bj][n] = (f32x4){0.f, 0.f, 0.f, 0.f}; }
#pragma unroll
        for (int ai = 0; ai < 2; ++ai)
#pragma unroll
            for (int m = 0; m < 4; ++m) { bf16_t* rowp = base + (size_t)(row0 + ai * HALF + m * 16) * ld + ch0;
#pragma unroll
                for (int bj = 0; bj < 2; ++bj) { f32x4 v0 = acc[ai][bj][m][0] + bv[bj][0], v1 = acc[ai][bj][m][1] + bv[bj][1];
                    if (kind != 3) {
#pragma unroll
                        for (int j = 0; j < 4; ++j) { v0[j] = sc * __builtin_amdgcn_rcpf(1.0f + __builtin_amdgcn_exp2f(-1.4426950408889634f * v0[j])); v1[j] = sc * __builtin_amdgcn_rcpf(1.0f + __builtin_amdgcn_exp2f(-1.4426950408889634f * v1[j])); } }
                    u32x4 w; w.x = cvt_pk_bf16(v0[0], v0[1]); w.y = cvt_pk_bf16(v0[2], v0[3]); w.z = cvt_pk_bf16(v1[0], v1[1]); w.w = cvt_pk_bf16(v1[2], v1[3]);
                    *(u32x4*)(rowp + bj * HALF) = w; } }
    }
};
struct EpiMoeDown {
    static constexpr bool PERM = true;
    struct Pre {}; __device__ __forceinline__ void prefetch(const Unit&, int, int, int, int, Pre&) const {}
    bf16_t* O; float* P;
    __device__ __forceinline__ void operator()(const f32x4 (&acc)[2][2][4][2], const Unit& u, int wr, int wc, int fr, int fq, const Pre&) const {
        const int rin0 = wr * 64 + fr, col0 = u.pn * BM + wc * 32 + 8 * fq;
        if (u.aux < 0) {
            bf16_t* base = O + (size_t)(u.pm * BM + rin0) * 2048 + col0;
#pragma unroll
            for (int ai = 0; ai < 2; ++ai)
#pragma unroll
                for (int m = 0; m < 4; ++m) { bf16_t* rowp = base + (size_t)(ai * HALF + m * 16) * 2048;
#pragma unroll
                    for (int bj = 0; bj < 2; ++bj) { const f32x4 v0 = acc[ai][bj][m][0], v1 = acc[ai][bj][m][1];
                        u32x4 w; w.x = cvt_pk_bf16(v0[0], v0[1]); w.y = cvt_pk_bf16(v0[2], v0[3]); w.z = cvt_pk_bf16(v1[0], v1[1]); w.w = cvt_pk_bf16(v1[2], v1[3]);
                        *(u32x4*)(rowp + bj * HALF) = w; } }
        } else {
            float* base = P + ((size_t)u.aux * 256 + rin0) * 2048 + col0;
#pragma unroll
            for (int ai = 0; ai < 2; ++ai)
#pragma unroll
                for (int m = 0; m < 4; ++m) { float* rowp = base + (size_t)(ai * HALF + m * 16) * 2048;
#pragma unroll
                    for (int bj = 0; bj < 2; ++bj) { *(f32x4*)(rowp + bj * HALF) = acc[ai][bj][m][0]; *(f32x4*)(rowp + bj * HALF + 4) = acc[ai][bj][m][1]; } }
        }
    }
};
struct EpiF32 {
    static constexpr bool PERM = false;
    struct Pre {}; __device__ __forceinline__ void prefetch(const Unit&, int, int, int, int, Pre&) const {}
    float* C; int ldc; size_t astride;
    __device__ __forceinline__ void operator()(const f32x4 (&acc)[2][2][4][2], const Unit& u, int wr, int wc, int fr, int fq, const Pre&) const {
        const int row0 = u.pm * BM + wr * 64 + fr, col0 = u.pn * BM + wc * 32 + 4 * fq; float* C = this->C + (size_t)u.aux * astride;
#pragma unroll
        for (int ai = 0; ai < 2; ++ai)
#pragma unroll
            for (int m = 0; m < 4; ++m) { float* rowp = C + (size_t)(row0 + ai * HALF + m * 16) * ldc + col0;
#pragma unroll
                for (int bj = 0; bj < 2; ++bj)
#pragma unroll
                    for (int n = 0; n < 2; ++n) *(f32x4*)(rowp + bj * HALF + n * 16) = acc[ai][bj][m][n]; }
    }
};
struct EpiSwiglu {
    static constexpr bool PERM = true;
    struct Pre {}; __device__ __forceinline__ void prefetch(const Unit&, int, int, int, int, Pre&) const {}
    bf16_t* O; int ldc;
    __device__ __forceinline__ void operator()(const f32x4 (&acc)[2][2][4][2], const Unit& u, int wr, int wc, int fr, int fq, const Pre&) const {
        const int row0 = u.pm * BM + wr * 64 + fr, col0 = u.pn * HALF + wc * 32 + 8 * fq;
#pragma unroll
        for (int ai = 0; ai < 2; ++ai)
#pragma unroll
            for (int m = 0; m < 4; ++m) { bf16_t* rowp = O + (size_t)(row0 + ai * HALF + m * 16) * ldc + col0;
                float o[8];
#pragma unroll
                for (int n = 0; n < 2; ++n)
#pragma unroll
                    for (int j = 0; j < 4; ++j) { const float g = acc[ai][0][m][n][j], up = acc[ai][1][m][n][j];
                        o[n * 4 + j] = g * up * __builtin_amdgcn_rcpf(1.0f + __builtin_amdgcn_exp2f(-1.4426950408889634f * g)); }
                u32x4 w; w.x = cvt_pk_bf16(o[0], o[1]); w.y = cvt_pk_bf16(o[2], o[3]); w.z = cvt_pk_bf16(o[4], o[5]); w.w = cvt_pk_bf16(o[6], o[7]);
                *(u32x4*)rowp = w; }
    }
};

typedef int i32x4 __attribute__((ext_vector_type(4)));
struct EpiBf16I8 {
    static constexpr bool PERM = true;
    bf16_t* O; int ldc; bf16_t* O1; int ldc1; const float* sr0; const float* sc0; const float* sr1; const float* sc1;
    struct Pre { float rsv[2]; float csv; };
    __device__ __forceinline__ void prefetch(const Unit& u, int wr, int wc, int fr, int fq, Pre& p) const {
        const bool x = (u.aux == 1 && O1); const float* sr = x ? sr1 : sr0; const float* sc = x ? sc1 : sc0; const int lane = fr + 16 * fq;
        p.rsv[0] = sr[u.pm * BM + wr * 64 + lane]; p.rsv[1] = sr[u.pm * BM + HALF + wr * 64 + lane];
        p.csv = sc[u.pn * BM + wc * 32 + (lane & 31) + (lane >> 5) * HALF];
    }
    __device__ __forceinline__ void operator()(const i32x4 (&acc)[2][2][4][2], const Unit& u, int wr, int wc, int fr, int fq, const Pre& p) const {
        const bool x = (u.aux == 1 && O1);
        bf16_t* base = x ? O1 : O; const int ld = x ? ldc1 : ldc;
        const int row0 = u.pm * BM + wr * 64 + fr, col0 = u.pn * BM + wc * 32 + 8 * fq;
        f32x4 cs[2][2];
#pragma unroll
        for (int bj = 0; bj < 2; ++bj)
#pragma unroll
            for (int n = 0; n < 2; ++n)
#pragma unroll
                for (int j = 0; j < 4; ++j) cs[bj][n][j] = __shfl(p.csv, 32 * bj + 8 * fq + 4 * n + j);
#pragma unroll
        for (int ai = 0; ai < 2; ++ai)
#pragma unroll
            for (int m = 0; m < 4; ++m) { const int r = row0 + ai * HALF + m * 16; const float rs = __shfl(p.rsv[ai], m * 16 + fr); bf16_t* rowp = base + (size_t)r * ld + col0;
#pragma unroll
                for (int bj = 0; bj < 2; ++bj) { const i32x4 a0 = acc[ai][bj][m][0], a1 = acc[ai][bj][m][1]; const f32x4 c0 = cs[bj][0] * rs, c1 = cs[bj][1] * rs;
                    u32x4 w; w.x = cvt_pk_bf16((float)a0[0] * c0[0], (float)a0[1] * c0[1]); w.y = cvt_pk_bf16((float)a0[2] * c0[2], (float)a0[3] * c0[3]);
                    w.z = cvt_pk_bf16((float)a1[0] * c1[0], (float)a1[1] * c1[1]); w.w = cvt_pk_bf16((float)a1[2] * c1[2], (float)a1[3] * c1[3]);
                    *(u32x4*)(rowp + bj * HALF) = w; } }
    }
};
struct EpiSwigluI8 {
    static constexpr bool PERM = true;
    bf16_t* O; int ldc; const float* sa; const float* sb; size_t sb_estride;
    struct Pre { float rsv[2]; float csv; };
    __device__ __forceinline__ void prefetch(const Unit& u, int wr, int wc, int fr, int fq, Pre& p) const {
        const int lane = fr + 16 * fq;
        p.rsv[0] = sa[u.pm * BM + wr * 64 + lane]; p.rsv[1] = sa[u.pm * BM + HALF + wr * 64 + lane];
        p.csv = sb[(size_t)u.aux * sb_estride + u.pn * BM + wc * 32 + (lane & 31) + (lane >> 5) * HALF];
    }
    __device__ __forceinline__ void operator()(const i32x4 (&acc)[2][2][4][2], const Unit& u, int wr, int wc, int fr, int fq, const Pre& p) const {
        const int row0 = u.pm * BM + wr * 64 + fr, col0 = u.pn * HALF + wc * 32 + 8 * fq;
        f32x4 sg[2], su[2];
#pragma unroll
        for (int n = 0; n < 2; ++n)
#pragma unroll
            for (int j = 0; j < 4; ++j) { sg[n][j] = __shfl(p.csv, 8 * fq + 4 * n + j); su[n][j] = __shfl(p.csv, 32 + 8 * fq + 4 * n + j); }
#pragma unroll
        for (int ai = 0; ai < 2; ++ai)
#pragma unroll
            for (int m = 0; m < 4; ++m) { const int r = row0 + ai * HALF + m * 16; const float sar = __shfl(p.rsv[ai], m * 16 + fr); bf16_t* rowp = O + (size_t)r * ldc + col0;
                f32x2 o[4];
#pragma unroll
                for (int n = 0; n < 2; ++n)
#pragma unroll
                    for (int jp = 0; jp < 2; ++jp) {
                        const f32x2 cg = {(float)acc[ai][0][m][n][2 * jp], (float)acc[ai][0][m][n][2 * jp + 1]}, cu = {(float)acc[ai][1][m][n][2 * jp], (float)acc[ai][1][m][n][2 * jp + 1]};
                        const f32x2 sgp = {sg[n][2 * jp], sg[n][2 * jp + 1]}, sup = {su[n][2 * jp], su[n][2 * jp + 1]};
                        const f32x2 g = cg * (sgp * sar), up = cu * (sup * sar);
                        const f32x2 t = g * -1.4426950408889634f;
                        const f32x2 d = (f32x2){__builtin_amdgcn_exp2f(t[0]), __builtin_amdgcn_exp2f(t[1])} + 1.0f;
                        const f32x2 rc = {__builtin_amdgcn_rcpf(d[0]), __builtin_amdgcn_rcpf(d[1])};
                        o[n * 2 + jp] = g * up * rc; }
                u32x4 w; w.x = cvt_pk_bf16(o[0][0], o[0][1]); w.y = cvt_pk_bf16(o[1][0], o[1][1]); w.z = cvt_pk_bf16(o[2][0], o[2][1]); w.w = cvt_pk_bf16(o[3][0], o[3][1]);
                *(u32x4*)rowp = w; }
    }
};
template <bool I8> struct MM;
template <> struct MM<false> { typedef f32x4 acc_t; static __device__ __forceinline__ acc_t zero() { return (f32x4){0.f, 0.f, 0.f, 0.f}; }
    static __device__ __forceinline__ acc_t mma(const bf16x8& b, const bf16x8& a, const acc_t& c) { return __builtin_amdgcn_mfma_f32_16x16x32_bf16(b, a, c, 0, 0, 0); } };
template <> struct MM<true> { typedef i32x4 acc_t; static __device__ __forceinline__ acc_t zero() { return (i32x4){0, 0, 0, 0}; }
    static __device__ __forceinline__ acc_t mma(const bf16x8& b, const bf16x8& a, const acc_t& c) { return __builtin_amdgcn_mfma_i32_16x16x64_i8(__builtin_bit_cast(i32x4, b), __builtin_bit_cast(i32x4, a), c, 0, 0, 0); } };
template <class Epi, class Sched, bool I8 = false, bool ALIGN_EPI = true, bool SP2 = true>
__device__ __forceinline__ void gemm_phase(LAS unsigned char* lds, const int Kb, const Sched& S, const Epi& E, const int Kloop = 0) {
    typedef typename MM<I8>::acc_t acc_t;
    const int tid = threadIdx.x, wid = __builtin_amdgcn_readfirstlane(tid >> 6), lane = tid & 63, wr = wid >> 2, wc = wid & 3, fr = lane & 15, fq = lane >> 4;
    const int nt = (Kloop ? Kloop : Kb) / 128;
    unsigned voffA[2], voffB[2];
#pragma unroll
    for (int i = 0; i < 2; ++i) { int R, C; stage_rc(tid * 16 + i * 8192, R, C); const int Rb = Epi::PERM ? ((R & ~31) + perm32(R & 31)) : R;
        voffA[i] = (unsigned)(R * Kb + C * 2); voffB[i] = (unsigned)(Rb * Kb + C * 2); }
    const size_t kstep = (size_t)(BK * 2);
    const size_t hstep = (size_t)HALF * Kb;
    const unsigned ldsw = (unsigned)wid * 1024u;
    const int aoff = lds_byte(wr * 64 + fr, fq * 8), boff = lds_byte(wc * 32 + fr, fq * 8);
#define PG8_SA(b, h) (((b) * 2 + (h)) * HTB)
#define PG8_SB(b, h) ((4 + (b) * 2 + (h)) * HTB)
#define PG8_STAGE(bufoff, gbase, voff) do { _Pragma("unroll") for (int _i = 0; _i < 2; ++_i) \
        __builtin_amdgcn_global_load_lds((const unsigned*)((const char*)(gbase) + (voff)[_i]), (LAS unsigned*)(lds + (bufoff) + ldsw + _i * 8192), 16, 0, 0); } while (0)
#define PG8_LDA(dst, b, h) do { _Pragma("unroll") for (int m = 0; m < 4; ++m) _Pragma("unroll") for (int k = 0; k < 2; ++k) dst[m][k] = *(const LAS bf16x8*)(lds + PG8_SA(b, h) + aoff + m * 2048 + k * 1024); } while (0)
#define PG8_LDB(dst, b, h) do { _Pragma("unroll") for (int n = 0; n < 2; ++n) _Pragma("unroll") for (int k = 0; k < 2; ++k) dst[n][k] = *(const LAS bf16x8*)(lds + PG8_SB(b, h) + boff + n * 2048 + k * 1024); } while (0)
#define PG8_MMA(ai, bj, At, Bt) do { __builtin_amdgcn_s_setprio(1); _Pragma("unroll") for (int m = 0; m < 4; ++m) _Pragma("unroll") for (int n = 0; n < 2; ++n) _Pragma("unroll") for (int k = 0; k < 2; ++k) \
        acc[ai][bj][m][n] = MM<I8>::mma(Bt[n][k], At[m][k], acc[ai][bj][m][n]); __builtin_amdgcn_s_setprio(0); } while (0)
#define PG8_WAIT_V(n) asm volatile("s_waitcnt vmcnt(" #n ")" ::: "memory")
#define PG8_WAIT_L(n) asm volatile("s_waitcnt lgkmcnt(" #n ")" ::: "memory")
#define PG8_BAR __builtin_amdgcn_s_barrier()
#define PG8_SCHED __builtin_amdgcn_sched_barrier(0)
    Unit cur, nxt; int ui = 0;
    if (!S.next(0, cur)) return;
    acc_t acc[2][2][4][2]; typename Epi::Pre pre;
#pragma unroll
    for (int a = 0; a < 2; ++a)
#pragma unroll
        for (int b = 0; b < 2; ++b)
#pragma unroll
            for (int m = 0; m < 4; ++m)
#pragma unroll
                for (int n = 0; n < 2; ++n) acc[a][b][m][n] = MM<I8>::zero();
    bf16x8 At[4][2], B0[2][2], B1[2][2];
    const char* cA = cur.a; const char* cB = cur.b;
    if constexpr (SP2) {
        PG8_STAGE(PG8_SB(0, 0), cB, voffB); PG8_STAGE(PG8_SB(0, 1), cB + hstep, voffB); PG8_STAGE(PG8_SA(0, 0), cA, voffA); PG8_STAGE(PG8_SA(0, 1), cA + hstep, voffA);
        if (wr == 1) PG8_BAR;
        PG8_WAIT_V(2); PG8_BAR;
        PG8_STAGE(PG8_SB(1, 0), cB + kstep, voffB); PG8_STAGE(PG8_SA(1, 0), cA + kstep, voffA); PG8_STAGE(PG8_SB(1, 1), cB + hstep + kstep, voffB);
        PG8_WAIT_V(6); PG8_BAR;
    } else {
        PG8_STAGE(PG8_SB(0, 0), cB, voffB); PG8_STAGE(PG8_SA(0, 0), cA, voffA); PG8_STAGE(PG8_SB(0, 1), cB + hstep, voffB); PG8_STAGE(PG8_SA(0, 1), cA + hstep, voffA);
        if (wr == 1) PG8_BAR;
        PG8_WAIT_V(4); PG8_BAR;
        PG8_STAGE(PG8_SB(1, 0), cB + kstep, voffB); PG8_STAGE(PG8_SA(1, 0), cA + kstep, voffA); PG8_STAGE(PG8_SB(1, 1), cB + hstep + kstep, voffB);
        PG8_WAIT_V(6); PG8_BAR;
    }
    for (;;) {
        const bool has_next = S.next(ui + 1, nxt);
        const char* nA = has_next ? nxt.a : cA; const char* nB = has_next ? nxt.b : cB;
        for (int t = 0; t < nt; t += 2) {
            const bool last = (t == nt - 2);
            if (last) E.prefetch(cur, wr, wc, fr, fq, pre);
            const char* a1 = cA + (size_t)(t + 1) * kstep;
            const char* a2 = last ? nA : cA + (size_t)(t + 2) * kstep; const char* b2 = last ? nB : cB + (size_t)(t + 2) * kstep;
            const char* a3 = a2 + kstep; const char* b3 = b2 + kstep;
            if constexpr (SP2) {
            PG8_LDB(B0, 0, 0); PG8_LDB(B1, 0, 1); PG8_SCHED; PG8_LDA(At, 0, 0); PG8_STAGE(PG8_SA(1, 1), a1 + hstep, voffA);
            PG8_WAIT_V(8); PG8_WAIT_L(0); PG8_BAR; PG8_MMA(0, 0, At, B0); PG8_MMA(0, 1, At, B1); PG8_BAR; PG8_SCHED;
            PG8_LDA(At, 0, 1); PG8_STAGE(PG8_SB(0, 0), b2, voffB); PG8_STAGE(PG8_SB(0, 1), b2 + hstep, voffB); PG8_STAGE(PG8_SA(0, 0), a2, voffA);
            PG8_WAIT_V(8); PG8_WAIT_L(0); PG8_BAR; PG8_MMA(1, 0, At, B0); PG8_MMA(1, 1, At, B1); PG8_BAR; PG8_SCHED;
            PG8_LDB(B0, 1, 0); PG8_LDB(B1, 1, 1); PG8_SCHED; PG8_LDA(At, 1, 0); PG8_STAGE(PG8_SA(0, 1), a2 + hstep, voffA);
            PG8_WAIT_V(8); PG8_WAIT_L(0); PG8_BAR; PG8_MMA(0, 0, At, B0); PG8_MMA(0, 1, At, B1); PG8_BAR; PG8_SCHED;
            PG8_LDA(At, 1, 1); PG8_STAGE(PG8_SB(1, 0), b3, voffB); PG8_STAGE(PG8_SB(1, 1), b3 + hstep, voffB); PG8_STAGE(PG8_SA(1, 0), a3, voffA);
            PG8_WAIT_V(8); PG8_WAIT_L(0); PG8_BAR; PG8_MMA(1, 0, At, B0); PG8_MMA(1, 1, At, B1); PG8_BAR; PG8_SCHED;
            } else {
            PG8_LDB(B0, 0, 0); PG8_SCHED; PG8_LDA(At, 0, 0); PG8_STAGE(PG8_SA(1, 1), a1 + hstep, voffA);
            PG8_WAIT_L(8); PG8_BAR; PG8_WAIT_L(0); PG8_MMA(0, 0, At, B0); PG8_BAR; PG8_SCHED;
            PG8_LDB(B1, 0, 1); PG8_STAGE(PG8_SB(0, 0), b2, voffB);
            PG8_BAR; PG8_WAIT_L(0); PG8_MMA(0, 1, At, B1); PG8_BAR;
            PG8_LDA(At, 0, 1); PG8_STAGE(PG8_SA(0, 0), a2, voffA);
            PG8_BAR; PG8_WAIT_L(0); PG8_MMA(1, 0, At, B0); PG8_BAR; PG8_SCHED;
            PG8_STAGE(PG8_SB(0, 1), b2 + hstep, voffB);
            PG8_WAIT_V(6); PG8_BAR; PG8_MMA(1, 1, At, B1); PG8_BAR;
            PG8_LDB(B0, 1, 0); PG8_SCHED; PG8_LDA(At, 1, 0); PG8_STAGE(PG8_SA(0, 1), a2 + hstep, voffA);
            PG8_WAIT_L(8); PG8_BAR; PG8_WAIT_L(0); PG8_MMA(0, 0, At, B0); PG8_BAR; PG8_SCHED;
            PG8_LDB(B1, 1, 1); PG8_STAGE(PG8_SB(1, 0), b3, voffB);
            PG8_BAR; PG8_WAIT_L(0); PG8_MMA(0, 1, At, B1); PG8_BAR;
            PG8_LDA(At, 1, 1); PG8_STAGE(PG8_SA(1, 0), a3, voffA);
            PG8_BAR; PG8_WAIT_L(0); PG8_MMA(1, 0, At, B0); PG8_BAR; PG8_SCHED;
            PG8_STAGE(PG8_SB(1, 1), b3 + hstep, voffB);
            PG8_WAIT_V(6); PG8_BAR; PG8_MMA(1, 1, At, B1); PG8_BAR;
            }
        }
        if constexpr (ALIGN_EPI) { if (wr == 0) PG8_BAR; }
        E(acc, cur, wr, wc, fr, fq, pre);
        if constexpr ((REPMASK >> 28) & 1u) E(acc, cur, wr, wc, fr, fq, pre);
        if (!has_next) break;
#pragma unroll
        for (int a = 0; a < 2; ++a)
#pragma unroll
            for (int b = 0; b < 2; ++b)
#pragma unroll
                for (int m = 0; m < 4; ++m)
#pragma unroll
                    for (int n = 0; n < 2; ++n) acc[a][b][m][n] = MM<I8>::zero();
        cur = nxt; cA = nA; cB = nB; ++ui;
        if constexpr (ALIGN_EPI) { if (wr == 1) PG8_BAR; }
    }
    PG8_WAIT_V(0);
    if constexpr (!ALIGN_EPI) { if (wr == 0) PG8_BAR; }
    PG8_BAR;
#undef PG8_SA
#undef PG8_SB
#undef PG8_STAGE
#undef PG8_LDA
#undef PG8_LDB
#undef PG8_MMA
#undef PG8_WAIT_V
#undef PG8_WAIT_L
#undef PG8_BAR
#undef PG8_SCHED
}
}

struct Args { const float* in[49]; float* out; unsigned char* ws; int ph_lo, ph_hi; };
enum { I_X = 0, I_C, I_CTX, I_CCTX, I_LBL, I_ADAW0, I_ADAB0, I_NMIXPRE0, I_NMIXPOST0, I_NFFNPRE0, I_NFFNPOST0, I_WIN0, I_WOUT0, I_SINK, I_HNORM, I_FG0, I_FU0, I_FD0,
       I_ADAW1, I_ADAB1, I_NMIXPRE1, I_NMIXPOST1, I_NFFNPRE1, I_NFFNPOST1, I_WIN1, I_WOUT1, I_GUPF, I_GUPB, I_GBIASF, I_GBIASB, I_GLANORM, I_MUPREV, I_MUNEXT, I_W0F, I_W0B, I_W2F, I_W2B,
       I_A0, I_A2, I_G2, I_KK, I_KA, I_RK, I_LNW, I_LNB, I_ROUTER, I_MG, I_MU, I_MD };

__device__ __forceinline__ void tr_item(const float* W, int K, int ld, int ncol0, bf16_t* WT, int drow0, int mode, int nblk, LAS float* scr, int item, int lane) {
    const int kb = item / nblk, nb = item - kb * nblk, k0 = 64 * kb, n0 = ncol0 + 32 * nb;
    int drow; if (mode == 0) drow = drow0 + 32 * nb; else { const int cc = 32 * nb; drow = (cc >> 7) * 256 + (cc & 127) + (mode == 2 ? 128 : 0); }
#pragma unroll 8
    for (int i = 0; i < 32; ++i) { const int kk = 2 * i + (lane >> 5); scr[kk * 33 + (lane & 31)] = __builtin_nontemporal_load(W + (size_t)(k0 + kk) * ld + n0 + (lane & 31)); }
    LDS_WAIT();
    const int c = lane & 7;
#pragma unroll
    for (int j = 0; j < 4; ++j) { const int n = (lane >> 3) + 8 * j; const LAS float* s = scr + (8 * c) * 33 + n;
        u32x4 o; o.x = pk2(s[0 * 33], s[1 * 33]); o.y = pk2(s[2 * 33], s[3 * 33]); o.z = pk2(s[4 * 33], s[5 * 33]); o.w = pk2(s[6 * 33], s[7 * 33]);
        *(u32x4*)(WT + (size_t)(drow + n) * K + k0 + 8 * c) = o; }
    LDS_WAIT();
}

constexpr int Q8_PITCH = 4100;
__device__ __forceinline__ void q8_strip(const float* W, int ld, int ncol0, signed char* dst, float* sdst, int drow0, LAS unsigned char* lds, int tid) {
    LAS unsigned* cmax = (LAS unsigned*)(lds + 32 * Q8_PITCH);
    const int lane = tid & 63, wave = tid >> 6;
    __syncthreads();
    if (tid < 32) cmax[tid] = 0u;
    __syncthreads();
    const int n4 = tid & 7, kr = tid >> 3;
    float mx[4] = {0.f, 0.f, 0.f, 0.f};
#pragma unroll 4
    for (int it = 0; it < 32; ++it) { const int k = it * 64 + kr; const f32x4 v = __builtin_nontemporal_load((const f32x4*)(W + (size_t)k * ld + ncol0 + 4 * n4));
#pragma unroll
        for (int e = 0; e < 4; ++e) { mx[e] = fmaxf(mx[e], fabsf(v[e])); *(LAS bf16_t*)(lds + (4 * n4 + e) * Q8_PITCH + k * 2) = (bf16_t)f2bf(v[e]); } }
#pragma unroll
    for (int e = 0; e < 4; ++e) __hip_atomic_fetch_max(cmax + 4 * n4 + e, __float_as_uint(mx[e]), __ATOMIC_RELAXED, __HIP_MEMORY_SCOPE_WORKGROUP);
    __syncthreads();
#pragma unroll 1
    for (int q = 0; q < 4; ++q) {
        const int n = 4 * wave + q; const float m = __uint_as_float(cmax[n]); const float inv = m > 0.f ? 127.0f / m : 0.f;
        const LAS unsigned* src = (const LAS unsigned*)(lds + n * Q8_PITCH + lane * 64);
        u32x4 o0, o1;
#pragma unroll
        for (int d = 0; d < 8; ++d) { const unsigned w0 = src[2 * d], w1 = src[2 * d + 1];
            const int q0 = (int)__builtin_rintf(bflo(w0) * inv), q1 = (int)__builtin_rintf(bfhi(w0) * inv), q2 = (int)__builtin_rintf(bflo(w1) * inv), q3 = (int)__builtin_rintf(bfhi(w1) * inv);
            const unsigned pk = (unsigned)(q0 & 0xff) | ((unsigned)(q1 & 0xff) << 8) | ((unsigned)(q2 & 0xff) << 16) | ((unsigned)(q3 & 0xff) << 24);
            if (d < 4) o0[d] = pk; else o1[d - 4] = pk; }
        u32x4* dp = (u32x4*)(dst + (size_t)(drow0 + n) * 2048 + 32 * lane);
        dp[0] = o0; dp[1] = o1;
        if (lane == 0) sdst[drow0 + n] = m > 0.f ? m * (1.0f / 127.0f) : 1.0f;
    }
}

__device__ __forceinline__ void p0_prologue(const Args& a, LAS unsigned char* lds, int tid, int lane, int wave) {
    unsigned char* ws = a.ws;
    const int G = gridDim.x, bx = blockIdx.x;
    {
        LAS float* sc = (LAS float*)lds;
        LAS float* red = (LAS float*)(lds + 16384);
        for (int i = tid; i < 2 * D; i += NTHR) { const float v = (i < D) ? a.in[I_C][i] : a.in[I_CCTX][i - D]; sc[i] = siluf_(v); }
        __syncthreads();
        float* mod = (float*)(ws + WS_MOD);
        for (int it = bx; it < 384; it += G) {
            const int l = it / 192, cg = it % 192; const float* W = a.in[l ? I_ADAW1 : I_ADAW0]; const float* B = a.in[l ? I_ADAB1 : I_ADAB0];
            const int col = cg * 64 + lane; float a0 = 0.f, a1 = 0.f;
            const float* wp = W + (size_t)(wave * 256) * 12288 + col;
#pragma unroll 8
            for (int k = 0; k < 256; ++k) { const float w = __builtin_nontemporal_load(wp + (size_t)k * 12288); a0 = fmaf(sc[wave * 256 + k], w, a0); a1 = fmaf(sc[D + wave * 256 + k], w, a1); }
            red[(wave * 2 + 0) * 64 + lane] = a0; red[(wave * 2 + 1) * 64 + lane] = a1;
            __syncthreads();
            if (wave < 2) { float s = 0.f;
#pragma unroll
                for (int w = 0; w < 8; ++w) s += red[(w * 2 + wave) * 64 + lane];
                mod[(size_t)(l * 2 + wave) * 12288 + col] = s + B[col]; }
            __syncthreads();
        }
    }
    {
        float* tab = (float*)(ws + WS_ROPE);
        const int gi = bx * NTHR + tid;
        if (gi < 320 * 32) { const int pos = gi >> 5, f = gi & 31; const int p = pos < 256 ? pos : pos - 256;
            const float inv = exp2f(-(float)f * (13.287712379549449f / 32.0f));
            const float ang = (float)p * inv; float sn, cs; sincosf(ang, &sn, &cs);
            tab[2 * gi] = cs; tab[2 * gi + 1] = sn; }
    }
    {
        bf16_t* wt = (bf16_t*)(ws + WS_LORA4);
        { float* lb = (float*)(ws + WS_LB); const int e = bx * NTHR + tid; if (e < 3072) lb[e] = e < 1024 ? a.in[I_W0F][e] : (e < 2048 ? a.in[I_W0B][e - 1024] : a.in[I_A0][e - 2048]); }
        for (int e = bx * NTHR + tid; e < 4 * 256 * 1024; e += G * NTHR) {
            const int m = e >> 18, kk = (e >> 10) & 255, n = e & 1023; float v = 0.f;
            if (m == 3) v = a.in[I_G2][kk * 1024 + n];
            else if (kk < 96) v = a.in[m == 0 ? I_W2F : (m == 1 ? I_W2B : I_A2)][kk * 1024 + n];
            wt[((size_t)m * 1024 + n) * 256 + kk] = (bf16_t)f2bf(v);
        }
    }
    {
        LAS float* scr = (LAS float*)(lds + wave * 16384);
        const int gw = bx * NWAVES + wave, NGW = G * NWAVES;
        constexpr int S3 = 32 * 64, S6 = 88 * 64, S8 = 32 * 64, SD = 112 * 64;
        constexpr int NIT = S3 + S6 + S8 + 8 * SD;
        for (int it = gw; it < NIT; it += NGW) {
            int r = it;
            if (r < S3) { tr_item(a.in[I_WOUT0], 2048, 2048, 0, (bf16_t*)(ws + W_OUT0T), 0, 0, 64, scr, r, lane); continue; } r -= S3;
            if (r < S6) { tr_item(a.in[I_FD0], 5632, 2048, 0, (bf16_t*)(ws + W_DN0T), 0, 0, 64, scr, r, lane); continue; } r -= S6;
            if (r < S8) { tr_item(a.in[I_WOUT1], 2048, 2048, 0, (bf16_t*)(ws + W_OUT1T), 0, 0, 64, scr, r, lane); continue; } r -= S8;
            { const int e = r / SD; tr_item(a.in[I_MD] + (size_t)e * 7168 * 2048, 7168, 2048, 0, (bf16_t*)(ws + W_MDNT) + (size_t)e * 2048 * 7168, 0, 0, 64, scr, r - e * SD, lane); }
        }
    }
    {
        constexpr int NS0 = 176, NSE = 224, NI0 = 208, NI1 = 210, NITEM = 2 * NS0 + 16 * NSE + NI0 + NI1;
        for (int it = bx; it < NITEM; it += G) {
            int r = it; const float* W; int ld, cc, up; signed char* dst; float* sd;
            if (r >= 2 * NS0 + 16 * NSE) {
                r -= 2 * NS0 + 16 * NSE; int drow;
                if (r < NI0) { cc = 32 * r; W = a.in[I_WIN0]; ld = 6656;
                    if (cc < 1280) { dst = (signed char*)(ws + W_IN0T); sd = (float*)(ws + WS_QI0); drow = cc; }
                    else if (cc < 1536) { dst = (signed char*)(ws + W_V0T); sd = (float*)(ws + WS_QV0); drow = cc - 1280; }
                    else if (cc < 2560) { dst = (signed char*)(ws + W_IN0T); sd = (float*)(ws + WS_QI0); drow = cc - 1536 + 1280; }
                    else if (cc < 3584) { dst = (signed char*)(ws + W_V0T); sd = (float*)(ws + WS_QV0); drow = cc - 2560 + 256; }
                    else { dst = (signed char*)(ws + W_IN0T); sd = (float*)(ws + WS_QI0); drow = cc - 3584 + 2304; } }
                else { cc = 32 * (r - NI0); W = a.in[I_WIN1]; ld = 6720;
                    if (cc < 1024) { dst = (signed char*)(ws + W_IN1T); sd = (float*)(ws + WS_QI1); drow = cc; }
                    else if (cc < 2048) { dst = (signed char*)(ws + W_GV1T); sd = (float*)(ws + WS_QG1); drow = cc - 1024; }
                    else { dst = (signed char*)(ws + W_IN1T); sd = (float*)(ws + WS_QI1); drow = cc - 2048 + 1024; } }
                q8_strip(W, ld, cc, dst, sd, drow, lds, tid);
                continue;
            }
            if (r < 2 * NS0) { up = r / NS0; cc = 32 * (r - up * NS0); W = a.in[up ? I_FU0 : I_FG0]; ld = 5632; dst = (signed char*)(ws + W_GU0T); sd = (float*)(ws + WS_QS0); }
            else { r -= 2 * NS0; const int e = r / (2 * NSE); r -= e * 2 * NSE; up = r / NSE; cc = 32 * (r - up * NSE); W = a.in[up ? I_MU : I_MG] + (size_t)e * 2048 * 7168; ld = 7168;
                   dst = (signed char*)(ws + W_MGUT) + (size_t)e * 14336 * 2048; sd = (float*)(ws + WS_QSM) + (size_t)e * 14336; }
            q8_strip(W, ld, cc, dst, sd, (cc >> 7) * 256 + (cc & 127) + (up ? 128 : 0), lds, tid);
        }
    }
}

__device__ __forceinline__ f32x4 ldp(const float* p, int lane, int j) { return *(const f32x4*)(p + 4 * lane + 256 * j); }
__device__ __forceinline__ void ldrow(const float* p, int lane, f32x4 (&v)[8]) {
#pragma unroll
    for (int j = 0; j < 8; ++j) v[j] = ldp(p, lane, j);
}
__device__ __forceinline__ void ldrow_bf(const bf16_t* p, int lane, f32x4 (&v)[8]) {
#pragma unroll
    for (int j = 0; j < 8; ++j) { const u32x2 y = *(const u32x2*)(p + 4 * lane + 256 * j); v[j] = (f32x4){bflo(y.x), bfhi(y.x), bflo(y.y), bfhi(y.y)}; }
}
__device__ __forceinline__ float rms_scale(const f32x4 (&v)[8]) {
    float s = 0.f;
#pragma unroll
    for (int j = 0; j < 8; ++j) s += (v[j][0] * v[j][0] + v[j][1] * v[j][1]) + (v[j][2] * v[j][2] + v[j][3] * v[j][3]);
    return __builtin_amdgcn_rsqf(wave_sum(s) * (1.0f / D) + NORM_EPS);
}
__device__ __forceinline__ void mod_store(f32x4 (&v)[8], const float* gpre, const float* sc, const float* sh, bf16_t* hrow, int lane) {
    const float rs = rms_scale(v);
#pragma unroll
    for (int j = 0; j < 8; ++j) { const f32x4 g = ldp(gpre, lane, j), s = ldp(sc, lane, j), b = ldp(sh, lane, j);
        v[j] = v[j] * rs * g * (s + 1.0f) + b;
        u32x2 w; w.x = pk2(v[j][0], v[j][1]); w.y = pk2(v[j][2], v[j][3]); *(u32x2*)(hrow + 4 * lane + 256 * j) = w; }
}
__device__ __forceinline__ void mod_store_i8(f32x4 (&v)[8], const float* gpre, const float* sc, const float* sh, signed char* hrow, float* scale_out, int lane) {
    const float rs = rms_scale(v); float mx = 0.f;
#pragma unroll
    for (int j = 0; j < 8; ++j) { const f32x4 g = ldp(gpre, lane, j), s = ldp(sc, lane, j), b = ldp(sh, lane, j);
        v[j] = v[j] * rs * g * (s + 1.0f) + b;
        mx = fmaxf(fmaxf(mx, fmaxf(fabsf(v[j][0]), fabsf(v[j][1]))), fmaxf(fabsf(v[j][2]), fabsf(v[j][3]))); }
#pragma unroll
    for (int o = 1; o < 64; o <<= 1) mx = fmaxf(mx, __shfl_xor(mx, o));
    const float inv = mx > 0.f ? 127.0f / mx : 0.f;
#pragma unroll
    for (int j = 0; j < 8; ++j) { const int q0 = (int)__builtin_rintf(v[j][0] * inv), q1 = (int)__builtin_rintf(v[j][1] * inv), q2 = (int)__builtin_rintf(v[j][2] * inv), q3 = (int)__builtin_rintf(v[j][3] * inv);
        *(unsigned*)(hrow + 4 * lane + 256 * j) = (unsigned)(q0 & 0xff) | ((unsigned)(q1 & 0xff) << 8) | ((unsigned)(q2 & 0xff) << 16) | ((unsigned)(q3 & 0xff) << 24); }
    if (lane == 0) *scale_out = mx > 0.f ? mx * (1.0f / 127.0f) : 1.0f;
}
__device__ __forceinline__ void add_branch(f32x4 (&v)[8], const f32x4 (&b)[8], const float* gpost, const float* gate, int lane) {
    const float rs = rms_scale(b);
#pragma unroll
    for (int j = 0; j < 8; ++j) { const f32x4 g = ldp(gpost, lane, j), gt = ldp(gate, lane, j); v[j] = v[j] + gt * (b[j] * rs * g); }
}
__device__ __forceinline__ void strow_bf(bf16_t* p, int lane, const f32x4 (&v)[8]) {
#pragma unroll
    for (int j = 0; j < 8; ++j) { u32x2 w; w.x = pk2(v[j][0], v[j][1]); w.y = pk2(v[j][2], v[j][3]); *(u32x2*)(p + 4 * lane + 256 * j) = w; }
}
__device__ __forceinline__ void strow(float* p, int lane, const f32x4 (&v)[8]) {
#pragma unroll
    for (int j = 0; j < 8; ++j) *(f32x4*)(p + 4 * lane + 256 * j) = v[j];
}

constexpr int KST = 272, VST = 136, ATT_V_OFF = 64 * KST;
__device__ __forceinline__ void attn_unit(LAS unsigned char* lds, const bf16_t* proj0, const bf16_t* vT, bf16_t* mix, const float* sinks, const float* ropetab,
                                          int kind, int qb, int g, int tid) {
    const int wave = tid >> 6, lane = tid & 63, c = lane & 31, hh = lane >> 5;
    const int head = g * 4 + (wave >> 1), sub = (wave & 1) * 32;
    const int qrow = (kind == 0 ? CTXL + qb * 64 : qb * 64) + sub + c;
    const float qscale = 0.08838834764831845f * 1.4426950408889634f;
    const float* rowtab = ropetab; const float* coltab = ropetab + 256 * 64;
    bf16x8 qf[8];
    {
        const bf16_t* qp = proj0 + (size_t)qrow * N0 + P0_QA + head * 128;
        const int tl = qrow - CTXL;
#pragma unroll
        for (int ax = 0; ax < 2; ++ax)
#pragma unroll
            for (int sp = 0; sp < 2; ++sp) {
                const int d1 = ax * 64 + sp * 16 + hh * 8;
                const u32x4 c1 = *(const u32x4*)(qp + d1), c2 = *(const u32x4*)(qp + d1 + 32);
                float x1[8], x2[8];
#pragma unroll
                for (int e = 0; e < 4; ++e) { x1[2 * e] = bflo(c1[e]); x1[2 * e + 1] = bfhi(c1[e]); x2[2 * e] = bflo(c2[e]); x2[2 * e + 1] = bfhi(c2[e]); }
                if (kind == 0) {
                    const int pos = ax == 0 ? (tl >> 6) : (tl & 63);
                    const float* tb = (ax == 0 ? rowtab : coltab) + (pos * 32 + sp * 16 + hh * 8) * 2;
#pragma unroll
                    for (int e = 0; e < 8; ++e) { const float cs = tb[2 * e], sn = tb[2 * e + 1]; const float o1 = x1[e] * cs - x2[e] * sn, o2 = x1[e] * sn + x2[e] * cs; x1[e] = o1; x2[e] = o2; }
                }
                u32x4 w1, w2;
#pragma unroll
                for (int e = 0; e < 4; ++e) { w1[e] = pk2(x1[2 * e] * qscale, x1[2 * e + 1] * qscale); w2[e] = pk2(x2[2 * e] * qscale, x2[2 * e + 1] * qscale); }
                qf[ax * 4 + sp] = __builtin_bit_cast(bf16x8, w1); qf[ax * 4 + sp + 2] = __builtin_bit_cast(bf16x8, w2);
            }
    }
    float m = sinks[head] * 1.4426950408889634f, lsum = (hh == 0) ? 1.0f : 0.0f;
    f32x16 o[4];
#pragma unroll
    for (int i = 0; i < 4; ++i)
#pragma unroll
        for (int r = 0; r < 16; ++r) o[i][r] = 0.f;
    const int ntile = (kind == 0) ? 9 : 4;
    for (int ti = 0; ti < ntile; ++ti) {
        int krow0, mode = 0; bool rope = false;
        if (ti < 4) krow0 = 64 * ti;
        else { const int j = ti - 6; const int tl0 = qb * 64 + 64 * j; if (tl0 < 0 || tl0 >= SEQ) continue; krow0 = CTXL + tl0; rope = true; mode = (j == -2) ? 1 : (j == 2 ? 2 : 0); }
        __syncthreads();
        {
            const int key = tid >> 3, p = tid & 7, ax = p >> 2, fc = p & 3; const int krow = krow0 + key;
            const bf16_t* kp = proj0 + (size_t)krow * N0 + P0_KA + g * 128 + ax * 64 + fc * 8;
            u32x4 c1 = *(const u32x4*)kp, c2 = *(const u32x4*)(kp + 32);
            if (rope) {
                const int tl = krow - CTXL; const int pos = ax == 0 ? (tl >> 6) : (tl & 63);
                const float* tb = (ax == 0 ? rowtab : coltab) + (pos * 32 + fc * 8) * 2;
                float x1[8], x2[8];
#pragma unroll
                for (int e = 0; e < 4; ++e) { x1[2 * e] = bflo(c1[e]); x1[2 * e + 1] = bfhi(c1[e]); x2[2 * e] = bflo(c2[e]); x2[2 * e + 1] = bfhi(c2[e]); }
#pragma unroll
                for (int e = 0; e < 8; ++e) { const float cs = tb[2 * e], sn = tb[2 * e + 1]; const float o1 = x1[e] * cs - x2[e] * sn, o2 = x1[e] * sn + x2[e] * cs; x1[e] = o1; x2[e] = o2; }
#pragma unroll
                for (int e = 0; e < 4; ++e) { c1[e] = pk2(x1[2 * e], x1[2 * e + 1]); c2[e] = pk2(x2[2 * e], x2[2 * e + 1]); }
            }
            *(LAS u32x4*)(lds + key * KST + (ax * 64 + fc * 8) * 2) = c1;
            *(LAS u32x4*)(lds + key * KST + (ax * 64 + fc * 8 + 32) * 2) = c2;
        }
#pragma unroll
        for (int i = 0; i < 2; ++i) {
            const int idx = tid + NTHR * i, d = idx >> 3, ch = idx & 7;
            const u32x4 v = *(const u32x4*)(vT + (size_t)(g * 128 + d) * T + krow0 + ch * 8);
            LAS u32x2* dst = (LAS u32x2*)(lds + ATT_V_OFF + d * VST + ch * 16);
            dst[0] = (u32x2){v.x, v.y}; dst[1] = (u32x2){v.z, v.w};
        }
        __syncthreads();
        f32x16 p0, p1;
#pragma unroll
        for (int r = 0; r < 16; ++r) { p0[r] = 0.f; p1[r] = 0.f; }
#pragma unroll
        for (int s = 0; s < 8; ++s) {
            const bf16x8 k0 = *(const LAS bf16x8*)(lds + c * KST + (16 * s + 8 * hh) * 2);
            const bf16x8 k1 = *(const LAS bf16x8*)(lds + (32 + c) * KST + (16 * s + 8 * hh) * 2);
            p0 = __builtin_amdgcn_mfma_f32_32x32x16_bf16(k0, qf[s], p0, 0, 0, 0);
            p1 = __builtin_amdgcn_mfma_f32_32x32x16_bf16(k1, qf[s], p1, 0, 0, 0);
        }
        if (mode != 0) {
            const int ii = sub + c;
#pragma unroll
            for (int r = 0; r < 16; ++r) { const int k0i = (r & 3) + 8 * (r >> 2) + 4 * hh, k1i = k0i + 32;
                const bool bad0 = (mode == 1) ? (k0i < ii) : (k0i > ii), bad1 = (mode == 1) ? (k1i < ii) : (k1i > ii);
                if (bad0) p0[r] = -INFINITY; if (bad1) p1[r] = -INFINITY; }
        }
        float mx = p0[0];
#pragma unroll
        for (int r = 0; r < 16; ++r) { mx = fmaxf(mx, p0[r]); mx = fmaxf(mx, p1[r]); }
        mx = fmaxf(mx, __shfl_xor(mx, 32));
        const float mnew = fmaxf(m, mx), alpha = fexp2(m - mnew); m = mnew;
        float rs = 0.f;
#pragma unroll
        for (int r = 0; r < 16; ++r) { p0[r] = fexp2(p0[r] - mnew); p1[r] = fexp2(p1[r] - mnew); rs += p0[r] + p1[r]; }
        lsum = lsum * alpha + rs;
#pragma unroll
        for (int i = 0; i < 4; ++i)
#pragma unroll
            for (int r = 0; r < 16; ++r) o[i][r] *= alpha;
        bf16x8 pf[2][2];
#pragma unroll
        for (int s2 = 0; s2 < 2; ++s2) {
            u32x4 w0, w1;
#pragma unroll
            for (int e = 0; e < 4; ++e) { w0[e] = pk2(p0[8 * s2 + 2 * e], p0[8 * s2 + 2 * e + 1]); w1[e] = pk2(p1[8 * s2 + 2 * e], p1[8 * s2 + 2 * e + 1]); }
            pf[0][s2] = __builtin_bit_cast(bf16x8, w0); pf[1][s2] = __builtin_bit_cast(bf16x8, w1);
        }
#pragma unroll
        for (int dt = 0; dt < 4; ++dt)
#pragma unroll
            for (int kt = 0; kt < 2; ++kt)
#pragma unroll
                for (int s2 = 0; s2 < 2; ++s2) {
                    const LAS unsigned char* vp = lds + ATT_V_OFF + (32 * dt + c) * VST + (32 * kt + 16 * s2 + 4 * hh) * 2;
                    const u32x2 lo = *(const LAS u32x2*)vp, hi = *(const LAS u32x2*)(vp + 16);
                    const u32x4 vv = (u32x4){lo.x, lo.y, hi.x, hi.y};
                    o[dt] = __builtin_amdgcn_mfma_f32_32x32x16_bf16(__builtin_bit_cast(bf16x8, vv), pf[kt][s2], o[dt], 0, 0, 0);
                }
    }
    const float ltot = lsum + __shfl_xor(lsum, 32), inv = 1.0f / ltot;
    bf16_t* op = mix + (size_t)qrow * D + head * 128;
#pragma unroll
    for (int dt = 0; dt < 4; ++dt)
#pragma unroll
        for (int gq = 0; gq < 4; ++gq) {
            u32x2 w; w.x = pk2(o[dt][4 * gq] * inv, o[dt][4 * gq + 1] * inv); w.y = pk2(o[dt][4 * gq + 2] * inv, o[dt][4 * gq + 3] * inv);
            *(u32x2*)(op + 32 * dt + 8 * gq + 4 * hh) = w;
        }
}

__device__ __forceinline__ int row_of(int dir, int n) { return dir == 0 ? n : (n < CTXL ? CTXL - 1 - n : T + CTXL - 1 - n); }

__device__ __forceinline__ float logsigf_(float x) { return fminf(x, 0.f) - __logf(1.0f + fexp(-fabsf(x))); }


template <int MIX> struct GL { static constexpr int NH = MIX ? 4 : 8, V = MIX ? 256 : 128, NVT = V / 32; };
constexpr int GL_KT_STRIDE = 80;
constexpr int GL_QK_STRIDE = 272;
constexpr int GL_RAW_OFF = 70 * 1024;
constexpr int GL_GD_OFF = 120 * 1024;
constexpr int GL_RED_OFF = 130 * 1024;
static_assert(GL_RED_OFF + 1024 <= MISC_OFF, "GL LDS map");
struct GLArgs { const bf16_t* proj; const bf16_t* vT; bf16_t* kvt; float* dec; bf16_t* mix; const float* lbl; const float* upf; const float* upb; const float* biasf; const float* biasb; const float* gain; };

template <int MIX> __device__ __forceinline__ int gl_scan_chunk(int dir, int step) { return dir == 0 ? step : (step < 8 ? 7 - step : NCHUNK + 7 - step); }

template <int MIX, bool NEEDQ>
__device__ __forceinline__ void gl_stage_raw(const GLArgs& g, LAS unsigned char* lds, int R0, int head, int tid) {
    constexpr int NT = MIX == 0 ? (NEEDQ ? 3 : 2) : (NEEDQ ? 2 : 1);
#pragma unroll
    for (int i = 0; i < 2 * NT; ++i) {
        const int idx = tid + NTHR * i, tile = idx >> 10, rem = idx & 1023, row = rem >> 4, ch = rem & 15;
        int col, slot;
        if constexpr (MIX == 0) { slot = tile; col = (tile == 0 ? P0_FF : (tile == 1 ? P0_FB : P0_QH)) + head * 128 + ch * 8; }
        else { slot = tile == 0 ? 0 : 2; col = (tile == 0 ? G_K : G_Q) + head * 128 + ch * 8; }
        const u32x4 v = *(const u32x4*)(g.proj + (size_t)(R0 + row) * (MIX ? N1 : N0) + col);
        *(LAS u32x4*)(lds + GL_RAW_OFF + slot * 16384 + row * 256 + ch * 16) = v;
    }
}
template <int MIX, bool NEEDQ>
__device__ __forceinline__ void gl_load(const LAS unsigned char* lds, int rloc, int k, int dir, unsigned short& x0, unsigned short& x1) {
    x1 = 0;
    x0 = *(const LAS bf16_t*)(lds + GL_RAW_OFF + (MIX == 0 ? dir : 0) * 16384 + rloc * 256 + k * 2);
    if (NEEDQ) x1 = *(const LAS bf16_t*)(lds + GL_RAW_OFF + 2 * 16384 + rloc * 256 + k * 2);
}
template <int MIX, bool NEEDQ>
__device__ __forceinline__ void gl_comp(unsigned short x0, unsigned short x1, float lbk, const float (&up)[16], float bias, const LAS float* gdrow, float& d, float& kv, float& q) {
    if constexpr (MIX == 0) {
        const float f = lbk + (1.0f - lbk) * sigmoidf_(bf2f(x0));
        d = f; kv = 1.0f - f; if (NEEDQ) q = siluf_(bf2f(x1));
    } else {
        f32x2 xa = {bias, 0.f};
#pragma unroll
        for (int q4 = 0; q4 < 4; ++q4) { const f32x4 gd = *(const LAS f32x4*)(gdrow + 4 * q4);
            xa = __builtin_elementwise_fma((f32x2){gd[0], gd[1]}, (f32x2){up[4 * q4], up[4 * q4 + 1]}, xa);
            xa = __builtin_elementwise_fma((f32x2){gd[2], gd[3]}, (f32x2){up[4 * q4 + 2], up[4 * q4 + 3]}, xa); }
        const float x = xa[0] + xa[1];
        d = fexp(logsigf_(x) * 0.0625f); kv = bf2f(x0); if (NEEDQ) q = bf2f(x1) * 0.08838834764831845f;
    }
}
template <int MIX>
__device__ __forceinline__ void gl_stage_gd(const GLArgs& g, LAS unsigned char* lds, int R0, int tid) {
    if constexpr (MIX == 1) {
        LAS float* gds = (LAS float*)(lds + GL_GD_OFF);
        for (int idx = tid; idx < 2048; idx += NTHR) { const int row = idx >> 5, dj = idx & 31, dir = dj >> 4, j = dj & 15;
            gds[(dir * 64 + row) * 16 + j] = bf2f(g.proj[(size_t)(R0 + row) * N1 + (dir ? G_GDB : G_GDF) + j]); }
    }
}
template <int MIX>
__device__ __forceinline__ void gl_walker_consts(const GLArgs& g, int head, int k, int dir, float& lbk, float (&up)[16], float& bias) {
    lbk = 0.f; bias = 0.f;
#pragma unroll
    for (int j = 0; j < 16; ++j) up[j] = 0.f;
    if constexpr (MIX == 0) { const int kk = head * 128 + k; lbk = 1.0f / (1.0f + fexp(g.lbl[1024 + kk] - g.lbl[kk])); }
    else { const float* upp = dir ? g.upb : g.upf; const int ch = head * 128 + k;
#pragma unroll
        for (int j = 0; j < 16; ++j) up[j] = upp[j * 512 + ch];
        bias = (dir ? g.biasb : g.biasf)[ch]; }
}

template <int MIX>
__device__ __forceinline__ void gl_phaseA(const GLArgs& g, LAS unsigned char* lds, int tid, int bid, int nblk) {
    constexpr int NH = GL<MIX>::NH, V = GL<MIX>::V, NVT = GL<MIX>::NVT;
    const int lane = tid & 63, wave = tid >> 6, c = lane & 31, hh = lane >> 5;
    const int wk = tid & 127, wc2 = (tid >> 7) & 1, wdir = tid >> 8;
    const int dir = wave >> 2, c2 = (wave >> 1) & 1, kh = wave & 1;
    for (int item = bid; item < NH * (T / 64); item += nblk) {
        const int head = item % NH, nb = item / NH, R0 = nb * 64;
        __syncthreads();
        gl_stage_gd<MIX>(g, lds, R0, tid); gl_stage_raw<MIX, false>(g, lds, R0, head, tid);
        const int rbase = R0 + 32 * c2, cr = (R0 >> 5) + c2;
        const bf16_t* vsrc = g.vT + (size_t)((MIX ? 0 : 256) + head * V) * T + rbase;
        bf16x8 bfv[NVT][2];
#pragma unroll
        for (int vt = 0; vt < NVT; ++vt)
#pragma unroll
            for (int s = 0; s < 2; ++s) bfv[vt][s] = *(const bf16x8*)(vsrc + (size_t)(32 * vt + c) * T + 16 * s + 8 * hh);
        float lbk, up[16], bias; gl_walker_consts<MIX>(g, head, wk, wdir, lbk, up, bias);
        __syncthreads();
        {
            float tail = 1.0f;
            LAS bf16_t* kt = (LAS bf16_t*)(lds + (wdir * 2 + wc2) * (128 * GL_KT_STRIDE) + wk * GL_KT_STRIDE);
#pragma unroll 8
            for (int s = 0; s < 32; ++s) {
                const int t = wdir == 0 ? 31 - s : s; unsigned short x0, x1; gl_load<MIX, false>(lds, 32 * wc2 + t, wk, wdir, x0, x1);
                float d, kv, q; gl_comp<MIX, false>(x0, x1, lbk, up, bias, (const LAS float*)(lds + GL_GD_OFF) + (wdir * 64 + 32 * wc2 + t) * 16, d, kv, q);
                kt[t] = (bf16_t)f2bf(kv * tail); tail *= d;
            }
            g.dec[((size_t)(wdir * NH + head) * NCHUNK + (R0 >> 5) + wc2) * 128 + wk] = tail;
        }
        __syncthreads();
        {
            const LAS unsigned char* ktile = lds + (dir * 2 + c2) * (128 * GL_KT_STRIDE);
            bf16x8 af[2][2];
#pragma unroll
            for (int kt2 = 0; kt2 < 2; ++kt2)
#pragma unroll
                for (int s = 0; s < 2; ++s) af[kt2][s] = *(const LAS bf16x8*)(ktile + (32 * (2 * kh + kt2) + c) * GL_KT_STRIDE + (16 * s + 8 * hh) * 2);
            bf16_t* kvo = g.kvt + ((size_t)(dir * NH + head) * NCHUNK + cr) * (V * 128);
#pragma unroll
            for (int pass = 0; pass < NVT / 4; ++pass) {
                f32x16 acc[4][2];
#pragma unroll
                for (int vt = 0; vt < 4; ++vt)
#pragma unroll
                    for (int kt2 = 0; kt2 < 2; ++kt2)
#pragma unroll
                        for (int r = 0; r < 16; ++r) acc[vt][kt2][r] = 0.f;
#pragma unroll
                for (int vt = 0; vt < 4; ++vt)
#pragma unroll
                    for (int s = 0; s < 2; ++s)
#pragma unroll
                        for (int kt2 = 0; kt2 < 2; ++kt2) acc[vt][kt2] = __builtin_amdgcn_mfma_f32_32x32x16_bf16(bfv[4 * pass + vt][s], af[kt2][s], acc[vt][kt2], 0, 0, 0);
#pragma unroll
                for (int vt = 0; vt < 4; ++vt)
#pragma unroll
                    for (int kt2 = 0; kt2 < 2; ++kt2)
#pragma unroll
                        for (int r = 0; r < 16; ++r) {
                            const int v = 32 * (4 * pass + vt) + (r & 3) + 8 * (r >> 2) + 4 * hh;
                            kvo[(size_t)v * 128 + 32 * (2 * kh + kt2) + c] = (bf16_t)f2bf(acc[vt][kt2][r]);
                        }
            }
        }
    }
}

template <int MIX, int KPT>
__device__ __forceinline__ void gl_phaseB(const GLArgs& g, int gidx) {
    constexpr int NH = GL<MIX>::NH, V = GL<MIX>::V, KG = 128 / KPT;
    if (gidx < 0 || gidx >= 2 * NH * V * KG) return;
    const int kq = gidx % KG; int rest = gidx / KG; const int v = rest % V; rest /= V; const int head = rest % NH, dir = rest / NH;
    bf16_t* base = g.kvt + (size_t)(dir * NH + head) * NCHUNK * (V * 128) + (size_t)v * 128 + KPT * kq;
    const float* dbase = g.dec + (size_t)(dir * NH + head) * NCHUNK * 128 + KPT * kq;
    float st[KPT];
#pragma unroll
    for (int e = 0; e < KPT; ++e) st[e] = 0.f;
    constexpr int UB = 10;
    unsigned kv[UB][KPT / 2], kvn[UB][KPT / 2]; float dd[UB][KPT], ddn[UB][KPT];
#define GLB_LOAD(KV, DD, ST0) do { _Pragma("unroll") for (int u = 0; u < UB; ++u) { const int cr_ = gl_scan_chunk<MIX>(dir, (ST0) + u); \
        if constexpr (KPT == 4) { const u32x2 k_ = *(const u32x2*)(base + (size_t)cr_ * (V * 128)); KV[u][0] = k_.x; KV[u][1] = k_.y; const f32x4 d_ = *(const f32x4*)(dbase + (size_t)cr_ * 128); DD[u][0] = d_[0]; DD[u][1] = d_[1]; DD[u][2] = d_[2]; DD[u][3] = d_[3]; } \
        else { _Pragma("unroll") for (int e = 0; e < KPT / 2; ++e) KV[u][e] = *((const unsigned*)(base + (size_t)cr_ * (V * 128)) + e); \
        _Pragma("unroll") for (int e = 0; e < KPT; ++e) DD[u][e] = dbase[(size_t)cr_ * 128 + e]; } } } while (0)
    GLB_LOAD(kv, dd, 0);
    for (int st0 = 0; st0 < NCHUNK; st0 += UB) {
        if (st0 + UB < NCHUNK) GLB_LOAD(kvn, ddn, st0 + UB);
#pragma unroll
        for (int u = 0; u < UB; ++u) { const int cr = gl_scan_chunk<MIX>(dir, st0 + u);
            if constexpr (KPT == 4) { *(u32x2*)(base + (size_t)cr * (V * 128)) = (u32x2){pk2(st[0], st[1]), pk2(st[2], st[3])}; }
#pragma unroll
            for (int e = 0; e < KPT / 2; ++e) { if constexpr (KPT != 4) *((unsigned*)(base + (size_t)cr * (V * 128)) + e) = pk2(st[2 * e], st[2 * e + 1]);
                st[2 * e] = fmaf(dd[u][2 * e], st[2 * e], bflo(kv[u][e])); st[2 * e + 1] = fmaf(dd[u][2 * e + 1], st[2 * e + 1], bfhi(kv[u][e])); } }
#pragma unroll
        for (int u = 0; u < UB; ++u) {
#pragma unroll
            for (int e = 0; e < KPT / 2; ++e) kv[u][e] = kvn[u][e];
#pragma unroll
            for (int e = 0; e < KPT; ++e) dd[u][e] = ddn[u][e]; }
    }
#undef GLB_LOAD
}

template <int MIX>
__device__ __forceinline__ void gl_phaseC(const GLArgs& g, LAS unsigned char* lds, int tid, int bid, int nblk) {
    constexpr int NH = GL<MIX>::NH, V = GL<MIX>::V, NVT = GL<MIX>::NVT, NP = NVT / 4;
    const int lane = tid & 63, wave = tid >> 6, c = lane & 31, hh = lane >> 5;
    const int wk = tid & 127, wc2 = (tid >> 7) & 1, wdir = tid >> 8;
    constexpr int TILE = 32 * GL_QK_STRIDE;
    for (int item = bid; item < NH * (T / 64); item += nblk) {
        const int head = item % NH, nb = item / NH, R0 = nb * 64;
        if (MIX == 1 && R0 < CTXL) continue;
        __syncthreads();
        gl_stage_gd<MIX>(g, lds, R0, tid); gl_stage_raw<MIX, true>(g, lds, R0, head, tid);
        const int c2 = wave >> 2, vg = wave & 3, rbase = R0 + 32 * c2, cr = (R0 >> 5) + c2;
        bf16x8 sf2[2][8]; u32x4 vf2[2][NP][2];
#pragma unroll
        for (int dir = 0; dir < 2; ++dir) {
            const bf16_t* sb_ = g.kvt + ((size_t)(dir * NH + head) * NCHUNK + cr) * (V * 128);
#pragma unroll
            for (int p = 0; p < NP; ++p) {
                const int vrow = 32 * (vg + 4 * p) + c;
                const bf16_t* vp = g.vT + (size_t)((MIX ? 0 : 256) + head * V + vrow) * T + rbase;
#pragma unroll
                for (int s2 = 0; s2 < 2; ++s2) { const u32x2 lo = *(const u32x2*)(vp + 16 * s2 + 4 * hh), hi = *(const u32x2*)(vp + 16 * s2 + 8 + 4 * hh); vf2[dir][p][s2] = (u32x4){lo.x, lo.y, hi.x, hi.y}; }
            }
#pragma unroll
            for (int s = 0; s < 8; ++s) sf2[dir][s] = *(const bf16x8*)(sb_ + (size_t)(32 * vg + c) * 128 + 16 * s + 8 * hh);
        }
        float lbk, up[16], bias; gl_walker_consts<MIX>(g, head, wk, wdir, lbk, up, bias);
        __syncthreads();
        {
            const int rbase = R0 + 32 * wc2; float P = 1.0f;
            LAS unsigned char* qt = lds + ((wdir * 2 + wc2) * 2) * TILE; LAS unsigned char* kt = qt + TILE;
#pragma unroll 8
            for (int s = 0; s < 32; ++s) {
                const int t = wdir == 0 ? s : 31 - s; unsigned short x0, x1; gl_load<MIX, true>(lds, 32 * wc2 + t, wk, wdir, x0, x1);
                float d, kv, q; gl_comp<MIX, true>(x0, x1, lbk, up, bias, (const LAS float*)(lds + GL_GD_OFF) + (wdir * 64 + 32 * wc2 + t) * 16, d, kv, q);
                P *= d;
                *(LAS bf16_t*)(qt + t * GL_QK_STRIDE + wk * 2) = (bf16_t)f2bf(q * P);
                *(LAS bf16_t*)(kt + t * GL_QK_STRIDE + wk * 2) = (bf16_t)f2bf(kv * fminf(__builtin_amdgcn_rcpf(P), 1e30f));
            }
        }
        __syncthreads();
        f32x16 o[NP];
#pragma unroll
        for (int p = 0; p < NP; ++p)
#pragma unroll
            for (int r = 0; r < 16; ++r) o[p][r] = 0.f;
        __builtin_amdgcn_sched_barrier(0);
#pragma unroll
        for (int dir = 0; dir < 2; ++dir) {
            const LAS unsigned char* qt = lds + ((dir * 2 + c2) * 2) * TILE; const LAS unsigned char* kt = qt + TILE;
            const bf16_t* sbase = g.kvt + ((size_t)(dir * NH + head) * NCHUNK + cr) * (V * 128);
            bf16x8 sf[8]; u32x4 vf[NP][2];
#pragma unroll
            for (int s = 0; s < 8; ++s) sf[s] = sf2[dir][s];
#pragma unroll
            for (int p = 0; p < NP; ++p) { vf[p][0] = vf2[dir][p][0]; vf[p][1] = vf2[dir][p][1]; }
            bf16x8 qf[8];
            f32x16 x;
#pragma unroll
            for (int r = 0; r < 16; ++r) x[r] = 0.f;
#pragma unroll
            for (int s = 0; s < 8; ++s) { qf[s] = *(const LAS bf16x8*)(qt + c * GL_QK_STRIDE + (16 * s + 8 * hh) * 2);
                const bf16x8 kf = *(const LAS bf16x8*)(kt + c * GL_QK_STRIDE + (16 * s + 8 * hh) * 2);
                x = __builtin_amdgcn_mfma_f32_32x32x16_bf16(kf, qf[s], x, 0, 0, 0); }
#pragma unroll
            for (int r = 0; r < 16; ++r) { const int j = (r & 3) + 8 * (r >> 2) + 4 * hh; const bool keep = dir == 0 ? (j <= c) : (j >= c); if (!keep) x[r] = 0.f; }
            bf16x8 xf[2];
#pragma unroll
            for (int s2 = 0; s2 < 2; ++s2) { u32x4 w;
#pragma unroll
                for (int e = 0; e < 4; ++e) w[e] = pk2(x[8 * s2 + 2 * e], x[8 * s2 + 2 * e + 1]);
                xf[s2] = __builtin_bit_cast(bf16x8, w); }
#pragma unroll
            for (int p = 0; p < NP; ++p) {
                bf16x8 sn[8];
                if (p + 1 < NP) {
#pragma unroll
                    for (int s = 0; s < 8; ++s) sn[s] = *(const bf16x8*)(sbase + (size_t)(32 * (vg + 4 * (p + 1)) + c) * 128 + 16 * s + 8 * hh);
                }
                __builtin_amdgcn_sched_barrier(0);
#pragma unroll
                for (int s2 = 0; s2 < 2; ++s2) o[p] = __builtin_amdgcn_mfma_f32_32x32x16_bf16(__builtin_bit_cast(bf16x8, vf[p][s2]), xf[s2], o[p], 0, 0, 0);
#pragma unroll
                for (int s = 0; s < 8; ++s) o[p] = __builtin_amdgcn_mfma_f32_32x32x16_bf16(sf[s], qf[s], o[p], 0, 0, 0);
                if (p + 1 < NP) {
#pragma unroll
                    for (int s = 0; s < 8; ++s) sf[s] = sn[s];
                }
            }
        }
        float ss = 0.f;
#pragma unroll
        for (int p = 0; p < NP; ++p)
#pragma unroll
            for (int r = 0; r < 16; ++r) ss += o[p][r] * o[p][r];
        ss += __shfl_xor(ss, 32);
        LAS float* red = (LAS float*)(lds + GL_RED_OFF);
        if (hh == 0) red[(c2 * 4 + vg) * 32 + c] = ss;
        __syncthreads();
        const float tot = (red[(c2 * 4 + 0) * 32 + c] + red[(c2 * 4 + 1) * 32 + c]) + (red[(c2 * 4 + 2) * 32 + c] + red[(c2 * 4 + 3) * 32 + c]);
        const float rs = __builtin_amdgcn_rsqf(tot * (1.0f / V) + NORM_EPS);
        const int r = rbase + c;
#pragma unroll
        for (int p = 0; p < NP; ++p)
#pragma unroll
            for (int gq = 0; gq < 4; ++gq) {
                const int v0 = 32 * (vg + 4 * p) + 8 * gq + 4 * hh;
                const f32x4 gn = *(const f32x4*)(g.gain + v0);
                const u32x2 gt = *(const u32x2*)(g.proj + (size_t)r * (MIX ? N1 : N0) + (MIX ? G_GR : P0_GH) + head * V + v0);
                u32x2 w; w.x = pk2(o[p][4 * gq] * rs * gn[0] * siluf_(bflo(gt.x)), o[p][4 * gq + 1] * rs * gn[1] * siluf_(bfhi(gt.x)));
                w.y = pk2(o[p][4 * gq + 2] * rs * gn[2] * siluf_(bflo(gt.y)), o[p][4 * gq + 3] * rs * gn[3] * siluf_(bfhi(gt.y)));
                bf16_t* op = MIX ? g.mix + (size_t)(r - CTXL) * D + head * V + v0 : g.mix + (size_t)r * D + 1024 + head * V + v0;
                *(u32x2*)op = w;
            }
    }
}

constexpr int RW_TS = 144, RW_TILE = 32 * RW_TS, RW_WAVE_LDS = 14336;
__host__ __device__ constexpr int rw_tri(int t) { return t <= 0 ? 0 : ((t - 1) / 4 + 1) * (2 * ((t - 1) / 4) + (t - 1) % 4); }
constexpr int RW_TRI_BYTES = 16 * rw_tri(32);
#ifndef RW_LB
#define RW_LB 2
#endif
static_assert(RW_TRI_BYTES + 2048 <= RW_TILE, "triangle rows + the parked fragments must fit the third tile slot");
struct RWArgs { const bf16_t* RP; const bf16_t* GOUT; bf16_t* MF; bf16_t* NB; bf16_t* QB; bf16_t* OB; bf16_t* mix; const float* rk; const float* lnw; const float* lnb; const float* ka; };
__device__ __forceinline__ int rw_scan_chunk(int dir, int cs) { return dir == 0 ? cs : (cs < 8 ? 7 - cs : NCHUNK + 7 - cs); }
__device__ __forceinline__ float rdlane(float v, int l) { return __int_as_float(__builtin_amdgcn_readlane(__float_as_int(v), l)); }
template <bool PERM>
__device__ __forceinline__ void rw_pack(const float (&x)[32], int hh, u32x4 (&f)[2][2]) {
#pragma unroll
    for (int s2 = 0; s2 < 2; ++s2)
#pragma unroll
        for (int e = 0; e < 4; ++e) {
            const int t0 = PERM ? 16 * s2 + 8 * ((2 * e) >> 2) + ((2 * e) & 3) : 16 * s2 + 2 * e;
            const int t1 = PERM ? t0 + 4 : t0 + 8;
            const unsigned p0 = pk2(x[t0], x[t0 + 1]), p1 = pk2(x[t1], x[t1 + 1]);
            const auto rr = __builtin_amdgcn_permlane32_swap(p0, p1, false, false);
            f[0][s2][e] = rr[0]; f[1][s2][e] = rr[1];
        }
    (void)hh;
}
__device__ __forceinline__ void rw_pack_pairs(const unsigned (&xp)[16], int hh, u32x4 (&f)[2][2]) {
#pragma unroll
    for (int s2 = 0; s2 < 2; ++s2)
#pragma unroll
        for (int e = 0; e < 4; ++e) { const auto rr = __builtin_amdgcn_permlane32_swap(xp[8 * s2 + e], xp[8 * s2 + 4 + e], false, false); f[0][s2][e] = rr[0]; f[1][s2][e] = rr[1]; }
    (void)hh;
}
__device__ __forceinline__ void rw_pack_pairs_perm(const unsigned (&xp)[16], int hh, u32x4 (&f)[2][2]) {
#pragma unroll
    for (int s2 = 0; s2 < 2; ++s2)
#pragma unroll
        for (int e = 0; e < 4; ++e) { const int t0 = 16 * s2 + 8 * (e >> 1) + 2 * (e & 1);
            const auto rr = __builtin_amdgcn_permlane32_swap(xp[t0 >> 1], xp[(t0 + 4) >> 1], false, false); f[0][s2][e] = rr[0]; f[1][s2][e] = rr[1]; }
    (void)hh;
}
__device__ __forceinline__ bf16x8 acc_frag(const f32x16& x, int s2) {
    u32x4 w;
#pragma unroll
    for (int e = 0; e < 4; ++e) w[e] = pk2(x[8 * s2 + 2 * e], x[8 * s2 + 2 * e + 1]);
    return __builtin_bit_cast(bf16x8, w);
}
#define MFMA32(A, B, C) __builtin_amdgcn_mfma_f32_32x32x16_bf16(A, B, C, 0, 0, 0)

__device__ __forceinline__ void rwkv_stageA(const RWArgs& g, LAS unsigned char* wl, int item, int lane) {
    __builtin_assume(item >= 0 && item < 2 * 16 * NCHUNK);
    const int dir = item / (16 * NCHUNK), rem = item - dir * 16 * NCHUNK, head = rem / NCHUNK, cs = rem - head * NCHUNK;
    const int cr = rw_scan_chunk(dir, cs), rbase = 32 * cr, c = lane & 31, hh = lane >> 5;
    LAS unsigned char* s0 = wl; LAS unsigned char* s1 = wl + RW_TILE; LAS unsigned char* s2p = wl + 2 * RW_TILE; LAS float* gam = (LAS float*)(wl + 3 * RW_TILE);
    unsigned vp[16], bp[16], kp[16];
    {
        float gprev = 1.0f; const bf16_t* rp0 = g.RP + head * 64; unsigned vo0 = (unsigned)lane * 2u, vo2 = vo0 + 4096u, vo4 = vo0 + 8192u, vo5 = vo0 + (unsigned)(5 + dir) * 2048u; asm volatile("" : "+v"(vo2), "+v"(vo4), "+v"(vo5)); const float kac = g.ka[head * 64 + lane];
#pragma unroll
        for (int sb = 0; sb < 32; sb += 16) {
            unsigned short raw[16][6];
#pragma unroll
            for (int u = 0; u < 16; ++u) { const int s = sb + u; const int r = rbase + (dir ? 31 - s : s); const char* pb = (const char*)(rp0 + (size_t)r * 7168);
                raw[u][0] = *(const bf16_t*)(pb + vo0); raw[u][1] = *(const bf16_t*)(pb + 2048 + vo0); raw[u][2] = *(const bf16_t*)(pb + vo2); raw[u][3] = *(const bf16_t*)(pb + 2048 + vo2);
                raw[u][4] = *(const bf16_t*)(pb + vo4); raw[u][5] = *(const bf16_t*)(pb + vo5); }
#pragma unroll
            for (int u = 0; u < 16; u += 2) { const int s = sb + u;
                float bq[2], kq[2], aq[2], rq[2];
#pragma unroll
                for (int h = 0; h < 2; ++h) {
                    const float rr = bf2f(raw[u + h][0]), kk = bf2f(raw[u + h][3]), aa = bf2f(raw[u + h][4]), lw = bf2f(raw[u + h][5]);
                    const float km = bf2f(raw[u + h][1]) * (1.0f + (aa - 1.0f) * kac);
                    const float gcur = gprev * fexp(lw), ginv = __builtin_amdgcn_rcpf(gcur);
                    bq[h] = kk * aa * ginv; kq[h] = km * ginv; aq[h] = -kk * gprev; rq[h] = rr * gcur;
                    gprev = gcur;
                }
                const unsigned bt2 = pk2(bq[0], bq[1]), kt2 = pk2(kq[0], kq[1]), at2 = pk2(aq[0], aq[1]), rt2 = pk2(rq[0], rq[1]);
                *(LAS bf16_t*)(s0 + s * RW_TS + lane * 2) = (bf16_t)(at2 & 0xffffu); *(LAS bf16_t*)(s0 + (s + 1) * RW_TS + lane * 2) = (bf16_t)(at2 >> 16);
                *(LAS bf16_t*)(s1 + s * RW_TS + lane * 2) = (bf16_t)(rt2 & 0xffffu); *(LAS bf16_t*)(s1 + (s + 1) * RW_TS + lane * 2) = (bf16_t)(rt2 >> 16);
                *(LAS bf16_t*)(s2p + s * RW_TS + lane * 2) = (bf16_t)(kt2 & 0xffffu); *(LAS bf16_t*)(s2p + (s + 1) * RW_TS + lane * 2) = (bf16_t)(kt2 >> 16);
                bp[s >> 1] = bt2; kp[s >> 1] = kt2; vp[s >> 1] = (unsigned)raw[u][2] | ((unsigned)raw[u + 1][2] << 16);
            }
        }
        gam[lane] = gprev;
    }
    LDS_WAIT();
    f32x16 g1, g2, g3, g4;
#pragma unroll
    for (int r = 0; r < 16; ++r) { g1[r] = 0.f; g2[r] = 0.f; g3[r] = 0.f; g4[r] = 0.f; }
    {
        bf16x8 fa[4], fr[4], fk[4];
#pragma unroll
        for (int ks = 0; ks < 4; ++ks) { fa[ks] = *(const LAS bf16x8*)(s0 + c * RW_TS + (16 * ks + 8 * hh) * 2); fr[ks] = *(const LAS bf16x8*)(s1 + c * RW_TS + (16 * ks + 8 * hh) * 2);
            fk[ks] = *(const LAS bf16x8*)(s2p + c * RW_TS + (16 * ks + 8 * hh) * 2); }
        LDS_WAIT();
#pragma unroll
        for (int s = 0; s < 32; ++s) *(LAS bf16_t*)(s2p + s * RW_TS + lane * 2) = (bf16_t)((s & 1) ? (bp[s >> 1] >> 16) : (bp[s >> 1] & 0xffffu));
        LDS_WAIT();
#pragma unroll
        for (int ks = 0; ks < 4; ++ks) {
            const bf16x8 fb = *(const LAS bf16x8*)(s2p + c * RW_TS + (16 * ks + 8 * hh) * 2);
            g1 = MFMA32(fb, fa[ks], g1); g2 = MFMA32(fk[ks], fa[ks], g2); g3 = MFMA32(fb, fr[ks], g3); g4 = MFMA32(fk[ks], fr[ks], g4);
        }
    }
#pragma unroll
    for (int r = 0; r < 16; ++r) { const int i = (r & 3) + 8 * (r >> 2) + 4 * hh; if (i > c) { g3[r] = 0.f; g4[r] = 0.f; } }
    const bf16x8 b3[2] = {acc_frag(g3, 0), acc_frag(g3, 1)}, b4[2] = {acc_frag(g4, 0), acc_frag(g4, 1)};
    LDS_WAIT();
    {
        int toff = 4 * rw_tri(c); asm volatile("" : "+v"(toff));
#pragma unroll
        for (int gq = 0; gq < 4; ++gq) { const int i0 = 8 * gq + 4 * hh;
            if (i0 < c) *(LAS f32x4*)(s2p + (toff + i0) * 4) = (f32x4){g1[4 * gq], g1[4 * gq + 1], g1[4 * gq + 2], g1[4 * gq + 3]}; }
        *(LAS bf16x8*)(s2p + RW_TRI_BYTES + lane * 16) = b4[0]; *(LAS bf16x8*)(s2p + RW_TRI_BYTES + 1024 + lane * 16) = b4[1];
    }
    f32x16 wxA, wxB;
    {
#pragma unroll
        for (int r = 0; r < 16; ++r) { const int i = (r & 3) + 8 * (r >> 2) + 4 * hh; if (i >= c) g2[r] = 0.f; }
        const bf16x8 a2[2] = {acc_frag(g2, 0), acc_frag(g2, 1)};
        u32x4 fVq[2][2]; rw_pack_pairs_perm(vp, hh, fVq);
        f32x16 x0, x1;
#pragma unroll
        for (int r = 0; r < 16; ++r) { x0[r] = 0.f; x1[r] = 0.f; }
#pragma unroll
        for (int q = 0; q < 2; ++q) { x0 = MFMA32(a2[q], __builtin_bit_cast(bf16x8, fVq[0][q]), x0); x1 = MFMA32(a2[q], __builtin_bit_cast(bf16x8, fVq[1][q]), x1); }
#pragma unroll
        for (int r = 0; r < 16; ++r) { const auto rr = __builtin_amdgcn_permlane32_swap(__float_as_uint(x0[r]), __float_as_uint(x1[r]), false, false); wxA[r] = __uint_as_float(rr[0]); wxB[r] = __uint_as_float(rr[1]); }
    }
    LDS_WAIT();
    float p[32], w[32];
    {
        f32x2 pw[32];
#pragma unroll
        for (int t = 0; t < 32; ++t) {
            f32x2 acc = {bf2f(*(const LAS bf16_t*)(s0 + t * RW_TS + lane * 2)), ((t >> 2) & 1) ? wxB[(t & 3) + 4 * (t >> 3)] : wxA[(t & 3) + 4 * (t >> 3)]};
#pragma unroll
            for (int ib = 0; ib < (t + 3) / 4; ib += RW_LB) {
                f32x4 lab[RW_LB];
#pragma unroll
                for (int b = 0; b < RW_LB; ++b) if (ib + b < (t + 3) / 4) lab[b] = *(const LAS f32x4*)(s2p + (4 * rw_tri(t) + 4 * (ib + b)) * 4);
#pragma unroll
                for (int b = 0; b < RW_LB; ++b) if (ib + b < (t + 3) / 4) {
                    const f32x2 l01 = {lab[b][0], lab[b][1]}, l23 = {lab[b][2], lab[b][3]};
                    const int i0 = 4 * (ib + b), n = t - i0;
#define RW_F0 "v_pk_fma_f32 %0, %1, %3, %0 op_sel_hi:[0,1,1]"
#define RW_F1 "\n\tv_pk_fma_f32 %0, %1, %4, %0 op_sel:[1,0,0] op_sel_hi:[1,1,1]"
#define RW_F2 "\n\tv_pk_fma_f32 %0, %2, %5, %0 op_sel_hi:[0,1,1]"
#define RW_F3 "\n\tv_pk_fma_f32 %0, %2, %6, %0 op_sel:[1,0,0] op_sel_hi:[1,1,1]"
                    if (n >= 4)      asm(RW_F0 RW_F1 RW_F2 RW_F3 : "+v"(acc) : "v"(l01), "v"(l23), "v"(pw[i0]), "v"(pw[i0 + 1]), "v"(pw[i0 + 2]), "v"(pw[i0 + 3]));
                    else if (n == 3) asm(RW_F0 RW_F1 RW_F2       : "+v"(acc) : "v"(l01), "v"(l23), "v"(pw[i0]), "v"(pw[i0 + 1]), "v"(pw[i0 + 2]));
                    else if (n == 2) asm(RW_F0 RW_F1             : "+v"(acc) : "v"(l01), "v"(l23), "v"(pw[i0]), "v"(pw[i0 + 1]));
                    else             asm(RW_F0                   : "+v"(acc) : "v"(l01), "v"(l23), "v"(pw[i0]));
#undef RW_F0
#undef RW_F1
#undef RW_F2
#undef RW_F3
                }
            }
            pw[t] = acc;
        }
#pragma unroll
        for (int t = 0; t < 32; ++t) { p[t] = pw[t][0]; w[t] = pw[t][1]; }
    }
#define BF(x) __builtin_bit_cast(bf16x8, x)
    u32x4 fBn[2][2], fKn[2][2];
    rw_pack_pairs(bp, hh, fBn); rw_pack_pairs(kp, hh, fKn);
    {
        u32x4 fPn[2][2], fPp[2][2];
        rw_pack<false>(p, hh, fPn); rw_pack<true>(p, hh, fPp);
        bf16_t* mf = g.MF + (size_t)item * 4096;
#pragma unroll
        for (int n = 0; n < 2; ++n) {
            const float gk = gam[32 * n + c];
#pragma unroll
            for (int mp = 0; mp < 2; ++mp) {
                f32x16 x;
#pragma unroll
                for (int r = 0; r < 16; ++r) x[r] = 0.f;
#pragma unroll
                for (int q = 0; q < 2; ++q) x = MFMA32(BF(fPn[mp][q]), BF(fBn[n][q]), x);
#pragma unroll
                for (int r = 0; r < 16; ++r) { const int kprime = (r & 3) + 8 * (r >> 2) + 4 * hh; x[r] = gk * (x[r] + ((mp == n && kprime == c) ? 1.0f : 0.0f)); }
#pragma unroll
                for (int q = 0; q < 2; ++q) *(bf16x8*)(mf + (size_t)(((n * 2 + mp) * 2 + q) * 64 + lane) * 8) = acc_frag(x, q);
            }
        }
        const int r = rbase + (dir ? 31 - c : c);
        bf16_t* qrow = g.QB + ((size_t)dir * T + r) * 1024 + head * 64;
#pragma unroll
        for (int mp = 0; mp < 2; ++mp) {
            f32x16 x;
#pragma unroll
            for (int rr = 0; rr < 16; ++rr) x[rr] = 0.f;
#pragma unroll
            for (int q = 0; q < 2; ++q) x = MFMA32(BF(fPp[mp][q]), b3[q], x);
#pragma unroll
            for (int gq = 0; gq < 4; ++gq) { const int k0 = 32 * mp + 8 * gq + 4 * hh; const u32x2 rt = *(const LAS u32x2*)(s1 + c * RW_TS + k0 * 2);
                u32x2 o; o.x = pk2(x[4 * gq] + bflo(rt.x), x[4 * gq + 1] + bfhi(rt.x)); o.y = pk2(x[4 * gq + 2] + bflo(rt.y), x[4 * gq + 3] + bfhi(rt.y));
                *(u32x2*)(qrow + k0) = o; }
        }
    }
    asm volatile("" ::: "memory");
    {
        u32x4 fWn[2][2], fVn[2][2], fWp[2][2], fVp[2][2];
        rw_pack<false>(w, hh, fWn); rw_pack_pairs(vp, hh, fVn); rw_pack<true>(w, hh, fWp); rw_pack_pairs_perm(vp, hh, fVp);
        bf16_t* nb = g.NB + (size_t)item * 4096;
#pragma unroll
        for (int n = 0; n < 2; ++n)
#pragma unroll
            for (int m = 0; m < 2; ++m) {
                f32x16 x;
#pragma unroll
                for (int r = 0; r < 16; ++r) x[r] = 0.f;
#pragma unroll
                for (int q = 0; q < 2; ++q) { x = MFMA32(BF(fBn[m][q]), BF(fWn[n][q]), x); x = MFMA32(BF(fKn[m][q]), BF(fVn[n][q]), x); }
                u32x4 o0, o1;
#pragma unroll
                for (int gq = 0; gq < 4; ++gq) { const f32x4 gg = *(const LAS f32x4*)(gam + 32 * m + 8 * gq + 4 * hh);
                    const unsigned a0 = pk2(x[4 * gq] * gg[0], x[4 * gq + 1] * gg[1]), a1 = pk2(x[4 * gq + 2] * gg[2], x[4 * gq + 3] * gg[3]);
                    if (gq < 2) { o0[2 * gq] = a0; o0[2 * gq + 1] = a1; } else { o1[2 * (gq - 2)] = a0; o1[2 * (gq - 2) + 1] = a1; } }
                u32x4* dst = (u32x4*)(nb + (size_t)((n * 2 + m) * 64 + lane) * 16);
                dst[0] = o0; dst[1] = o1;
            }
        const int lrow = (dir ? 31 - c : c) + 32 * hh;
        bf16_t* ob = g.OB + ((size_t)((dir * 16 + head) * NCHUNK + cr)) * 2048;
#pragma unroll
        for (int n = 0; n < 2; ++n) {
            f32x16 x;
#pragma unroll
            for (int rr = 0; rr < 16; ++rr) x[rr] = 0.f;
#pragma unroll
            for (int q = 0; q < 2; ++q) { x = MFMA32(BF(fWp[n][q]), b3[q], x); x = MFMA32(BF(fVp[n][q]), *(const LAS bf16x8*)(s2p + RW_TRI_BYTES + q * 1024 + lane * 16), x); }
            u32x4 o0, o1;
#pragma unroll
            for (int e = 0; e < 4; ++e) { o0[e] = pk2(x[2 * e], x[2 * e + 1]); o1[e] = pk2(x[8 + 2 * e], x[8 + 2 * e + 1]); }
            u32x4* dst = (u32x4*)(ob + (size_t)(n * 64 + lrow) * 16);
            dst[0] = o0; dst[1] = o1;
        }
    }
    LDS_WAIT();
}

constexpr int RWB_SLOT = 12288, RWB_FLAGS = MISC_OFF + 1536;
__device__ __forceinline__ void rwkv_stageB(const RWArgs& g, LAS unsigned char* lds, int tk, int wave, int lane) {
    const int n = tk & 1, dh = tk >> 1;
    const bf16_t* mfb = g.MF + (size_t)dh * NCHUNK * 4096; bf16_t* nbb = g.NB + (size_t)dh * NCHUNK * 4096 + (size_t)n * 2048;
    volatile LAS unsigned* flags = (volatile LAS unsigned*)(lds + RWB_FLAGS);
    if (wave != 0) {
        const int sl = wave - 1; LAS unsigned char* slot = lds + sl * RWB_SLOT;
        for (int cs = sl; cs < NCHUNK; cs += 7) {
            u32x4 v[12];
            const u32x4* mp_ = (const u32x4*)(mfb + (size_t)cs * 4096); const u32x4* np_ = (const u32x4*)(nbb + (size_t)cs * 4096);
#pragma unroll
            for (int q = 0; q < 8; ++q) v[q] = mp_[q * 64 + lane];
#pragma unroll
            for (int q = 0; q < 4; ++q) v[8 + q] = np_[q * 64 + lane];
            unsigned sp = 0; while ((int)flags[8] + 7 <= cs) { __builtin_amdgcn_s_sleep(1); if (++sp > (1u << 26)) break; }
#pragma unroll
            for (int q = 0; q < 12; ++q) *(LAS u32x4*)(slot + q * 1024 + lane * 16) = v[q];
            LDS_WAIT();
            if (lane == 0) flags[sl] = (unsigned)(cs + 1);
        }
        return;
    }
    f32x16 H[2];
#pragma unroll
    for (int m = 0; m < 2; ++m)
#pragma unroll
        for (int r = 0; r < 16; ++r) H[m][r] = 0.f;
    for (int cs = 0; cs < NCHUNK; ++cs) {
        const int sl = cs % 7; const LAS unsigned char* slot = lds + sl * RWB_SLOT;
        { unsigned sp = 0; while (flags[sl] != (unsigned)(cs + 1)) { __builtin_amdgcn_s_sleep(1); if (++sp > (1u << 26)) break; } }
        bf16x8 cm[2][2][2]; u32x4 cn[2][2];
#pragma unroll
        for (int m = 0; m < 2; ++m) {
#pragma unroll
            for (int mp = 0; mp < 2; ++mp)
#pragma unroll
                for (int q = 0; q < 2; ++q) cm[m][mp][q] = *(const LAS bf16x8*)(slot + ((m * 2 + mp) * 2 + q) * 1024 + lane * 16);
            cn[m][0] = *(const LAS u32x4*)(slot + 8192 + (m * 64 + lane) * 32); cn[m][1] = *(const LAS u32x4*)(slot + 8192 + (m * 64 + lane) * 32 + 16);
        }
        LDS_WAIT();
        if (lane == 0) flags[8] = (unsigned)(cs + 1);
        bf16x8 hb[2][2];
#pragma unroll
        for (int mp = 0; mp < 2; ++mp)
#pragma unroll
            for (int q = 0; q < 2; ++q) hb[mp][q] = acc_frag(H[mp], q);
        bf16_t* hf = nbb + (size_t)cs * 4096;
#pragma unroll
        for (int mp = 0; mp < 2; ++mp)
#pragma unroll
            for (int q = 0; q < 2; ++q) *(bf16x8*)(hf + (size_t)((mp * 2 + q) * 64 + lane) * 8) = hb[mp][q];
        f32x16 Hn[2];
#pragma unroll
        for (int m = 0; m < 2; ++m) {
#pragma unroll
            for (int e = 0; e < 4; ++e) { Hn[m][2 * e] = bflo(cn[m][0][e]); Hn[m][2 * e + 1] = bfhi(cn[m][0][e]); Hn[m][8 + 2 * e] = bflo(cn[m][1][e]); Hn[m][8 + 2 * e + 1] = bfhi(cn[m][1][e]); }
#pragma unroll
            for (int mp = 0; mp < 2; ++mp)
#pragma unroll
                for (int q = 0; q < 2; ++q) Hn[m] = MFMA32(cm[m][mp][q], hb[mp][q], Hn[m]);
        }
        H[0] = Hn[0]; H[1] = Hn[1];
    }
}

__device__ __forceinline__ void rwkv_stageC(const RWArgs& g, int head, int cr, int lane) {
    const int c = lane & 31, hh = lane >> 5, r = 32 * cr + c, t = r - CTXL;
    f32x16 o[2];
#pragma unroll
    for (int n = 0; n < 2; ++n)
#pragma unroll
        for (int q = 0; q < 16; ++q) o[n][q] = 0.f;
    bf16x8 qf[2][2][2], hf[2][2][2][2]; u32x4 ov[2][2][2];
#pragma unroll
    for (int dir = 0; dir < 2; ++dir) {
        const int cs = rw_scan_chunk(dir, cr);
        const bf16_t* qrow = g.QB + ((size_t)dir * T + r) * 1024 + head * 64;
        const bf16_t* hfb = g.NB + ((size_t)(dir * 16 + head) * NCHUNK + cs) * 4096;
        const bf16_t* ob = g.OB + ((size_t)((dir * 16 + head) * NCHUNK + cr)) * 2048;
#pragma unroll
        for (int mp = 0; mp < 2; ++mp)
#pragma unroll
            for (int q = 0; q < 2; ++q) { const u32x2 lo = *(const u32x2*)(qrow + 32 * mp + 16 * q + 4 * hh), hi = *(const u32x2*)(qrow + 32 * mp + 16 * q + 8 + 4 * hh);
                qf[dir][mp][q] = __builtin_bit_cast(bf16x8, ((u32x4){lo.x, lo.y, hi.x, hi.y})); }
#pragma unroll
        for (int n = 0; n < 2; ++n) {
            const u32x4* src = (const u32x4*)(ob + (size_t)(n * 64 + lane) * 16); ov[dir][n][0] = src[0]; ov[dir][n][1] = src[1];
#pragma unroll
            for (int mp = 0; mp < 2; ++mp)
#pragma unroll
                for (int q = 0; q < 2; ++q) hf[dir][n][mp][q] = *(const bf16x8*)(hfb + (size_t)n * 2048 + (size_t)((mp * 2 + q) * 64 + lane) * 8);
        }
    }
    const bf16_t* rp = g.RP + (size_t)r * 7168 + head * 64;
    u32x4 ra[4], ka[4], aa4[4];
#pragma unroll
    for (int q4 = 0; q4 < 4; ++q4) { ra[q4] = *(const u32x4*)(rp + 32 * hh + 8 * q4); ka[q4] = *(const u32x4*)(rp + 1024 + 32 * hh + 8 * q4); aa4[q4] = *(const u32x4*)(rp + 4096 + 32 * hh + 8 * q4); }
    __builtin_amdgcn_sched_barrier(0);
#pragma unroll
    for (int dir = 0; dir < 2; ++dir)
#pragma unroll
        for (int n = 0; n < 2; ++n) {
#pragma unroll
            for (int e = 0; e < 4; ++e) { o[n][2 * e] += bflo(ov[dir][n][0][e]); o[n][2 * e + 1] += bfhi(ov[dir][n][0][e]); o[n][8 + 2 * e] += bflo(ov[dir][n][1][e]); o[n][8 + 2 * e + 1] += bfhi(ov[dir][n][1][e]); }
#pragma unroll
            for (int mp = 0; mp < 2; ++mp)
#pragma unroll
                for (int q = 0; q < 2; ++q) o[n] = MFMA32(hf[dir][n][mp][q], qf[dir][mp][q], o[n]);
        }
    float sm = 0.f;
#pragma unroll
    for (int n = 0; n < 2; ++n)
#pragma unroll
        for (int q = 0; q < 16; ++q) sm += o[n][q];
    sm += __shfl_xor(sm, 32); const float mu = sm * (1.0f / 64.0f);
    float sv = 0.f;
#pragma unroll
    for (int n = 0; n < 2; ++n)
#pragma unroll
        for (int q = 0; q < 16; ++q) { const float d = o[n][q] - mu; sv += d * d; }
    sv += __shfl_xor(sv, 32); const float rs = __builtin_amdgcn_rsqf(sv * (1.0f / 64.0f) + 64e-5f);
    float bs = 0.f;
#pragma unroll
    for (int q4 = 0; q4 < 4; ++q4) { const float* rk = g.rk + head * 64 + 32 * hh + 8 * q4; const float* kac = g.ka + head * 64 + 32 * hh + 8 * q4;
#pragma unroll
        for (int e = 0; e < 4; ++e) { const float km0 = bflo(ka[q4][e]) * (1.0f + (bflo(aa4[q4][e]) - 1.0f) * kac[2 * e]), km1 = bfhi(ka[q4][e]) * (1.0f + (bfhi(aa4[q4][e]) - 1.0f) * kac[2 * e + 1]);
            bs = fmaf(bflo(ra[q4][e]) * km0, rk[2 * e], bs); bs = fmaf(bfhi(ra[q4][e]) * km1, rk[2 * e + 1], bs); } }
    bs += __shfl_xor(bs, 32);
#pragma unroll
    for (int n = 0; n < 2; ++n)
#pragma unroll
        for (int gq = 0; gq < 4; ++gq) {
            const int v0 = 32 * n + 8 * gq + 4 * hh, ch = head * 64 + v0;
            const u32x2 vv = *(const u32x2*)(rp + 2048 + v0), go = *(const u32x2*)(g.GOUT + (size_t)r * 1024 + ch);
            const f32x4 lw = *(const f32x4*)(g.lnw + ch), lb = *(const f32x4*)(g.lnb + ch);
            const float e0 = ((o[n][4 * gq] - mu) * rs * lw[0] + lb[0] + bs * bflo(vv.x)) * bflo(go.x), e1 = ((o[n][4 * gq + 1] - mu) * rs * lw[1] + lb[1] + bs * bfhi(vv.x)) * bfhi(go.x);
            const float e2 = ((o[n][4 * gq + 2] - mu) * rs * lw[2] + lb[2] + bs * bflo(vv.y)) * bflo(go.y), e3 = ((o[n][4 * gq + 3] - mu) * rs * lw[3] + lb[3] + bs * bfhi(vv.y)) * bfhi(go.y);
            u32x2 w; w.x = pk2(e0, e1); w.y = pk2(e2, e3);
            *(u32x2*)(g.mix + (size_t)t * D + 1024 + ch) = w;
        }
}
#undef BF

__device__ __forceinline__ void shifted4(const bf16_t* P, int r, int col, const float* mup, const float* mun, float (&o)[4]) {
    const u32x2 p = *(const u32x2*)(P + (size_t)r * N1 + col);
    u32x2 pv = (u32x2){0u, 0u}, nx = (u32x2){0u, 0u};
    if (!(r == 0 || r == CTXL)) pv = *(const u32x2*)(P + (size_t)(r - 1) * N1 + col);
    if (!(r == CTXL - 1 || r == T - 1)) nx = *(const u32x2*)(P + (size_t)(r + 1) * N1 + col);
    const f32x4 mp = *(const f32x4*)(mup + col - R_R), mn = *(const f32x4*)(mun + col - R_R);
    const float pc[4] = {bflo(p.x), bfhi(p.x), bflo(p.y), bfhi(p.y)}, pp[4] = {bflo(pv.x), bfhi(pv.x), bflo(pv.y), bfhi(pv.y)}, pn[4] = {bflo(nx.x), bfhi(nx.x), bflo(nx.y), bfhi(nx.y)};
#pragma unroll
    for (int e = 0; e < 4; ++e) o[e] = pc[e] + mp[e] * (pp[e] - pc[e]) + mn[e] * (pn[e] - pc[e]);
}
__device__ __forceinline__ void st4bf(bf16_t* p, float a0, float a1, float a2, float a3) { u32x2 w; w.x = pk2(a0, a1); w.y = pk2(a2, a3); *(u32x2*)p = w; }
__device__ __forceinline__ void rwkv_xfill(const Args& a, const bf16_t* P, bf16_t* XL, int gtid, int gthreads) {
    const float* mup = a.in[I_MUPREV]; const float* mun = a.in[I_MUNEXT];
    for (int idx = gtid; idx < T * 256; idx += gthreads) {
        const int row = idx >> 8, q = idx & 255, plane = q >> 6, col = (q & 63) * 4;
        float v[4] = {0.f, 0.f, 0.f, 0.f};
        if (plane == 3 || col < 96) {
            shifted4(P, row, R_WDF + (plane == 3 ? 288 : plane * 96) + col, mup, mun, v);
            if (plane < 2) { for (int e = 0; e < 4; ++e) v[e] = tanhf_(v[e]); }
            else if (plane == 3) { for (int e = 0; e < 4; ++e) v[e] = sigmoidf_(v[e]); }
        }
        st4bf(XL + ((size_t)plane * T + row) * 256 + col, v[0], v[1], v[2], v[3]);
    }
}
__device__ __forceinline__ void rwkv_rkv(const Args& a, const bf16_t* P, bf16_t* RP, int gw, int ngw, int lane) {
    const float* mup = a.in[I_MUPREV]; const float* mun = a.in[I_MUNEXT];
    for (int it = gw; it < T * 4; it += ngw) {
        const int r = it >> 2, ch = (it & 3) * 256 + 4 * lane;
        float x[4], k[4], y[4];
        shifted4(P, r, R_R + ch, mup, mun, x); shifted4(P, r, R_K + ch, mup, mun, k); shifted4(P, r, R_V + ch, mup, mun, y);
        bf16_t* rp = RP + (size_t)r * 7168;
        const f32x4 kkc = *(const f32x4*)(a.in[I_KK] + ch);
        float kq[4], ss = 0.f;
#pragma unroll
        for (int e = 0; e < 4; ++e) { kq[e] = k[e] * kkc[e]; ss += kq[e] * kq[e]; }
        ss += __shfl_xor(ss, 1); ss += __shfl_xor(ss, 2); ss += __shfl_xor(ss, 4); ss += __shfl_xor(ss, 8);
        const float rn = __builtin_amdgcn_rsqf(ss + 1e-12f);
        st4bf(rp + ch, x[0], x[1], x[2], x[3]);
        st4bf(rp + 1024 + ch, k[0], k[1], k[2], k[3]);
        st4bf(rp + 2048 + ch, y[0], y[1], y[2], y[3]);
        st4bf(rp + 3072 + ch, kq[0] * rn, kq[1] * rn, kq[2] * rn, kq[3] * rn);
    }
}

__device__ __forceinline__ void moe_tables(LAS unsigned char* lds, const int* blkcnt, int tid) {
    LAS int* tab = (LAS int*)(lds + MOE_TAB_OFF); LAS int* pref = (LAS int*)(lds + PREF_OFF);
    const int lane = tid & 63, e = tid >> 6;
    __syncthreads();
    int cnt[4], run = 0;
#pragma unroll
    for (int i = 0; i < 4; ++i) { cnt[i] = blkcnt[(4 * lane + i) * 8 + e]; run += cnt[i]; }
    int inc = run;
#pragma unroll
    for (int o = 1; o < 64; o <<= 1) { const int v = __shfl_up(inc, o); if (lane >= o) inc += v; }
    int ex = inc - run;
#pragma unroll
    for (int i = 0; i < 4; ++i) { pref[(4 * lane + i) * 8 + e] = ex; ex += cnt[i]; }
    if (lane == 63) tab[e] = inc;
    __syncthreads();
    int off = 0, np = 0, mye = -1;
#pragma unroll
    for (int x = 0; x < 8; ++x) { const int npe = (tab[x] + 255) >> 8; if (tid == 0) tab[8 + x] = off; if (tid >= np && tid < np + npe) mye = x; off += npe * 256; np += npe; }
    if (mye >= 0) tab[18 + tid] = mye;
    if (tid == 0) { tab[16] = off; tab[17] = np; }
    __syncthreads();
}

constexpr int NPH = 23;
__global__ void __launch_bounds__(NTHR, 2) trunk_fwd(Args a) {
    extern __shared__ __attribute__((aligned(16))) unsigned char lds_raw[];
    LAS unsigned char* lds = (LAS unsigned char*)lds_raw;
    const int tid = threadIdx.x, lane = tid & 63, wave = __builtin_amdgcn_readfirstlane(tid >> 6);
    const int bx = blockIdx.x, G = gridDim.x, gw = bx * NWAVES + wave, NGW = G * NWAVES;
    unsigned char* ws = a.ws;
    for (int u = tid; u < (LDS_BYTES - MISC_OFF) / 4; u += NTHR) ((LAS unsigned*)(lds + MISC_OFF))[u] = 0u;
    __syncthreads();
    const int lo = a.ph_lo, hi = a.ph_hi;
    XcdBarrier bar; bar.bar = (unsigned*)(ws + WS_CTL) + CW_BAR; bar.x = 0; bar.st = (volatile LAS unsigned*)(lds + MISC_OFF);
    if (hi - lo > 1) bar = xcd_barrier_post((unsigned*)(ws + WS_CTL) + CW_BAR, (volatile LAS unsigned*)(lds + MISC_OFF));
#ifdef ONLY_PHASE
#define IN(k) ((k) == ONLY_PHASE && lo <= (k) && (k) < hi)
#else
#define IN(k) (lo <= (k) && (k) < hi)
#endif
#define SEAM(k) do { if (IN(k) && IN((k) + 1)) xcd_barrier(bar); } while (0)
#define MODP(l, vec, which) (mod + (size_t)(((l) * 2 + (vec)) * 6 + (which)) * 2048)
    const float* mod = (const float*)(ws + WS_MOD);
    bf16_t* H = (bf16_t*)(ws + WS_H);
    bf16_t* XB = (bf16_t*)(ws + WS_XB);
    float* out = a.out;
    const size_t TS2048 = (size_t)256 * 2048 * 2;

    if (IN(0)) for (int rep_ = 0; rep_ <= (int)((REPMASK >> 0) & 1u); ++rep_) { if (rep_) __syncthreads(); p0_prologue(a, lds, tid, lane, wave); }
    SEAM(0);
    if (IN(1)) for (int rep_ = 0; rep_ <= (int)((REPMASK >> 1) & 1u); ++rep_) { if (rep_) __syncthreads();
        for (int r = gw; r < T; r += NGW) {
            const int vec = r < CTXL ? 1 : 0; const float* xin = vec ? a.in[I_CTX] + (size_t)r * D : a.in[I_X] + (size_t)(r - CTXL) * D;
            f32x4 v[8]; ldrow(xin, lane, v);
            mod_store_i8(v, a.in[I_NMIXPRE0], MODP(0, vec, 1), MODP(0, vec, 0), (signed char*)(ws + WS_H) + (size_t)r * D, (float*)(ws + WS_HSC) + r, lane);
        }
    }
    SEAM(1);
    if (IN(2)) for (int rep_ = 0; rep_ <= (int)((REPMASK >> 2) & 1u); ++rep_) { if (rep_) __syncthreads();
        pg8::SchedPlain S{(const char*)(ws + WS_H), (const char*)(ws + W_IN0T), 65, 21, G, bx, (size_t)256 * 2048, 5 * 65, (const char*)(ws + W_V0T), (const char*)(ws + WS_H), 65, 0};
        pg8::EpiBf16I8 E{(bf16_t*)(ws + A_PROJ0), N0, (bf16_t*)(ws + A_VT), T, (const float*)(ws + WS_HSC), (const float*)(ws + WS_QI0), (const float*)(ws + WS_QV0), (const float*)(ws + WS_HSC)};
        pg8::gemm_phase<pg8::EpiBf16I8, pg8::SchedPlain, true>(lds, 2048, S, E);
    }
    SEAM(2);
    const GLArgs g0{(const bf16_t*)(ws + A_PROJ0), (const bf16_t*)(ws + A_VT), (bf16_t*)(ws + A_KVT0), (float*)(ws + A_DEC0), (bf16_t*)(ws + A_MIX0), a.in[I_LBL], nullptr, nullptr, nullptr, nullptr, a.in[I_HNORM]};
    if (IN(3)) for (int rep_ = 0; rep_ <= (int)((REPMASK >> 3) & 1u); ++rep_) { if (rep_) __syncthreads();
        const float* ropetab = (const float*)(ws + WS_ROPE);
        for (int rq_ = 0; rq_ <= (int)((REPMASK >> 24) & 1u); ++rq_)
        for (int u = bx; u < 520; u += G) {
            const int kind = u < 512 ? 0 : 1, uu = u < 512 ? u : u - 512;
            attn_unit(lds, (const bf16_t*)(ws + A_PROJ0), (const bf16_t*)(ws + A_VT), (bf16_t*)(ws + A_MIX0), a.in[I_SINK], ropetab, kind, uu >> 1, uu & 1, tid);
        }
        for (int rq_ = 0; rq_ <= (int)((REPMASK >> 25) & 1u); ++rq_) gl_phaseA<0>(g0, lds, tid, bx, G);
    }
    SEAM(3);
    if (IN(4)) { gl_phaseB<0, 4>(g0, tid < 256 ? bx * 256 + tid : -1);
        if ((REPMASK >> 23) & 1u) { GLArgs gx = g0; gx.kvt = (bf16_t*)(ws + WS_A + 700 * MiB); gx.dec = (float*)(ws + WS_A + 965 * MiB); gl_phaseB<0, 4>(gx, tid < 256 ? bx * 256 + tid : -1); } }
    SEAM(4);
    if (IN(5)) for (int rep_ = 0; rep_ <= (int)((REPMASK >> 5) & 1u); ++rep_) { if (rep_) __syncthreads(); gl_phaseC<0>(g0, lds, tid, bx, G); }
    SEAM(5);
    if (IN(6)) for (int rep_ = 0; rep_ <= (int)((REPMASK >> 6) & 1u); ++rep_) { if (rep_) __syncthreads();
        pg8::SchedPlain S{(const char*)(ws + A_MIX0), (const char*)(ws + W_OUT0T), 64, 8, G, bx, TS2048, 0, nullptr, nullptr, 1, 1};
        pg8::EpiBf16 E{(bf16_t*)(ws + A_Y0), 2048, nullptr, 0};
        pg8::gemm_phase<pg8::EpiBf16, pg8::SchedPlain>(lds, 4096, S, E);
        pg8::SchedSplit S2{(const char*)(ws + A_MIX0), (const char*)(ws + W_OUT0T), 8, 8, G, bx, TS2048, (size_t)512};
        pg8::EpiF32 E2{(float*)(ws + A_PY0), 2048, (size_t)256 * 2048};
        pg8::gemm_phase<pg8::EpiF32, pg8::SchedSplit>(lds, 4096, S2, E2, 512 + (lo >> 20));
    }
    SEAM(6);
    if (IN(7)) for (int rep_ = 0; rep_ <= (int)((REPMASK >> 7) & 1u); ++rep_) { if (rep_) __syncthreads();
        const bf16_t* Y0 = (const bf16_t*)(ws + A_Y0);
        for (int r = gw; r < T; r += NGW) {
            const int vec = r < CTXL ? 1 : 0; const float* xin = vec ? a.in[I_CTX] + (size_t)r * D : a.in[I_X] + (size_t)(r - CTXL) * D;
            bf16_t* xo = XB + (size_t)r * D;
            f32x4 v[8], b[8]; ldrow(xin, lane, v);
            if (vec) { const float* pp = (const float*)(ws + A_PY0) + (size_t)r * D; ldrow(pp, lane, b);
                for (int ks = 1; ks < 8; ++ks) { f32x4 t2[8]; ldrow(pp + (size_t)ks * 256 * 2048, lane, t2);
#pragma unroll
                    for (int j = 0; j < 8; ++j) b[j] += t2[j]; } }
            else ldrow_bf(Y0 + (size_t)r * D, lane, b);
            add_branch(v, b, a.in[I_NMIXPOST0], MODP(0, vec, 2), lane); strow_bf(xo, lane, v);
            mod_store_i8(v, a.in[I_NFFNPRE0], MODP(0, vec, 4), MODP(0, vec, 3), (signed char*)(ws + WS_H) + (size_t)r * D, (float*)(ws + WS_HSC) + r, lane);
        }
    }
    SEAM(7);
    if (IN(8)) for (int rep_ = 0; rep_ <= (int)((REPMASK >> 8) & 1u); ++rep_) { if (rep_) __syncthreads();
        pg8::SchedPlain S{(const char*)(ws + WS_H), (const char*)(ws + W_GU0T), 65, 44, G, bx, (size_t)256 * 2048, 0, nullptr, nullptr, 1, 0};
        pg8::EpiSwigluI8 E{(bf16_t*)(ws + A_HID0), FF0, (const float*)(ws + WS_HSC), (const float*)(ws + WS_QS0), 0};
        pg8::gemm_phase<pg8::EpiSwigluI8, pg8::SchedPlain, true>(lds, 2048, S, E);
    }
    SEAM(8);
    if (IN(9)) for (int rep_ = 0; rep_ <= (int)((REPMASK >> 9) & 1u); ++rep_) { if (rep_) __syncthreads();
        pg8::SchedPlain S{(const char*)(ws + A_HID0), (const char*)(ws + W_DN0T), 64, 8, G, bx, (size_t)256 * FF0 * 2, 0, nullptr, nullptr, 1, 1};
        pg8::EpiBf16 E{(bf16_t*)(ws + A_F0), 2048, nullptr, 0};
        pg8::gemm_phase<pg8::EpiBf16, pg8::SchedPlain>(lds, 2 * FF0, S, E);
        pg8::SchedSplit S2{(const char*)(ws + A_HID0), (const char*)(ws + W_DN0T), 8, 22, G, bx, (size_t)256 * FF0 * 2, (size_t)512};
        pg8::EpiF32 E2{(float*)(ws + A_PF0), 2048, (size_t)256 * 2048};
        pg8::gemm_phase<pg8::EpiF32, pg8::SchedSplit>(lds, 2 * FF0, S2, E2, 512 + (lo >> 20));
    }
    SEAM(9);
    if (IN(10)) {
        const bf16_t* F0 = (const bf16_t*)(ws + A_F0);
        for (int r = gw; r < T; r += NGW) {
            const int vec = r < CTXL ? 1 : 0; bf16_t* xo = XB + (size_t)r * D;
            f32x4 v[8], b[8]; ldrow_bf(xo, lane, v);
            if (vec) { const float* pp = (const float*)(ws + A_PF0) + (size_t)r * D; ldrow(pp, lane, b);
                for (int ks = 1; ks < 22; ++ks) { f32x4 t2[8]; ldrow(pp + (size_t)ks * 256 * 2048, lane, t2);
#pragma unroll
                    for (int j = 0; j < 8; ++j) b[j] += t2[j]; } }
            else ldrow_bf(F0 + (size_t)r * D, lane, b);
            add_branch(v, b, a.in[I_NFFNPOST0], MODP(0, vec, 5), lane); strow_bf(xo, lane, v);
            mod_store_i8(v, a.in[I_NMIXPRE1], MODP(1, vec, 1), MODP(1, vec, 0), (signed char*)(ws + WS_H) + (size_t)r * D, (float*)(ws + WS_HSC) + r, lane);
        }
    }
    SEAM(10);
    if (IN(11)) for (int rep_ = 0; rep_ <= (int)((REPMASK >> 11) & 1u); ++rep_) { if (rep_) __syncthreads();
        pg8::SchedPlain S{(const char*)(ws + WS_H), (const char*)(ws + W_IN1T), 65, 23, G, bx, (size_t)256 * 2048, 4 * 65, (const char*)(ws + W_GV1T), (const char*)(ws + WS_H), 65, 0};
        pg8::EpiBf16I8 E{(bf16_t*)(ws + A_PROJ1), N1, (bf16_t*)(ws + A_GVT), T, (const float*)(ws + WS_HSC), (const float*)(ws + WS_QI1), (const float*)(ws + WS_QG1), (const float*)(ws + WS_HSC)};
        pg8::gemm_phase<pg8::EpiBf16I8, pg8::SchedPlain, true>(lds, 2048, S, E);
    }
    SEAM(11);
    const GLArgs g1{(const bf16_t*)(ws + A_PROJ1), (const bf16_t*)(ws + A_GVT), (bf16_t*)(ws + A_KVT1), (float*)(ws + A_DEC1), (bf16_t*)(ws + A_MIX1), nullptr, a.in[I_GUPF], a.in[I_GUPB], a.in[I_GBIASF], a.in[I_GBIASB], a.in[I_GLANORM]};
    const RWArgs rwa{(const bf16_t*)(ws + A_RP), (const bf16_t*)(ws + A_GOUT), (bf16_t*)(ws + A_MF), (bf16_t*)(ws + A_NB), (bf16_t*)(ws + A_QB), (bf16_t*)(ws + A_OB), (bf16_t*)(ws + A_MIX1), a.in[I_RK], a.in[I_LNW], a.in[I_LNB], a.in[I_KA]};
    if (IN(12)) for (int rep_ = 0; rep_ <= (int)((REPMASK >> 12) & 1u); ++rep_) { if (rep_) __syncthreads();
        rwkv_xfill(a, (const bf16_t*)(ws + A_PROJ1), (bf16_t*)(ws + A_XL), bx * NTHR + tid, G * NTHR);
        rwkv_rkv(a, (const bf16_t*)(ws + A_PROJ1), (bf16_t*)(ws + A_RP), gw, NGW, lane);
        gl_phaseA<1>(g1, lds, tid, bx, G);
    }
    SEAM(12);
    if (IN(13)) {
        pg8::SchedLora S{(const char*)(ws + A_XL), (const char*)(ws + WS_LORA4), (size_t)T * 512, G, bx};
        pg8::EpiLora E{(bf16_t*)(ws + A_RP), ((long)A_GOUT - (long)A_RP) / 2, (const float*)(ws + WS_LB)};
        pg8::gemm_phase<pg8::EpiLora, pg8::SchedLora>(lds, 512 + (lo >> 20), S, E);
    }
    SEAM(13);
    if (IN(14)) {
        volatile LAS int* ictr = (volatile LAS int*)(lds + MISC_OFF + 1600);
        if (tid == 0) *ictr = 0;
        __syncthreads();
        if (wave >= 4) gl_phaseB<1, 4>(g1, bx * 256 + (tid - 256));
        {
            const int nw = wave < 4 ? (wave == 0 ? 11 : 10) : 6, jb = wave < 4 ? wave : 40 + (wave - 4);
            for (int i = 0; i < nw; ++i) { const int j = (wave == 0 && i == 10) ? 64 : jb + 4 * i; rwkv_stageA(rwa, lds + wave * RW_WAVE_LDS, bx + 256 * j, lane); }
        }
    }
    SEAM(14);
    if (IN(15)) {
        if (bx < 64) rwkv_stageB(rwa, lds, bx, wave, lane);
        else for (int rq_ = 0; rq_ <= (int)((REPMASK >> 29) & 1u); ++rq_) gl_phaseC<1>(g1, lds, tid, bx - 64, G - 64);
    }
    SEAM(15);
    if (IN(16)) for (int rep_ = 0; rep_ <= (int)((REPMASK >> 15) & 1u); ++rep_) { if (rep_) __syncthreads();
        for (int it = gw; it < 16 * (NCHUNK - 8); it += NGW) rwkv_stageC(rwa, it & 15, 8 + (it >> 4), lane);
    }
    SEAM(16);
    if (IN(17)) for (int rep_ = 0; rep_ <= (int)((REPMASK >> 18) & 1u); ++rep_) { if (rep_) __syncthreads();
        pg8::SchedPlain S{(const char*)(ws + A_MIX1), (const char*)(ws + W_OUT1T), 64, 8, G, bx, TS2048, 0, nullptr, nullptr, 1, 0};
        pg8::EpiBf16 E{(bf16_t*)(ws + A_Y1), 2048, nullptr, 0};
        pg8::gemm_phase<pg8::EpiBf16, pg8::SchedPlain>(lds, 4096, S, E);
    }
    SEAM(17);
    int* tk_e = (int*)(ws + WS_TK); float* tk_w = (float*)(ws + WS_TK + 128 * 1024); int* tk_lr = (int*)(ws + WS_TK + 256 * 1024); int* tk_pos = (int*)(ws + WS_TK + 384 * 1024);
    int* blkcnt = (int*)(ws + WS_BLKCNT);
    if (IN(18)) {
        LAS int* ecnt = (LAS int*)(lds + ECNT_OFF);
        if (tid < 8) ecnt[tid] = 0;
        __syncthreads();
        const bf16_t* Y1 = (const bf16_t*)(ws + A_Y1); const float* router = a.in[I_ROUTER];
        for (int t = gw; t < SEQ; t += NGW) {
            f32x4 v[8], b[8]; ldrow_bf(XB + (size_t)(t + CTXL) * D, lane, v); ldrow_bf(Y1 + (size_t)t * D, lane, b);
            add_branch(v, b, a.in[I_NMIXPOST1], MODP(1, 0, 2), lane); strow_bf(XB + (size_t)(t + CTXL) * D, lane, v);
            mod_store(v, a.in[I_NFFNPRE1], MODP(1, 0, 4), MODP(1, 0, 3), H + (size_t)t * D, lane);
            float lg[8];
#pragma unroll
            for (int e = 0; e < 8; ++e) lg[e] = 0.f;
#pragma unroll
            for (int j = 0; j < 8; ++j)
#pragma unroll
                for (int q = 0; q < 4; ++q) { const float* rp = router + (size_t)(4 * lane + 256 * j + q) * 8; const f32x4 r0 = *(const f32x4*)rp, r1 = *(const f32x4*)(rp + 4); const float hv = v[j][q];
                    lg[0] = fmaf(hv, r0[0], lg[0]); lg[1] = fmaf(hv, r0[1], lg[1]); lg[2] = fmaf(hv, r0[2], lg[2]); lg[3] = fmaf(hv, r0[3], lg[3]);
                    lg[4] = fmaf(hv, r1[0], lg[4]); lg[5] = fmaf(hv, r1[1], lg[5]); lg[6] = fmaf(hv, r1[2], lg[6]); lg[7] = fmaf(hv, r1[3], lg[7]); }
#pragma unroll
            for (int e = 0; e < 8; ++e) lg[e] = wave_sum(lg[e]);
            int ea = 0; float va = lg[0];
#pragma unroll
            for (int e = 1; e < 8; ++e) if (lg[e] > va) { va = lg[e]; ea = e; }
            int eb = -1; float vb = -INFINITY;
#pragma unroll
            for (int e = 0; e < 8; ++e) if (e != ea && lg[e] > vb) { vb = lg[e]; eb = e; }
            if (eb < 0) eb = (ea + 1) & 7;
            const float wa = 1.0f / (1.0f + fexp(vb - va)), wb = 1.0f - wa;
            if (lane == 0) {
                const int la = __hip_atomic_fetch_add(ecnt + ea, 1, __ATOMIC_RELAXED, __HIP_MEMORY_SCOPE_WORKGROUP);
                const int lb = __hip_atomic_fetch_add(ecnt + eb, 1, __ATOMIC_RELAXED, __HIP_MEMORY_SCOPE_WORKGROUP);
                tk_e[2 * t] = ea; tk_e[2 * t + 1] = eb; tk_w[2 * t] = wa; tk_w[2 * t + 1] = wb; tk_lr[2 * t] = la; tk_lr[2 * t + 1] = lb;
            }
        }
        __syncthreads();
        if (tid < 8) blkcnt[bx * 8 + tid] = ecnt[tid];
    }
    SEAM(18);
    if (IN(19)) for (int rep_ = 0; rep_ <= (int)((REPMASK >> 20) & 1u); ++rep_) { if (rep_) __syncthreads();
        moe_tables(lds, blkcnt, tid);
        const LAS int* tab = (const LAS int*)(lds + MOE_TAB_OFF); const LAS int* pref = (const LAS int*)(lds + PREF_OFF);
        signed char* SORT = (signed char*)(ws + A_SORT); float* ssc = (float*)(ws + WS_SSC);
        for (int t = gw; t < SEQ; t += NGW) {
            const int b = (t % NGW) / NWAVES;
            const u32x4* src = (const u32x4*)(H + (size_t)t * D); u32x4 hv[4]; float mx = 0.f;
#pragma unroll
            for (int j = 0; j < 4; ++j) { hv[j] = src[lane + 64 * j];
#pragma unroll
                for (int e = 0; e < 4; ++e) mx = fmaxf(mx, fmaxf(fabsf(bflo(hv[j][e])), fabsf(bfhi(hv[j][e])))); }
#pragma unroll
            for (int o = 1; o < 64; o <<= 1) mx = fmaxf(mx, __shfl_xor(mx, o));
            const float inv = mx > 0.f ? 127.0f / mx : 0.f, scl = mx > 0.f ? mx * (1.0f / 127.0f) : 1.0f;
            u32x2 qv[4];
#pragma unroll
            for (int j = 0; j < 4; ++j) { unsigned pk[2];
#pragma unroll
                for (int hq = 0; hq < 2; ++hq) { const unsigned w0 = hv[j][2 * hq], w1 = hv[j][2 * hq + 1];
                    const int q0 = (int)__builtin_rintf(bflo(w0) * inv), q1 = (int)__builtin_rintf(bfhi(w0) * inv), q2 = (int)__builtin_rintf(bflo(w1) * inv), q3 = (int)__builtin_rintf(bfhi(w1) * inv);
                    pk[hq] = (unsigned)(q0 & 0xff) | ((unsigned)(q1 & 0xff) << 8) | ((unsigned)(q2 & 0xff) << 16) | ((unsigned)(q3 & 0xff) << 24); }
                qv[j] = (u32x2){pk[0], pk[1]}; }
#pragma unroll
            for (int sl = 0; sl < 2; ++sl) {
                const int e = tk_e[2 * t + sl], lr = tk_lr[2 * t + sl];
                const int pos = tab[8 + e] + pref[b * 8 + e] + lr;
                if (lane == 0) { tk_pos[2 * t + sl] = pos; ssc[pos] = scl; }
                u32x2* dst = (u32x2*)(SORT + (size_t)pos * D);
#pragma unroll
                for (int j = 0; j < 4; ++j) dst[lane + 64 * j] = qv[j];
            }
        }
    }
    SEAM(19);
    if (IN(20)) for (int rep_ = 0; rep_ <= (int)((REPMASK >> 21) & 1u); ++rep_) { if (rep_) __syncthreads();
        moe_tables(lds, blkcnt, tid);
        const LAS int* tab = (const LAS int*)(lds + MOE_TAB_OFF);
        pg8::SchedMoe S{(const char*)(ws + A_SORT), (const char*)(ws + W_MGUT), (size_t)14336 * 2048, tab[17], 56, G, bx, (size_t)256 * 2048, tab + 18};
        pg8::EpiSwigluI8 E{(bf16_t*)(ws + A_HID1), FFE, (const float*)(ws + WS_SSC), (const float*)(ws + WS_QSM), 14336};
        pg8::gemm_phase<pg8::EpiSwigluI8, pg8::SchedMoe, true>(lds, 2048, S, E);
    }
    SEAM(20);
    if (IN(21)) for (int rep_ = 0; rep_ <= (int)((REPMASK >> 22) & 1u); ++rep_) { if (rep_) __syncthreads();
        moe_tables(lds, blkcnt, tid);
        const LAS int* tab = (const LAS int*)(lds + MOE_TAB_OFF);
        const int nwg = tab[17] * 8, nfull = (nwg >> 8) << 8, rem = nwg - nfull;
        const int split = rem == 0 ? 1 : (rem * 8 <= 256 ? 8 : (rem * 4 <= 256 ? 4 : (rem * 2 <= 256 ? 2 : 1)));
        const size_t kslice = (size_t)(2 * FFE) / split;
        pg8::SchedMoeDown S{(const char*)(ws + A_HID1), (const char*)(ws + W_MDNT), (size_t)2048 * FFE * 2, split > 1 ? nfull : nwg, G, bx, (size_t)256 * FFE * 2, tab + 18, 0, 0, nfull, 0};
        pg8::EpiMoeDown E{(bf16_t*)(ws + A_YDN), (float*)(ws + A_PYD)};
        pg8::gemm_phase<pg8::EpiMoeDown, pg8::SchedMoeDown>(lds, 2 * FFE, S, E);
        if (split > 1) {
            pg8::SchedMoeDown S2{(const char*)(ws + A_HID1), (const char*)(ws + W_MDNT), (size_t)2048 * FFE * 2, 0, G, bx, (size_t)256 * FFE * 2, tab + 18, split, rem, nfull, kslice};
            pg8::gemm_phase<pg8::EpiMoeDown, pg8::SchedMoeDown>(lds, 2 * FFE, S2, E, (int)kslice);
        }
    }
    SEAM(21);
    if (IN(22)) {
        const bf16_t* YDN = (const bf16_t*)(ws + A_YDN); const float* PYD = (const float*)(ws + A_PYD);
        moe_tables(lds, blkcnt, tid);
        const LAS int* tab = (const LAS int*)(lds + MOE_TAB_OFF);
        const int nwg = tab[17] * 8, nfull = (nwg >> 8) << 8, rem = nwg - nfull, pfull = nfull >> 3;
        const int split = rem == 0 ? 1 : (rem * 8 <= 256 ? 8 : (rem * 4 <= 256 ? 4 : (rem * 2 <= 256 ? 2 : 1)));
        for (int t = gw; t < SEQ; t += NGW) {
            f32x4 v[8], b[8]; ldrow_bf(XB + (size_t)(t + CTXL) * D, lane, v);
            const int pa = tk_pos[2 * t], pb = tk_pos[2 * t + 1]; const float wa = tk_w[2 * t], wb = tk_w[2 * t + 1];
            if (split > 1 && ((pa >> 8) >= pfull || (pb >> 8) >= pfull)) {
#pragma unroll
                for (int j = 0; j < 8; ++j) b[j] = (f32x4){0.f, 0.f, 0.f, 0.f};
#pragma unroll 1
                for (int sl = 0; sl < 2; ++sl) { const int pos = sl ? pb : pa; const float w = sl ? wb : wa;
                    if ((pos >> 8) >= pfull) { for (int ks = 0; ks < split; ++ks) { f32x4 t2[8]; ldrow(PYD + ((size_t)(((pos >> 8) - pfull) * split + ks) * 256 + (pos & 255)) * 2048, lane, t2);
#pragma unroll
                            for (int j = 0; j < 8; ++j) b[j] += t2[j] * w; } }
                    else {
#pragma unroll
                        for (int j = 0; j < 8; ++j) { const u32x2 y = *(const u32x2*)(YDN + (size_t)pos * D + 4 * lane + 256 * j); b[j] += (f32x4){bflo(y.x), bfhi(y.x), bflo(y.y), bfhi(y.y)} * w; } } }
                add_branch(v, b, a.in[I_NFFNPOST1], MODP(1, 0, 5), lane); strow(out + (size_t)t * D, lane, v);
                continue;
            }
#pragma unroll
            for (int j = 0; j < 8; ++j) { const u32x2 ya = *(const u32x2*)(YDN + (size_t)pa * D + 4 * lane + 256 * j), yb = *(const u32x2*)(YDN + (size_t)pb * D + 4 * lane + 256 * j);
                b[j] = (f32x4){wa * bflo(ya.x) + wb * bflo(yb.x), wa * bfhi(ya.x) + wb * bfhi(yb.x), wa * bflo(ya.y) + wb * bflo(yb.y), wa * bfhi(ya.y) + wb * bfhi(yb.y)}; }
            add_branch(v, b, a.in[I_NFFNPOST1], MODP(1, 0, 5), lane); strow(out + (size_t)t * D, lane, v);
        }
    }
#undef IN
#undef SEAM
#undef MODP
}

extern "C" void kernel_launch(void* const* d_in, const int* in_sizes, int n_in, void* d_out, int out_size, void* d_ws, size_t ws_size, hipStream_t stream) {
    static int state = 0;
    if (state == 0) {
        state = -1;
        if (n_in != 49 || out_size != SEQ * D || ws_size < WS_END) { fprintf(stderr, "kernel_launch: unexpected shapes (n_in %d, out %d, ws %zu, need %zu)\n", n_in, out_size, ws_size, (size_t)WS_END); return; }
        if (hipFuncSetAttribute((const void*)trunk_fwd, hipFuncAttributeMaxDynamicSharedMemorySize, LDS_BYTES) != hipSuccess) { fprintf(stderr, "kernel_launch: hipFuncSetAttribute failed\n"); return; }
        int per_cu = 0; (void)hipOccupancyMaxActiveBlocksPerMultiprocessor(&per_cu, (const void*)trunk_fwd, NTHR, LDS_BYTES); (void)hipGetLastError();
        if (per_cu < 1) fprintf(stderr, "kernel_launch: occupancy query says %d\n", per_cu);
        state = 1;
    }
    if (state < 0) return;
    (void)hipMemsetAsync((char*)d_ws + WS_CTL, 0, CTL_ZERO_BYTES, stream);
    Args a{};
    for (int i = 0; i < 49; ++i) a.in[i] = (const float*)d_in[i];
    a.out = (float*)d_out; a.ws = (unsigned char*)d_ws;
    const int grid = 256;
#if N_LAUNCH_MODE == 0
    for (int ph = 0; ph < NPH; ++ph) { a.ph_lo = ph; a.ph_hi = ph + 1; hipLaunchKernelGGL(trunk_fwd, dim3(grid), dim3(NTHR), LDS_BYTES, stream, a); }
#else
    a.ph_lo = 0; a.ph_hi = NPH; hipLaunchKernelGGL(trunk_fwd, dim3(grid), dim3(NTHR), LDS_BYTES, stream, a);
#endif
}
```

```cpp
#include <hip/hip_runtime.h>
#include <cstdio>
#include <cstdint>

#define LAS __attribute__((address_space(3)))
#define GAS __attribute__((address_space(1)))
typedef unsigned short bf16_t;
typedef short bf16x8 __attribute__((ext_vector_type(8)));
typedef float f32x4 __attribute__((ext_vector_type(4)));
typedef float f32x2 __attribute__((ext_vector_type(2)));
typedef float f32x16 __attribute__((ext_vector_type(16)));
typedef unsigned u32x4 __attribute__((ext_vector_type(4)));
typedef unsigned u32x2 __attribute__((ext_vector_type(2)));

#ifndef REPMASK
#define REPMASK 0u
#endif
#ifndef N_LAUNCH_MODE
#define N_LAUNCH_MODE 1
#endif

constexpr int D = 2048, SEQ = 16384, CTXL = 256, T = SEQ + CTXL;
constexpr int NWAVES = 8, NTHR = 512;
constexpr float NORM_EPS = 1e-6f;
constexpr int N0 = 5376, P0_QA = 0, P0_KA = 1024, P0_QH = 1280, P0_FF = 2304, P0_FB = 3328, P0_GH = 4352;
constexpr int VT_ROWS = 1280;
constexpr int N1 = 5888, G_Q = 0, G_K = 512, G_GDF = 1024, G_GDB = 1040, G_GR = 1056;
constexpr int R_R = 2080, R_K = 3104, R_V = 4128, R_WDF = 5152, R_WDB = 5248, R_AD = 5344, R_GD = 5440;
constexpr int FF0 = 5632, FFE = 7168, NE = 8;
constexpr int MOE_ROWS = 2 * SEQ + NE * 256;
constexpr int MOE_MAXPAN = MOE_ROWS / 256;
constexpr int NCHUNK = T / 32;

constexpr size_t MiB = (size_t)1 << 20;
constexpr size_t WS_CTL = 0, CTL_ZERO_BYTES = 1 * MiB;
constexpr size_t WS_MOD = 1 * MiB;
constexpr size_t WS_ROPE = WS_MOD + 256 * 1024;
constexpr size_t WS_BLKCNT = WS_ROPE + 128 * 1024;
constexpr size_t WS_TK = 2 * MiB;
constexpr size_t WS_XC = 4 * MiB;
constexpr size_t WS_LORA = 6 * MiB;
constexpr size_t WS_QS0 = WS_LORA + 1280 * 1024;
constexpr size_t WS_QSM = WS_QS0 + 64 * 1024;
constexpr size_t WS_QI0 = WS_TK + 512 * 1024;
constexpr size_t WS_QV0 = WS_QI0 + 32 * 1024;
constexpr size_t WS_QI1 = WS_QV0 + 8 * 1024;
constexpr size_t WS_QG1 = WS_QI1 + 32 * 1024;
constexpr size_t WS_LB = WS_QG1 + 8 * 1024;
constexpr size_t WS_HSC = WS_TK + 1024 * 1024;
constexpr size_t WS_SSC = WS_HSC + 128 * 1024;
constexpr size_t WS_W = 8 * MiB;
constexpr size_t W_IN0T = WS_W;
constexpr size_t W_V0T = W_IN0T + 21 * MiB;
constexpr size_t W_OUT0T = W_V0T + 5 * MiB;
constexpr size_t W_GU0T = W_OUT0T + 8 * MiB;
constexpr size_t W_DN0T = W_GU0T + 44 * MiB;
constexpr size_t W_IN1T = W_DN0T + 22 * MiB;
constexpr size_t W_GV1T = W_IN1T + 23 * MiB;
constexpr size_t W_OUT1T = W_GV1T + 4 * MiB;
constexpr size_t W_MGUT = W_OUT1T + 8 * MiB;
constexpr size_t W_MDNT = W_MGUT + 448 * MiB;
constexpr size_t WS_LORA4 = W_GU0T + 22 * MiB;
constexpr size_t WS_XB = W_MGUT + 224 * MiB;
constexpr size_t WS_H = W_MDNT + 224 * MiB;
constexpr size_t WS_A = WS_H + 66 * MiB;
constexpr size_t A_PROJ0 = WS_A;
constexpr size_t A_VT = WS_A + 171 * MiB;
constexpr size_t A_MIX0 = WS_A + 212 * MiB;
constexpr size_t A_KVT0 = WS_A + 277 * MiB;
constexpr size_t A_DEC0 = WS_A + 537 * MiB;
constexpr size_t A_Y0 = WS_A + 542 * MiB;
constexpr size_t A_PY0 = WS_A + 672 * MiB;
constexpr size_t A_PF0 = WS_A + 690 * MiB;
constexpr size_t A_HID0 = WS_A;
constexpr size_t A_F0 = WS_A + 179 * MiB;
static_assert(A_HID0 + (size_t)T * FF0 * 2 <= A_F0 && A_F0 + (size_t)T * 2048 * 4 <= A_Y0, "layer-0 overlays");
constexpr size_t A_PROJ1 = WS_A;
constexpr size_t A_GVT = WS_A + 187 * MiB;
constexpr size_t A_RP = WS_A + 220 * MiB;
constexpr size_t A_KVT1 = WS_A + 448 * MiB;
constexpr size_t A_DEC1 = WS_A + 708 * MiB;
constexpr size_t A_MF = WS_A + 711 * MiB;
constexpr size_t A_XL = A_MF;
constexpr size_t A_NB = WS_A + 841 * MiB;
constexpr size_t A_MIX1 = WS_A + 971 * MiB;
constexpr size_t A_QB = W_IN0T;
constexpr size_t A_GOUT = W_IN0T + 65 * MiB;
constexpr size_t A_OB = WS_H;
constexpr size_t A_Y1 = WS_A;
constexpr size_t A_SORT = WS_A + 128 * MiB;
constexpr size_t A_HID1 = WS_A + 264 * MiB;
constexpr size_t A_YDN = WS_A + 740 * MiB;
constexpr size_t A_PYD = WS_A + 880 * MiB;
constexpr size_t WS_END = WS_A + 1035 * MiB;
static_assert(A_YDN + (size_t)MOE_ROWS * 2048 * 2 <= A_PYD && A_PYD + (size_t)32 * 256 * 2048 * 4 <= A_MIX1, "moe partials");
static_assert(A_SORT + (size_t)MOE_ROWS * 2048 * 2 <= A_HID1 && A_HID1 + (size_t)MOE_ROWS * FFE * 2 <= A_YDN && A_YDN + (size_t)MOE_ROWS * 2048 * 2 <= A_MIX1, "moe overlay");
static_assert(A_PROJ1 + (size_t)T * N1 * 2 <= A_GVT && A_GVT + (size_t)1024 * T * 2 <= A_RP && A_RP + (size_t)T * 7168 * 2 <= A_KVT1 && A_KVT1 + (size_t)2 * 4 * 520 * 256 * 128 * 2 <= A_DEC1, "layer-1 map");
static_assert(A_MF + (size_t)2 * 16 * 520 * 8192 <= A_NB && A_NB + (size_t)2 * 16 * 520 * 8192 <= A_MIX1 && A_MIX1 + (size_t)SEQ * 2048 * 2 <= WS_END, "layer-1 map 2");
static_assert(A_GOUT + (size_t)T * 1024 * 2 <= W_OUT1T && A_QB + (size_t)2 * T * 1024 * 2 <= A_GOUT && A_OB + (size_t)2 * 16 * 520 * 4096 <= WS_A, "overlays on dead weights / h");
static_assert(A_PROJ0 + (size_t)T * N0 * 2 <= A_VT && A_VT + (size_t)VT_ROWS * T * 2 <= A_MIX0 && A_KVT0 + (size_t)2 * 8 * 520 * 128 * 128 * 2 <= A_DEC0, "layer-0 map");
constexpr int CW_BAR = 4096;

constexpr int LDS_BYTES = 147456;
constexpr int MISC_OFF = 135168;
constexpr int MOE_TAB_OFF = MISC_OFF + 64, ECNT_OFF = MISC_OFF + 1024, PREF_OFF = MISC_OFF + 2048;

__device__ __forceinline__ float bf2f(unsigned b) { return __uint_as_float(b << 16); }
__device__ __forceinline__ float bflo(unsigned w) { return __uint_as_float(w << 16); }
__device__ __forceinline__ float bfhi(unsigned w) { return __uint_as_float(w & 0xffff0000u); }
typedef __bf16 bf16x2_t __attribute__((ext_vector_type(2)));
__device__ __forceinline__ unsigned pk2(float lo, float hi) { const f32x2 v = {lo, hi}; const bf16x2_t b = __builtin_convertvector(v, bf16x2_t); return __builtin_bit_cast(unsigned, b); }
__device__ __forceinline__ unsigned f2bf(float f) { return pk2(f, 0.f) & 0xffffu; }
__device__ __forceinline__ float wave_sum(float v) {
#pragma unroll
    for (int o = 1; o < 64; o <<= 1) v += __shfl_xor(v, o);
    return v;
}
__device__ __forceinline__ float fexp2(float x) { return __builtin_amdgcn_exp2f(x); }
__device__ __forceinline__ float fexp(float x) { return __builtin_amdgcn_exp2f(x * 1.4426950408889634f); }
__device__ __forceinline__ float sigmoidf_(float x) { return __builtin_amdgcn_rcpf(1.0f + fexp(-x)); }
__device__ __forceinline__ float siluf_(float x) { return x * __builtin_amdgcn_rcpf(1.0f + fexp(-x)); }
__device__ __forceinline__ float tanhf_(float x) { return 1.0f - 2.0f * __builtin_amdgcn_rcpf(1.0f + fexp(2.0f * x)); }
#define LDS_WAIT() asm volatile("s_waitcnt lgkmcnt(0)" ::: "memory")
#define VM_WAIT() asm volatile("s_waitcnt vmcnt(0)" ::: "memory")

#define XB_TMO      128
#define XB_XCNT(j)  (256  + 64 * (j))
#define XB_XSUB(j)  (1280 + 64 * (j))
#define XB_XGEN(j)  (2304 + 64 * (j))
#define XB_TOP      3328
#define XB_TOPGEN   3392
#define XCD_BAR_WORDS 3456
#define XB_SPIN_CAP (1u << 24)
__device__ __forceinline__ unsigned xb_ld(unsigned* p)              { return __hip_atomic_load(p, __ATOMIC_RELAXED, __HIP_MEMORY_SCOPE_AGENT); }
__device__ __forceinline__ unsigned xb_add(unsigned* p, unsigned v) { return __hip_atomic_fetch_add(p, v, __ATOMIC_RELAXED, __HIP_MEMORY_SCOPE_AGENT); }
__device__ __forceinline__ unsigned xb_xcc_id() { return (unsigned)__builtin_amdgcn_s_getreg((3 << 11) | 20) & 0xFu; }
#define XB_SPIN(cond, bar) do { unsigned _sp = 0; while (cond) { __builtin_amdgcn_s_sleep(1); \
    if ((++_sp & 255u) == 0u) { if (xb_ld(&(bar)[XB_TMO])) break; if (_sp > XB_SPIN_CAP) { atomicAdd(&(bar)[XB_TMO], 1u); break; } } } } while (0)
struct XcdBarrier { unsigned* bar; unsigned x; volatile LAS unsigned* st; };
__device__ __forceinline__ XcdBarrier xcd_barrier_post(unsigned* bar, volatile LAS unsigned* st) {
    XcdBarrier b; b.bar = bar; b.x = xb_xcc_id(); b.st = st;
    if (threadIdx.x == 0) (void)xb_add(&bar[XB_XCNT(b.x)], 1u);
    return b;
}
__device__ __forceinline__ void xcd_barrier_complete(unsigned* bar, unsigned x, unsigned& nloc, unsigned& nx) {
    const unsigned G = gridDim.x * gridDim.y * gridDim.z;
    unsigned sum, cnt, mine, sp = 0u;
    for (;;) {
        sum = 0u; cnt = 0u; mine = 0u;
#pragma unroll
        for (unsigned j = 0; j < 16; ++j) { const unsigned c = xb_ld(&bar[XB_XCNT(j)]); sum += c; cnt += (c > 0u) ? 1u : 0u; mine = (j == x) ? c : mine; }
        if (sum == G) break;
        __builtin_amdgcn_s_sleep(1);
        if ((++sp & 255u) == 0u) { if (xb_ld(&bar[XB_TMO])) break; if (sp > XB_SPIN_CAP) { atomicAdd(&bar[XB_TMO], 1u); break; } }
    }
    nloc = mine > 0u ? mine : 1u; nx = cnt > 0u ? cnt : 1u;
}
__device__ __forceinline__ void xcd_barrier(const XcdBarrier& b) {
    asm volatile("s_waitcnt vmcnt(0)" ::: "memory");
    __syncthreads();
    if (threadIdx.x == 0) {
        unsigned* bar = b.bar;
        __builtin_amdgcn_s_waitcnt(0);
        unsigned nloc = b.st[0], nx = b.st[1];
        if (nloc == 0u) { xcd_barrier_complete(bar, b.x, nloc, nx); b.st[0] = nloc; b.st[1] = nx; }
        const unsigned old = xb_add(&bar[XB_XSUB(b.x)], 1u);
        const unsigned gen = old / nloc;
        if (old + 1u == (gen + 1u) * nloc) {
            __builtin_amdgcn_fence(__ATOMIC_RELEASE, "agent");
            asm volatile("s_waitcnt vmcnt(0)" ::: "memory");
            const unsigned og = xb_add(&bar[XB_TOP], 1u);
            const unsigned tg = og / nx;
            if (og + 1u == (tg + 1u) * nx) xb_add(&bar[XB_TOPGEN], 1u);
            else XB_SPIN(xb_ld(&bar[XB_TOPGEN]) == tg, bar);
            __builtin_amdgcn_fence(__ATOMIC_ACQUIRE, "agent");
            xb_add(&bar[XB_XGEN(b.x)], 1u);
            asm volatile("s_waitcnt vmcnt(0)" ::: "memory");
        } else {
            XB_SPIN(xb_ld(&bar[XB_XGEN(b.x)]) == gen, bar);
            __builtin_amdgcn_fence(__ATOMIC_ACQUIRE, "agent");
            asm volatile("s_waitcnt vmcnt(0)" ::: "memory");
        }
    }
    __syncthreads();
}

namespace pg8 {
constexpr int BM = 256, BK = 64, HALF = 128, HTB = HALF * BK * 2, STAGE_BYTES = 8 * HTB, NXCD = 8, WGM = 8;
__host__ __device__ __forceinline__ int lds_byte(int r, int c) { const int st = (r >> 4) * 2 + (c >> 5), rr = r & 15, cc = c & 31, ob = rr * 64 + cc * 2; return st * 1024 + (ob ^ (((ob >> 9) & 1) << 5)); }
__host__ __device__ __forceinline__ void stage_rc(int b, int& R, int& C) { const int st = b / 1024, sb = b % 1024, swz = sb ^ (((sb >> 9) & 1) << 5); R = (st >> 1) * 16 + swz / 64; C = (st & 1) * 32 + (swz % 64) / 2; }
__host__ __device__ __forceinline__ int perm32(int rho) { const int n = rho >> 4, i = rho & 15; return 8 * (i >> 2) + 4 * n + (i & 3); }

struct Unit { int pm, pn; const char* a; const char* b; int aux; };

__device__ __forceinline__ void order_map(int wgid, int nM, int nN, int& pm, int& pn) {
    const int nwg = nM * nN;
    { const int q = nwg / NXCD, r = nwg % NXCD, xcd = wgid % NXCD, off = wgid / NXCD; wgid = (xcd < r ? xcd * (q + 1) : r * (q + 1) + (xcd - r) * q) + off; }
    const int nig = WGM * nN, gid = wgid / nig, fm = gid * WGM, gsz = (nM - fm) < WGM ? (nM - fm) : WGM;
    pm = fm + ((wgid % nig) % gsz); pn = (wgid % nig) / gsz;
}
struct SchedPlain {
    const char* A; const char* Bt; int nM, nN, G, c; size_t tstep; int nextra; const char* A2; const char* B2; int nN2; int pm0;
    __device__ __forceinline__ bool next(int i, Unit& u) const {
        const long L = (long)i * G + c; const int nwg = nM * nN;
        if (L >= nwg + nextra) return false;
        if (L >= nwg) { const int j = (int)L - nwg, pm2 = j / nN2, pn2 = j - pm2 * nN2; u.pm = pm2; u.pn = pn2; u.a = A2 + (size_t)pm2 * tstep; u.b = B2 + (size_t)pn2 * tstep; u.aux = 1; return true; }
        int pm, pn; order_map((int)L, nM, nN, pm, pn);
        u.pm = pm + pm0; u.pn = pn; u.a = A + (size_t)(pm + pm0) * tstep; u.b = Bt + (size_t)pn * tstep; u.aux = 0; return true;
    }
};
struct SchedSplit {
    const char* A; const char* Bt; int nN, nsplit, G, c; size_t tstep, kslice;
    __device__ __forceinline__ bool next(int i, Unit& u) const {
        const long L = (long)i * G + c; if (L >= (long)nN * nsplit) return false;
        const int pn = (int)L % nN, ks = (int)L / nN;
        u.pm = 0; u.pn = pn; u.a = A + (size_t)ks * kslice; u.b = Bt + (size_t)pn * tstep + (size_t)ks * kslice; u.aux = ks; return true;
    }
};
struct SchedMoe {
    const char* A; const char* Wt; size_t wstride; int nM, nN, G, c; size_t tstep; const LAS int* pexp;
    __device__ __forceinline__ bool next(int i, Unit& u) const {
        const long L = (long)i * G + c; const int nwg = nM * nN;
        if (L >= nwg) return false;
        int pm, pn; order_map((int)L, nM, nN, pm, pn);
        const int e = pexp[pm];
        u.pm = pm; u.pn = pn; u.a = A + (size_t)pm * tstep; u.b = Wt + (size_t)e * wstride + (size_t)pn * tstep; u.aux = e; return true;
    }
};

struct SchedLora {
    const char* X; const char* Wt; size_t plane; int G, c;
    __device__ __forceinline__ bool next(int i, Unit& u) const {
        const long L = (long)i * G + c; if (L >= 65 * 16) return false;
        int pm, pn; order_map((int)L, 65, 16, pm, pn);
        u.pm = pm; u.pn = pn; u.a = X + (size_t)(pn >> 2) * plane + (size_t)pm * 131072; u.b = Wt + (size_t)pn * 131072; u.aux = pn >> 2; return true;
    }
};
struct SchedMoeDown {
    const char* A; const char* Wt; size_t wstride; int nunits, G, c; size_t tstep; const LAS int* pexp; int split, rem, nfull; size_t kslice;
    __device__ __forceinline__ bool next(int i, Unit& u) const {
        const long L = (long)i * G + c; int Lb = 0, ks = 0;
        int pm, pn;
        if (split == 0) { if (L >= nunits) return false; order_map((int)L, nunits >> 3, 8, pm, pn); }
        else { if (L >= (long)rem * split) return false; Lb = nfull + (int)(L % rem); ks = (int)(L / rem); pm = Lb >> 3; pn = Lb & 7; }
        const int e = pexp[pm];
        u.pm = pm; u.pn = pn; u.a = A + (size_t)pm * tstep + (size_t)ks * kslice; u.b = Wt + (size_t)e * wstride + (size_t)pn * tstep + (size_t)ks * kslice;
        u.aux = split == 0 ? -1 : ((pm - (nfull >> 3)) * split + ks); return true;
    }
};
__device__ __forceinline__ unsigned cvt_pk_bf16(float lo, float hi) { unsigned r; asm volatile("v_cvt_pk_bf16_f32 %0, %1, %2" : "=v"(r) : "v"(lo), "v"(hi)); return r; }
struct EpiBf16 {
    static constexpr bool PERM = true;
    struct Pre {}; __device__ __forceinline__ void prefetch(const Unit&, int, int, int, int, Pre&) const {}
    bf16_t* O; int ldc; bf16_t* O1; int ldc1;
    __device__ __forceinline__ void operator()(const f32x4 (&acc)[2][2][4][2], const Unit& u, int wr, int wc, int fr, int fq, const Pre&) const {
        bf16_t* base = (u.aux == 1 && O1) ? O1 : O; const int ld = (u.aux == 1 && O1) ? ldc1 : ldc;
        const int row0 = u.pm * BM + wr * 64 + fr, col0 = u.pn * BM + wc * 32 + 8 * fq;
#pragma unroll
        for (int ai = 0; ai < 2; ++ai)
#pragma unroll
            for (int m = 0; m < 4; ++m) { bf16_t* rowp = base + (size_t)(row0 + ai * HALF + m * 16) * ld + col0;
#pragma unroll
                for (int bj = 0; bj < 2; ++bj) { const f32x4 v0 = acc[ai][bj][m][0], v1 = acc[ai][bj][m][1];
                    u32x4 w; w.x = cvt_pk_bf16(v0[0], v0[1]); w.y = cvt_pk_bf16(v0[2], v0[3]); w.z = cvt_pk_bf16(v1[0], v1[1]); w.w = cvt_pk_bf16(v1[2], v1[3]);
                    *(u32x4*)(rowp + bj * HALF) = w; } }
    }
};
struct EpiLora {
    static constexpr bool PERM = true;
    struct Pre {}; __device__ __forceinline__ void prefetch(const Unit&, int, int, int, int, Pre&) const {}
    bf16_t* RP; long gdelta; const float* bias3;
    __device__ __forceinline__ void operator()(const f32x4 (&acc)[2][2][4][2], const Unit& u, int wr, int wc, int fr, int fq, const Pre&) const {
        const int kind = u.aux, row0 = u.pm * BM + wr * 64 + fr, ch0 = (u.pn & 3) * BM + wc * 32 + 8 * fq;
        const float* bias = bias3 + (kind < 3 ? kind : 0) * 1024;
        const long poff = kind == 3 ? gdelta : (kind == 0 ? 5120 : (kind == 1 ? 6144 : 4096)); const int ld = kind == 3 ? 1024 : 7168;
        bf16_t* base = RP + poff;
        const float sc = kind < 2 ? -0.6065306597126334f : 1.0f;
        f32x4 bv[2][2];
#pragma unroll
        for (int bj = 0; bj < 2; ++bj)
#pragma unroll
            for (int n = 0; n < 2; ++n) { bv[bj][n] = *(const f32x4*)(bias + ch0 + bj * HALF + 4 * n); if (kind == 3) bv[bj][n] = (f32x4){0.f, 0.f, 0.f, 0.f}; }
#pragma unroll
        for (int ai = 0; ai < 2; ++ai)
#pragma unroll
            for (int m = 0; m < 4; ++m) { bf16_t* rowp = base + (size_t)(row0 + ai * HALF + m * 16) * ld + ch0;
#pragma unroll
                for (int bj = 0; bj < 2; ++bj) { f32x4 v0 = acc[ai][bj][m][0] + bv[bj][0], v1 = acc[ai][bj][m][1] + bv[bj][1];
                    if (kind != 3) {
#pragma unroll
                        for (int j = 0; j < 4; ++j) { v0[j] = sc * __builtin_amdgcn_rcpf(1.0f + __builtin_amdgcn_exp2f(-1.4426950408889634f * v0[j])); v1[j] = sc * __builtin_amdgcn_rcpf(1.0f + __builtin_amdgcn_exp2f(-1.4426950408889634f * v1[j])); } }
                    u32x4 w; w.x = cvt_pk_bf16(v0[0], v0[1]); w.y = cvt_pk_bf16(v0[2], v0[3]); w.z = cvt_pk_bf16(v1[0], v1[1]); w.w = cvt_pk_bf16(v1[2], v1[3]);
                    *(u32x4*)(rowp + bj * HALF) = w; } }
    }
};
struct EpiMoeDown {
    static constexpr bool PERM = true;
    struct Pre {}; __device__ __forceinline__ void prefetch(const Unit&, int, int, int, int, Pre&) const {}
    bf16_t* O; float* P;
    __device__ __forceinline__ void operator()(const f32x4 (&acc)[2][2][4][2], const Unit& u, int wr, int wc, int fr, int fq, const Pre&) const {
        const int rin0 = wr * 64 + fr, col0 = u.pn * BM + wc * 32 + 8 * fq;
        if (u.aux < 0) {
            bf16_t* base = O + (size_t)(u.pm * BM + rin0) * 2048 + col0;
#pragma unroll
            for (int ai = 0; ai < 2; ++ai)
#pragma unroll
                for (int m = 0; m < 4; ++m) { bf16_t* rowp = base + (size_t)(ai * HALF + m * 16) * 2048;
#pragma unroll
                    for (int bj = 0; bj < 2; ++bj) { const f32x4 v0 = acc[ai][bj][m][0], v1 = acc[ai][bj][m][1];
                        u32x4 w; w.x = cvt_pk_bf16(v0[0], v0[1]); w.y = cvt_pk_bf16(v0[2], v0[3]); w.z = cvt_pk_bf16(v1[0], v1[1]); w.w = cvt_pk_bf16(v1[2], v1[3]);
                        *(u32x4*)(rowp + bj * HALF) = w; } }
        } else {
            float* base = P + ((size_t)u.aux * 256 + rin0) * 2048 + col0;
#pragma unroll
            for (int ai = 0; ai < 2; ++ai)
#pragma unroll
                for (int m = 0; m < 4; ++m) { float* rowp = base + (size_t)(ai * HALF + m * 16) * 2048;
#pragma unroll
                    for (int bj = 0; bj < 2; ++bj) { *(f32x4*)(rowp + bj * HALF) = acc[ai][bj][m][0]; *(f32x4*)(rowp + bj * HALF + 4) = acc[ai][bj][m][1]; } }
        }
    }
};
struct EpiF32 {
    static constexpr bool PERM = false;
    struct Pre {}; __device__ __forceinline__ void prefetch(const Unit&, int, int, int, int, Pre&) const {}
    float* C; int ldc; size_t astride;
    __device__ __forceinline__ void operator()(const f32x4 (&acc)[2][2][4][2], const Unit& u, int wr, int wc, int fr, int fq, const Pre&) const {
        const int row0 = u.pm * BM + wr * 64 + fr, col0 = u.pn * BM + wc * 32 + 4 * fq; float* C = this->C + (size_t)u.aux * astride;
#pragma unroll
        for (int ai = 0; ai < 2; ++ai)
#pragma unroll
            for (int m = 0; m < 4; ++m) { float* rowp = C + (size_t)(row0 + ai * HALF + m * 16) * ldc + col0;
#pragma unroll
                for (int bj = 0; bj < 2; ++bj)
#pragma unroll
                    for (int n = 0; n < 2; ++n) *(f32x4*)(rowp + bj * HALF + n * 16) = acc[ai][bj][m][n]; }
    }
};
struct EpiSwiglu {
    static constexpr bool PERM = true;
    struct Pre {}; __device__ __forceinline__ void prefetch(const Unit&, int, int, int, int, Pre&) const {}
    bf16_t* O; int ldc;
    __device__ __forceinline__ void operator()(const f32x4 (&acc)[2][2][4][2], const Unit& u, int wr, int wc, int fr, int fq, const Pre&) const {
        const int row0 = u.pm * BM + wr * 64 + fr, col0 = u.pn * HALF + wc * 32 + 8 * fq;
#pragma unroll
        for (int ai = 0; ai < 2; ++ai)
#pragma unroll
            for (int m = 0; m < 4; ++m) { bf16_t* rowp = O + (size_t)(row0 + ai * HALF + m * 16) * ldc + col0;
                float o[8];
#pragma unroll
                for (int n = 0; n < 2; ++n)
#pragma unroll
                    for (int j = 0; j < 4; ++j) { const float g = acc[ai][0][m][n][j], up = acc[ai][1][m][n][j];
                        o[n * 4 + j] = g * up * __builtin_amdgcn_rcpf(1.0f + __builtin_amdgcn_exp2f(-1.4426950408889634f * g)); }
                u32x4 w; w.x = cvt_pk_bf16(o[0], o[1]); w.y = cvt_pk_bf16(o[2], o[3]); w.z = cvt_pk_bf16(o[4], o[5]); w.w = cvt_pk_bf16(o[6], o[7]);
                *(u32x4*)rowp = w; }
    }
};

typedef int i32x4 __attribute__((ext_vector_type(4)));
struct EpiBf16I8 {
    static constexpr bool PERM = true;
    bf16_t* O; int ldc; bf16_t* O1; int ldc1; const float* sr0; const float* sc0; const float* sr1; const float* sc1;
    struct Pre { float rsv[2]; float csv; };
    __device__ __forceinline__ void prefetch(const Unit& u, int wr, int wc, int fr, int fq, Pre& p) const {
        const bool x = (u.aux == 1 && O1); const float* sr = x ? sr1 : sr0; const float* sc = x ? sc1 : sc0; const int lane = fr + 16 * fq;
        p.rsv[0] = sr[u.pm * BM + wr * 64 + lane]; p.rsv[1] = sr[u.pm * BM + HALF + wr * 64 + lane];
        p.csv = sc[u.pn * BM + wc * 32 + (lane & 31) + (lane >> 5) * HALF];
    }
    __device__ __forceinline__ void operator()(const i32x4 (&acc)[2][2][4][2], const Unit& u, int wr, int wc, int fr, int fq, const Pre& p) const {
        const bool x = (u.aux == 1 && O1);
        bf16_t* base = x ? O1 : O; const int ld = x ? ldc1 : ldc;
        const int row0 = u.pm * BM + wr * 64 + fr, col0 = u.pn * BM + wc * 32 + 8 * fq;
        f32x4 cs[2][2];
#pragma unroll
        for (int bj = 0; bj < 2; ++bj)
#pragma unroll
            for (int n = 0; n < 2; ++n)
#pragma unroll
                for (int j = 0; j < 4; ++j) cs[bj][n][j] = __shfl(p.csv, 32 * bj + 8 * fq + 4 * n + j);
#pragma unroll
        for (int ai = 0; ai < 2; ++ai)
#pragma unroll
            for (int m = 0; m < 4; ++m) { const int r = row0 + ai * HALF + m * 16; const float rs = __shfl(p.rsv[ai], m * 16 + fr); bf16_t* rowp = base + (size_t)r * ld + col0;
#pragma unroll
                for (int bj = 0; bj < 2; ++bj) { const i32x4 a0 = acc[ai][bj][m][0], a1 = acc[ai][bj][m][1]; const f32x4 c0 = cs[bj][0] * rs, c1 = cs[bj][1] * rs;
                    const f32x4 f0 = __builtin_convertvector(a0, f32x4) * c0, f1 = __builtin_convertvector(a1, f32x4) * c1;
                    u32x4 w; w.x = cvt_pk_bf16(f0[0], f0[1]); w.y = cvt_pk_bf16(f0[2], f0[3]); w.z = cvt_pk_bf16(f1[0], f1[1]); w.w = cvt_pk_bf16(f1[2], f1[3]);
                    *(u32x4*)(rowp + bj * HALF) = w; } }
    }
};
struct EpiSwigluI8 {
    static constexpr bool PERM = true;
    bf16_t* O; int ldc; const float* sa; const float* sb; size_t sb_estride;
    struct Pre { float rsv[2]; float csv; };
    __device__ __forceinline__ void prefetch(const Unit& u, int wr, int wc, int fr, int fq, Pre& p) const {
        const int lane = fr + 16 * fq;
        p.rsv[0] = sa[u.pm * BM + wr * 64 + lane]; p.rsv[1] = sa[u.pm * BM + HALF + wr * 64 + lane];
        p.csv = sb[(size_t)u.aux * sb_estride + u.pn * BM + wc * 32 + (lane & 31) + (lane >> 5) * HALF];
    }
    __device__ __forceinline__ void operator()(const i32x4 (&acc)[2][2][4][2], const Unit& u, int wr, int wc, int fr, int fq, const Pre& p) const {
        const int row0 = u.pm * BM + wr * 64 + fr, col0 = u.pn * HALF + wc * 32 + 8 * fq;
        f32x4 sg[2], su[2];
#pragma unroll
        for (int n = 0; n < 2; ++n)
#pragma unroll
            for (int j = 0; j < 4; ++j) { sg[n][j] = __shfl(p.csv, 8 * fq + 4 * n + j); su[n][j] = __shfl(p.csv, 32 + 8 * fq + 4 * n + j); }
#pragma unroll
        for (int ai = 0; ai < 2; ++ai)
#pragma unroll
            for (int m = 0; m < 4; ++m) { const int r = row0 + ai * HALF + m * 16; const float sar = __shfl(p.rsv[ai], m * 16 + fr); bf16_t* rowp = O + (size_t)r * ldc + col0;
                f32x2 o[4];
#pragma unroll
                for (int n = 0; n < 2; ++n)
#pragma unroll
                    for (int jp = 0; jp < 2; ++jp) {
                        const f32x2 cg = {(float)acc[ai][0][m][n][2 * jp], (float)acc[ai][0][m][n][2 * jp + 1]}, cu = {(float)acc[ai][1][m][n][2 * jp], (float)acc[ai][1][m][n][2 * jp + 1]};
                        const f32x2 sgp = {sg[n][2 * jp], sg[n][2 * jp + 1]}, sup = {su[n][2 * jp], su[n][2 * jp + 1]};
                        const f32x2 g = cg * (sgp * sar), up = cu * (sup * sar);
                        const f32x2 t = g * -1.4426950408889634f;
                        const f32x2 d = (f32x2){__builtin_amdgcn_exp2f(t[0]), __builtin_amdgcn_exp2f(t[1])} + 1.0f;
                        const f32x2 rc = {__builtin_amdgcn_rcpf(d[0]), __builtin_amdgcn_rcpf(d[1])};
                        o[n * 2 + jp] = g * up * rc; }
                u32x4 w; w.x = cvt_pk_bf16(o[0][0], o[0][1]); w.y = cvt_pk_bf16(o[1][0], o[1][1]); w.z = cvt_pk_bf16(o[2][0], o[2][1]); w.w = cvt_pk_bf16(o[3][0], o[3][1]);
                *(u32x4*)rowp = w; }
    }
};
template <bool I8> struct MM;
template <> struct MM<false> { typedef f32x4 acc_t; static __device__ __forceinline__ acc_t zero() { return (f32x4){0.f, 0.f, 0.f, 0.f}; }
    static __device__ __forceinline__ acc_t mma(const bf16x8& b, const bf16x8& a, const acc_t& c) { return __builtin_amdgcn_mfma_f32_16x16x32_bf16(b, a, c, 0, 0, 0); } };
template <> struct MM<true> { typedef i32x4 acc_t; static __device__ __forceinline__ acc_t zero() { return (i32x4){0, 0, 0, 0}; }
    static __device__ __forceinline__ acc_t mma(const bf16x8& b, const bf16x8& a, const acc_t& c) { return __builtin_amdgcn_mfma_i32_16x16x64_i8(__builtin_bit_cast(i32x4, b), __builtin_bit_cast(i32x4, a), c, 0, 0, 0); } };
template <class Epi, class Sched, bool I8 = false, bool ALIGN_EPI = true, bool SP2 = true>
__device__ __forceinline__ void gemm_phase(LAS unsigned char* lds, const int Kb, const Sched& S, const Epi& E, const int Kloop = 0) {
    typedef typename MM<I8>::acc_t acc_t;
    const int tid = threadIdx.x, wid = __builtin_amdgcn_readfirstlane(tid >> 6), lane = tid & 63, wr = wid >> 2, wc = wid & 3, fr = lane & 15, fq = lane >> 4;
    const int nt = (Kloop ? Kloop : Kb) / 128;
    unsigned voffA[2], voffB[2];
#pragma unroll
    for (int i = 0; i < 2; ++i) { int R, C; stage_rc(tid * 16 + i * 8192, R, C); const int Rb = Epi::PERM ? ((R & ~31) + perm32(R & 31)) : R;
        voffA[i] = (unsigned)(R * Kb + C * 2); voffB[i] = (unsigned)(Rb * Kb + C * 2); }
    const size_t kstep = (size_t)(BK * 2);
    const size_t hstep = (size_t)HALF * Kb;
    const unsigned ldsw = (unsigned)wid * 1024u;
    const int aoff = lds_byte(wr * 64 + fr, fq * 8), boff = lds_byte(wc * 32 + fr, fq * 8);
#define PG8_SA(b, h) (((b) * 2 + (h)) * HTB)
#define PG8_SB(b, h) ((4 + (b) * 2 + (h)) * HTB)
#define PG8_STAGE(bufoff, gbase, voff) do { _Pragma("unroll") for (int _i = 0; _i < 2; ++_i) \
        __builtin_amdgcn_global_load_lds((const unsigned*)((const char*)(gbase) + (voff)[_i]), (LAS unsigned*)(lds + (bufoff) + ldsw + _i * 8192), 16, 0, 0); } while (0)
#define PG8_LDA(dst, b, h) do { _Pragma("unroll") for (int m = 0; m < 4; ++m) _Pragma("unroll") for (int k = 0; k < 2; ++k) dst[m][k] = *(const LAS bf16x8*)(lds + PG8_SA(b, h) + aoff + m * 2048 + k * 1024); } while (0)
#define PG8_LDB(dst, b, h) do { _Pragma("unroll") for (int n = 0; n < 2; ++n) _Pragma("unroll") for (int k = 0; k < 2; ++k) dst[n][k] = *(const LAS bf16x8*)(lds + PG8_SB(b, h) + boff + n * 2048 + k * 1024); } while (0)
#define PG8_MMA(ai, bj, At, Bt) do { __builtin_amdgcn_s_setprio(1); _Pragma("unroll") for (int m = 0; m < 4; ++m) _Pragma("unroll") for (int n = 0; n < 2; ++n) _Pragma("unroll") for (int k = 0; k < 2; ++k) \
        acc[ai][bj][m][n] = MM<I8>::mma(Bt[n][k], At[m][k], acc[ai][bj][m][n]); __builtin_amdgcn_s_setprio(0); } while (0)
#define PG8_WAIT_V(n) asm volatile("s_waitcnt vmcnt(" #n ")" ::: "memory")
#define PG8_WAIT_L(n) asm volatile("s_waitcnt lgkmcnt(" #n ")" ::: "memory")
#define PG8_BAR __builtin_amdgcn_s_barrier()
#define PG8_SCHED __builtin_amdgcn_sched_barrier(0)
    Unit cur, nxt; int ui = 0;
    if (!S.next(0, cur)) return;
    acc_t acc[2][2][4][2]; typename Epi::Pre pre;
#pragma unroll
    for (int a = 0; a < 2; ++a)
#pragma unroll
        for (int b = 0; b < 2; ++b)
#pragma unroll
            for (int m = 0; m < 4; ++m)
#pragma unroll
                for (int n = 0; n < 2; ++n) acc[a][b][m][n] = MM<I8>::zero();
    bf16x8 At[4][2], B0[2][2], B1[2][2];
    const char* cA = cur.a; const char* cB = cur.b;
    if constexpr (SP2) {
        PG8_STAGE(PG8_SB(0, 0), cB, voffB); PG8_STAGE(PG8_SB(0, 1), cB + hstep, voffB); PG8_STAGE(PG8_SA(0, 0), cA, voffA); PG8_STAGE(PG8_SA(0, 1), cA + hstep, voffA);
        if (wr == 1) PG8_BAR;
        PG8_WAIT_V(2); PG8_BAR;
        PG8_STAGE(PG8_SB(1, 0), cB + kstep, voffB); PG8_STAGE(PG8_SA(1, 0), cA + kstep, voffA); PG8_STAGE(PG8_SB(1, 1), cB + hstep + kstep, voffB);
        PG8_WAIT_V(6); PG8_BAR;
    } else {
        PG8_STAGE(PG8_SB(0, 0), cB, voffB); PG8_STAGE(PG8_SA(0, 0), cA, voffA); PG8_STAGE(PG8_SB(0, 1), cB + hstep, voffB); PG8_STAGE(PG8_SA(0, 1), cA + hstep, voffA);
        if (wr == 1) PG8_BAR;
        PG8_WAIT_V(4); PG8_BAR;
        PG8_STAGE(PG8_SB(1, 0), cB + kstep, voffB); PG8_STAGE(PG8_SA(1, 0), cA + kstep, voffA); PG8_STAGE(PG8_SB(1, 1), cB + hstep + kstep, voffB);
        PG8_WAIT_V(6); PG8_BAR;
    }
    for (;;) {
        const bool has_next = S.next(ui + 1, nxt);
        const char* nA = has_next ? nxt.a : cA; const char* nB = has_next ? nxt.b : cB;
        for (int t = 0; t < nt; t += 2) {
            const bool last = (t == nt - 2);
            if (last) E.prefetch(cur, wr, wc, fr, fq, pre);
            const char* a1 = cA + (size_t)(t + 1) * kstep;
            const char* a2 = last ? nA : cA + (size_t)(t + 2) * kstep; const char* b2 = last ? nB : cB + (size_t)(t + 2) * kstep;
            const char* a3 = a2 + kstep; const char* b3 = b2 + kstep;
            if constexpr (SP2) {
            PG8_LDB(B0, 0, 0); PG8_LDB(B1, 0, 1); PG8_SCHED; PG8_LDA(At, 0, 0); PG8_STAGE(PG8_SA(1, 1), a1 + hstep, voffA);
            PG8_WAIT_V(8); PG8_WAIT_L(0); PG8_BAR; PG8_MMA(0, 0, At, B0); PG8_MMA(0, 1, At, B1); PG8_BAR; PG8_SCHED;
            PG8_LDA(At, 0, 1); PG8_STAGE(PG8_SB(0, 0), b2, voffB); PG8_STAGE(PG8_SB(0, 1), b2 + hstep, voffB); PG8_STAGE(PG8_SA(0, 0), a2, voffA);
            PG8_WAIT_V(8); PG8_WAIT_L(0); PG8_BAR; PG8_MMA(1, 0, At, B0); PG8_MMA(1, 1, At, B1); PG8_BAR; PG8_SCHED;
            PG8_LDB(B0, 1, 0); PG8_LDB(B1, 1, 1); PG8_SCHED; PG8_LDA(At, 1, 0); PG8_STAGE(PG8_SA(0, 1), a2 + hstep, voffA);
            PG8_WAIT_V(8); PG8_WAIT_L(0); PG8_BAR; PG8_MMA(0, 0, At, B0); PG8_MMA(0, 1, At, B1); PG8_BAR; PG8_SCHED;
            PG8_LDA(At, 1, 1); PG8_STAGE(PG8_SB(1, 0), b3, voffB); PG8_STAGE(PG8_SB(1, 1), b3 + hstep, voffB); PG8_STAGE(PG8_SA(1, 0), a3, voffA);
            PG8_WAIT_V(8); PG8_WAIT_L(0); PG8_BAR; PG8_MMA(1, 0, At, B0); PG8_MMA(1, 1, At, B1); PG8_BAR; PG8_SCHED;
            } else {
            PG8_LDB(B0, 0, 0); PG8_SCHED; PG8_LDA(At, 0, 0); PG8_STAGE(PG8_SA(1, 1), a1 + hstep, voffA);
            PG8_WAIT_L(8); PG8_BAR; PG8_WAIT_L(0); PG8_MMA(0, 0, At, B0); PG8_BAR; PG8_SCHED;
            PG8_LDB(B1, 0, 1); PG8_STAGE(PG8_SB(0, 0), b2, voffB);
            PG8_BAR; PG8_WAIT_L(0); PG8_MMA(0, 1, At, B1); PG8_BAR;
            PG8_LDA(At, 0, 1); PG8_STAGE(PG8_SA(0, 0), a2, voffA);
            PG8_BAR; PG8_WAIT_L(0); PG8_MMA(1, 0, At, B0); PG8_BAR; PG8_SCHED;
            PG8_STAGE(PG8_SB(0, 1), b2 + hstep, voffB);
            PG8_WAIT_V(6); PG8_BAR; PG8_MMA(1, 1, At, B1); PG8_BAR;
            PG8_LDB(B0, 1, 0); PG8_SCHED; PG8_LDA(At, 1, 0); PG8_STAGE(PG8_SA(0, 1), a2 + hstep, voffA);
            PG8_WAIT_L(8); PG8_BAR; PG8_WAIT_L(0); PG8_MMA(0, 0, At, B0); PG8_BAR; PG8_SCHED;
            PG8_LDB(B1, 1, 1); PG8_STAGE(PG8_SB(1, 0), b3, voffB);
            PG8_BAR; PG8_WAIT_L(0); PG8_MMA(0, 1, At, B1); PG8_BAR;
            PG8_LDA(At, 1, 1); PG8_STAGE(PG8_SA(1, 0), a3, voffA);
            PG8_BAR; PG8_WAIT_L(0); PG8_MMA(1, 0, At, B0); PG8_BAR; PG8_SCHED;
            PG8_STAGE(PG8_SB(1, 1), b3 + hstep, voffB);
            PG8_WAIT_V(6); PG8_BAR; PG8_MMA(1, 1, At, B1); PG8_BAR;
            }
        }
        if constexpr (ALIGN_EPI) { if (wr == 0) PG8_BAR; }
        E(acc, cur, wr, wc, fr, fq, pre);
        if constexpr ((REPMASK >> 28) & 1u) E(acc, cur, wr, wc, fr, fq, pre);
        if (!has_next) break;
#pragma unroll
        for (int a = 0; a < 2; ++a)
#pragma unroll
            for (int b = 0; b < 2; ++b)
#pragma unroll
                for (int m = 0; m < 4; ++m)
#pragma unroll
                    for (int n = 0; n < 2; ++n) acc[a][b][m][n] = MM<I8>::zero();
        cur = nxt; cA = nA; cB = nB; ++ui;
        if constexpr (ALIGN_EPI) { if (wr == 1) PG8_BAR; }
    }
    PG8_WAIT_V(0);
    if constexpr (!ALIGN_EPI) { if (wr == 0) PG8_BAR; }
    PG8_BAR;
#undef PG8_SA
#undef PG8_SB
#undef PG8_STAGE
#undef PG8_LDA
#undef PG8_LDB
#undef PG8_MMA
#undef PG8_WAIT_V
#undef PG8_WAIT_L
#undef PG8_BAR
#undef PG8_SCHED
}
}

struct Args { const float* in[49]; float* out; unsigned char* ws; int ph_lo, ph_hi; };
enum { I_X = 0, I_C, I_CTX, I_CCTX, I_LBL, I_ADAW0, I_ADAB0, I_NMIXPRE0, I_NMIXPOST0, I_NFFNPRE0, I_NFFNPOST0, I_WIN0, I_WOUT0, I_SINK, I_HNORM, I_FG0, I_FU0, I_FD0,
       I_ADAW1, I_ADAB1, I_NMIXPRE1, I_NMIXPOST1, I_NFFNPRE1, I_NFFNPOST1, I_WIN1, I_WOUT1, I_GUPF, I_GUPB, I_GBIASF, I_GBIASB, I_GLANORM, I_MUPREV, I_MUNEXT, I_W0F, I_W0B, I_W2F, I_W2B,
       I_A0, I_A2, I_G2, I_KK, I_KA, I_RK, I_LNW, I_LNB, I_ROUTER, I_MG, I_MU, I_MD };

__device__ __forceinline__ void tr_item(const float* W, int K, int ld, int ncol0, bf16_t* WT, int drow0, int mode, int nblk, LAS float* scr, int item, int lane) {
    const int kb = item / nblk, nb = item - kb * nblk, k0 = 64 * kb, n0 = ncol0 + 32 * nb;
    int drow; if (mode == 0) drow = drow0 + 32 * nb; else { const int cc = 32 * nb; drow = (cc >> 7) * 256 + (cc & 127) + (mode == 2 ? 128 : 0); }
#pragma unroll 8
    for (int i = 0; i < 32; ++i) { const int kk = 2 * i + (lane >> 5); scr[kk * 33 + (lane & 31)] = __builtin_nontemporal_load(W + (size_t)(k0 + kk) * ld + n0 + (lane & 31)); }
    LDS_WAIT();
    const int c = lane & 7;
#pragma unroll
    for (int j = 0; j < 4; ++j) { const int n = (lane >> 3) + 8 * j; const LAS float* s = scr + (8 * c) * 33 + n;
        u32x4 o; o.x = pk2(s[0 * 33], s[1 * 33]); o.y = pk2(s[2 * 33], s[3 * 33]); o.z = pk2(s[4 * 33], s[5 * 33]); o.w = pk2(s[6 * 33], s[7 * 33]);
        *(u32x4*)(WT + (size_t)(drow + n) * K + k0 + 8 * c) = o; }
    LDS_WAIT();
}

constexpr int Q8_PITCH = 4100;
__device__ __forceinline__ void q8_strip(const float* W, int ld, int ncol0, signed char* dst, float* sdst, int drow0, LAS unsigned char* lds, int tid) {
    LAS unsigned* cmax = (LAS unsigned*)(lds + 32 * Q8_PITCH);
    const int lane = tid & 63, wave = tid >> 6;
    __syncthreads();
    if (tid < 32) cmax[tid] = 0u;
    __syncthreads();
    const int n4 = tid & 7, kr = tid >> 3;
    float mx[4] = {0.f, 0.f, 0.f, 0.f};
#pragma unroll 4
    for (int it = 0; it < 32; ++it) { const int k = it * 64 + kr; const f32x4 v = __builtin_nontemporal_load((const f32x4*)(W + (size_t)k * ld + ncol0 + 4 * n4));
#pragma unroll
        for (int e = 0; e < 4; ++e) { mx[e] = fmaxf(mx[e], fabsf(v[e])); *(LAS bf16_t*)(lds + (4 * n4 + e) * Q8_PITCH + k * 2) = (bf16_t)f2bf(v[e]); } }
#pragma unroll
    for (int e = 0; e < 4; ++e) __hip_atomic_fetch_max(cmax + 4 * n4 + e, __float_as_uint(mx[e]), __ATOMIC_RELAXED, __HIP_MEMORY_SCOPE_WORKGROUP);
    __syncthreads();
#pragma unroll 1
    for (int q = 0; q < 4; ++q) {
        const int n = 4 * wave + q; const float m = __uint_as_float(cmax[n]); const float inv = m > 0.f ? 127.0f / m : 0.f;
        const LAS unsigned* src = (const LAS unsigned*)(lds + n * Q8_PITCH + lane * 64);
        u32x4 o0, o1;
#pragma unroll
        for (int d = 0; d < 8; ++d) { const unsigned w0 = src[2 * d], w1 = src[2 * d + 1];
            const int q0 = (int)__builtin_rintf(bflo(w0) * inv), q1 = (int)__builtin_rintf(bfhi(w0) * inv), q2 = (int)__builtin_rintf(bflo(w1) * inv), q3 = (int)__builtin_rintf(bfhi(w1) * inv);
            const unsigned pk = (unsigned)(q0 & 0xff) | ((unsigned)(q1 & 0xff) << 8) | ((unsigned)(q2 & 0xff) << 16) | ((unsigned)(q3 & 0xff) << 24);
            if (d < 4) o0[d] = pk; else o1[d - 4] = pk; }
        u32x4* dp = (u32x4*)(dst + (size_t)(drow0 + n) * 2048 + 32 * lane);
        dp[0] = o0; dp[1] = o1;
        if (lane == 0) sdst[drow0 + n] = m > 0.f ? m * (1.0f / 127.0f) : 1.0f;
    }
}

__device__ __forceinline__ void p0_prologue(const Args& a, LAS unsigned char* lds, int tid, int lane, int wave) {
    unsigned char* ws = a.ws;
    const int G = gridDim.x, bx = blockIdx.x;
    {
        LAS float* sc = (LAS float*)lds;
        LAS float* red = (LAS float*)(lds + 16384);
        for (int i = tid; i < 2 * D; i += NTHR) { const float v = (i < D) ? a.in[I_C][i] : a.in[I_CCTX][i - D]; sc[i] = siluf_(v); }
        __syncthreads();
        float* mod = (float*)(ws + WS_MOD);
        for (int it = bx; it < 384; it += G) {
            const int l = it / 192, cg = it % 192; const float* W = a.in[l ? I_ADAW1 : I_ADAW0]; const float* B = a.in[l ? I_ADAB1 : I_ADAB0];
            const int col = cg * 64 + lane; float a0 = 0.f, a1 = 0.f;
            const float* wp = W + (size_t)(wave * 256) * 12288 + col;
#pragma unroll 8
            for (int k = 0; k < 256; ++k) { const float w = __builtin_nontemporal_load(wp + (size_t)k * 12288); a0 = fmaf(sc[wave * 256 + k], w, a0); a1 = fmaf(sc[D + wave * 256 + k], w, a1); }
            red[(wave * 2 + 0) * 64 + lane] = a0; red[(wave * 2 + 1) * 64 + lane] = a1;
            __syncthreads();
            if (wave < 2) { float s = 0.f;
#pragma unroll
                for (int w = 0; w < 8; ++w) s += red[(w * 2 + wave) * 64 + lane];
                mod[(size_t)(l * 2 + wave) * 12288 + col] = s + B[col]; }
            __syncthreads();
        }
    }
    {
        float* tab = (float*)(ws + WS_ROPE);
        const int gi = bx * NTHR + tid;
        if (gi < 320 * 32) { const int pos = gi >> 5, f = gi & 31; const int p = pos < 256 ? pos : pos - 256;
            const float inv = exp2f(-(float)f * (13.287712379549449f / 32.0f));
            const float ang = (float)p * inv; float sn, cs; sincosf(ang, &sn, &cs);
            tab[2 * gi] = cs; tab[2 * gi + 1] = sn; }
    }
    {
        bf16_t* wt = (bf16_t*)(ws + WS_LORA4);
        { float* lb = (float*)(ws + WS_LB); const int e = bx * NTHR + tid; if (e < 3072) lb[e] = e < 1024 ? a.in[I_W0F][e] : (e < 2048 ? a.in[I_W0B][e - 1024] : a.in[I_A0][e - 2048]); }
        for (int e = bx * NTHR + tid; e < 4 * 256 * 1024; e += G * NTHR) {
            const int m = e >> 18, kk = (e >> 10) & 255, n = e & 1023; float v = 0.f;
            if (m == 3) v = a.in[I_G2][kk * 1024 + n];
            else if (kk < 96) v = a.in[m == 0 ? I_W2F : (m == 1 ? I_W2B : I_A2)][kk * 1024 + n];
            wt[((size_t)m * 1024 + n) * 256 + kk] = (bf16_t)f2bf(v);
        }
    }
    {
        LAS float* scr = (LAS float*)(lds + wave * 16384);
        const int gw = bx * NWAVES + wave, NGW = G * NWAVES;
        constexpr int S3 = 32 * 64, S6 = 88 * 64, S8 = 32 * 64, SD = 112 * 64;
        constexpr int NIT = S3 + S6 + S8 + 8 * SD;
        for (int it = gw; it < NIT; it += NGW) {
            int r = it;
            if (r < S3) { tr_item(a.in[I_WOUT0], 2048, 2048, 0, (bf16_t*)(ws + W_OUT0T), 0, 0, 64, scr, r, lane); continue; } r -= S3;
            if (r < S6) { tr_item(a.in[I_FD0], 5632, 2048, 0, (bf16_t*)(ws + W_DN0T), 0, 0, 64, scr, r, lane); continue; } r -= S6;
            if (r < S8) { tr_item(a.in[I_WOUT1], 2048, 2048, 0, (bf16_t*)(ws + W_OUT1T), 0, 0, 64, scr, r, lane); continue; } r -= S8;
            { const int e = r / SD; tr_item(a.in[I_MD] + (size_t)e * 7168 * 2048, 7168, 2048, 0, (bf16_t*)(ws + W_MDNT) + (size_t)e * 2048 * 7168, 0, 0, 64, scr, r - e * SD, lane); }
        }
    }
    {
        constexpr int NS0 = 176, NSE = 224, NI0 = 208, NI1 = 210, NITEM = 2 * NS0 + 16 * NSE + NI0 + NI1;
        for (int it = bx; it < NITEM; it += G) {
            int r = it; const float* W; int ld, cc, up; signed char* dst; float* sd;
            if (r >= 2 * NS0 + 16 * NSE) {
                r -= 2 * NS0 + 16 * NSE; int drow;
                if (r < NI0) { cc = 32 * r; W = a.in[I_WIN0]; ld = 6656;
                    if (cc < 1280) { dst = (signed char*)(ws + W_IN0T); sd = (float*)(ws + WS_QI0); drow = cc; }
                    else if (cc < 1536) { dst = (signed char*)(ws + W_V0T); sd = (float*)(ws + WS_QV0); drow = cc - 1280; }
                    else if (cc < 2560) { dst = (signed char*)(ws + W_IN0T); sd = (float*)(ws + WS_QI0); drow = cc - 1536 + 1280; }
                    else if (cc < 3584) { dst = (signed char*)(ws + W_V0T); sd = (float*)(ws + WS_QV0); drow = cc - 2560 + 256; }
                    else { dst = (signed char*)(ws + W_IN0T); sd = (float*)(ws + WS_QI0); drow = cc - 3584 + 2304; } }
                else { cc = 32 * (r - NI0); W = a.in[I_WIN1]; ld = 6720;
                    if (cc < 1024) { dst = (signed char*)(ws + W_IN1T); sd = (float*)(ws + WS_QI1); drow = cc; }
                    else if (cc < 2048) { dst = (signed char*)(ws + W_GV1T); sd = (float*)(ws + WS_QG1); drow = cc - 1024; }
                    else { dst = (signed char*)(ws + W_IN1T); sd = (float*)(ws + WS_QI1); drow = cc - 2048 + 1024; } }
                q8_strip(W, ld, cc, dst, sd, drow, lds, tid);
                continue;
            }
            if (r < 2 * NS0) { up = r / NS0; cc = 32 * (r - up * NS0); W = a.in[up ? I_FU0 : I_FG0]; ld = 5632; dst = (signed char*)(ws + W_GU0T); sd = (float*)(ws + WS_QS0); }
            else { r -= 2 * NS0; const int e = r / (2 * NSE); r -= e * 2 * NSE; up = r / NSE; cc = 32 * (r - up * NSE); W = a.in[up ? I_MU : I_MG] + (size_t)e * 2048 * 7168; ld = 7168;
                   dst = (signed char*)(ws + W_MGUT) + (size_t)e * 14336 * 2048; sd = (float*)(ws + WS_QSM) + (size_t)e * 14336; }
            q8_strip(W, ld, cc, dst, sd, (cc >> 7) * 256 + (cc & 127) + (up ? 128 : 0), lds, tid);
        }
    }
}

__device__ __forceinline__ f32x4 ldp(const float* p, int lane, int j) { return *(const f32x4*)(p + 4 * lane + 256 * j); }
__device__ __forceinline__ void ldrow(const float* p, int lane, f32x4 (&v)[8]) {
#pragma unroll
    for (int j = 0; j < 8; ++j) v[j] = ldp(p, lane, j);
}
__device__ __forceinline__ void ldrow_bf(const bf16_t* p, int lane, f32x4 (&v)[8]) {
#pragma unroll
    for (int j = 0; j < 8; ++j) { const u32x2 y = *(const u32x2*)(p + 4 * lane + 256 * j); v[j] = (f32x4){bflo(y.x), bfhi(y.x), bflo(y.y), bfhi(y.y)}; }
}
__device__ __forceinline__ float rms_scale(const f32x4 (&v)[8]) {
    float s = 0.f;
#pragma unroll
    for (int j = 0; j < 8; ++j) s += (v[j][0] * v[j][0] + v[j][1] * v[j][1]) + (v[j][2] * v[j][2] + v[j][3] * v[j][3]);
    return __builtin_amdgcn_rsqf(wave_sum(s) * (1.0f / D) + NORM_EPS);
}
__device__ __forceinline__ void mod_store(f32x4 (&v)[8], const float* gpre, const float* sc, const float* sh, bf16_t* hrow, int lane) {
    const float rs = rms_scale(v);
#pragma unroll
    for (int j = 0; j < 8; ++j) { const f32x4 g = ldp(gpre, lane, j), s = ldp(sc, lane, j), b = ldp(sh, lane, j);
        v[j] = v[j] * rs * g * (s + 1.0f) + b;
        u32x2 w; w.x = pk2(v[j][0], v[j][1]); w.y = pk2(v[j][2], v[j][3]); *(u32x2*)(hrow + 4 * lane + 256 * j) = w; }
}
__device__ __forceinline__ void mod_store_i8(f32x4 (&v)[8], const float* gpre, const float* sc, const float* sh, signed char* hrow, float* scale_out, int lane) {
    const float rs = rms_scale(v); float mx = 0.f;
#pragma unroll
    for (int j = 0; j < 8; ++j) { const f32x4 g = ldp(gpre, lane, j), s = ldp(sc, lane, j), b = ldp(sh, lane, j);
        v[j] = v[j] * rs * g * (s + 1.0f) + b;
        mx = fmaxf(fmaxf(mx, fmaxf(fabsf(v[j][0]), fabsf(v[j][1]))), fmaxf(fabsf(v[j][2]), fabsf(v[j][3]))); }
#pragma unroll
    for (int o = 1; o < 64; o <<= 1) mx = fmaxf(mx, __shfl_xor(mx, o));
    const float inv = mx > 0.f ? 127.0f / mx : 0.f;
#pragma unroll
    for (int j = 0; j < 8; ++j) { const int q0 = (int)__builtin_rintf(v[j][0] * inv), q1 = (int)__builtin_rintf(v[j][1] * inv), q2 = (int)__builtin_rintf(v[j][2] * inv), q3 = (int)__builtin_rintf(v[j][3] * inv);
        *(unsigned*)(hrow + 4 * lane + 256 * j) = (unsigned)(q0 & 0xff) | ((unsigned)(q1 & 0xff) << 8) | ((unsigned)(q2 & 0xff) << 16) | ((unsigned)(q3 & 0xff) << 24); }
    if (lane == 0) *scale_out = mx > 0.f ? mx * (1.0f / 127.0f) : 1.0f;
}
__device__ __forceinline__ void add_branch(f32x4 (&v)[8], const f32x4 (&b)[8], const float* gpost, const float* gate, int lane) {
    const float rs = rms_scale(b);
#pragma unroll
    for (int j = 0; j < 8; ++j) { const f32x4 g = ldp(gpost, lane, j), gt = ldp(gate, lane, j); v[j] = v[j] + gt * (b[j] * rs * g); }
}
__device__ __forceinline__ void strow_bf(bf16_t* p, int lane, const f32x4 (&v)[8]) {
#pragma unroll
    for (int j = 0; j < 8; ++j) { u32x2 w; w.x = pk2(v[j][0], v[j][1]); w.y = pk2(v[j][2], v[j][3]); *(u32x2*)(p + 4 * lane + 256 * j) = w; }
}
__device__ __forceinline__ void strow(float* p, int lane, const f32x4 (&v)[8]) {
#pragma unroll
    for (int j = 0; j < 8; ++j) *(f32x4*)(p + 4 * lane + 256 * j) = v[j];
}

constexpr int KST = 272, VST = 136, ATT_V_OFF = 64 * KST;
__device__ __forceinline__ void attn_unit(LAS unsigned char* lds, const bf16_t* proj0, const bf16_t* vT, bf16_t* mix, const float* sinks, const float* ropetab,
                                          int kind, int qb, int g, int tid) {
    const int wave = tid >> 6, lane = tid & 63, c = lane & 31, hh = lane >> 5;
    const int head = g * 4 + (wave >> 1), sub = (wave & 1) * 32;
    const int qrow = (kind == 0 ? CTXL + qb * 64 : qb * 64) + sub + c;
    const float qscale = 0.08838834764831845f * 1.4426950408889634f;
    const float* rowtab = ropetab; const float* coltab = ropetab + 256 * 64;
    bf16x8 qf[8];
    {
        const bf16_t* qp = proj0 + (size_t)qrow * N0 + P0_QA + head * 128;
        const int tl = qrow - CTXL;
#pragma unroll
        for (int ax = 0; ax < 2; ++ax)
#pragma unroll
            for (int sp = 0; sp < 2; ++sp) {
                const int d1 = ax * 64 + sp * 16 + hh * 8;
                const u32x4 c1 = *(const u32x4*)(qp + d1), c2 = *(const u32x4*)(qp + d1 + 32);
                float x1[8], x2[8];
#pragma unroll
                for (int e = 0; e < 4; ++e) { x1[2 * e] = bflo(c1[e]); x1[2 * e + 1] = bfhi(c1[e]); x2[2 * e] = bflo(c2[e]); x2[2 * e + 1] = bfhi(c2[e]); }
                if (kind == 0) {
                    const int pos = ax == 0 ? (tl >> 6) : (tl & 63);
                    const float* tb = (ax == 0 ? rowtab : coltab) + (pos * 32 + sp * 16 + hh * 8) * 2;
#pragma unroll
                    for (int e = 0; e < 8; ++e) { const float cs = tb[2 * e], sn = tb[2 * e + 1]; const float o1 = x1[e] * cs - x2[e] * sn, o2 = x1[e] * sn + x2[e] * cs; x1[e] = o1; x2[e] = o2; }
                }
                u32x4 w1, w2;
#pragma unroll
                for (int e = 0; e < 4; ++e) { w1[e] = pk2(x1[2 * e] * qscale, x1[2 * e + 1] * qscale); w2[e] = pk2(x2[2 * e] * qscale, x2[2 * e + 1] * qscale); }
                qf[ax * 4 + sp] = __builtin_bit_cast(bf16x8, w1); qf[ax * 4 + sp + 2] = __builtin_bit_cast(bf16x8, w2);
            }
    }
    float m = sinks[head] * 1.4426950408889634f, lsum = (hh == 0) ? 1.0f : 0.0f;
    f32x16 o[4];
#pragma unroll
    for (int i = 0; i < 4; ++i)
#pragma unroll
        for (int r = 0; r < 16; ++r) o[i][r] = 0.f;
    const int ntile = (kind == 0) ? 9 : 4;
    for (int ti = 0; ti < ntile; ++ti) {
        int krow0, mode = 0; bool rope = false;
        if (ti < 4) krow0 = 64 * ti;
        else { const int j = ti - 6; const int tl0 = qb * 64 + 64 * j; if (tl0 < 0 || tl0 >= SEQ) continue; krow0 = CTXL + tl0; rope = true; mode = (j == -2) ? 1 : (j == 2 ? 2 : 0); }
        __syncthreads();
        {
            const int key = tid >> 3, p = tid & 7, ax = p >> 2, fc = p & 3; const int krow = krow0 + key;
            const bf16_t* kp = proj0 + (size_t)krow * N0 + P0_KA + g * 128 + ax * 64 + fc * 8;
            u32x4 c1 = *(const u32x4*)kp, c2 = *(const u32x4*)(kp + 32);
            if (rope) {
                const int tl = krow - CTXL; const int pos = ax == 0 ? (tl >> 6) : (tl & 63);
                const float* tb = (ax == 0 ? rowtab : coltab) + (pos * 32 + fc * 8) * 2;
                float x1[8], x2[8];
#pragma unroll
                for (int e = 0; e < 4; ++e) { x1[2 * e] = bflo(c1[e]); x1[2 * e + 1] = bfhi(c1[e]); x2[2 * e] = bflo(c2[e]); x2[2 * e + 1] = bfhi(c2[e]); }
#pragma unroll
                for (int e = 0; e < 8; ++e) { const float cs = tb[2 * e], sn = tb[2 * e + 1]; const float o1 = x1[e] * cs - x2[e] * sn, o2 = x1[e] * sn + x2[e] * cs; x1[e] = o1; x2[e] = o2; }
#pragma unroll
                for (int e = 0; e < 4; ++e) { c1[e] = pk2(x1[2 * e], x1[2 * e + 1]); c2[e] = pk2(x2[2 * e], x2[2 * e + 1]); }
            }
            *(LAS u32x4*)(lds + key * KST + (ax * 64 + fc * 8) * 2) = c1;
            *(LAS u32x4*)(lds + key * KST + (ax * 64 + fc * 8 + 32) * 2) = c2;
        }
#pragma unroll
        for (int i = 0; i < 2; ++i) {
            const int idx = tid + NTHR * i, d = idx >> 3, ch = idx & 7;
            const u32x4 v = *(const u32x4*)(vT + (size_t)(g * 128 + d) * T + krow0 + ch * 8);
            LAS u32x2* dst = (LAS u32x2*)(lds + ATT_V_OFF + d * VST + ch * 16);
            dst[0] = (u32x2){v.x, v.y}; dst[1] = (u32x2){v.z, v.w};
        }
        __syncthreads();
        f32x16 p0, p1;
#pragma unroll
        for (int r = 0; r < 16; ++r) { p0[r] = 0.f; p1[r] = 0.f; }
#pragma unroll
        for (int s = 0; s < 8; ++s) {
            const bf16x8 k0 = *(const LAS bf16x8*)(lds + c * KST + (16 * s + 8 * hh) * 2);
            const bf16x8 k1 = *(const LAS bf16x8*)(lds + (32 + c) * KST + (16 * s + 8 * hh) * 2);
            p0 = __builtin_amdgcn_mfma_f32_32x32x16_bf16(k0, qf[s], p0, 0, 0, 0);
            p1 = __builtin_amdgcn_mfma_f32_32x32x16_bf16(k1, qf[s], p1, 0, 0, 0);
        }
        if (mode != 0) {
            const int ii = sub + c;
#pragma unroll
            for (int r = 0; r < 16; ++r) { const int k0i = (r & 3) + 8 * (r >> 2) + 4 * hh, k1i = k0i + 32;
                const bool bad0 = (mode == 1) ? (k0i < ii) : (k0i > ii), bad1 = (mode == 1) ? (k1i < ii) : (k1i > ii);
                if (bad0) p0[r] = -INFINITY; if (bad1) p1[r] = -INFINITY; }
        }
        float mx = p0[0];
#pragma unroll
        for (int r = 0; r < 16; ++r) { mx = fmaxf(mx, p0[r]); mx = fmaxf(mx, p1[r]); }
        mx = fmaxf(mx, __shfl_xor(mx, 32));
        const float mnew = fmaxf(m, mx), alpha = fexp2(m - mnew); m = mnew;
        p0 = p0 - mnew; p1 = p1 - mnew;
#pragma unroll
        for (int r = 0; r < 16; ++r) { p0[r] = fexp2(p0[r]); p1[r] = fexp2(p1[r]); }
        const f32x16 psum = p0 + p1; float rs = 0.f;
#pragma unroll
        for (int r = 0; r < 16; ++r) rs += psum[r];
        lsum = lsum * alpha + rs;
#pragma unroll
        for (int i = 0; i < 4; ++i)
#pragma unroll
            for (int r = 0; r < 16; ++r) o[i][r] *= alpha;
        bf16x8 pf[2][2];
#pragma unroll
        for (int s2 = 0; s2 < 2; ++s2) {
            u32x4 w0, w1;
#pragma unroll
            for (int e = 0; e < 4; ++e) { w0[e] = pk2(p0[8 * s2 + 2 * e], p0[8 * s2 + 2 * e + 1]); w1[e] = pk2(p1[8 * s2 + 2 * e], p1[8 * s2 + 2 * e + 1]); }
            pf[0][s2] = __builtin_bit_cast(bf16x8, w0); pf[1][s2] = __builtin_bit_cast(bf16x8, w1);
        }
#pragma unroll
        for (int dt = 0; dt < 4; ++dt)
#pragma unroll
            for (int kt = 0; kt < 2; ++kt)
#pragma unroll
                for (int s2 = 0; s2 < 2; ++s2) {
                    const LAS unsigned char* vp = lds + ATT_V_OFF + (32 * dt + c) * VST + (32 * kt + 16 * s2 + 4 * hh) * 2;
                    const u32x2 lo = *(const LAS u32x2*)vp, hi = *(const LAS u32x2*)(vp + 16);
                    const u32x4 vv = (u32x4){lo.x, lo.y, hi.x, hi.y};
                    o[dt] = __builtin_amdgcn_mfma_f32_32x32x16_bf16(__builtin_bit_cast(bf16x8, vv), pf[kt][s2], o[dt], 0, 0, 0);
                }
    }
    const float ltot = lsum + __shfl_xor(lsum, 32), inv = 1.0f / ltot;
    bf16_t* op = mix + (size_t)qrow * D + head * 128;
#pragma unroll
    for (int dt = 0; dt < 4; ++dt)
#pragma unroll
        for (int gq = 0; gq < 4; ++gq) {
            u32x2 w; w.x = pk2(o[dt][4 * gq] * inv, o[dt][4 * gq + 1] * inv); w.y = pk2(o[dt][4 * gq + 2] * inv, o[dt][4 * gq + 3] * inv);
            *(u32x2*)(op + 32 * dt + 8 * gq + 4 * hh) = w;
        }
}

__device__ __forceinline__ int row_of(int dir, int n) { return dir == 0 ? n : (n < CTXL ? CTXL - 1 - n : T + CTXL - 1 - n); }

__device__ __forceinline__ float logsigf_(float x) { return fminf(x, 0.f) - __logf(1.0f + fexp(-fabsf(x))); }


template <int MIX> struct GL { static constexpr int NH = MIX ? 4 : 8, V = MIX ? 256 : 128, NVT = V / 32; };
constexpr int GL_KT_STRIDE = 80;
constexpr int GL_QK_STRIDE = 272;
constexpr int GL_RAW_OFF = 70 * 1024;
constexpr int GL_GD_OFF = 120 * 1024;
constexpr int GL_RED_OFF = 130 * 1024;
static_assert(GL_RED_OFF + 1024 <= MISC_OFF, "GL LDS map");
struct GLArgs { const bf16_t* proj; const bf16_t* vT; bf16_t* kvt; float* dec; bf16_t* mix; const float* lbl; const float* upf; const float* upb; const float* biasf; const float* biasb; const float* gain; };

template <int MIX> __device__ __forceinline__ int gl_scan_chunk(int dir, int step) { return dir == 0 ? step : (step < 8 ? 7 - step : NCHUNK + 7 - step); }

template <int MIX, bool NEEDQ>
__device__ __forceinline__ void gl_stage_raw(const GLArgs& g, LAS unsigned char* lds, int R0, int head, int tid) {
    constexpr int NT = MIX == 0 ? (NEEDQ ? 3 : 2) : (NEEDQ ? 2 : 1);
#pragma unroll
    for (int i = 0; i < 2 * NT; ++i) {
        const int idx = tid + NTHR * i, tile = idx >> 10, rem = idx & 1023, row = rem >> 4, ch = rem & 15;
        int col, slot;
        if constexpr (MIX == 0) { slot = tile; col = (tile == 0 ? P0_FF : (tile == 1 ? P0_FB : P0_QH)) + head * 128 + ch * 8; }
        else { slot = tile == 0 ? 0 : 2; col = (tile == 0 ? G_K : G_Q) + head * 128 + ch * 8; }
        const u32x4 v = *(const u32x4*)(g.proj + (size_t)(R0 + row) * (MIX ? N1 : N0) + col);
        *(LAS u32x4*)(lds + GL_RAW_OFF + slot * 16384 + row * 256 + ch * 16) = v;
    }
}
template <int MIX, bool NEEDQ>
__device__ __forceinline__ void gl_load(const LAS unsigned char* lds, int rloc, int k, int dir, unsigned short& x0, unsigned short& x1) {
    x1 = 0;
    x0 = *(const LAS bf16_t*)(lds + GL_RAW_OFF + (MIX == 0 ? dir : 0) * 16384 + rloc * 256 + k * 2);
    if (NEEDQ) x1 = *(const LAS bf16_t*)(lds + GL_RAW_OFF + 2 * 16384 + rloc * 256 + k * 2);
}
template <int MIX, bool NEEDQ>
__device__ __forceinline__ void gl_comp(unsigned short x0, unsigned short x1, float lbk, const float (&up)[16], float bias, const LAS float* gdrow, float& d, float& kv, float& q) {
    if constexpr (MIX == 0) {
        const float f = lbk + (1.0f - lbk) * sigmoidf_(bf2f(x0));
        d = f; kv = 1.0f - f; if (NEEDQ) q = siluf_(bf2f(x1));
    } else {
        f32x2 xa = {bias, 0.f};
#pragma unroll
        for (int q4 = 0; q4 < 4; ++q4) { const f32x4 gd = *(const LAS f32x4*)(gdrow + 4 * q4);
            xa = __builtin_elementwise_fma((f32x2){gd[0], gd[1]}, (f32x2){up[4 * q4], up[4 * q4 + 1]}, xa);
            xa = __builtin_elementwise_fma((f32x2){gd[2], gd[3]}, (f32x2){up[4 * q4 + 2], up[4 * q4 + 3]}, xa); }
        const float x = xa[0] + xa[1];
        d = fexp(logsigf_(x) * 0.0625f); kv = bf2f(x0); if (NEEDQ) q = bf2f(x1) * 0.08838834764831845f;
    }
}
template <int MIX>
__device__ __forceinline__ void gl_stage_gd(const GLArgs& g, LAS unsigned char* lds, int R0, int tid) {
    if constexpr (MIX == 1) {
        LAS float* gds = (LAS float*)(lds + GL_GD_OFF);
        for (int idx = tid; idx < 2048; idx += NTHR) { const int row = idx >> 5, dj = idx & 31, dir = dj >> 4, j = dj & 15;
            gds[(dir * 64 + row) * 16 + j] = bf2f(g.proj[(size_t)(R0 + row) * N1 + (dir ? G_GDB : G_GDF) + j]); }
    }
}
template <int MIX>
__device__ __forceinline__ void gl_walker_consts(const GLArgs& g, int head, int k, int dir, float& lbk, float (&up)[16], float& bias) {
    lbk = 0.f; bias = 0.f;
#pragma unroll
    for (int j = 0; j < 16; ++j) up[j] = 0.f;
    if constexpr (MIX == 0) { const int kk = head * 128 + k; lbk = 1.0f / (1.0f + fexp(g.lbl[1024 + kk] - g.lbl[kk])); }
    else { const float* upp = dir ? g.upb : g.upf; const int ch = head * 128 + k;
#pragma unroll
        for (int j = 0; j < 16; ++j) up[j] = upp[j * 512 + ch];
        bias = (dir ? g.biasb : g.biasf)[ch]; }
}

template <int MIX>
__device__ __forceinline__ void gl_phaseA(const GLArgs& g, LAS unsigned char* lds, int tid, int bid, int nblk) {
    constexpr int NH = GL<MIX>::NH, V = GL<MIX>::V, NVT = GL<MIX>::NVT;
    const int lane = tid & 63, wave = tid >> 6, c = lane & 31, hh = lane >> 5;
    const int wk = tid & 127, wc2 = (tid >> 7) & 1, wdir = tid >> 8;
    const int dir = wave >> 2, c2 = (wave >> 1) & 1, kh = wave & 1;
    for (int item = bid; item < NH * (T / 64); item += nblk) {
        const int head = item % NH, nb = item / NH, R0 = nb * 64;
        __syncthreads();
        gl_stage_gd<MIX>(g, lds, R0, tid); gl_stage_raw<MIX, false>(g, lds, R0, head, tid);
        const int rbase = R0 + 32 * c2, cr = (R0 >> 5) + c2;
        const bf16_t* vsrc = g.vT + (size_t)((MIX ? 0 : 256) + head * V) * T + rbase;
        bf16x8 bfv[NVT][2];
#pragma unroll
        for (int vt = 0; vt < NVT; ++vt)
#pragma unroll
            for (int s = 0; s < 2; ++s) bfv[vt][s] = *(const bf16x8*)(vsrc + (size_t)(32 * vt + c) * T + 16 * s + 8 * hh);
        float lbk, up[16], bias; gl_walker_consts<MIX>(g, head, wk, wdir, lbk, up, bias);
        __syncthreads();
        {
            float tail = 1.0f;
            LAS bf16_t* kt = (LAS bf16_t*)(lds + (wdir * 2 + wc2) * (128 * GL_KT_STRIDE) + wk * GL_KT_STRIDE);
#pragma unroll 8
            for (int s = 0; s < 32; ++s) {
                const int t = wdir == 0 ? 31 - s : s; unsigned short x0, x1; gl_load<MIX, false>(lds, 32 * wc2 + t, wk, wdir, x0, x1);
                float d, kv, q; gl_comp<MIX, false>(x0, x1, lbk, up, bias, (const LAS float*)(lds + GL_GD_OFF) + (wdir * 64 + 32 * wc2 + t) * 16, d, kv, q);
                kt[t] = (bf16_t)f2bf(kv * tail); tail *= d;
            }
            g.dec[((size_t)(wdir * NH + head) * NCHUNK + (R0 >> 5) + wc2) * 128 + wk] = tail;
        }
        __syncthreads();
        {
            const LAS unsigned char* ktile = lds + (dir * 2 + c2) * (128 * GL_KT_STRIDE);
            bf16x8 af[2][2];
#pragma unroll
            for (int kt2 = 0; kt2 < 2; ++kt2)
#pragma unroll
                for (int s = 0; s < 2; ++s) af[kt2][s] = *(const LAS bf16x8*)(ktile + (32 * (2 * kh + kt2) + c) * GL_KT_STRIDE + (16 * s + 8 * hh) * 2);
            bf16_t* kvo = g.kvt + ((size_t)(dir * NH + head) * NCHUNK + cr) * (V * 128);
#pragma unroll
            for (int pass = 0; pass < NVT / 4; ++pass) {
                f32x16 acc[4][2];
#pragma unroll
                for (int vt = 0; vt < 4; ++vt)
#pragma unroll
                    for (int kt2 = 0; kt2 < 2; ++kt2)
#pragma unroll
                        for (int r = 0; r < 16; ++r) acc[vt][kt2][r] = 0.f;
#pragma unroll
                for (int vt = 0; vt < 4; ++vt)
#pragma unroll
                    for (int s = 0; s < 2; ++s)
#pragma unroll
                        for (int kt2 = 0; kt2 < 2; ++kt2) acc[vt][kt2] = __builtin_amdgcn_mfma_f32_32x32x16_bf16(bfv[4 * pass + vt][s], af[kt2][s], acc[vt][kt2], 0, 0, 0);
#pragma unroll
                for (int vt = 0; vt < 4; ++vt)
#pragma unroll
                    for (int kt2 = 0; kt2 < 2; ++kt2)
#pragma unroll
                        for (int r = 0; r < 16; ++r) {
                            const int v = 32 * (4 * pass + vt) + (r & 3) + 8 * (r >> 2) + 4 * hh;
                            kvo[(size_t)v * 128 + 32 * (2 * kh + kt2) + c] = (bf16_t)f2bf(acc[vt][kt2][r]);
                        }
            }
        }
    }
}

template <int MIX, int KPT>
__device__ __forceinline__ void gl_phaseB(const GLArgs& g, int gidx) {
    constexpr int NH = GL<MIX>::NH, V = GL<MIX>::V, KG = 128 / KPT;
    if (gidx < 0 || gidx >= 2 * NH * V * KG) return;
    const int kq = gidx % KG; int rest = gidx / KG; const int v = rest % V; rest /= V; const int head = rest % NH, dir = rest / NH;
    bf16_t* base = g.kvt + (size_t)(dir * NH + head) * NCHUNK * (V * 128) + (size_t)v * 128 + KPT * kq;
    const float* dbase = g.dec + (size_t)(dir * NH + head) * NCHUNK * 128 + KPT * kq;
    float st[KPT];
#pragma unroll
    for (int e = 0; e < KPT; ++e) st[e] = 0.f;
    constexpr int UB = 10;
    unsigned kv[UB][KPT / 2], kvn[UB][KPT / 2]; float dd[UB][KPT], ddn[UB][KPT];
#define GLB_LOAD(KV, DD, ST0) do { _Pragma("unroll") for (int u = 0; u < UB; ++u) { const int cr_ = gl_scan_chunk<MIX>(dir, (ST0) + u); \
        if constexpr (KPT == 4) { const u32x2 k_ = *(const u32x2*)(base + (size_t)cr_ * (V * 128)); KV[u][0] = k_.x; KV[u][1] = k_.y; const f32x4 d_ = *(const f32x4*)(dbase + (size_t)cr_ * 128); DD[u][0] = d_[0]; DD[u][1] = d_[1]; DD[u][2] = d_[2]; DD[u][3] = d_[3]; } \
        else { _Pragma("unroll") for (int e = 0; e < KPT / 2; ++e) KV[u][e] = *((const unsigned*)(base + (size_t)cr_ * (V * 128)) + e); \
        _Pragma("unroll") for (int e = 0; e < KPT; ++e) DD[u][e] = dbase[(size_t)cr_ * 128 + e]; } } } while (0)
    GLB_LOAD(kv, dd, 0);
    for (int st0 = 0; st0 < NCHUNK; st0 += UB) {
        if (st0 + UB < NCHUNK) GLB_LOAD(kvn, ddn, st0 + UB);
#pragma unroll
        for (int u = 0; u < UB; ++u) { const int cr = gl_scan_chunk<MIX>(dir, st0 + u);
            if constexpr (KPT == 4) { *(u32x2*)(base + (size_t)cr * (V * 128)) = (u32x2){pk2(st[0], st[1]), pk2(st[2], st[3])}; }
#pragma unroll
            for (int e = 0; e < KPT / 2; ++e) { if constexpr (KPT != 4) *((unsigned*)(base + (size_t)cr * (V * 128)) + e) = pk2(st[2 * e], st[2 * e + 1]);
                st[2 * e] = fmaf(dd[u][2 * e], st[2 * e], bflo(kv[u][e])); st[2 * e + 1] = fmaf(dd[u][2 * e + 1], st[2 * e + 1], bfhi(kv[u][e])); } }
#pragma unroll
        for (int u = 0; u < UB; ++u) {
#pragma unroll
            for (int e = 0; e < KPT / 2; ++e) kv[u][e] = kvn[u][e];
#pragma unroll
            for (int e = 0; e < KPT; ++e) dd[u][e] = ddn[u][e]; }
    }
#undef GLB_LOAD
}

template <int MIX>
__device__ __forceinline__ void gl_phaseC(const GLArgs& g, LAS unsigned char* lds, int tid, int bid, int nblk) {
    constexpr int NH = GL<MIX>::NH, V = GL<MIX>::V, NVT = GL<MIX>::NVT, NP = NVT / 4;
    const int lane = tid & 63, wave = tid >> 6, c = lane & 31, hh = lane >> 5;
    const int wk = tid & 127, wc2 = (tid >> 7) & 1, wdir = tid >> 8;
    constexpr int TILE = 32 * GL_QK_STRIDE;
    for (int item = bid; item < NH * (T / 64); item += nblk) {
        const int head = item % NH, nb = item / NH, R0 = nb * 64;
        if (MIX == 1 && R0 < CTXL) continue;
        __syncthreads();
        gl_stage_gd<MIX>(g, lds, R0, tid); gl_stage_raw<MIX, true>(g, lds, R0, head, tid);
        const int c2 = wave >> 2, vg = wave & 3, rbase = R0 + 32 * c2, cr = (R0 >> 5) + c2;
        bf16x8 sf2[2][8]; u32x4 vf2[2][NP][2];
#pragma unroll
        for (int dir = 0; dir < 2; ++dir) {
            const bf16_t* sb_ = g.kvt + ((size_t)(dir * NH + head) * NCHUNK + cr) * (V * 128);
#pragma unroll
            for (int p = 0; p < NP; ++p) {
                const int vrow = 32 * (vg + 4 * p) + c;
                const bf16_t* vp = g.vT + (size_t)((MIX ? 0 : 256) + head * V + vrow) * T + rbase;
#pragma unroll
                for (int s2 = 0; s2 < 2; ++s2) { const u32x2 lo = *(const u32x2*)(vp + 16 * s2 + 4 * hh), hi = *(const u32x2*)(vp + 16 * s2 + 8 + 4 * hh); vf2[dir][p][s2] = (u32x4){lo.x, lo.y, hi.x, hi.y}; }
            }
#pragma unroll
            for (int s = 0; s < 8; ++s) sf2[dir][s] = *(const bf16x8*)(sb_ + (size_t)(32 * vg + c) * 128 + 16 * s + 8 * hh);
        }
        float lbk, up[16], bias; gl_walker_consts<MIX>(g, head, wk, wdir, lbk, up, bias);
        __syncthreads();
        {
            const int rbase = R0 + 32 * wc2; float P = 1.0f;
            LAS unsigned char* qt = lds + ((wdir * 2 + wc2) * 2) * TILE; LAS unsigned char* kt = qt + TILE;
#pragma unroll 8
            for (int s = 0; s < 32; ++s) {
                const int t = wdir == 0 ? s : 31 - s; unsigned short x0, x1; gl_load<MIX, true>(lds, 32 * wc2 + t, wk, wdir, x0, x1);
                float d, kv, q; gl_comp<MIX, true>(x0, x1, lbk, up, bias, (const LAS float*)(lds + GL_GD_OFF) + (wdir * 64 + 32 * wc2 + t) * 16, d, kv, q);
                P *= d;
                *(LAS bf16_t*)(qt + t * GL_QK_STRIDE + wk * 2) = (bf16_t)f2bf(q * P);
                *(LAS bf16_t*)(kt + t * GL_QK_STRIDE + wk * 2) = (bf16_t)f2bf(kv * fminf(__builtin_amdgcn_rcpf(P), 1e30f));
            }
        }
        __syncthreads();
        f32x16 o[NP];
#pragma unroll
        for (int p = 0; p < NP; ++p)
#pragma unroll
            for (int r = 0; r < 16; ++r) o[p][r] = 0.f;
        __builtin_amdgcn_sched_barrier(0);
#pragma unroll
        for (int dir = 0; dir < 2; ++dir) {
            const LAS unsigned char* qt = lds + ((dir * 2 + c2) * 2) * TILE; const LAS unsigned char* kt = qt + TILE;
            const bf16_t* sbase = g.kvt + ((size_t)(dir * NH + head) * NCHUNK + cr) * (V * 128);
            bf16x8 sf[8]; u32x4 vf[NP][2];
#pragma unroll
            for (int s = 0; s < 8; ++s) sf[s] = sf2[dir][s];
#pragma unroll
            for (int p = 0; p < NP; ++p) { vf[p][0] = vf2[dir][p][0]; vf[p][1] = vf2[dir][p][1]; }
            bf16x8 qf[8];
            f32x16 x;
#pragma unroll
            for (int r = 0; r < 16; ++r) x[r] = 0.f;
#pragma unroll
            for (int s = 0; s < 8; ++s) { qf[s] = *(const LAS bf16x8*)(qt + c * GL_QK_STRIDE + (16 * s + 8 * hh) * 2);
                const bf16x8 kf = *(const LAS bf16x8*)(kt + c * GL_QK_STRIDE + (16 * s + 8 * hh) * 2);
                x = __builtin_amdgcn_mfma_f32_32x32x16_bf16(kf, qf[s], x, 0, 0, 0); }
#pragma unroll
            for (int r = 0; r < 16; ++r) { const int j = (r & 3) + 8 * (r >> 2) + 4 * hh; const bool keep = dir == 0 ? (j <= c) : (j >= c); if (!keep) x[r] = 0.f; }
            bf16x8 xf[2];
#pragma unroll
            for (int s2 = 0; s2 < 2; ++s2) { u32x4 w;
#pragma unroll
                for (int e = 0; e < 4; ++e) w[e] = pk2(x[8 * s2 + 2 * e], x[8 * s2 + 2 * e + 1]);
                xf[s2] = __builtin_bit_cast(bf16x8, w); }
#pragma unroll
            for (int p = 0; p < NP; ++p) {
                bf16x8 sn[8];
                if (p + 1 < NP) {
#pragma unroll
                    for (int s = 0; s < 8; ++s) sn[s] = *(const bf16x8*)(sbase + (size_t)(32 * (vg + 4 * (p + 1)) + c) * 128 + 16 * s + 8 * hh);
                }
                __builtin_amdgcn_sched_barrier(0);
#pragma unroll
                for (int s2 = 0; s2 < 2; ++s2) o[p] = __builtin_amdgcn_mfma_f32_32x32x16_bf16(__builtin_bit_cast(bf16x8, vf[p][s2]), xf[s2], o[p], 0, 0, 0);
#pragma unroll
                for (int s = 0; s < 8; ++s) o[p] = __builtin_amdgcn_mfma_f32_32x32x16_bf16(sf[s], qf[s], o[p], 0, 0, 0);
                if (p + 1 < NP) {
#pragma unroll
                    for (int s = 0; s < 8; ++s) sf[s] = sn[s];
                }
            }
        }
        float ss = 0.f;
#pragma unroll
        for (int p = 0; p < NP; ++p)
#pragma unroll
            for (int r = 0; r < 16; ++r) ss += o[p][r] * o[p][r];
        ss += __shfl_xor(ss, 32);
        LAS float* red = (LAS float*)(lds + GL_RED_OFF);
        if (hh == 0) red[(c2 * 4 + vg) * 32 + c] = ss;
        __syncthreads();
        const float tot = (red[(c2 * 4 + 0) * 32 + c] + red[(c2 * 4 + 1) * 32 + c]) + (red[(c2 * 4 + 2) * 32 + c] + red[(c2 * 4 + 3) * 32 + c]);
        const float rs = __builtin_amdgcn_rsqf(tot * (1.0f / V) + NORM_EPS);
        const int r = rbase + c;
#pragma unroll
        for (int p = 0; p < NP; ++p)
#pragma unroll
            for (int gq = 0; gq < 4; ++gq) {
                const int v0 = 32 * (vg + 4 * p) + 8 * gq + 4 * hh;
                const f32x4 gn = *(const f32x4*)(g.gain + v0);
                const u32x2 gt = *(const u32x2*)(g.proj + (size_t)r * (MIX ? N1 : N0) + (MIX ? G_GR : P0_GH) + head * V + v0);
                u32x2 w; w.x = pk2(o[p][4 * gq] * rs * gn[0] * siluf_(bflo(gt.x)), o[p][4 * gq + 1] * rs * gn[1] * siluf_(bfhi(gt.x)));
                w.y = pk2(o[p][4 * gq + 2] * rs * gn[2] * siluf_(bflo(gt.y)), o[p][4 * gq + 3] * rs * gn[3] * siluf_(bfhi(gt.y)));
                bf16_t* op = MIX ? g.mix + (size_t)(r - CTXL) * D + head * V + v0 : g.mix + (size_t)r * D + 1024 + head * V + v0;
                *(u32x2*)op = w;
            }
    }
}

constexpr int RW_TS = 144, RW_TILE = 32 * RW_TS, RW_WAVE_LDS = 14336;
__host__ __device__ constexpr int rw_tri(int t) { return t <= 0 ? 0 : ((t - 1) / 4 + 1) * (2 * ((t - 1) / 4) + (t - 1) % 4); }
constexpr int RW_TRI_BYTES = 16 * rw_tri(32);
#ifndef RW_LB
#define RW_LB 2
#endif
static_assert(RW_TRI_BYTES + 2048 <= RW_TILE, "triangle rows + the parked fragments must fit the third tile slot");
struct RWArgs { const bf16_t* RP; const bf16_t* GOUT; bf16_t* MF; bf16_t* NB; bf16_t* QB; bf16_t* OB; bf16_t* mix; const float* rk; const float* lnw; const float* lnb; const float* ka; };
__device__ __forceinline__ int rw_scan_chunk(int dir, int cs) { return dir == 0 ? cs : (cs < 8 ? 7 - cs : NCHUNK + 7 - cs); }
__device__ __forceinline__ float rdlane(float v, int l) { return __int_as_float(__builtin_amdgcn_readlane(__float_as_int(v), l)); }
template <bool PERM>
__device__ __forceinline__ void rw_pack(const float (&x)[32], int hh, u32x4 (&f)[2][2]) {
#pragma unroll
    for (int s2 = 0; s2 < 2; ++s2)
#pragma unroll
        for (int e = 0; e < 4; ++e) {
            const int t0 = PERM ? 16 * s2 + 8 * ((2 * e) >> 2) + ((2 * e) & 3) : 16 * s2 + 2 * e;
            const int t1 = PERM ? t0 + 4 : t0 + 8;
            const unsigned p0 = pk2(x[t0], x[t0 + 1]), p1 = pk2(x[t1], x[t1 + 1]);
            const auto rr = __builtin_amdgcn_permlane32_swap(p0, p1, false, false);
            f[0][s2][e] = rr[0]; f[1][s2][e] = rr[1];
        }
    (void)hh;
}
__device__ __forceinline__ void rw_pack_pairs(const unsigned (&xp)[16], int hh, u32x4 (&f)[2][2]) {
#pragma unroll
    for (int s2 = 0; s2 < 2; ++s2)
#pragma unroll
        for (int e = 0; e < 4; ++e) { const auto rr = __builtin_amdgcn_permlane32_swap(xp[8 * s2 + e], xp[8 * s2 + 4 + e], false, false); f[0][s2][e] = rr[0]; f[1][s2][e] = rr[1]; }
    (void)hh;
}
__device__ __forceinline__ void rw_pack_pairs_perm(const unsigned (&xp)[16], int hh, u32x4 (&f)[2][2]) {
#pragma unroll
    for (int s2 = 0; s2 < 2; ++s2)
#pragma unroll
        for (int e = 0; e < 4; ++e) { const int t0 = 16 * s2 + 8 * (e >> 1) + 2 * (e & 1);
            const auto rr = __builtin_amdgcn_permlane32_swap(xp[t0 >> 1], xp[(t0 + 4) >> 1], false, false); f[0][s2][e] = rr[0]; f[1][s2][e] = rr[1]; }
    (void)hh;
}
__device__ __forceinline__ bf16x8 acc_frag(const f32x16& x, int s2) {
    u32x4 w;
#pragma unroll
    for (int e = 0; e < 4; ++e) w[e] = pk2(x[8 * s2 + 2 * e], x[8 * s2 + 2 * e + 1]);
    return __builtin_bit_cast(bf16x8, w);
}
#define MFMA32(A, B, C) __builtin_amdgcn_mfma_f32_32x32x16_bf16(A, B, C, 0, 0, 0)

__device__ __forceinline__ void rwkv_stageA(const RWArgs& g, LAS unsigned char* wl, int item, int lane) {
    __builtin_assume(item >= 0 && item < 2 * 16 * NCHUNK);
    const int dir = item / (16 * NCHUNK), rem = item - dir * 16 * NCHUNK, head = rem / NCHUNK, cs = rem - head * NCHUNK;
    const int cr = rw_scan_chunk(dir, cs), rbase = 32 * cr, c = lane & 31, hh = lane >> 5;
    LAS unsigned char* s0 = wl; LAS unsigned char* s1 = wl + RW_TILE; LAS unsigned char* s2p = wl + 2 * RW_TILE; LAS float* gam = (LAS float*)(wl + 3 * RW_TILE);
    unsigned vp[16], bp[16], kp[16];
    {
        float gprev = 1.0f; const bf16_t* rp0 = g.RP + head * 64; unsigned vo0 = (unsigned)lane * 2u, vo2 = vo0 + 4096u, vo4 = vo0 + 8192u, vo5 = vo0 + (unsigned)(5 + dir) * 2048u; asm volatile("" : "+v"(vo2), "+v"(vo4), "+v"(vo5)); const float kac = g.ka[head * 64 + lane];
#pragma unroll
        for (int sb = 0; sb < 32; sb += 16) {
            unsigned short raw[16][6];
#pragma unroll
            for (int u = 0; u < 16; ++u) { const int s = sb + u; const int r = rbase + (dir ? 31 - s : s); const char* pb = (const char*)(rp0 + (size_t)r * 7168);
                raw[u][0] = *(const bf16_t*)(pb + vo0); raw[u][1] = *(const bf16_t*)(pb + 2048 + vo0); raw[u][2] = *(const bf16_t*)(pb + vo2); raw[u][3] = *(const bf16_t*)(pb + 2048 + vo2);
                raw[u][4] = *(const bf16_t*)(pb + vo4); raw[u][5] = *(const bf16_t*)(pb + vo5); }
#pragma unroll
            for (int u = 0; u < 16; u += 2) { const int s = sb + u;
                float bq[2], kq[2], aq[2], rq[2];
#pragma unroll
                for (int h = 0; h < 2; ++h) {
                    const float rr = bf2f(raw[u + h][0]), kk = bf2f(raw[u + h][3]), aa = bf2f(raw[u + h][4]), lw = bf2f(raw[u + h][5]);
                    const float km = bf2f(raw[u + h][1]) * (1.0f + (aa - 1.0f) * kac);
                    const float gcur = gprev * fexp(lw), ginv = __builtin_amdgcn_rcpf(gcur);
                    bq[h] = kk * aa * ginv; kq[h] = km * ginv; aq[h] = -kk * gprev; rq[h] = rr * gcur;
                    gprev = gcur;
                }
                const unsigned bt2 = pk2(bq[0], bq[1]), kt2 = pk2(kq[0], kq[1]), at2 = pk2(aq[0], aq[1]), rt2 = pk2(rq[0], rq[1]);
                *(LAS bf16_t*)(s0 + s * RW_TS + lane * 2) = (bf16_t)(at2 & 0xffffu); *(LAS bf16_t*)(s0 + (s + 1) * RW_TS + lane * 2) = (bf16_t)(at2 >> 16);
                *(LAS bf16_t*)(s1 + s * RW_TS + lane * 2) = (bf16_t)(rt2 & 0xffffu); *(LAS bf16_t*)(s1 + (s + 1) * RW_TS + lane * 2) = (bf16_t)(rt2 >> 16);
                *(LAS bf16_t*)(s2p + s * RW_TS + lane * 2) = (bf16_t)(kt2 & 0xffffu); *(LAS bf16_t*)(s2p + (s + 1) * RW_TS + lane * 2) = (bf16_t)(kt2 >> 16);
                bp[s >> 1] = bt2; kp[s >> 1] = kt2; vp[s >> 1] = (unsigned)raw[u][2] | ((unsigned)raw[u + 1][2] << 16);
            }
        }
        gam[lane] = gprev;
    }
    LDS_WAIT();
    f32x16 g1, g2, g3, g4;
#pragma unroll
    for (int r = 0; r < 16; ++r) { g1[r] = 0.f; g2[r] = 0.f; g3[r] = 0.f; g4[r] = 0.f; }
    {
        bf16x8 fa[4], fr[4], fk[4];
#pragma unroll
        for (int ks = 0; ks < 4; ++ks) { fa[ks] = *(const LAS bf16x8*)(s0 + c * RW_TS + (16 * ks + 8 * hh) * 2); fr[ks] = *(const LAS bf16x8*)(s1 + c * RW_TS + (16 * ks + 8 * hh) * 2);
            fk[ks] = *(const LAS bf16x8*)(s2p + c * RW_TS + (16 * ks + 8 * hh) * 2); }
        LDS_WAIT();
#pragma unroll
        for (int s = 0; s < 32; ++s) *(LAS bf16_t*)(s2p + s * RW_TS + lane * 2) = (bf16_t)((s & 1) ? (bp[s >> 1] >> 16) : (bp[s >> 1] & 0xffffu));
        LDS_WAIT();
#pragma unroll
        for (int ks = 0; ks < 4; ++ks) {
            const bf16x8 fb = *(const LAS bf16x8*)(s2p + c * RW_TS + (16 * ks + 8 * hh) * 2);
            g1 = MFMA32(fb, fa[ks], g1); g2 = MFMA32(fk[ks], fa[ks], g2); g3 = MFMA32(fb, fr[ks], g3); g4 = MFMA32(fk[ks], fr[ks], g4);
        }
    }
#pragma unroll
    for (int r = 0; r < 16; ++r) { const int i = (r & 3) + 8 * (r >> 2) + 4 * hh; if (i > c) { g3[r] = 0.f; g4[r] = 0.f; } }
    const bf16x8 b3[2] = {acc_frag(g3, 0), acc_frag(g3, 1)}, b4[2] = {acc_frag(g4, 0), acc_frag(g4, 1)};
    LDS_WAIT();
    {
        int toff = 4 * rw_tri(c); asm volatile("" : "+v"(toff));
#pragma unroll
        for (int gq = 0; gq < 4; ++gq) { const int i0 = 8 * gq + 4 * hh;
            if (i0 < c) *(LAS f32x4*)(s2p + (toff + i0) * 4) = (f32x4){g1[4 * gq], g1[4 * gq + 1], g1[4 * gq + 2], g1[4 * gq + 3]}; }
        *(LAS bf16x8*)(s2p + RW_TRI_BYTES + lane * 16) = b4[0]; *(LAS bf16x8*)(s2p + RW_TRI_BYTES + 1024 + lane * 16) = b4[1];
    }
    f32x16 wxA, wxB;
    {
#pragma unroll
        for (int r = 0; r < 16; ++r) { const int i = (r & 3) + 8 * (r >> 2) + 4 * hh; if (i >= c) g2[r] = 0.f; }
        const bf16x8 a2[2] = {acc_frag(g2, 0), acc_frag(g2, 1)};
        u32x4 fVq[2][2]; rw_pack_pairs_perm(vp, hh, fVq);
        f32x16 x0, x1;
#pragma unroll
        for (int r = 0; r < 16; ++r) { x0[r] = 0.f; x1[r] = 0.f; }
#pragma unroll
        for (int q = 0; q < 2; ++q) { x0 = MFMA32(a2[q], __builtin_bit_cast(bf16x8, fVq[0][q]), x0); x1 = MFMA32(a2[q], __builtin_bit_cast(bf16x8, fVq[1][q]), x1); }
#pragma unroll
        for (int r = 0; r < 16; ++r) { const auto rr = __builtin_amdgcn_permlane32_swap(__float_as_uint(x0[r]), __float_as_uint(x1[r]), false, false); wxA[r] = __uint_as_float(rr[0]); wxB[r] = __uint_as_float(rr[1]); }
    }
    LDS_WAIT();
    float p[32], w[32];
    {
        f32x2 pw[32];
#pragma unroll
        for (int t = 0; t < 32; ++t) {
            f32x2 acc = {bf2f(*(const LAS bf16_t*)(s0 + t * RW_TS + lane * 2)), ((t >> 2) & 1) ? wxB[(t & 3) + 4 * (t >> 3)] : wxA[(t & 3) + 4 * (t >> 3)]};
#pragma unroll
            for (int ib = 0; ib < (t + 3) / 4; ib += RW_LB) {
                f32x4 lab[RW_LB];
#pragma unroll
                for (int b = 0; b < RW_LB; ++b) if (ib + b < (t + 3) / 4) lab[b] = *(const LAS f32x4*)(s2p + (4 * rw_tri(t) + 4 * (ib + b)) * 4);
#pragma unroll
                for (int b = 0; b < RW_LB; ++b) if (ib + b < (t + 3) / 4) {
                    const f32x2 l01 = {lab[b][0], lab[b][1]}, l23 = {lab[b][2], lab[b][3]};
                    const int i0 = 4 * (ib + b), n = t - i0;
#define RW_F0 "v_pk_fma_f32 %0, %1, %3, %0 op_sel_hi:[0,1,1]"
#define RW_F1 "\n\tv_pk_fma_f32 %0, %1, %4, %0 op_sel:[1,0,0] op_sel_hi:[1,1,1]"
#define RW_F2 "\n\tv_pk_fma_f32 %0, %2, %5, %0 op_sel_hi:[0,1,1]"
#define RW_F3 "\n\tv_pk_fma_f32 %0, %2, %6, %0 op_sel:[1,0,0] op_sel_hi:[1,1,1]"
                    if (n >= 4)      asm(RW_F0 RW_F1 RW_F2 RW_F3 : "+v"(acc) : "v"(l01), "v"(l23), "v"(pw[i0]), "v"(pw[i0 + 1]), "v"(pw[i0 + 2]), "v"(pw[i0 + 3]));
                    else if (n == 3) asm(RW_F0 RW_F1 RW_F2       : "+v"(acc) : "v"(l01), "v"(l23), "v"(pw[i0]), "v"(pw[i0 + 1]), "v"(pw[i0 + 2]));
                    else if (n == 2) asm(RW_F0 RW_F1             : "+v"(acc) : "v"(l01), "v"(l23), "v"(pw[i0]), "v"(pw[i0 + 1]));
                    else             asm(RW_F0                   : "+v"(acc) : "v"(l01), "v"(l23), "v"(pw[i0]));
#undef RW_F0
#undef RW_F1
#undef RW_F2
#undef RW_F3
                }
            }
            pw[t] = acc;
        }
#pragma unroll
        for (int t = 0; t < 32; ++t) { p[t] = pw[t][0]; w[t] = pw[t][1]; }
    }
#define BF(x) __builtin_bit_cast(bf16x8, x)
    u32x4 fBn[2][2], fKn[2][2];
    rw_pack_pairs(bp, hh, fBn); rw_pack_pairs(kp, hh, fKn);
    {
        u32x4 fPn[2][2], fPp[2][2];
        rw_pack<false>(p, hh, fPn); rw_pack<true>(p, hh, fPp);
        bf16_t* mf = g.MF + (size_t)item * 4096;
#pragma unroll
        for (int n = 0; n < 2; ++n) {
            const float gk = gam[32 * n + c];
#pragma unroll
            for (int mp = 0; mp < 2; ++mp) {
                f32x16 x;
#pragma unroll
                for (int r = 0; r < 16; ++r) x[r] = 0.f;
#pragma unroll
                for (int q = 0; q < 2; ++q) x = MFMA32(BF(fPn[mp][q]), BF(fBn[n][q]), x);
#pragma unroll
                for (int r = 0; r < 16; ++r) { const int kprime = (r & 3) + 8 * (r >> 2) + 4 * hh; x[r] = gk * (x[r] + ((mp == n && kprime == c) ? 1.0f : 0.0f)); }
#pragma unroll
                for (int q = 0; q < 2; ++q) *(bf16x8*)(mf + (size_t)(((n * 2 + mp) * 2 + q) * 64 + lane) * 8) = acc_frag(x, q);
            }
        }
        const int r = rbase + (dir ? 31 - c : c);
        bf16_t* qrow = g.QB + ((size_t)dir * T + r) * 1024 + head * 64;
#pragma unroll
        for (int mp = 0; mp < 2; ++mp) {
            f32x16 x;
#pragma unroll
            for (int rr = 0; rr < 16; ++rr) x[rr] = 0.f;
#pragma unroll
            for (int q = 0; q < 2; ++q) x = MFMA32(BF(fPp[mp][q]), b3[q], x);
#pragma unroll
            for (int gq = 0; gq < 4; ++gq) { const int k0 = 32 * mp + 8 * gq + 4 * hh; const u32x2 rt = *(const LAS u32x2*)(s1 + c * RW_TS + k0 * 2);
                u32x2 o; o.x = pk2(x[4 * gq] + bflo(rt.x), x[4 * gq + 1] + bfhi(rt.x)); o.y = pk2(x[4 * gq + 2] + bflo(rt.y), x[4 * gq + 3] + bfhi(rt.y));
                *(u32x2*)(qrow + k0) = o; }
        }
    }
    asm volatile("" ::: "memory");
    {
        u32x4 fWn[2][2], fVn[2][2], fWp[2][2], fVp[2][2];
        rw_pack<false>(w, hh, fWn); rw_pack_pairs(vp, hh, fVn); rw_pack<true>(w, hh, fWp); rw_pack_pairs_perm(vp, hh, fVp);
        bf16_t* nb = g.NB + (size_t)item * 4096;
#pragma unroll
        for (int n = 0; n < 2; ++n)
#pragma unroll
            for (int m = 0; m < 2; ++m) {
                f32x16 x;
#pragma unroll
                for (int r = 0; r < 16; ++r) x[r] = 0.f;
#pragma unroll
                for (int q = 0; q < 2; ++q) { x = MFMA32(BF(fBn[m][q]), BF(fWn[n][q]), x); x = MFMA32(BF(fKn[m][q]), BF(fVn[n][q]), x); }
                u32x4 o0, o1;
#pragma unroll
                for (int gq = 0; gq < 4; ++gq) { const f32x4 gg = *(const LAS f32x4*)(gam + 32 * m + 8 * gq + 4 * hh);
                    const unsigned a0 = pk2(x[4 * gq] * gg[0], x[4 * gq + 1] * gg[1]), a1 = pk2(x[4 * gq + 2] * gg[2], x[4 * gq + 3] * gg[3]);
                    if (gq < 2) { o0[2 * gq] = a0; o0[2 * gq + 1] = a1; } else { o1[2 * (gq - 2)] = a0; o1[2 * (gq - 2) + 1] = a1; } }
                u32x4* dst = (u32x4*)(nb + (size_t)((n * 2 + m) * 64 + lane) * 16);
                dst[0] = o0; dst[1] = o1;
            }
        const int lrow = (dir ? 31 - c : c) + 32 * hh;
        bf16_t* ob = g.OB + ((size_t)((dir * 16 + head) * NCHUNK + cr)) * 2048;
#pragma unroll
        for (int n = 0; n < 2; ++n) {
            f32x16 x;
#pragma unroll
            for (int rr = 0; rr < 16; ++rr) x[rr] = 0.f;
#pragma unroll
            for (int q = 0; q < 2; ++q) { x = MFMA32(BF(fWp[n][q]), b3[q], x); x = MFMA32(BF(fVp[n][q]), *(const LAS bf16x8*)(s2p + RW_TRI_BYTES + q * 1024 + lane * 16), x); }
            u32x4 o0, o1;
#pragma unroll
            for (int e = 0; e < 4; ++e) { o0[e] = pk2(x[2 * e], x[2 * e + 1]); o1[e] = pk2(x[8 + 2 * e], x[8 + 2 * e + 1]); }
            u32x4* dst = (u32x4*)(ob + (size_t)(n * 64 + lrow) * 16);
            dst[0] = o0; dst[1] = o1;
        }
    }
    LDS_WAIT();
}

constexpr int RWB_SLOT = 12288, RWB_FLAGS = MISC_OFF + 1536;
__device__ __forceinline__ void rwkv_stageB(const RWArgs& g, LAS unsigned char* lds, int tk, int wave, int lane) {
    const int n = tk & 1, dh = tk >> 1;
    const bf16_t* mfb = g.MF + (size_t)dh * NCHUNK * 4096; bf16_t* nbb = g.NB + (size_t)dh * NCHUNK * 4096 + (size_t)n * 2048;
    volatile LAS unsigned* flags = (volatile LAS unsigned*)(lds + RWB_FLAGS);
    if (wave != 0) {
        const int sl = wave - 1; LAS unsigned char* slot = lds + sl * RWB_SLOT;
        for (int cs = sl; cs < NCHUNK; cs += 7) {
            u32x4 v[12];
            const u32x4* mp_ = (const u32x4*)(mfb + (size_t)cs * 4096); const u32x4* np_ = (const u32x4*)(nbb + (size_t)cs * 4096);
#pragma unroll
            for (int q = 0; q < 8; ++q) v[q] = mp_[q * 64 + lane];
#pragma unroll
            for (int q = 0; q < 4; ++q) v[8 + q] = np_[q * 64 + lane];
            unsigned sp = 0; while ((int)flags[8] + 7 <= cs) { __builtin_amdgcn_s_sleep(1); if (++sp > (1u << 26)) break; }
#pragma unroll
            for (int q = 0; q < 12; ++q) *(LAS u32x4*)(slot + q * 1024 + lane * 16) = v[q];
            LDS_WAIT();
            if (lane == 0) flags[sl] = (unsigned)(cs + 1);
        }
        return;
    }
    f32x16 H[2];
#pragma unroll
    for (int m = 0; m < 2; ++m)
#pragma unroll
        for (int r = 0; r < 16; ++r) H[m][r] = 0.f;
    for (int cs = 0; cs < NCHUNK; ++cs) {
        const int sl = cs % 7; const LAS unsigned char* slot = lds + sl * RWB_SLOT;
        { unsigned sp = 0; while (flags[sl] != (unsigned)(cs + 1)) { __builtin_amdgcn_s_sleep(1); if (++sp > (1u << 26)) break; } }
        bf16x8 cm[2][2][2]; u32x4 cn[2][2];
#pragma unroll
        for (int m = 0; m < 2; ++m) {
#pragma unroll
            for (int mp = 0; mp < 2; ++mp)
#pragma unroll
                for (int q = 0; q < 2; ++q) cm[m][mp][q] = *(const LAS bf16x8*)(slot + ((m * 2 + mp) * 2 + q) * 1024 + lane * 16);
            cn[m][0] = *(const LAS u32x4*)(slot + 8192 + (m * 64 + lane) * 32); cn[m][1] = *(const LAS u32x4*)(slot + 8192 + (m * 64 + lane) * 32 + 16);
        }
        LDS_WAIT();
        if (lane == 0) flags[8] = (unsigned)(cs + 1);
        bf16x8 hb[2][2];
#pragma unroll
        for (int mp = 0; mp < 2; ++mp)
#pragma unroll
            for (int q = 0; q < 2; ++q) hb[mp][q] = acc_frag(H[mp], q);
        bf16_t* hf = nbb + (size_t)cs * 4096;
#pragma unroll
        for (int mp = 0; mp < 2; ++mp)
#pragma unroll
            for (int q = 0; q < 2; ++q) *(bf16x8*)(hf + (size_t)((mp * 2 + q) * 64 + lane) * 8) = hb[mp][q];
        f32x16 Hn[2];
#pragma unroll
        for (int m = 0; m < 2; ++m) {
#pragma unroll
            for (int e = 0; e < 4; ++e) { Hn[m][2 * e] = bflo(cn[m][0][e]); Hn[m][2 * e + 1] = bfhi(cn[m][0][e]); Hn[m][8 + 2 * e] = bflo(cn[m][1][e]); Hn[m][8 + 2 * e + 1] = bfhi(cn[m][1][e]); }
#pragma unroll
            for (int mp = 0; mp < 2; ++mp)
#pragma unroll
                for (int q = 0; q < 2; ++q) Hn[m] = MFMA32(cm[m][mp][q], hb[mp][q], Hn[m]);
        }
        H[0] = Hn[0]; H[1] = Hn[1];
    }
}

__device__ __forceinline__ void rwkv_stageC(const RWArgs& g, int head, int cr, int lane) {
    const int c = lane & 31, hh = lane >> 5, r = 32 * cr + c, t = r - CTXL;
    f32x16 o[2];
#pragma unroll
    for (int n = 0; n < 2; ++n)
#pragma unroll
        for (int q = 0; q < 16; ++q) o[n][q] = 0.f;
    bf16x8 qf[2][2][2], hf[2][2][2][2]; u32x4 ov[2][2][2];
#pragma unroll
    for (int dir = 0; dir < 2; ++dir) {
        const int cs = rw_scan_chunk(dir, cr);
        const bf16_t* qrow = g.QB + ((size_t)dir * T + r) * 1024 + head * 64;
        const bf16_t* hfb = g.NB + ((size_t)(dir * 16 + head) * NCHUNK + cs) * 4096;
        const bf16_t* ob = g.OB + ((size_t)((dir * 16 + head) * NCHUNK + cr)) * 2048;
#pragma unroll
        for (int mp = 0; mp < 2; ++mp)
#pragma unroll
            for (int q = 0; q < 2; ++q) { const u32x2 lo = *(const u32x2*)(qrow + 32 * mp + 16 * q + 4 * hh), hi = *(const u32x2*)(qrow + 32 * mp + 16 * q + 8 + 4 * hh);
                qf[dir][mp][q] = __builtin_bit_cast(bf16x8, ((u32x4){lo.x, lo.y, hi.x, hi.y})); }
#pragma unroll
        for (int n = 0; n < 2; ++n) {
            const u32x4* src = (const u32x4*)(ob + (size_t)(n * 64 + lane) * 16); ov[dir][n][0] = src[0]; ov[dir][n][1] = src[1];
#pragma unroll
            for (int mp = 0; mp < 2; ++mp)
#pragma unroll
                for (int q = 0; q < 2; ++q) hf[dir][n][mp][q] = *(const bf16x8*)(hfb + (size_t)n * 2048 + (size_t)((mp * 2 + q) * 64 + lane) * 8);
        }
    }
    const bf16_t* rp = g.RP + (size_t)r * 7168 + head * 64;
    u32x4 ra[4], ka[4], aa4[4];
#pragma unroll
    for (int q4 = 0; q4 < 4; ++q4) { ra[q4] = *(const u32x4*)(rp + 32 * hh + 8 * q4); ka[q4] = *(const u32x4*)(rp + 1024 + 32 * hh + 8 * q4); aa4[q4] = *(const u32x4*)(rp + 4096 + 32 * hh + 8 * q4); }
    __builtin_amdgcn_sched_barrier(0);
#pragma unroll
    for (int dir = 0; dir < 2; ++dir)
#pragma unroll
        for (int n = 0; n < 2; ++n) {
#pragma unroll
            for (int e = 0; e < 4; ++e) { o[n][2 * e] += bflo(ov[dir][n][0][e]); o[n][2 * e + 1] += bfhi(ov[dir][n][0][e]); o[n][8 + 2 * e] += bflo(ov[dir][n][1][e]); o[n][8 + 2 * e + 1] += bfhi(ov[dir][n][1][e]); }
#pragma unroll
            for (int mp = 0; mp < 2; ++mp)
#pragma unroll
                for (int q = 0; q < 2; ++q) o[n] = MFMA32(hf[dir][n][mp][q], qf[dir][mp][q], o[n]);
        }
    float sm = 0.f;
#pragma unroll
    for (int n = 0; n < 2; ++n)
#pragma unroll
        for (int q = 0; q < 16; ++q) sm += o[n][q];
    sm += __shfl_xor(sm, 32); const float mu = sm * (1.0f / 64.0f);
    float sv = 0.f;
#pragma unroll
    for (int n = 0; n < 2; ++n)
#pragma unroll
        for (int q = 0; q < 16; ++q) { const float d = o[n][q] - mu; sv += d * d; }
    sv += __shfl_xor(sv, 32); const float rs = __builtin_amdgcn_rsqf(sv * (1.0f / 64.0f) + 64e-5f);
    float bs = 0.f;
#pragma unroll
    for (int q4 = 0; q4 < 4; ++q4) { const float* rk = g.rk + head * 64 + 32 * hh + 8 * q4; const float* kac = g.ka + head * 64 + 32 * hh + 8 * q4;
#pragma unroll
        for (int e = 0; e < 4; ++e) { const float km0 = bflo(ka[q4][e]) * (1.0f + (bflo(aa4[q4][e]) - 1.0f) * kac[2 * e]), km1 = bfhi(ka[q4][e]) * (1.0f + (bfhi(aa4[q4][e]) - 1.0f) * kac[2 * e + 1]);
            bs = fmaf(bflo(ra[q4][e]) * km0, rk[2 * e], bs); bs = fmaf(bfhi(ra[q4][e]) * km1, rk[2 * e + 1], bs); } }
    bs += __shfl_xor(bs, 32);
#pragma unroll
    for (int n = 0; n < 2; ++n)
#pragma unroll
        for (int gq = 0; gq < 4; ++gq) {
            const int v0 = 32 * n + 8 * gq + 4 * hh, ch = head * 64 + v0;
            const u32x2 vv = *(const u32x2*)(rp + 2048 + v0), go = *(const u32x2*)(g.GOUT + (size_t)r * 1024 + ch);
            const f32x4 lw = *(const f32x4*)(g.lnw + ch), lb = *(const f32x4*)(g.lnb + ch);
            const float e0 = ((o[n][4 * gq] - mu) * rs * lw[0] + lb[0] + bs * bflo(vv.x)) * bflo(go.x), e1 = ((o[n][4 * gq + 1] - mu) * rs * lw[1] + lb[1] + bs * bfhi(vv.x)) * bfhi(go.x);
            const float e2 = ((o[n][4 * gq + 2] - mu) * rs * lw[2] + lb[2] + bs * bflo(vv.y)) * bflo(go.y), e3 = ((o[n][4 * gq + 3] - mu) * rs * lw[3] + lb[3] + bs * bfhi(vv.y)) * bfhi(go.y);
            u32x2 w; w.x = pk2(e0, e1); w.y = pk2(e2, e3);
            *(u32x2*)(g.mix + (size_t)t * D + 1024 + ch) = w;
        }
}
#undef BF

__device__ __forceinline__ void shifted4(const bf16_t* P, int r, int col, const float* mup, const float* mun, float (&o)[4]) {
    const u32x2 p = *(const u32x2*)(P + (size_t)r * N1 + col);
    u32x2 pv = (u32x2){0u, 0u}, nx = (u32x2){0u, 0u};
    if (!(r == 0 || r == CTXL)) pv = *(const u32x2*)(P + (size_t)(r - 1) * N1 + col);
    if (!(r == CTXL - 1 || r == T - 1)) nx = *(const u32x2*)(P + (size_t)(r + 1) * N1 + col);
    const f32x4 mp = *(const f32x4*)(mup + col - R_R), mn = *(const f32x4*)(mun + col - R_R);
    const float pc[4] = {bflo(p.x), bfhi(p.x), bflo(p.y), bfhi(p.y)}, pp[4] = {bflo(pv.x), bfhi(pv.x), bflo(pv.y), bfhi(pv.y)}, pn[4] = {bflo(nx.x), bfhi(nx.x), bflo(nx.y), bfhi(nx.y)};
#pragma unroll
    for (int e = 0; e < 4; ++e) o[e] = pc[e] + mp[e] * (pp[e] - pc[e]) + mn[e] * (pn[e] - pc[e]);
}
__device__ __forceinline__ void st4bf(bf16_t* p, float a0, float a1, float a2, float a3) { u32x2 w; w.x = pk2(a0, a1); w.y = pk2(a2, a3); *(u32x2*)p = w; }
__device__ __forceinline__ void rwkv_xfill(const Args& a, const bf16_t* P, bf16_t* XL, int gtid, int gthreads) {
    const float* mup = a.in[I_MUPREV]; const float* mun = a.in[I_MUNEXT];
    for (int idx = gtid; idx < T * 256; idx += gthreads) {
        const int row = idx >> 8, q = idx & 255, plane = q >> 6, col = (q & 63) * 4;
        float v[4] = {0.f, 0.f, 0.f, 0.f};
        if (plane == 3 || col < 96) {
            shifted4(P, row, R_WDF + (plane == 3 ? 288 : plane * 96) + col, mup, mun, v);
            if (plane < 2) { for (int e = 0; e < 4; ++e) v[e] = tanhf_(v[e]); }
            else if (plane == 3) { for (int e = 0; e < 4; ++e) v[e] = sigmoidf_(v[e]); }
        }
        st4bf(XL + ((size_t)plane * T + row) * 256 + col, v[0], v[1], v[2], v[3]);
    }
}
__device__ __forceinline__ void rwkv_rkv(const Args& a, const bf16_t* P, bf16_t* RP, int gw, int ngw, int lane) {
    const float* mup = a.in[I_MUPREV]; const float* mun = a.in[I_MUNEXT];
    for (int it = gw; it < T * 4; it += ngw) {
        const int r = it >> 2, ch = (it & 3) * 256 + 4 * lane;
        float x[4], k[4], y[4];
        shifted4(P, r, R_R + ch, mup, mun, x); shifted4(P, r, R_K + ch, mup, mun, k); shifted4(P, r, R_V + ch, mup, mun, y);
        bf16_t* rp = RP + (size_t)r * 7168;
        const f32x4 kkc = *(const f32x4*)(a.in[I_KK] + ch);
        float kq[4], ss = 0.f;
#pragma unroll
        for (int e = 0; e < 4; ++e) { kq[e] = k[e] * kkc[e]; ss += kq[e] * kq[e]; }
        ss += __shfl_xor(ss, 1); ss += __shfl_xor(ss, 2); ss += __shfl_xor(ss, 4); ss += __shfl_xor(ss, 8);
        const float rn = __builtin_amdgcn_rsqf(ss + 1e-12f);
        st4bf(rp + ch, x[0], x[1], x[2], x[3]);
        st4bf(rp + 1024 + ch, k[0], k[1], k[2], k[3]);
        st4bf(rp + 2048 + ch, y[0], y[1], y[2], y[3]);
        st4bf(rp + 3072 + ch, kq[0] * rn, kq[1] * rn, kq[2] * rn, kq[3] * rn);
    }
}

__device__ __forceinline__ void moe_tables(LAS unsigned char* lds, const int* blkcnt, int tid) {
    LAS int* tab = (LAS int*)(lds + MOE_TAB_OFF); LAS int* pref = (LAS int*)(lds + PREF_OFF);
    const int lane = tid & 63, e = tid >> 6;
    __syncthreads();
    int cnt[4], run = 0;
#pragma unroll
    for (int i = 0; i < 4; ++i) { cnt[i] = blkcnt[(4 * lane + i) * 8 + e]; run += cnt[i]; }
    int inc = run;
#pragma unroll
    for (int o = 1; o < 64; o <<= 1) { const int v = __shfl_up(inc, o); if (lane >= o) inc += v; }
    int ex = inc - run;
#pragma unroll
    for (int i = 0; i < 4; ++i) { pref[(4 * lane + i) * 8 + e] = ex; ex += cnt[i]; }
    if (lane == 63) tab[e] = inc;
    __syncthreads();
    int off = 0, np = 0, mye = -1;
#pragma unroll
    for (int x = 0; x < 8; ++x) { const int npe = (tab[x] + 255) >> 8; if (tid == 0) tab[8 + x] = off; if (tid >= np && tid < np + npe) mye = x; off += npe * 256; np += npe; }
    if (mye >= 0) tab[18 + tid] = mye;
    if (tid == 0) { tab[16] = off; tab[17] = np; }
    __syncthreads();
}

constexpr int NPH = 23;
__global__ void __launch_bounds__(NTHR, 2) trunk_fwd(Args a) {
    extern __shared__ __attribute__((aligned(16))) unsigned char lds_raw[];
    LAS unsigned char* lds = (LAS unsigned char*)lds_raw;
    const int tid = threadIdx.x, lane = tid & 63, wave = __builtin_amdgcn_readfirstlane(tid >> 6);
    const int bx = blockIdx.x, G = gridDim.x, gw = bx * NWAVES + wave, NGW = G * NWAVES;
    unsigned char* ws = a.ws;
    for (int u = tid; u < (LDS_BYTES - MISC_OFF) / 4; u += NTHR) ((LAS unsigned*)(lds + MISC_OFF))[u] = 0u;
    __syncthreads();
    const int lo = a.ph_lo, hi = a.ph_hi;
    XcdBarrier bar; bar.bar = (unsigned*)(ws + WS_CTL) + CW_BAR; bar.x = 0; bar.st = (volatile LAS unsigned*)(lds + MISC_OFF);
    if (hi - lo > 1) bar = xcd_barrier_post((unsigned*)(ws + WS_CTL) + CW_BAR, (volatile LAS unsigned*)(lds + MISC_OFF));
#ifdef ONLY_PHASE
#define IN(k) ((k) == ONLY_PHASE && lo <= (k) && (k) < hi)
#else
#define IN(k) (lo <= (k) && (k) < hi)
#endif
#define SEAM(k) do { if (IN(k) && IN((k) + 1)) xcd_barrier(bar); } while (0)
#define MODP(l, vec, which) (mod + (size_t)(((l) * 2 + (vec)) * 6 + (which)) * 2048)
    const float* mod = (const float*)(ws + WS_MOD);
    bf16_t* H = (bf16_t*)(ws + WS_H);
    bf16_t* XB = (bf16_t*)(ws + WS_XB);
    float* out = a.out;
    const size_t TS2048 = (size_t)256 * 2048 * 2;

    if (IN(0)) for (int rep_ = 0; rep_ <= (int)((REPMASK >> 0) & 1u); ++rep_) { if (rep_) __syncthreads(); p0_prologue(a, lds, tid, lane, wave); }
    SEAM(0);
    if (IN(1)) for (int rep_ = 0; rep_ <= (int)((REPMASK >> 1) & 1u); ++rep_) { if (rep_) __syncthreads();
        for (int r = gw; r < T; r += NGW) {
            const int vec = r < CTXL ? 1 : 0; const float* xin = vec ? a.in[I_CTX] + (size_t)r * D : a.in[I_X] + (size_t)(r - CTXL) * D;
            f32x4 v[8]; ldrow(xin, lane, v);
            mod_store_i8(v, a.in[I_NMIXPRE0], MODP(0, vec, 1), MODP(0, vec, 0), (signed char*)(ws + WS_H) + (size_t)r * D, (float*)(ws + WS_HSC) + r, lane);
        }
    }
    SEAM(1);
    if (IN(2)) for (int rep_ = 0; rep_ <= (int)((REPMASK >> 2) & 1u); ++rep_) { if (rep_) __syncthreads();
        pg8::SchedPlain S{(const char*)(ws + WS_H), (const char*)(ws + W_IN0T), 65, 21, G, bx, (size_t)256 * 2048, 5 * 65, (const char*)(ws + W_V0T), (const char*)(ws + WS_H), 65, 0};
        pg8::EpiBf16I8 E{(bf16_t*)(ws + A_PROJ0), N0, (bf16_t*)(ws + A_VT), T, (const float*)(ws + WS_HSC), (const float*)(ws + WS_QI0), (const float*)(ws + WS_QV0), (const float*)(ws + WS_HSC)};
        pg8::gemm_phase<pg8::EpiBf16I8, pg8::SchedPlain, true>(lds, 2048, S, E);
    }
    SEAM(2);
    const GLArgs g0{(const bf16_t*)(ws + A_PROJ0), (const bf16_t*)(ws + A_VT), (bf16_t*)(ws + A_KVT0), (float*)(ws + A_DEC0), (bf16_t*)(ws + A_MIX0), a.in[I_LBL], nullptr, nullptr, nullptr, nullptr, a.in[I_HNORM]};
    if (IN(3)) for (int rep_ = 0; rep_ <= (int)((REPMASK >> 3) & 1u); ++rep_) { if (rep_) __syncthreads();
        const float* ropetab = (const float*)(ws + WS_ROPE);
        for (int rq_ = 0; rq_ <= (int)((REPMASK >> 24) & 1u); ++rq_)
        for (int u = bx; u < 520; u += G) {
            const int kind = u < 512 ? 0 : 1, uu = u < 512 ? u : u - 512;
            attn_unit(lds, (const bf16_t*)(ws + A_PROJ0), (const bf16_t*)(ws + A_VT), (bf16_t*)(ws + A_MIX0), a.in[I_SINK], ropetab, kind, uu >> 1, uu & 1, tid);
        }
        for (int rq_ = 0; rq_ <= (int)((REPMASK >> 25) & 1u); ++rq_) gl_phaseA<0>(g0, lds, tid, bx, G);
    }
    SEAM(3);
    if (IN(4)) { gl_phaseB<0, 4>(g0, tid < 256 ? bx * 256 + tid : -1);
        if ((REPMASK >> 23) & 1u) { GLArgs gx = g0; gx.kvt = (bf16_t*)(ws + WS_A + 700 * MiB); gx.dec = (float*)(ws + WS_A + 965 * MiB); gl_phaseB<0, 4>(gx, tid < 256 ? bx * 256 + tid : -1); } }
    SEAM(4);
    if (IN(5)) for (int rep_ = 0; rep_ <= (int)((REPMASK >> 5) & 1u); ++rep_) { if (rep_) __syncthreads(); gl_phaseC<0>(g0, lds, tid, bx, G); }
    SEAM(5);
    if (IN(6)) for (int rep_ = 0; rep_ <= (int)((REPMASK >> 6) & 1u); ++rep_) { if (rep_) __syncthreads();
        pg8::SchedPlain S{(const char*)(ws + A_MIX0), (const char*)(ws + W_OUT0T), 64, 8, G, bx, TS2048, 0, nullptr, nullptr, 1, 1};
        pg8::EpiBf16 E{(bf16_t*)(ws + A_Y0), 2048, nullptr, 0};
        pg8::gemm_phase<pg8::EpiBf16, pg8::SchedPlain>(lds, 4096, S, E);
        pg8::SchedSplit S2{(const char*)(ws + A_MIX0), (const char*)(ws + W_OUT0T), 8, 8, G, bx, TS2048, (size_t)512};
        pg8::EpiF32 E2{(float*)(ws + A_PY0), 2048, (size_t)256 * 2048};
        pg8::gemm_phase<pg8::EpiF32, pg8::SchedSplit>(lds, 4096, S2, E2, 512 + (lo >> 20));
    }
    SEAM(6);
    if (IN(7)) for (int rep_ = 0; rep_ <= (int)((REPMASK >> 7) & 1u); ++rep_) { if (rep_) __syncthreads();
        const bf16_t* Y0 = (const bf16_t*)(ws + A_Y0);
        for (int r = gw; r < T; r += NGW) {
            const int vec = r < CTXL ? 1 : 0; const float* xin = vec ? a.in[I_CTX] + (size_t)r * D : a.in[I_X] + (size_t)(r - CTXL) * D;
            bf16_t* xo = XB + (size_t)r * D;
            f32x4 v[8], b[8]; ldrow(xin, lane, v);
            if (vec) { const float* pp = (const float*)(ws + A_PY0) + (size_t)r * D; ldrow(pp, lane, b);
                for (int ks = 1; ks < 8; ++ks) { f32x4 t2[8]; ldrow(pp + (size_t)ks * 256 * 2048, lane, t2);
#pragma unroll
                    for (int j = 0; j < 8; ++j) b[j] += t2[j]; } }
            else ldrow_bf(Y0 + (size_t)r * D, lane, b);
            add_branch(v, b, a.in[I_NMIXPOST0], MODP(0, vec, 2), lane); strow_bf(xo, lane, v);
            mod_store_i8(v, a.in[I_NFFNPRE0], MODP(0, vec, 4), MODP(0, vec, 3), (signed char*)(ws + WS_H) + (size_t)r * D, (float*)(ws + WS_HSC) + r, lane);
        }
    }
    SEAM(7);
    if (IN(8)) for (int rep_ = 0; rep_ <= (int)((REPMASK >> 8) & 1u); ++rep_) { if (rep_) __syncthreads();
        pg8::SchedPlain S{(const char*)(ws + WS_H), (const char*)(ws + W_GU0T), 65, 44, G, bx, (size_t)256 * 2048, 0, nullptr, nullptr, 1, 0};
        pg8::EpiSwigluI8 E{(bf16_t*)(ws + A_HID0), FF0, (const float*)(ws + WS_HSC), (const float*)(ws + WS_QS0), 0};
        pg8::gemm_phase<pg8::EpiSwigluI8, pg8::SchedPlain, true>(lds, 2048, S, E);
    }
    SEAM(8);
    if (IN(9)) for (int rep_ = 0; rep_ <= (int)((REPMASK >> 9) & 1u); ++rep_) { if (rep_) __syncthreads();
        pg8::SchedPlain S{(const char*)(ws + A_HID0), (const char*)(ws + W_DN0T), 64, 8, G, bx, (size_t)256 * FF0 * 2, 0, nullptr, nullptr, 1, 1};
        pg8::EpiBf16 E{(bf16_t*)(ws + A_F0), 2048, nullptr, 0};
        pg8::gemm_phase<pg8::EpiBf16, pg8::SchedPlain>(lds, 2 * FF0, S, E);
        pg8::SchedSplit S2{(const char*)(ws + A_HID0), (const char*)(ws + W_DN0T), 8, 22, G, bx, (size_t)256 * FF0 * 2, (size_t)512};
        pg8::EpiF32 E2{(float*)(ws + A_PF0), 2048, (size_t)256 * 2048};
        pg8::gemm_phase<pg8::EpiF32, pg8::SchedSplit>(lds, 2 * FF0, S2, E2, 512 + (lo >> 20));
    }
    SEAM(9);
    if (IN(10)) {
        const bf16_t* F0 = (const bf16_t*)(ws + A_F0);
        for (int r = gw; r < T; r += NGW) {
            const int vec = r < CTXL ? 1 : 0; bf16_t* xo = XB + (size_t)r * D;
            f32x4 v[8], b[8]; ldrow_bf(xo, lane, v);
            if (vec) { const float* pp = (const float*)(ws + A_PF0) + (size_t)r * D; ldrow(pp, lane, b);
                for (int ks = 1; ks < 22; ++ks) { f32x4 t2[8]; ldrow(pp + (size_t)ks * 256 * 2048, lane, t2);
#pragma unroll
                    for (int j = 0; j < 8; ++j) b[j] += t2[j]; } }
            else ldrow_bf(F0 + (size_t)r * D, lane, b);
            add_branch(v, b, a.in[I_NFFNPOST0], MODP(0, vec, 5), lane); strow_bf(xo, lane, v);
            mod_store_i8(v, a.in[I_NMIXPRE1], MODP(1, vec, 1), MODP(1, vec, 0), (signed char*)(ws + WS_H) + (size_t)r * D, (float*)(ws + WS_HSC) + r, lane);
        }
    }
    SEAM(10);
    if (IN(11)) for (int rep_ = 0; rep_ <= (int)((REPMASK >> 11) & 1u); ++rep_) { if (rep_) __syncthreads();
        pg8::SchedPlain S{(const char*)(ws + WS_H), (const char*)(ws + W_IN1T), 65, 23, G, bx, (size_t)256 * 2048, 4 * 65, (const char*)(ws + W_GV1T), (const char*)(ws + WS_H), 65, 0};
        pg8::EpiBf16I8 E{(bf16_t*)(ws + A_PROJ1), N1, (bf16_t*)(ws + A_GVT), T, (const float*)(ws + WS_HSC), (const float*)(ws + WS_QI1), (const float*)(ws + WS_QG1), (const float*)(ws + WS_HSC)};
        pg8::gemm_phase<pg8::EpiBf16I8, pg8::SchedPlain, true>(lds, 2048, S, E);
    }
    SEAM(11);
    const GLArgs g1{(const bf16_t*)(ws + A_PROJ1), (const bf16_t*)(ws + A_GVT), (bf16_t*)(ws + A_KVT1), (float*)(ws + A_DEC1), (bf16_t*)(ws + A_MIX1), nullptr, a.in[I_GUPF], a.in[I_GUPB], a.in[I_GBIASF], a.in[I_GBIASB], a.in[I_GLANORM]};
    const RWArgs rwa{(const bf16_t*)(ws + A_RP), (const bf16_t*)(ws + A_GOUT), (bf16_t*)(ws + A_MF), (bf16_t*)(ws + A_NB), (bf16_t*)(ws + A_QB), (bf16_t*)(ws + A_OB), (bf16_t*)(ws + A_MIX1), a.in[I_RK], a.in[I_LNW], a.in[I_LNB], a.in[I_KA]};
    if (IN(12)) for (int rep_ = 0; rep_ <= (int)((REPMASK >> 12) & 1u); ++rep_) { if (rep_) __syncthreads();
        rwkv_xfill(a, (const bf16_t*)(ws + A_PROJ1), (bf16_t*)(ws + A_XL), bx * NTHR + tid, G * NTHR);
        rwkv_rkv(a, (const bf16_t*)(ws + A_PROJ1), (bf16_t*)(ws + A_RP), gw, NGW, lane);
        gl_phaseA<1>(g1, lds, tid, bx, G);
    }
    SEAM(12);
    if (IN(13)) {
        pg8::SchedLora S{(const char*)(ws + A_XL), (const char*)(ws + WS_LORA4), (size_t)T * 512, G, bx};
        pg8::EpiLora E{(bf16_t*)(ws + A_RP), ((long)A_GOUT - (long)A_RP) / 2, (const float*)(ws + WS_LB)};
        pg8::gemm_phase<pg8::EpiLora, pg8::SchedLora>(lds, 512 + (lo >> 20), S, E);
    }
    SEAM(13);
    if (IN(14)) {
        volatile LAS int* ictr = (volatile LAS int*)(lds + MISC_OFF + 1600);
        if (tid == 0) *ictr = 0;
        __syncthreads();
        if (wave >= 4) gl_phaseB<1, 4>(g1, bx * 256 + (tid - 256));
        {
            const int nw = wave < 4 ? (wave == 0 ? 11 : 10) : 6, jb = wave < 4 ? wave : 40 + (wave - 4);
            for (int i = 0; i < nw; ++i) { const int j = (wave == 0 && i == 10) ? 64 : jb + 4 * i; rwkv_stageA(rwa, lds + wave * RW_WAVE_LDS, bx + 256 * j, lane); }
        }
    }
    SEAM(14);
    if (IN(15)) {
        if (bx < 64) rwkv_stageB(rwa, lds, bx, wave, lane);
        else for (int rq_ = 0; rq_ <= (int)((REPMASK >> 29) & 1u); ++rq_) gl_phaseC<1>(g1, lds, tid, bx - 64, G - 64);
    }
    SEAM(15);
    if (IN(16)) for (int rep_ = 0; rep_ <= (int)((REPMASK >> 15) & 1u); ++rep_) { if (rep_) __syncthreads();
        for (int it = gw; it < 16 * (NCHUNK - 8); it += NGW) rwkv_stageC(rwa, it & 15, 8 + (it >> 4), lane);
    }
    SEAM(16);
    if (IN(17)) for (int rep_ = 0; rep_ <= (int)((REPMASK >> 18) & 1u); ++rep_) { if (rep_) __syncthreads();
        pg8::SchedPlain S{(const char*)(ws + A_MIX1), (const char*)(ws + W_OUT1T), 64, 8, G, bx, TS2048, 0, nullptr, nullptr, 1, 0};
        pg8::EpiBf16 E{(bf16_t*)(ws + A_Y1), 2048, nullptr, 0};
        pg8::gemm_phase<pg8::EpiBf16, pg8::SchedPlain>(lds, 4096, S, E);
    }
    SEAM(17);
    int* tk_e = (int*)(ws + WS_TK); float* tk_w = (float*)(ws + WS_TK + 128 * 1024); int* tk_lr = (int*)(ws + WS_TK + 256 * 1024); int* tk_pos = (int*)(ws + WS_TK + 384 * 1024);
    int* blkcnt = (int*)(ws + WS_BLKCNT);
    if (IN(18)) {
        LAS int* ecnt = (LAS int*)(lds + ECNT_OFF);
        if (tid < 8) ecnt[tid] = 0;
        __syncthreads();
        const bf16_t* Y1 = (const bf16_t*)(ws + A_Y1); const float* router = a.in[I_ROUTER];
        for (int t = gw; t < SEQ; t += NGW) {
            f32x4 v[8], b[8]; ldrow_bf(XB + (size_t)(t + CTXL) * D, lane, v); ldrow_bf(Y1 + (size_t)t * D, lane, b);
            add_branch(v, b, a.in[I_NMIXPOST1], MODP(1, 0, 2), lane); strow_bf(XB + (size_t)(t + CTXL) * D, lane, v);
            mod_store(v, a.in[I_NFFNPRE1], MODP(1, 0, 4), MODP(1, 0, 3), H + (size_t)t * D, lane);
            float lg[8];
#pragma unroll
            for (int e = 0; e < 8; ++e) lg[e] = 0.f;
#pragma unroll
            for (int j = 0; j < 8; ++j)
#pragma unroll
                for (int q = 0; q < 4; ++q) { const float* rp = router + (size_t)(4 * lane + 256 * j + q) * 8; const f32x4 r0 = *(const f32x4*)rp, r1 = *(const f32x4*)(rp + 4); const float hv = v[j][q];
                    lg[0] = fmaf(hv, r0[0], lg[0]); lg[1] = fmaf(hv, r0[1], lg[1]); lg[2] = fmaf(hv, r0[2], lg[2]); lg[3] = fmaf(hv, r0[3], lg[3]);
                    lg[4] = fmaf(hv, r1[0], lg[4]); lg[5] = fmaf(hv, r1[1], lg[5]); lg[6] = fmaf(hv, r1[2], lg[6]); lg[7] = fmaf(hv, r1[3], lg[7]); }
#pragma unroll
            for (int e = 0; e < 8; ++e) lg[e] = wave_sum(lg[e]);
            int ea = 0; float va = lg[0];
#pragma unroll
            for (int e = 1; e < 8; ++e) if (lg[e] > va) { va = lg[e]; ea = e; }
            int eb = -1; float vb = -INFINITY;
#pragma unroll
            for (int e = 0; e < 8; ++e) if (e != ea && lg[e] > vb) { vb = lg[e]; eb = e; }
            if (eb < 0) eb = (ea + 1) & 7;
            const float wa = 1.0f / (1.0f + fexp(vb - va)), wb = 1.0f - wa;
            if (lane == 0) {
                const int la = __hip_atomic_fetch_add(ecnt + ea, 1, __ATOMIC_RELAXED, __HIP_MEMORY_SCOPE_WORKGROUP);
                const int lb = __hip_atomic_fetch_add(ecnt + eb, 1, __ATOMIC_RELAXED, __HIP_MEMORY_SCOPE_WORKGROUP);
                tk_e[2 * t] = ea; tk_e[2 * t + 1] = eb; tk_w[2 * t] = wa; tk_w[2 * t + 1] = wb; tk_lr[2 * t] = la; tk_lr[2 * t + 1] = lb;
            }
        }
        __syncthreads();
        if (tid < 8) blkcnt[bx * 8 + tid] = ecnt[tid];
    }
    SEAM(18);
    if (IN(19)) for (int rep_ = 0; rep_ <= (int)((REPMASK >> 20) & 1u); ++rep_) { if (rep_) __syncthreads();
        moe_tables(lds, blkcnt, tid);
        const LAS int* tab = (const LAS int*)(lds + MOE_TAB_OFF); const LAS int* pref = (const LAS int*)(lds + PREF_OFF);
        signed char* SORT = (signed char*)(ws + A_SORT); float* ssc = (float*)(ws + WS_SSC);
        for (int t = gw; t < SEQ; t += NGW) {
            const int b = (t % NGW) / NWAVES;
            const u32x4* src = (const u32x4*)(H + (size_t)t * D); u32x4 hv[4]; float mx = 0.f;
#pragma unroll
            for (int j = 0; j < 4; ++j) { hv[j] = src[lane + 64 * j];
#pragma unroll
                for (int e = 0; e < 4; ++e) mx = fmaxf(mx, fmaxf(fabsf(bflo(hv[j][e])), fabsf(bfhi(hv[j][e])))); }
#pragma unroll
            for (int o = 1; o < 64; o <<= 1) mx = fmaxf(mx, __shfl_xor(mx, o));
            const float inv = mx > 0.f ? 127.0f / mx : 0.f, scl = mx > 0.f ? mx * (1.0f / 127.0f) : 1.0f;
            u32x2 qv[4];
#pragma unroll
            for (int j = 0; j < 4; ++j) { unsigned pk[2];
#pragma unroll
                for (int hq = 0; hq < 2; ++hq) { const unsigned w0 = hv[j][2 * hq], w1 = hv[j][2 * hq + 1];
                    const int q0 = (int)__builtin_rintf(bflo(w0) * inv), q1 = (int)__builtin_rintf(bfhi(w0) * inv), q2 = (int)__builtin_rintf(bflo(w1) * inv), q3 = (int)__builtin_rintf(bfhi(w1) * inv);
                    pk[hq] = (unsigned)(q0 & 0xff) | ((unsigned)(q1 & 0xff) << 8) | ((unsigned)(q2 & 0xff) << 16) | ((unsigned)(q3 & 0xff) << 24); }
                qv[j] = (u32x2){pk[0], pk[1]}; }
#pragma unroll
            for (int sl = 0; sl < 2; ++sl) {
                const int e = tk_e[2 * t + sl], lr = tk_lr[2 * t + sl];
                const int pos = tab[8 + e] + pref[b * 8 + e] + lr;
                if (lane == 0) { tk_pos[2 * t + sl] = pos; ssc[pos] = scl; }
                u32x2* dst = (u32x2*)(SORT + (size_t)pos * D);
#pragma unroll
                for (int j = 0; j < 4; ++j) dst[lane + 64 * j] = qv[j];
            }
        }
    }
    SEAM(19);
    if (IN(20)) for (int rep_ = 0; rep_ <= (int)((REPMASK >> 21) & 1u); ++rep_) { if (rep_) __syncthreads();
        moe_tables(lds, blkcnt, tid);
        const LAS int* tab = (const LAS int*)(lds + MOE_TAB_OFF);
        pg8::SchedMoe S{(const char*)(ws + A_SORT), (const char*)(ws + W_MGUT), (size_t)14336 * 2048, tab[17], 56, G, bx, (size_t)256 * 2048, tab + 18};
        pg8::EpiSwigluI8 E{(bf16_t*)(ws + A_HID1), FFE, (const float*)(ws + WS_SSC), (const float*)(ws + WS_QSM), 14336};
        pg8::gemm_phase<pg8::EpiSwigluI8, pg8::SchedMoe, true>(lds, 2048, S, E);
    }
    SEAM(20);
    if (IN(21)) for (int rep_ = 0; rep_ <= (int)((REPMASK >> 22) & 1u); ++rep_) { if (rep_) __syncthreads();
        moe_tables(lds, blkcnt, tid);
        const LAS int* tab = (const LAS int*)(lds + MOE_TAB_OFF);
        const int nwg = tab[17] * 8, nfull = (nwg >> 8) << 8, rem = nwg - nfull;
        const int split = rem == 0 ? 1 : (rem * 8 <= 256 ? 8 : (rem * 4 <= 256 ? 4 : (rem * 2 <= 256 ? 2 : 1)));
        const size_t kslice = (size_t)(2 * FFE) / split;
        pg8::SchedMoeDown S{(const char*)(ws + A_HID1), (const char*)(ws + W_MDNT), (size_t)2048 * FFE * 2, split > 1 ? nfull : nwg, G, bx, (size_t)256 * FFE * 2, tab + 18, 0, 0, nfull, 0};
        pg8::EpiMoeDown E{(bf16_t*)(ws + A_YDN), (float*)(ws + A_PYD)};
        pg8::gemm_phase<pg8::EpiMoeDown, pg8::SchedMoeDown>(lds, 2 * FFE, S, E);
        if (split > 1) {
            pg8::SchedMoeDown S2{(const char*)(ws + A_HID1), (const char*)(ws + W_MDNT), (size_t)2048 * FFE * 2, 0, G, bx, (size_t)256 * FFE * 2, tab + 18, split, rem, nfull, kslice};
            pg8::gemm_phase<pg8::EpiMoeDown, pg8::SchedMoeDown>(lds, 2 * FFE, S2, E, (int)kslice);
        }
    }
    SEAM(21);
    if (IN(22)) {
        const bf16_t* YDN = (const bf16_t*)(ws + A_YDN); const float* PYD = (const float*)(ws + A_PYD);
        moe_tables(lds, blkcnt, tid);
        const LAS int* tab = (const LAS int*)(lds + MOE_TAB_OFF);
        const int nwg = tab[17] * 8, nfull = (nwg >> 8) << 8, rem = nwg - nfull, pfull = nfull >> 3;
        const int split = rem == 0 ? 1 : (rem * 8 <= 256 ? 8 : (rem * 4 <= 256 ? 4 : (rem * 2 <= 256 ? 2 : 1)));
        for (int t = gw; t < SEQ; t += NGW) {
            f32x4 v[8], b[8]; ldrow_bf(XB + (size_t)(t + CTXL) * D, lane, v);
            const int pa = tk_pos[2 * t], pb = tk_pos[2 * t + 1]; const float wa = tk_w[2 * t], wb = tk_w[2 * t + 1];
            if (split > 1 && ((pa >> 8) >= pfull || (pb >> 8) >= pfull)) {
#pragma unroll
                for (int j = 0; j < 8; ++j) b[j] = (f32x4){0.f, 0.f, 0.f, 0.f};
#pragma unroll 1
                for (int sl = 0; sl < 2; ++sl) { const int pos = sl ? pb : pa; const float w = sl ? wb : wa;
                    if ((pos >> 8) >= pfull) { for (int ks = 0; ks < split; ++ks) { f32x4 t2[8]; ldrow(PYD + ((size_t)(((pos >> 8) - pfull) * split + ks) * 256 + (pos & 255)) * 2048, lane, t2);
#pragma unroll
                            for (int j = 0; j < 8; ++j) b[j] += t2[j] * w; } }
                    else {
#pragma unroll
                        for (int j = 0; j < 8; ++j) { const u32x2 y = *(const u32x2*)(YDN + (size_t)pos * D + 4 * lane + 256 * j); b[j] += (f32x4){bflo(y.x), bfhi(y.x), bflo(y.y), bfhi(y.y)} * w; } } }
                add_branch(v, b, a.in[I_NFFNPOST1], MODP(1, 0, 5), lane); strow(out + (size_t)t * D, lane, v);
                continue;
            }
#pragma unroll
            for (int j = 0; j < 8; ++j) { const u32x2 ya = *(const u32x2*)(YDN + (size_t)pa * D + 4 * lane + 256 * j), yb = *(const u32x2*)(YDN + (size_t)pb * D + 4 * lane + 256 * j);
                b[j] = (f32x4){wa * bflo(ya.x) + wb * bflo(yb.x), wa * bfhi(ya.x) + wb * bfhi(yb.x), wa * bflo(ya.y) + wb * bflo(yb.y), wa * bfhi(ya.y) + wb * bfhi(yb.y)}; }
            add_branch(v, b, a.in[I_NFFNPOST1], MODP(1, 0, 5), lane); strow(out + (size_t)t * D, lane, v);
        }
    }
#undef IN
#undef SEAM
#undef MODP
}

extern "C" void kernel_launch(void* const* d_in, const int* in_sizes, int n_in, void* d_out, int out_size, void* d_ws, size_t ws_size, hipStream_t stream) {
    static int state = 0;
    if (state == 0) {
        state = -1;
        if (n_in != 49 || out_size != SEQ * D || ws_size < WS_END) { fprintf(stderr, "kernel_launch: unexpected shapes (n_in %d, out %d, ws %zu, need %zu)\n", n_in, out_size, ws_size, (size_t)WS_END); return; }
        if (hipFuncSetAttribute((const void*)trunk_fwd, hipFuncAttributeMaxDynamicSharedMemorySize, LDS_BYTES) != hipSuccess) { fprintf(stderr, "kernel_launch: hipFuncSetAttribute failed\n"); return; }
        int per_cu = 0; (void)hipOccupancyMaxActiveBlocksPerMultiprocessor(&per_cu, (const void*)trunk_fwd, NTHR, LDS_BYTES); (void)hipGetLastError();
        if (per_cu < 1) fprintf(stderr, "kernel_launch: occupancy query says %d\n", per_cu);
        state = 1;
    }
    if (state < 0) return;
    (void)hipMemsetAsync((char*)d_ws + WS_CTL, 0, CTL_ZERO_BYTES, stream);
    Args a{};
    for (int i = 0; i < 49; ++i) a.in[i] = (const float*)d_in[i];
    a.out = (float*)d_out; a.ws = (unsigned char*)d_ws;
    const int grid = 256;
#if N_LAUNCH_MODE == 0
    for (int ph = 0; ph < NPH; ++ph) { a.ph_lo = ph; a.ph_hi = ph + 1; hipLaunchKernelGGL(trunk_fwd, dim3(grid), dim3(NTHR), LDS_BYTES, stream, a); }
#else
    a.ph_lo = 0; a.ph_hi = NPH; hipLaunchKernelGGL(trunk_fwd, dim3(grid), dim3(NTHR), LDS_BYTES, stream, a);
#endif
}
```

```cpp
#include <hip/hip_runtime.h>
#include <cstdio>
#include <cstdint>

#define LAS __attribute__((address_space(3)))
#define GAS __attribute__((address_space(1)))
typedef unsigned short bf16_t;
typedef short bf16x8 __attribute__((ext_vector_type(8)));
typedef float f32x4 __attribute__((ext_vector_type(4)));
typedef float f32x2 __attribute__((ext_vector_type(2)));
typedef float f32x16 __attribute__((ext_vector_type(16)));
typedef unsigned u32x4 __attribute__((ext_vector_type(4)));
typedef unsigned u32x2 __attribute__((ext_vector_type(2)));

#ifndef REPMASK
#define REPMASK 0u
#endif
#ifndef N_LAUNCH_MODE
#define N_LAUNCH_MODE 1
#endif

constexpr int D = 2048, SEQ = 16384, CTXL = 256, T = SEQ + CTXL;
constexpr int NWAVES = 8, NTHR = 512;
constexpr float NORM_EPS = 1e-6f;
constexpr int N0 = 5376, P0_QA = 0, P0_KA = 1024, P0_QH = 1280, P0_FF = 2304, P0_FB = 3328, P0_GH = 4352;
constexpr int VT_ROWS = 1280;
constexpr int N1 = 5888, G_Q = 0, G_K = 512, G_GDF = 1024, G_GDB = 1040, G_GR = 1056;
constexpr int R_R = 2080, R_K = 3104, R_V = 4128, R_WDF = 5152, R_WDB = 5248, R_AD = 5344, R_GD = 5440;
constexpr int FF0 = 5632, FFE = 7168, NE = 8;
constexpr int MOE_ROWS = 2 * SEQ + NE * 256;
constexpr int MOE_MAXPAN = MOE_ROWS / 256;
constexpr int NCHUNK = T / 32;

constexpr size_t MiB = (size_t)1 << 20;
constexpr size_t WS_CTL = 0, CTL_ZERO_BYTES = 1 * MiB;
constexpr size_t WS_MOD = 1 * MiB;
constexpr size_t WS_ROPE = WS_MOD + 256 * 1024;
constexpr size_t WS_BLKCNT = WS_ROPE + 128 * 1024;
constexpr size_t WS_TK = 2 * MiB;
constexpr size_t WS_XC = 4 * MiB;
constexpr size_t WS_LORA = 6 * MiB;
constexpr size_t WS_QS0 = WS_LORA + 1280 * 1024;
constexpr size_t WS_QSM = WS_QS0 + 64 * 1024;
constexpr size_t WS_QI0 = WS_TK + 512 * 1024;
constexpr size_t WS_QV0 = WS_QI0 + 32 * 1024;
constexpr size_t WS_QI1 = WS_QV0 + 8 * 1024;
constexpr size_t WS_QG1 = WS_QI1 + 32 * 1024;
constexpr size_t WS_LB = WS_QG1 + 8 * 1024;
constexpr size_t WS_HSC = WS_TK + 1024 * 1024;
constexpr size_t WS_SSC = WS_HSC + 128 * 1024;
constexpr size_t WS_W = 8 * MiB;
constexpr size_t W_IN0T = WS_W;
constexpr size_t W_V0T = W_IN0T + 21 * MiB;
constexpr size_t W_OUT0T = W_V0T + 5 * MiB;
constexpr size_t W_GU0T = W_OUT0T + 8 * MiB;
constexpr size_t W_DN0T = W_GU0T + 44 * MiB;
constexpr size_t W_IN1T = W_DN0T + 22 * MiB;
constexpr size_t W_GV1T = W_IN1T + 23 * MiB;
constexpr size_t W_OUT1T = W_GV1T + 4 * MiB;
constexpr size_t W_MGUT = W_OUT1T + 8 * MiB;
constexpr size_t W_MDNT = W_MGUT + 448 * MiB;
constexpr size_t WS_LORA4 = W_GU0T + 22 * MiB;
constexpr size_t WS_XB = W_MGUT + 224 * MiB;
constexpr size_t WS_H = W_MDNT + 224 * MiB;
constexpr size_t WS_A = WS_H + 66 * MiB;
constexpr size_t A_PROJ0 = WS_A;
constexpr size_t A_VT = WS_A + 171 * MiB;
constexpr size_t A_MIX0 = WS_A + 212 * MiB;
constexpr size_t A_KVT0 = WS_A + 277 * MiB;
constexpr size_t A_DEC0 = WS_A + 537 * MiB;
constexpr size_t A_Y0 = WS_A + 542 * MiB;
constexpr size_t A_PY0 = WS_A + 672 * MiB;
constexpr size_t A_PF0 = WS_A + 690 * MiB;
constexpr size_t A_HID0 = WS_A;
constexpr size_t A_F0 = WS_A + 179 * MiB;
static_assert(A_HID0 + (size_t)T * FF0 * 2 <= A_F0 && A_F0 + (size_t)T * 2048 * 4 <= A_Y0, "layer-0 overlays");
constexpr size_t A_PROJ1 = WS_A;
constexpr size_t A_GVT = WS_A + 187 * MiB;
constexpr size_t A_RP = WS_A + 220 * MiB;
constexpr size_t A_KVT1 = WS_A + 448 * MiB;
constexpr size_t A_DEC1 = WS_A + 708 * MiB;
constexpr size_t A_MF = WS_A + 711 * MiB;
constexpr size_t A_XL = A_MF;
constexpr size_t A_NB = WS_A + 841 * MiB;
constexpr size_t A_MIX1 = WS_A + 971 * MiB;
constexpr size_t A_QB = W_IN0T;
constexpr size_t A_GOUT = W_IN0T + 65 * MiB;
constexpr size_t A_OB = WS_H;
constexpr size_t A_Y1 = WS_A;
constexpr size_t A_SORT = WS_A + 128 * MiB;
constexpr size_t A_HID1 = WS_A + 264 * MiB;
constexpr size_t A_YDN = WS_A + 740 * MiB;
constexpr size_t A_PYD = WS_A + 880 * MiB;
constexpr size_t WS_END = WS_A + 1035 * MiB;
static_assert(A_YDN + (size_t)MOE_ROWS * 2048 * 2 <= A_PYD && A_PYD + (size_t)32 * 256 * 2048 * 4 <= A_MIX1, "moe partials");
static_assert(A_SORT + (size_t)MOE_ROWS * 2048 * 2 <= A_HID1 && A_HID1 + (size_t)MOE_ROWS * FFE * 2 <= A_YDN && A_YDN + (size_t)MOE_ROWS * 2048 * 2 <= A_MIX1, "moe overlay");
static_assert(A_PROJ1 + (size_t)T * N1 * 2 <= A_GVT && A_GVT + (size_t)1024 * T * 2 <= A_RP && A_RP + (size_t)T * 7168 * 2 <= A_KVT1 && A_KVT1 + (size_t)2 * 4 * 520 * 256 * 128 * 2 <= A_DEC1, "layer-1 map");
static_assert(A_MF + (size_t)2 * 16 * 520 * 8192 <= A_NB && A_NB + (size_t)2 * 16 * 520 * 8192 <= A_MIX1 && A_MIX1 + (size_t)SEQ * 2048 * 2 <= WS_END, "layer-1 map 2");
static_assert(A_GOUT + (size_t)T * 1024 * 2 <= W_OUT1T && A_QB + (size_t)2 * T * 1024 * 2 <= A_GOUT && A_OB + (size_t)2 * 16 * 520 * 4096 <= WS_A, "overlays on dead weights / h");
static_assert(A_PROJ0 + (size_t)T * N0 * 2 <= A_VT && A_VT + (size_t)VT_ROWS * T * 2 <= A_MIX0 && A_KVT0 + (size_t)2 * 8 * 520 * 128 * 128 * 2 <= A_DEC0, "layer-0 map");
constexpr int CW_BAR = 4096;

constexpr int LDS_BYTES = 147456;
constexpr int MISC_OFF = 135168;
constexpr int MOE_TAB_OFF = MISC_OFF + 64, ECNT_OFF = MISC_OFF + 1024, PREF_OFF = MISC_OFF + 2048;

__device__ __forceinline__ float bf2f(unsigned b) { return __uint_as_float(b << 16); }
__device__ __forceinline__ float bflo(unsigned w) { return __uint_as_float(w << 16); }
__device__ __forceinline__ float bfhi(unsigned w) { return __uint_as_float(w & 0xffff0000u); }
typedef __bf16 bf16x2_t __attribute__((ext_vector_type(2)));
__device__ __forceinline__ unsigned pk2(float lo, float hi) { const f32x2 v = {lo, hi}; const bf16x2_t b = __builtin_convertvector(v, bf16x2_t); return __builtin_bit_cast(unsigned, b); }
__device__ __forceinline__ unsigned f2bf(float f) { return pk2(f, 0.f) & 0xffffu; }
__device__ __forceinline__ float wave_sum(float v) {
#pragma unroll
    for (int o = 1; o < 64; o <<= 1) v += __shfl_xor(v, o);
    return v;
}
__device__ __forceinline__ float fexp2(float x) { return __builtin_amdgcn_exp2f(x); }
__device__ __forceinline__ float fexp(float x) { return __builtin_amdgcn_exp2f(x * 1.4426950408889634f); }
__device__ __forceinline__ float sigmoidf_(float x) { return __builtin_amdgcn_rcpf(1.0f + fexp(-x)); }
__device__ __forceinline__ float siluf_(float x) { return x * __builtin_amdgcn_rcpf(1.0f + fexp(-x)); }
__device__ __forceinline__ float tanhf_(float x) { return 1.0f - 2.0f * __builtin_amdgcn_rcpf(1.0f + fexp(2.0f * x)); }
#define LDS_WAIT() asm volatile("s_waitcnt lgkmcnt(0)" ::: "memory")
#define VM_WAIT() asm volatile("s_waitcnt vmcnt(0)" ::: "memory")

#define XB_TMO      128
#define XB_XCNT(j)  (256  + 64 * (j))
#define XB_XSUB(j)  (1280 + 64 * (j))
#define XB_XGEN(j)  (2304 + 64 * (j))
#define XB_TOP      3328
#define XB_TOPGEN   3392
#define XCD_BAR_WORDS 3456
#define XB_SPIN_CAP (1u << 24)
__device__ __forceinline__ unsigned xb_ld(unsigned* p)              { return __hip_atomic_load(p, __ATOMIC_RELAXED, __HIP_MEMORY_SCOPE_AGENT); }
__device__ __forceinline__ unsigned xb_add(unsigned* p, unsigned v) { return __hip_atomic_fetch_add(p, v, __ATOMIC_RELAXED, __HIP_MEMORY_SCOPE_AGENT); }
__device__ __forceinline__ unsigned xb_xcc_id() { return (unsigned)__builtin_amdgcn_s_getreg((3 << 11) | 20) & 0xFu; }
#define XB_SPIN(cond, bar) do { unsigned _sp = 0; while (cond) { __builtin_amdgcn_s_sleep(1); \
    if ((++_sp & 255u) == 0u) { if (xb_ld(&(bar)[XB_TMO])) break; if (_sp > XB_SPIN_CAP) { atomicAdd(&(bar)[XB_TMO], 1u); break; } } } } while (0)
struct XcdBarrier { unsigned* bar; unsigned x; volatile LAS unsigned* st; };
__device__ __forceinline__ XcdBarrier xcd_barrier_post(unsigned* bar, volatile LAS unsigned* st) {
    XcdBarrier b; b.bar = bar; b.x = xb_xcc_id(); b.st = st;
    if (threadIdx.x == 0) (void)xb_add(&bar[XB_XCNT(b.x)], 1u);
    return b;
}
__device__ __forceinline__ void xcd_barrier_complete(unsigned* bar, unsigned x, unsigned& nloc, unsigned& nx) {
    const unsigned G = gridDim.x * gridDim.y * gridDim.z;
    unsigned sum, cnt, mine, sp = 0u;
    for (;;) {
        sum = 0u; cnt = 0u; mine = 0u;
#pragma unroll
        for (unsigned j = 0; j < 16; ++j) { const unsigned c = xb_ld(&bar[XB_XCNT(j)]); sum += c; cnt += (c > 0u) ? 1u : 0u; mine = (j == x) ? c : mine; }
        if (sum == G) break;
        __builtin_amdgcn_s_sleep(1);
        if ((++sp & 255u) == 0u) { if (xb_ld(&bar[XB_TMO])) break; if (sp > XB_SPIN_CAP) { atomicAdd(&bar[XB_TMO], 1u); break; } }
    }
    nloc = mine > 0u ? mine : 1u; nx = cnt > 0u ? cnt : 1u;
}
__device__ __forceinline__ void xcd_barrier(const XcdBarrier& b) {
    asm volatile("s_waitcnt vmcnt(0)" ::: "memory");
    __syncthreads();
    if (threadIdx.x == 0) {
        unsigned* bar = b.bar;
        __builtin_amdgcn_s_waitcnt(0);
        unsigned nloc = b.st[0], nx = b.st[1];
        if (nloc == 0u) { xcd_barrier_complete(bar, b.x, nloc, nx); b.st[0] = nloc; b.st[1] = nx; }
        const unsigned old = xb_add(&bar[XB_XSUB(b.x)], 1u);
        const unsigned gen = old / nloc;
        if (old + 1u == (gen + 1u) * nloc) {
            __builtin_amdgcn_fence(__ATOMIC_RELEASE, "agent");
            asm volatile("s_waitcnt vmcnt(0)" ::: "memory");
            const unsigned og = xb_add(&bar[XB_TOP], 1u);
            const unsigned tg = og / nx;
            if (og + 1u == (tg + 1u) * nx) xb_add(&bar[XB_TOPGEN], 1u);
            else XB_SPIN(xb_ld(&bar[XB_TOPGEN]) == tg, bar);
            __builtin_amdgcn_fence(__ATOMIC_ACQUIRE, "agent");
            xb_add(&bar[XB_XGEN(b.x)], 1u);
            asm volatile("s_waitcnt vmcnt(0)" ::: "memory");
        } else {
            XB_SPIN(xb_ld(&bar[XB_XGEN(b.x)]) == gen, bar);
            __builtin_amdgcn_fence(__ATOMIC_ACQUIRE, "agent");
            asm volatile("s_waitcnt vmcnt(0)" ::: "memory");
        }
    }
    __syncthreads();
}

namespace pg8 {
constexpr int BM = 256, BK = 64, HALF = 128, HTB = HALF * BK * 2, STAGE_BYTES = 8 * HTB, NXCD = 8, WGM = 8;
__host__ __device__ __forceinline__ int lds_byte(int r, int c) { const int st = (r >> 4) * 2 + (c >> 5), rr = r & 15, cc = c & 31, ob = rr * 64 + cc * 2; return st * 1024 + (ob ^ (((ob >> 9) & 1) << 5)); }
__host__ __device__ __forceinline__ void stage_rc(int b, int& R, int& C) { const int st = b / 1024, sb = b % 1024, swz = sb ^ (((sb >> 9) & 1) << 5); R = (st >> 1) * 16 + swz / 64; C = (st & 1) * 32 + (swz % 64) / 2; }
__host__ __device__ __forceinline__ int perm32(int rho) { const int n = rho >> 4, i = rho & 15; return 8 * (i >> 2) + 4 * n + (i & 3); }

struct Unit { int pm, pn; const char* a; const char* b; int aux; };

__device__ __forceinline__ void order_map(int wgid, int nM, int nN, int& pm, int& pn) {
    const int nwg = nM * nN;
    { const int q = nwg / NXCD, r = nwg % NXCD, xcd = wgid % NXCD, off = wgid / NXCD; wgid = (xcd < r ? xcd * (q + 1) : r * (q + 1) + (xcd - r) * q) + off; }
    const int nig = WGM * nN, gid = wgid / nig, fm = gid * WGM, gsz = (nM - fm) < WGM ? (nM - fm) : WGM;
    pm = fm + ((wgid % nig) % gsz); pn = (wgid % nig) / gsz;
}
struct SchedPlain {
    const char* A; const char* Bt; int nM, nN, G, c; size_t tstep; int nextra; const char* A2; const char* B2; int nN2; int pm0;
    __device__ __forceinline__ bool next(int i, Unit& u) const {
        const long L = (long)i * G + c; const int nwg = nM * nN;
        if (L >= nwg + nextra) return false;
        if (L >= nwg) { const int j = (int)L - nwg, pm2 = j / nN2, pn2 = j - pm2 * nN2; u.pm = pm2; u.pn = pn2; u.a = A2 + (size_t)pm2 * tstep; u.b = B2 + (size_t)pn2 * tstep; u.aux = 1; return true; }
        int pm, pn; order_map((int)L, nM, nN, pm, pn);
        u.pm = pm + pm0; u.pn = pn; u.a = A + (size_t)(pm + pm0) * tstep; u.b = Bt + (size_t)pn * tstep; u.aux = 0; return true;
    }
};
struct SchedSplit {
    const char* A; const char* Bt; int nN, nsplit, G, c; size_t tstep, kslice;
    __device__ __forceinline__ bool next(int i, Unit& u) const {
        const long L = (long)i * G + c; if (L >= (long)nN * nsplit) return false;
        const int pn = (int)L % nN, ks = (int)L / nN;
        u.pm = 0; u.pn = pn; u.a = A + (size_t)ks * kslice; u.b = Bt + (size_t)pn * tstep + (size_t)ks * kslice; u.aux = ks; return true;
    }
};
struct SchedMoe {
    const char* A; const char* Wt; size_t wstride; int nM, nN, G, c; size_t tstep; const LAS int* pexp;
    __device__ __forceinline__ bool next(int i, Unit& u) const {
        const long L = (long)i * G + c; const int nwg = nM * nN;
        if (L >= nwg) return false;
        int pm, pn; order_map((int)L, nM, nN, pm, pn);
        const int e = pexp[pm];
        u.pm = pm; u.pn = pn; u.a = A + (size_t)pm * tstep; u.b = Wt + (size_t)e * wstride + (size_t)pn * tstep; u.aux = e; return true;
    }
};

struct SchedLora {
    const char* X; const char* Wt; size_t plane; int G, c;
    __device__ __forceinline__ bool next(int i, Unit& u) const {
        const long L = (long)i * G + c; if (L >= 65 * 16) return false;
        int pm, pn; order_map((int)L, 65, 16, pm, pn);
        u.pm = pm; u.pn = pn; u.a = X + (size_t)(pn >> 2) * plane + (size_t)pm * 131072; u.b = Wt + (size_t)pn * 131072; u.aux = pn >> 2; return true;
    }
};
struct SchedMoeDown {
    const char* A; const char* Wt; size_t wstride; int nunits, G, c; size_t tstep; const LAS int* pexp; int split, rem, nfull; size_t kslice;
    __device__ __forceinline__ bool next(int i, Unit& u) const {
        const long L = (long)i * G + c; int Lb = 0, ks = 0;
        int pm, pn;
        if (split == 0) { if (L >= nunits) return false; order_map((int)L, nunits >> 3, 8, pm, pn); }
        else { if (L >= (long)rem * split) return false; Lb = nfull + (int)(L % rem); ks = (int)(L / rem); pm = Lb >> 3; pn = Lb & 7; }
        const int e = pexp[pm];
        u.pm = pm; u.pn = pn; u.a = A + (size_t)pm * tstep + (size_t)ks * kslice; u.b = Wt + (size_t)e * wstride + (size_t)pn * tstep + (size_t)ks * kslice;
        u.aux = split == 0 ? -1 : ((pm - (nfull >> 3)) * split + ks); return true;
    }
};
__device__ __forceinline__ unsigned cvt_pk_bf16(float lo, float hi) { unsigned r; asm volatile("v_cvt_pk_bf16_f32 %0, %1, %2" : "=v"(r) : "v"(lo), "v"(hi)); return r; }
struct EpiBf16 {
    static constexpr bool PERM = true;
    struct Pre {}; __device__ __forceinline__ void prefetch(const Unit&, int, int, int, int, Pre&) const {}
    bf16_t* O; int ldc; bf16_t* O1; int ldc1;
    __device__ __forceinline__ void operator()(const f32x4 (&acc)[2][2][4][2], const Unit& u, int wr, int wc, int fr, int fq, const Pre&) const {
        bf16_t* base = (u.aux == 1 && O1) ? O1 : O; const int ld = (u.aux == 1 && O1) ? ldc1 : ldc;
        const int row0 = u.pm * BM + wr * 64 + fr, col0 = u.pn * BM + wc * 32 + 8 * fq;
#pragma unroll
        for (int ai = 0; ai < 2; ++ai)
#pragma unroll
            for (int m = 0; m < 4; ++m) { bf16_t* rowp = base + (size_t)(row0 + ai * HALF + m * 16) * ld + col0;
#pragma unroll
                for (int bj = 0; bj < 2; ++bj) { const f32x4 v0 = acc[ai][bj][m][0], v1 = acc[ai][bj][m][1];
                    u32x4 w; w.x = cvt_pk_bf16(v0[0], v0[1]); w.y = cvt_pk_bf16(v0[2], v0[3]); w.z = cvt_pk_bf16(v1[0], v1[1]); w.w = cvt_pk_bf16(v1[2], v1[3]);
                    *(u32x4*)(rowp + bj * HALF) = w; } }
    }
};
struct EpiLora {
    static constexpr bool PERM = true;
    struct Pre {}; __device__ __forceinline__ void prefetch(const Unit&, int, int, int, int, Pre&) const {}
    bf16_t* RP; long gdelta; const float* bias3;
    __device__ __forceinline__ void operator()(const f32x4 (&acc)[2][2][4][2], const Unit& u, int wr, int wc, int fr, int fq, const Pre&) const {
        const int kind = u.aux, row0 = u.pm * BM + wr * 64 + fr, ch0 = (u.pn & 3) * BM + wc * 32 + 8 * fq;
        const float* bias = bias3 + (kind < 3 ? kind : 0) * 1024;
        const long poff = kind == 3 ? gdelta : (kind == 0 ? 5120 : (kind == 1 ? 6144 : 4096)); const int ld = kind == 3 ? 1024 : 7168;
        bf16_t* base = RP + poff;
        const float sc = kind < 2 ? -0.6065306597126334f : 1.0f;
        f32x4 bv[2][2];
#pragma unroll
        for (int bj = 0; bj < 2; ++bj)
#pragma unroll
            for (int n = 0; n < 2; ++n) { bv[bj][n] = *(const f32x4*)(bias + ch0 + bj * HALF + 4 * n); if (kind == 3) bv[bj][n] = (f32x4){0.f, 0.f, 0.f, 0.f}; }
#pragma unroll
        for (int ai = 0; ai < 2; ++ai)
#pragma unroll
            for (int m = 0; m < 4; ++m) { bf16_t* rowp = base + (size_t)(row0 + ai * HALF + m * 16) * ld + ch0;
#pragma unroll
                for (int bj = 0; bj < 2; ++bj) { f32x4 v0 = acc[ai][bj][m][0] + bv[bj][0], v1 = acc[ai][bj][m][1] + bv[bj][1];
                    if (kind != 3) {
#pragma unroll
                        for (int j = 0; j < 4; ++j) { v0[j] = sc * __builtin_amdgcn_rcpf(1.0f + __builtin_amdgcn_exp2f(-1.4426950408889634f * v0[j])); v1[j] = sc * __builtin_amdgcn_rcpf(1.0f + __builtin_amdgcn_exp2f(-1.4426950408889634f * v1[j])); } }
                    u32x4 w; w.x = cvt_pk_bf16(v0[0], v0[1]); w.y = cvt_pk_bf16(v0[2], v0[3]); w.z = cvt_pk_bf16(v1[0], v1[1]); w.w = cvt_pk_bf16(v1[2], v1[3]);
                    *(u32x4*)(rowp + bj * HALF) = w; } }
    }
};
struct EpiMoeDown {
    static constexpr bool PERM = true;
    struct Pre {}; __device__ __forceinline__ void prefetch(const Unit&, int, int, int, int, Pre&) const {}
    bf16_t* O; float* P;
    __device__ __forceinline__ void operator()(const f32x4 (&acc)[2][2][4][2], const Unit& u, int wr, int wc, int fr, int fq, const Pre&) const {
        const int rin0 = wr * 64 + fr, col0 = u.pn * BM + wc * 32 + 8 * fq;
        if (u.aux < 0) {
            bf16_t* base = O + (size_t)(u.pm * BM + rin0) * 2048 + col0;
#pragma unroll
            for (int ai = 0; ai < 2; ++ai)
#pragma unroll
                for (int m = 0; m < 4; ++m) { bf16_t* rowp = base + (size_t)(ai * HALF + m * 16) * 2048;
#pragma unroll
                    for (int bj = 0; bj < 2; ++bj) { const f32x4 v0 = acc[ai][bj][m][0], v1 = acc[ai][bj][m][1];
                        u32x4 w; w.x = cvt_pk_bf16(v0[0], v0[1]); w.y = cvt_pk_bf16(v0[2], v0[3]); w.z = cvt_pk_bf16(v1[0], v1[1]); w.w = cvt_pk_bf16(v1[2], v1[3]);
                        *(u32x4*)(rowp + bj * HALF) = w; } }
        } else {
            float* base = P + ((size_t)u.aux * 256 + rin0) * 2048 + col0;
#pragma unroll
            for (int ai = 0; ai < 2; ++ai)
#pragma unroll
                for (int m = 0; m < 4; ++m) { float* rowp = base + (size_t)(ai * HALF + m * 16) * 2048;
#pragma unroll
                    for (int bj = 0; bj < 2; ++bj) { *(f32x4*)(rowp + bj * HALF) = acc[ai][bj][m][0]; *(f32x4*)(rowp + bj * HALF + 4) = acc[ai][bj][m][1]; } }
        }
    }
};
struct EpiF32 {
    static constexpr bool PERM = false;
    struct Pre {}; __device__ __forceinline__ void prefetch(const Unit&, int, int, int, int, Pre&) const {}
    float* C; int ldc; size_t astride;
    __device__ __forceinline__ void operator()(const f32x4 (&acc)[2][2][4][2], const Unit& u, int wr, int wc, int fr, int fq, const Pre&) const {
        const int row0 = u.pm * BM + wr * 64 + fr, col0 = u.pn * BM + wc * 32 + 4 * fq; float* C = this->C + (size_t)u.aux * astride;
#pragma unroll
        for (int ai = 0; ai < 2; ++ai)
#pragma unroll
            for (int m = 0; m < 4; ++m) { float* rowp = C + (size_t)(row0 + ai * HALF + m * 16) * ldc + col0;
#pragma unroll
                for (int bj = 0; bj < 2; ++bj)
#pragma unroll
                    for (int n = 0; n < 2; ++n) *(f32x4*)(rowp + bj * HALF + n * 16) = acc[ai][bj][m][n]; }
    }
};
struct EpiSwiglu {
    static constexpr bool PERM = true;
    struct Pre {}; __device__ __forceinline__ void prefetch(const Unit&, int, int, int, int, Pre&) const {}
    bf16_t* O; int ldc;
    __device__ __forceinline__ void operator()(const f32x4 (&acc)[2][2][4][2], const Unit& u, int wr, int wc, int fr, int fq, const Pre&) const {
        const int row0 = u.pm * BM + wr * 64 + fr, col0 = u.pn * HALF + wc * 32 + 8 * fq;
#pragma unroll
        for (int ai = 0; ai < 2; ++ai)
#pragma unroll
            for (int m = 0; m < 4; ++m) { bf16_t* rowp = O + (size_t)(row0 + ai * HALF + m * 16) * ldc + col0;
                float o[8];
#pragma unroll
                for (int n = 0; n < 2; ++n)
#pragma unroll
                    for (int j = 0; j < 4; ++j) { const float g = acc[ai][0][m][n][j], up = acc[ai][1][m][n][j];
                        o[n * 4 + j] = g * up * __builtin_amdgcn_rcpf(1.0f + __builtin_amdgcn_exp2f(-1.4426950408889634f * g)); }
                u32x4 w; w.x = cvt_pk_bf16(o[0], o[1]); w.y = cvt_pk_bf16(o[2], o[3]); w.z = cvt_pk_bf16(o[4], o[5]); w.w = cvt_pk_bf16(o[6], o[7]);
                *(u32x4*)rowp = w; }
    }
};

typedef int i32x4 __attribute__((ext_vector_type(4)));
struct EpiBf16I8 {
    static constexpr bool PERM = true;
    bf16_t* O; int ldc; bf16_t* O1; int ldc1; const float* sr0; const float* sc0; const float* sr1; const float* sc1;
    struct Pre { float rsv[2]; float csv; };
    __device__ __forceinline__ void prefetch(const Unit& u, int wr, int wc, int fr, int fq, Pre& p) const {
        const bool x = (u.aux == 1 && O1); const float* sr = x ? sr1 : sr0; const float* sc = x ? sc1 : sc0; const int lane = fr + 16 * fq;
        p.rsv[0] = sr[u.pm * BM + wr * 64 + lane]; p.rsv[1] = sr[u.pm * BM + HALF + wr * 64 + lane];
        p.csv = sc[u.pn * BM + wc * 32 + (lane & 31) + (lane >> 5) * HALF];
    }
    __device__ __forceinline__ void operator()(const i32x4 (&acc)[2][2][4][2], const Unit& u, int wr, int wc, int fr, int fq, const Pre& p) const {
        const bool x = (u.aux == 1 && O1);
        bf16_t* base = x ? O1 : O; const int ld = x ? ldc1 : ldc;
        const int row0 = u.pm * BM + wr * 64 + fr, col0 = u.pn * BM + wc * 32 + 8 * fq;
        f32x4 cs[2][2];
#pragma unroll
        for (int bj = 0; bj < 2; ++bj)
#pragma unroll
            for (int n = 0; n < 2; ++n)
#pragma unroll
                for (int j = 0; j < 4; ++j) cs[bj][n][j] = __shfl(p.csv, 32 * bj + 8 * fq + 4 * n + j);
#pragma unroll
        for (int ai = 0; ai < 2; ++ai)
#pragma unroll
            for (int m = 0; m < 4; ++m) { const int r = row0 + ai * HALF + m * 16; const float rs = __shfl(p.rsv[ai], m * 16 + fr); bf16_t* rowp = base + (size_t)r * ld + col0;
#pragma unroll
                for (int bj = 0; bj < 2; ++bj) { const i32x4 a0 = acc[ai][bj][m][0], a1 = acc[ai][bj][m][1]; const f32x4 c0 = cs[bj][0] * rs, c1 = cs[bj][1] * rs;
                    const f32x4 f0 = __builtin_convertvector(a0, f32x4) * c0, f1 = __builtin_convertvector(a1, f32x4) * c1;
                    u32x4 w; w.x = cvt_pk_bf16(f0[0], f0[1]); w.y = cvt_pk_bf16(f0[2], f0[3]); w.z = cvt_pk_bf16(f1[0], f1[1]); w.w = cvt_pk_bf16(f1[2], f1[3]);
                    *(u32x4*)(rowp + bj * HALF) = w; } }
    }
};
struct EpiSwigluI8 {
    static constexpr bool PERM = true;
    bf16_t* O; int ldc; const float* sa; const float* sb; size_t sb_estride;
    struct Pre { float rsv[2]; float csv; };
    __device__ __forceinline__ void prefetch(const Unit& u, int wr, int wc, int fr, int fq, Pre& p) const {
        const int lane = fr + 16 * fq;
        p.rsv[0] = sa[u.pm * BM + wr * 64 + lane]; p.rsv[1] = sa[u.pm * BM + HALF + wr * 64 + lane];
        p.csv = sb[(size_t)u.aux * sb_estride + u.pn * BM + wc * 32 + (lane & 31) + (lane >> 5) * HALF];
    }
    __device__ __forceinline__ void operator()(const i32x4 (&acc)[2][2][4][2], const Unit& u, int wr, int wc, int fr, int fq, const Pre& p) const {
        const int row0 = u.pm * BM + wr * 64 + fr, col0 = u.pn * HALF + wc * 32 + 8 * fq;
        f32x4 sg[2], su[2];
#pragma unroll
        for (int n = 0; n < 2; ++n)
#pragma unroll
            for (int j = 0; j < 4; ++j) { sg[n][j] = __shfl(p.csv, 8 * fq + 4 * n + j); su[n][j] = __shfl(p.csv, 32 + 8 * fq + 4 * n + j); }
#pragma unroll
        for (int ai = 0; ai < 2; ++ai)
#pragma unroll
            for (int m = 0; m < 4; ++m) { const int r = row0 + ai * HALF + m * 16; const float sar = __shfl(p.rsv[ai], m * 16 + fr); bf16_t* rowp = O + (size_t)r * ldc + col0;
                f32x2 o[4];
#pragma unroll
                for (int n = 0; n < 2; ++n)
#pragma unroll
                    for (int jp = 0; jp < 2; ++jp) {
                        const f32x2 cg = {(float)acc[ai][0][m][n][2 * jp], (float)acc[ai][0][m][n][2 * jp + 1]}, cu = {(float)acc[ai][1][m][n][2 * jp], (float)acc[ai][1][m][n][2 * jp + 1]};
                        const f32x2 sgp = {sg[n][2 * jp], sg[n][2 * jp + 1]}, sup = {su[n][2 * jp], su[n][2 * jp + 1]};
                        const f32x2 g = cg * (sgp * sar), up = cu * (sup * sar);
                        const f32x2 t = g * -1.4426950408889634f;
                        const f32x2 d = (f32x2){__builtin_amdgcn_exp2f(t[0]), __builtin_amdgcn_exp2f(t[1])} + 1.0f;
                        const f32x2 rc = {__builtin_amdgcn_rcpf(d[0]), __builtin_amdgcn_rcpf(d[1])};
                        o[n * 2 + jp] = g * up * rc; }
                u32x4 w; w.x = cvt_pk_bf16(o[0][0], o[0][1]); w.y = cvt_pk_bf16(o[1][0], o[1][1]); w.z = cvt_pk_bf16(o[2][0], o[2][1]); w.w = cvt_pk_bf16(o[3][0], o[3][1]);
                *(u32x4*)rowp = w; }
    }
};
template <bool I8> struct MM;
template <> struct MM<false> { typedef f32x4 acc_t; static __device__ __forceinline__ acc_t zero() { return (f32x4){0.f, 0.f, 0.f, 0.f}; }
    static __device__ __forceinline__ acc_t mma(const bf16x8& b, const bf16x8& a, const acc_t& c) { return __builtin_amdgcn_mfma_f32_16x16x32_bf16(b, a, c, 0, 0, 0); } };
template <> struct MM<true> { typedef i32x4 acc_t; static __device__ __forceinline__ acc_t zero() { return (i32x4){0, 0, 0, 0}; }
    static __device__ __forceinline__ acc_t mma(const bf16x8& b, const bf16x8& a, const acc_t& c) { return __builtin_amdgcn_mfma_i32_16x16x64_i8(__builtin_bit_cast(i32x4, b), __builtin_bit_cast(i32x4, a), c, 0, 0, 0); } };
template <class Epi, class Sched, bool I8 = false, bool ALIGN_EPI = true, bool SP2 = true>
__device__ __forceinline__ void gemm_phase(LAS unsigned char* lds, const int Kb, const Sched& S, const Epi& E, const int Kloop = 0) {
    typedef typename MM<I8>::acc_t acc_t;
    const int tid = threadIdx.x, wid = __builtin_amdgcn_readfirstlane(tid >> 6), lane = tid & 63, wr = wid >> 2, wc = wid & 3, fr = lane & 15, fq = lane >> 4;
    const int nt = (Kloop ? Kloop : Kb) / 128;
    unsigned voffA[2], voffB[2];
#pragma unroll
    for (int i = 0; i < 2; ++i) { int R, C; stage_rc(tid * 16 + i * 8192, R, C); const int Rb = Epi::PERM ? ((R & ~31) + perm32(R & 31)) : R;
        voffA[i] = (unsigned)(R * Kb + C * 2); voffB[i] = (unsigned)(Rb * Kb + C * 2); }
    const size_t kstep = (size_t)(BK * 2);
    const size_t hstep = (size_t)HALF * Kb;
    const unsigned ldsw = (unsigned)wid * 1024u;
    const int aoff = lds_byte(wr * 64 + fr, fq * 8), boff = lds_byte(wc * 32 + fr, fq * 8);
#define PG8_SA(b, h) (((b) * 2 + (h)) * HTB)
#define PG8_SB(b, h) ((4 + (b) * 2 + (h)) * HTB)
#define PG8_STAGE(bufoff, gbase, voff) do { _Pragma("unroll") for (int _i = 0; _i < 2; ++_i) \
        __builtin_amdgcn_global_load_lds((const unsigned*)((const char*)(gbase) + (voff)[_i]), (LAS unsigned*)(lds + (bufoff) + ldsw + _i * 8192), 16, 0, 0); } while (0)
#define PG8_LDA(dst, b, h) do { _Pragma("unroll") for (int m = 0; m < 4; ++m) _Pragma("unroll") for (int k = 0; k < 2; ++k) dst[m][k] = *(const LAS bf16x8*)(lds + PG8_SA(b, h) + aoff + m * 2048 + k * 1024); } while (0)
#define PG8_LDB(dst, b, h) do { _Pragma("unroll") for (int n = 0; n < 2; ++n) _Pragma("unroll") for (int k = 0; k < 2; ++k) dst[n][k] = *(const LAS bf16x8*)(lds + PG8_SB(b, h) + boff + n * 2048 + k * 1024); } while (0)
#define PG8_MMA(ai, bj, At, Bt) do { __builtin_amdgcn_s_setprio(1); _Pragma("unroll") for (int m = 0; m < 4; ++m) _Pragma("unroll") for (int n = 0; n < 2; ++n) _Pragma("unroll") for (int k = 0; k < 2; ++k) \
        acc[ai][bj][m][n] = MM<I8>::mma(Bt[n][k], At[m][k], acc[ai][bj][m][n]); __builtin_amdgcn_s_setprio(0); } while (0)
#define PG8_WAIT_V(n) asm volatile("s_waitcnt vmcnt(" #n ")" ::: "memory")
#define PG8_WAIT_L(n) asm volatile("s_waitcnt lgkmcnt(" #n ")" ::: "memory")
#define PG8_BAR __builtin_amdgcn_s_barrier()
#define PG8_SCHED __builtin_amdgcn_sched_barrier(0)
    Unit cur, nxt; int ui = 0;
    if (!S.next(0, cur)) return;
    acc_t acc[2][2][4][2]; typename Epi::Pre pre;
#pragma unroll
    for (int a = 0; a < 2; ++a)
#pragma unroll
        for (int b = 0; b < 2; ++b)
#pragma unroll
            for (int m = 0; m < 4; ++m)
#pragma unroll
                for (int n = 0; n < 2; ++n) acc[a][b][m][n] = MM<I8>::zero();
    bf16x8 At[4][2], B0[2][2], B1[2][2];
    const char* cA = cur.a; const char* cB = cur.b;
    if constexpr (SP2) {
        PG8_STAGE(PG8_SB(0, 0), cB, voffB); PG8_STAGE(PG8_SB(0, 1), cB + hstep, voffB); PG8_STAGE(PG8_SA(0, 0), cA, voffA); PG8_STAGE(PG8_SA(0, 1), cA + hstep, voffA);
        if (wr == 1) PG8_BAR;
        PG8_WAIT_V(2); PG8_BAR;
        PG8_STAGE(PG8_SB(1, 0), cB + kstep, voffB); PG8_STAGE(PG8_SA(1, 0), cA + kstep, voffA); PG8_STAGE(PG8_SB(1, 1), cB + hstep + kstep, voffB);
        PG8_WAIT_V(6); PG8_BAR;
    } else {
        PG8_STAGE(PG8_SB(0, 0), cB, voffB); PG8_STAGE(PG8_SA(0, 0), cA, voffA); PG8_STAGE(PG8_SB(0, 1), cB + hstep, voffB); PG8_STAGE(PG8_SA(0, 1), cA + hstep, voffA);
        if (wr == 1) PG8_BAR;
        PG8_WAIT_V(4); PG8_BAR;
        PG8_STAGE(PG8_SB(1, 0), cB + kstep, voffB); PG8_STAGE(PG8_SA(1, 0), cA + kstep, voffA); PG8_STAGE(PG8_SB(1, 1), cB + hstep + kstep, voffB);
        PG8_WAIT_V(6); PG8_BAR;
    }
    for (;;) {
        const bool has_next = S.next(ui + 1, nxt);
        const char* nA = has_next ? nxt.a : cA; const char* nB = has_next ? nxt.b : cB;
        for (int t = 0; t < nt; t += 2) {
            const bool last = (t == nt - 2);
            if (last) E.prefetch(cur, wr, wc, fr, fq, pre);
            const char* a1 = cA + (size_t)(t + 1) * kstep;
            const char* a2 = last ? nA : cA + (size_t)(t + 2) * kstep; const char* b2 = last ? nB : cB + (size_t)(t + 2) * kstep;
            const char* a3 = a2 + kstep; const char* b3 = b2 + kstep;
            if constexpr (SP2) {
            PG8_LDB(B0, 0, 0); PG8_LDB(B1, 0, 1); PG8_SCHED; PG8_LDA(At, 0, 0); PG8_STAGE(PG8_SA(1, 1), a1 + hstep, voffA);
            PG8_WAIT_V(8); PG8_WAIT_L(0); PG8_BAR; PG8_MMA(0, 0, At, B0); PG8_MMA(0, 1, At, B1); PG8_BAR; PG8_SCHED;
            PG8_LDA(At, 0, 1); PG8_STAGE(PG8_SB(0, 0), b2, voffB); PG8_STAGE(PG8_SB(0, 1), b2 + hstep, voffB); PG8_STAGE(PG8_SA(0, 0), a2, voffA);
            PG8_WAIT_V(8); PG8_WAIT_L(0); PG8_BAR; PG8_MMA(1, 0, At, B0); PG8_MMA(1, 1, At, B1); PG8_BAR; PG8_SCHED;
            PG8_LDB(B0, 1, 0); PG8_LDB(B1, 1, 1); PG8_SCHED; PG8_LDA(At, 1, 0); PG8_STAGE(PG8_SA(0, 1), a2 + hstep, voffA);
            PG8_WAIT_V(8); PG8_WAIT_L(0); PG8_BAR; PG8_MMA(0, 0, At, B0); PG8_MMA(0, 1, At, B1); PG8_BAR; PG8_SCHED;
            PG8_LDA(At, 1, 1); PG8_STAGE(PG8_SB(1, 0), b3, voffB); PG8_STAGE(PG8_SB(1, 1), b3 + hstep, voffB); PG8_STAGE(PG8_SA(1, 0), a3, voffA);
            PG8_WAIT_V(8); PG8_WAIT_L(0); PG8_BAR; PG8_MMA(1, 0, At, B0); PG8_MMA(1, 1, At, B1); PG8_BAR; PG8_SCHED;
            } else {
            PG8_LDB(B0, 0, 0); PG8_SCHED; PG8_LDA(At, 0, 0); PG8_STAGE(PG8_SA(1, 1), a1 + hstep, voffA);
            PG8_WAIT_L(8); PG8_BAR; PG8_WAIT_L(0); PG8_MMA(0, 0, At, B0); PG8_BAR; PG8_SCHED;
            PG8_LDB(B1, 0, 1); PG8_STAGE(PG8_SB(0, 0), b2, voffB);
            PG8_BAR; PG8_WAIT_L(0); PG8_MMA(0, 1, At, B1); PG8_BAR;
            PG8_LDA(At, 0, 1); PG8_STAGE(PG8_SA(0, 0), a2, voffA);
            PG8_BAR; PG8_WAIT_L(0); PG8_MMA(1, 0, At, B0); PG8_BAR; PG8_SCHED;
            PG8_STAGE(PG8_SB(0, 1), b2 + hstep, voffB);
            PG8_WAIT_V(6); PG8_BAR; PG8_MMA(1, 1, At, B1); PG8_BAR;
            PG8_LDB(B0, 1, 0); PG8_SCHED; PG8_LDA(At, 1, 0); PG8_STAGE(PG8_SA(0, 1), a2 + hstep, voffA);
            PG8_WAIT_L(8); PG8_BAR; PG8_WAIT_L(0); PG8_MMA(0, 0, At, B0); PG8_BAR; PG8_SCHED;
            PG8_LDB(B1, 1, 1); PG8_STAGE(PG8_SB(1, 0), b3, voffB);
            PG8_BAR; PG8_WAIT_L(0); PG8_MMA(0, 1, At, B1); PG8_BAR;
            PG8_LDA(At, 1, 1); PG8_STAGE(PG8_SA(1, 0), a3, voffA);
            PG8_BAR; PG8_WAIT_L(0); PG8_MMA(1, 0, At, B0); PG8_BAR; PG8_SCHED;
            PG8_STAGE(PG8_SB(1, 1), b3 + hstep, voffB);
            PG8_WAIT_V(6); PG8_BAR; PG8_MMA(1, 1, At, B1); PG8_BAR;
            }
        }
        if constexpr (ALIGN_EPI) { if (wr == 0) PG8_BAR; }
        E(acc, cur, wr, wc, fr, fq, pre);
        if constexpr ((REPMASK >> 28) & 1u) E(acc, cur, wr, wc, fr, fq, pre);
        if (!has_next) break;
#pragma unroll
        for (int a = 0; a < 2; ++a)
#pragma unroll
            for (int b = 0; b < 2; ++b)
#pragma unroll
                for (int m = 0; m < 4; ++m)
#pragma unroll
                    for (int n = 0; n < 2; ++n) acc[a][b][m][n] = MM<I8>::zero();
        cur = nxt; cA = nA; cB = nB; ++ui;
        if constexpr (ALIGN_EPI) { if (wr == 1) PG8_BAR; }
    }
    PG8_WAIT_V(0);
    if constexpr (!ALIGN_EPI) { if (wr == 0) PG8_BAR; }
    PG8_BAR;
#undef PG8_SA
#undef PG8_SB
#undef PG8_STAGE
#undef PG8_LDA
#undef PG8_LDB
#undef PG8_MMA
#undef PG8_WAIT_V
#undef PG8_WAIT_L
#undef PG8_BAR
#undef PG8_SCHED
}
}

struct Args { const float* in[49]; float* out; unsigned char* ws; int ph_lo, ph_hi; };
enum { I_X = 0, I_C, I_CTX, I_CCTX, I_LBL, I_ADAW0, I_ADAB0, I_NMIXPRE0, I_NMIXPOST0, I_NFFNPRE0, I_NFFNPOST0, I_WIN0, I_WOUT0, I_SINK, I_HNORM, I_FG0, I_FU0, I_FD0,
       I_ADAW1, I_ADAB1, I_NMIXPRE1, I_NMIXPOST1, I_NFFNPRE1, I_NFFNPOST1, I_WIN1, I_WOUT1, I_GUPF, I_GUPB, I_GBIASF, I_GBIASB, I_GLANORM, I_MUPREV, I_MUNEXT, I_W0F, I_W0B, I_W2F, I_W2B,
       I_A0, I_A2, I_G2, I_KK, I_KA, I_RK, I_LNW, I_LNB, I_ROUTER, I_MG, I_MU, I_MD };

__device__ __forceinline__ void tr_item(const float* W, int K, int ld, int ncol0, bf16_t* WT, int drow0, int mode, int nblk, LAS float* scr, int item, int lane) {
    const int kb = item / nblk, nb = item - kb * nblk, k0 = 64 * kb, n0 = ncol0 + 32 * nb;
    int drow; if (mode == 0) drow = drow0 + 32 * nb; else { const int cc = 32 * nb; drow = (cc >> 7) * 256 + (cc & 127) + (mode == 2 ? 128 : 0); }
#pragma unroll 8
    for (int i = 0; i < 32; ++i) { const int kk = 2 * i + (lane >> 5); scr[kk * 33 + (lane & 31)] = __builtin_nontemporal_load(W + (size_t)(k0 + kk) * ld + n0 + (lane & 31)); }
    LDS_WAIT();
    const int c = lane & 7;
#pragma unroll
    for (int j = 0; j < 4; ++j) { const int n = (lane >> 3) + 8 * j; const LAS float* s = scr + (8 * c) * 33 + n;
        u32x4 o; o.x = pk2(s[0 * 33], s[1 * 33]); o.y = pk2(s[2 * 33], s[3 * 33]); o.z = pk2(s[4 * 33], s[5 * 33]); o.w = pk2(s[6 * 33], s[7 * 33]);
        *(u32x4*)(WT + (size_t)(drow + n) * K + k0 + 8 * c) = o; }
    LDS_WAIT();
}

constexpr int Q8_PITCH = 4100;
__device__ __forceinline__ void q8_strip(const float* W, int ld, int ncol0, signed char* dst, float* sdst, int drow0, LAS unsigned char* lds, int tid) {
    LAS unsigned* cmax = (LAS unsigned*)(lds + 32 * Q8_PITCH);
    const int lane = tid & 63, wave = tid >> 6;
    __syncthreads();
    if (tid < 32) cmax[tid] = 0u;
    __syncthreads();
    const int n4 = tid & 7, kr = tid >> 3;
    float mx[4] = {0.f, 0.f, 0.f, 0.f};
#pragma unroll 4
    for (int it = 0; it < 32; ++it) { const int k = it * 64 + kr; const f32x4 v = __builtin_nontemporal_load((const f32x4*)(W + (size_t)k * ld + ncol0 + 4 * n4));
#pragma unroll
        for (int e = 0; e < 4; ++e) { mx[e] = fmaxf(mx[e], fabsf(v[e])); *(LAS bf16_t*)(lds + (4 * n4 + e) * Q8_PITCH + k * 2) = (bf16_t)f2bf(v[e]); } }
#pragma unroll
    for (int e = 0; e < 4; ++e) __hip_atomic_fetch_max(cmax + 4 * n4 + e, __float_as_uint(mx[e]), __ATOMIC_RELAXED, __HIP_MEMORY_SCOPE_WORKGROUP);
    __syncthreads();
#pragma unroll 1
    for (int q = 0; q < 4; ++q) {
        const int n = 4 * wave + q; const float m = __uint_as_float(cmax[n]); const float inv = m > 0.f ? 127.0f / m : 0.f;
        const LAS unsigned* src = (const LAS unsigned*)(lds + n * Q8_PITCH + lane * 64);
        u32x4 o0, o1;
#pragma unroll
        for (int d = 0; d < 8; ++d) { const unsigned w0 = src[2 * d], w1 = src[2 * d + 1];
            const int q0 = (int)__builtin_rintf(bflo(w0) * inv), q1 = (int)__builtin_rintf(bfhi(w0) * inv), q2 = (int)__builtin_rintf(bflo(w1) * inv), q3 = (int)__builtin_rintf(bfhi(w1) * inv);
            const unsigned pk = (unsigned)(q0 & 0xff) | ((unsigned)(q1 & 0xff) << 8) | ((unsigned)(q2 & 0xff) << 16) | ((unsigned)(q3 & 0xff) << 24);
            if (d < 4) o0[d] = pk; else o1[d - 4] = pk; }
        u32x4* dp = (u32x4*)(dst + (size_t)(drow0 + n) * 2048 + 32 * lane);
        dp[0] = o0; dp[1] = o1;
        if (lane == 0) sdst[drow0 + n] = m > 0.f ? m * (1.0f / 127.0f) : 1.0f;
    }
}

__device__ __forceinline__ void p0_prologue(const Args& a, LAS unsigned char* lds, int tid, int lane, int wave) {
    unsigned char* ws = a.ws;
    const int G = gridDim.x, bx = blockIdx.x;
    {
        LAS float* sc = (LAS float*)lds;
        LAS float* red = (LAS float*)(lds + 16384);
        for (int i = tid; i < 2 * D; i += NTHR) { const float v = (i < D) ? a.in[I_C][i] : a.in[I_CCTX][i - D]; sc[i] = siluf_(v); }
        __syncthreads();
        float* mod = (float*)(ws + WS_MOD);
        for (int it = bx; it < 384; it += G) {
            const int l = it / 192, cg = it % 192; const float* W = a.in[l ? I_ADAW1 : I_ADAW0]; const float* B = a.in[l ? I_ADAB1 : I_ADAB0];
            const int col = cg * 64 + lane; float a0 = 0.f, a1 = 0.f;
            const float* wp = W + (size_t)(wave * 256) * 12288 + col;
#pragma unroll 8
            for (int k = 0; k < 256; ++k) { const float w = __builtin_nontemporal_load(wp + (size_t)k * 12288); a0 = fmaf(sc[wave * 256 + k], w, a0); a1 = fmaf(sc[D + wave * 256 + k], w, a1); }
            red[(wave * 2 + 0) * 64 + lane] = a0; red[(wave * 2 + 1) * 64 + lane] = a1;
            __syncthreads();
            if (wave < 2) { float s = 0.f;
#pragma unroll
                for (int w = 0; w < 8; ++w) s += red[(w * 2 + wave) * 64 + lane];
                mod[(size_t)(l * 2 + wave) * 12288 + col] = s + B[col]; }
            __syncthreads();
        }
    }
    {
        float* tab = (float*)(ws + WS_ROPE);
        const int gi = bx * NTHR + tid;
        if (gi < 320 * 32) { const int pos = gi >> 5, f = gi & 31; const int p = pos < 256 ? pos : pos - 256;
            const float inv = exp2f(-(float)f * (13.287712379549449f / 32.0f));
            const float ang = (float)p * inv; float sn, cs; sincosf(ang, &sn, &cs);
            tab[2 * gi] = cs; tab[2 * gi + 1] = sn; }
    }
    {
        bf16_t* wt = (bf16_t*)(ws + WS_LORA4);
        { float* lb = (float*)(ws + WS_LB); const int e = bx * NTHR + tid; if (e < 3072) lb[e] = e < 1024 ? a.in[I_W0F][e] : (e < 2048 ? a.in[I_W0B][e - 1024] : a.in[I_A0][e - 2048]); }
        for (int e = bx * NTHR + tid; e < 4 * 256 * 1024; e += G * NTHR) {
            const int m = e >> 18, kk = (e >> 10) & 255, n = e & 1023; float v = 0.f;
            if (m == 3) v = a.in[I_G2][kk * 1024 + n];
            else if (kk < 96) v = a.in[m == 0 ? I_W2F : (m == 1 ? I_W2B : I_A2)][kk * 1024 + n];
            wt[((size_t)m * 1024 + n) * 256 + kk] = (bf16_t)f2bf(v);
        }
    }
    {
        LAS float* scr = (LAS float*)(lds + wave * 16384);
        const int gw = bx * NWAVES + wave, NGW = G * NWAVES;
        constexpr int S3 = 32 * 64, S6 = 88 * 64, S8 = 32 * 64, SD = 112 * 64;
        constexpr int NIT = S3 + S6 + S8 + 8 * SD;
        for (int it = gw; it < NIT; it += NGW) {
            int r = it;
            if (r < S3) { tr_item(a.in[I_WOUT0], 2048, 2048, 0, (bf16_t*)(ws + W_OUT0T), 0, 0, 64, scr, r, lane); continue; } r -= S3;
            if (r < S6) { tr_item(a.in[I_FD0], 5632, 2048, 0, (bf16_t*)(ws + W_DN0T), 0, 0, 64, scr, r, lane); continue; } r -= S6;
            if (r < S8) { tr_item(a.in[I_WOUT1], 2048, 2048, 0, (bf16_t*)(ws + W_OUT1T), 0, 0, 64, scr, r, lane); continue; } r -= S8;
            { const int e = r / SD; tr_item(a.in[I_MD] + (size_t)e * 7168 * 2048, 7168, 2048, 0, (bf16_t*)(ws + W_MDNT) + (size_t)e * 2048 * 7168, 0, 0, 64, scr, r - e * SD, lane); }
        }
    }
    {
        constexpr int NS0 = 176, NSE = 224, NI0 = 208, NI1 = 210, NITEM = 2 * NS0 + 16 * NSE + NI0 + NI1;
        for (int it = bx; it < NITEM; it += G) {
            int r = it; const float* W; int ld, cc, up; signed char* dst; float* sd;
            if (r >= 2 * NS0 + 16 * NSE) {
                r -= 2 * NS0 + 16 * NSE; int drow;
                if (r < NI0) { cc = 32 * r; W = a.in[I_WIN0]; ld = 6656;
                    if (cc < 1280) { dst = (signed char*)(ws + W_IN0T); sd = (float*)(ws + WS_QI0); drow = cc; }
                    else if (cc < 1536) { dst = (signed char*)(ws + W_V0T); sd = (float*)(ws + WS_QV0); drow = cc - 1280; }
                    else if (cc < 2560) { dst = (signed char*)(ws + W_IN0T); sd = (float*)(ws + WS_QI0); drow = cc - 1536 + 1280; }
                    else if (cc < 3584) { dst = (signed char*)(ws + W_V0T); sd = (float*)(ws + WS_QV0); drow = cc - 2560 + 256; }
                    else { dst = (signed char*)(ws + W_IN0T); sd = (float*)(ws + WS_QI0); drow = cc - 3584 + 2304; } }
                else { cc = 32 * (r - NI0); W = a.in[I_WIN1]; ld = 6720;
                    if (cc < 1024) { dst = (signed char*)(ws + W_IN1T); sd = (float*)(ws + WS_QI1); drow = cc; }
                    else if (cc < 2048) { dst = (signed char*)(ws + W_GV1T); sd = (float*)(ws + WS_QG1); drow = cc - 1024; }
                    else { dst = (signed char*)(ws + W_IN1T); sd = (float*)(ws + WS_QI1); drow = cc - 2048 + 1024; } }
                q8_strip(W, ld, cc, dst, sd, drow, lds, tid);
                continue;
            }
            if (r < 2 * NS0) { up = r / NS0; cc = 32 * (r - up * NS0); W = a.in[up ? I_FU0 : I_FG0]; ld = 5632; dst = (signed char*)(ws + W_GU0T); sd = (float*)(ws + WS_QS0); }
            else { r -= 2 * NS0; const int e = r / (2 * NSE); r -= e * 2 * NSE; up = r / NSE; cc = 32 * (r - up * NSE); W = a.in[up ? I_MU : I_MG] + (size_t)e * 2048 * 7168; ld = 7168;
                   dst = (signed char*)(ws + W_MGUT) + (size_t)e * 14336 * 2048; sd = (float*)(ws + WS_QSM) + (size_t)e * 14336; }
            q8_strip(W, ld, cc, dst, sd, (cc >> 7) * 256 + (cc & 127) + (up ? 128 : 0), lds, tid);
        }
    }
}

__device__ __forceinline__ f32x4 ldp(const float* p, int lane, int j) { return *(const f32x4*)(p + 4 * lane + 256 * j); }
__device__ __forceinline__ void ldrow(const float* p, int lane, f32x4 (&v)[8]) {
#pragma unroll
    for (int j = 0; j < 8; ++j) v[j] = ldp(p, lane, j);
}
__device__ __forceinline__ void ldrow_bf(const bf16_t* p, int lane, f32x4 (&v)[8]) {
#pragma unroll
    for (int j = 0; j < 8; ++j) { const u32x2 y = *(const u32x2*)(p + 4 * lane + 256 * j); v[j] = (f32x4){bflo(y.x), bfhi(y.x), bflo(y.y), bfhi(y.y)}; }
}
__device__ __forceinline__ float rms_scale(const f32x4 (&v)[8]) {
    float s = 0.f;
#pragma unroll
    for (int j = 0; j < 8; ++j) s += (v[j][0] * v[j][0] + v[j][1] * v[j][1]) + (v[j][2] * v[j][2] + v[j][3] * v[j][3]);
    return __builtin_amdgcn_rsqf(wave_sum(s) * (1.0f / D) + NORM_EPS);
}
__device__ __forceinline__ void mod_store(f32x4 (&v)[8], const float* gpre, const float* sc, const float* sh, bf16_t* hrow, int lane) {
    const float rs = rms_scale(v);
#pragma unroll
    for (int j = 0; j < 8; ++j) { const f32x4 g = ldp(gpre, lane, j), s = ldp(sc, lane, j), b = ldp(sh, lane, j);
        v[j] = v[j] * rs * g * (s + 1.0f) + b;
        u32x2 w; w.x = pk2(v[j][0], v[j][1]); w.y = pk2(v[j][2], v[j][3]); *(u32x2*)(hrow + 4 * lane + 256 * j) = w; }
}
__device__ __forceinline__ void mod_store_i8(f32x4 (&v)[8], const float* gpre, const float* sc, const float* sh, signed char* hrow, float* scale_out, int lane) {
    const float rs = rms_scale(v); float mx = 0.f;
#pragma unroll
    for (int j = 0; j < 8; ++j) { const f32x4 g = ldp(gpre, lane, j), s = ldp(sc, lane, j), b = ldp(sh, lane, j);
        v[j] = v[j] * rs * g * (s + 1.0f) + b;
        mx = fmaxf(fmaxf(mx, fmaxf(fabsf(v[j][0]), fabsf(v[j][1]))), fmaxf(fabsf(v[j][2]), fabsf(v[j][3]))); }
#pragma unroll
    for (int o = 1; o < 64; o <<= 1) mx = fmaxf(mx, __shfl_xor(mx, o));
    const float inv = mx > 0.f ? 127.0f / mx : 0.f;
#pragma unroll
    for (int j = 0; j < 8; ++j) { const int q0 = (int)__builtin_rintf(v[j][0] * inv), q1 = (int)__builtin_rintf(v[j][1] * inv), q2 = (int)__builtin_rintf(v[j][2] * inv), q3 = (int)__builtin_rintf(v[j][3] * inv);
        *(unsigned*)(hrow + 4 * lane + 256 * j) = (unsigned)(q0 & 0xff) | ((unsigned)(q1 & 0xff) << 8) | ((unsigned)(q2 & 0xff) << 16) | ((unsigned)(q3 & 0xff) << 24); }
    if (lane == 0) *scale_out = mx > 0.f ? mx * (1.0f / 127.0f) : 1.0f;
}
__device__ __forceinline__ void add_branch(f32x4 (&v)[8], const f32x4 (&b)[8], const float* gpost, const float* gate, int lane) {
    const float rs = rms_scale(b);
#pragma unroll
    for (int j = 0; j < 8; ++j) { const f32x4 g = ldp(gpost, lane, j), gt = ldp(gate, lane, j); v[j] = v[j] + gt * (b[j] * rs * g); }
}
__device__ __forceinline__ void strow_bf(bf16_t* p, int lane, const f32x4 (&v)[8]) {
#pragma unroll
    for (int j = 0; j < 8; ++j) { u32x2 w; w.x = pk2(v[j][0], v[j][1]); w.y = pk2(v[j][2], v[j][3]); *(u32x2*)(p + 4 * lane + 256 * j) = w; }
}
__device__ __forceinline__ void strow(float* p, int lane, const f32x4 (&v)[8]) {
#pragma unroll
    for (int j = 0; j < 8; ++j) *(f32x4*)(p + 4 * lane + 256 * j) = v[j];
}

constexpr int KST = 272, VST = 136, ATT_V_OFF = 64 * KST;
__device__ __forceinline__ void attn_unit(LAS unsigned char* lds, const bf16_t* proj0, const bf16_t* vT, bf16_t* mix, const float* sinks, const float* ropetab,
                                          int kind, int qb, int g, int tid) {
    const int wave = tid >> 6, lane = tid & 63, c = lane & 31, hh = lane >> 5;
    const int head = g * 4 + (wave >> 1), sub = (wave & 1) * 32;
    const int qrow = (kind == 0 ? CTXL + qb * 64 : qb * 64) + sub + c;
    const float qscale = 0.08838834764831845f * 1.4426950408889634f;
    const float* rowtab = ropetab; const float* coltab = ropetab + 256 * 64;
    bf16x8 qf[8];
    {
        const bf16_t* qp = proj0 + (size_t)qrow * N0 + P0_QA + head * 128;
        const int tl = qrow - CTXL;
#pragma unroll
        for (int ax = 0; ax < 2; ++ax)
#pragma unroll
            for (int sp = 0; sp < 2; ++sp) {
                const int d1 = ax * 64 + sp * 16 + hh * 8;
                const u32x4 c1 = *(const u32x4*)(qp + d1), c2 = *(const u32x4*)(qp + d1 + 32);
                float x1[8], x2[8];
#pragma unroll
                for (int e = 0; e < 4; ++e) { x1[2 * e] = bflo(c1[e]); x1[2 * e + 1] = bfhi(c1[e]); x2[2 * e] = bflo(c2[e]); x2[2 * e + 1] = bfhi(c2[e]); }
                if (kind == 0) {
                    const int pos = ax == 0 ? (tl >> 6) : (tl & 63);
                    const float* tb = (ax == 0 ? rowtab : coltab) + (pos * 32 + sp * 16 + hh * 8) * 2;
#pragma unroll
                    for (int e = 0; e < 8; ++e) { const float cs = tb[2 * e], sn = tb[2 * e + 1]; const float o1 = x1[e] * cs - x2[e] * sn, o2 = x1[e] * sn + x2[e] * cs; x1[e] = o1; x2[e] = o2; }
                }
                u32x4 w1, w2;
#pragma unroll
                for (int e = 0; e < 4; ++e) { w1[e] = pk2(x1[2 * e] * qscale, x1[2 * e + 1] * qscale); w2[e] = pk2(x2[2 * e] * qscale, x2[2 * e + 1] * qscale); }
                qf[ax * 4 + sp] = __builtin_bit_cast(bf16x8, w1); qf[ax * 4 + sp + 2] = __builtin_bit_cast(bf16x8, w2);
            }
    }
    float m = sinks[head] * 1.4426950408889634f, lsum = (hh == 0) ? 1.0f : 0.0f;
    f32x16 o[4];
#pragma unroll
    for (int i = 0; i < 4; ++i)
#pragma unroll
        for (int r = 0; r < 16; ++r) o[i][r] = 0.f;
    const int ntile = (kind == 0) ? 9 : 4;
    for (int ti = 0; ti < ntile; ++ti) {
        int krow0, mode = 0; bool rope = false;
        if (ti < 4) krow0 = 64 * ti;
        else { const int j = ti - 6; const int tl0 = qb * 64 + 64 * j; if (tl0 < 0 || tl0 >= SEQ) continue; krow0 = CTXL + tl0; rope = true; mode = (j == -2) ? 1 : (j == 2 ? 2 : 0); }
        __syncthreads();
        {
            const int key = tid >> 3, p = tid & 7, ax = p >> 2, fc = p & 3; const int krow = krow0 + key;
            const bf16_t* kp = proj0 + (size_t)krow * N0 + P0_KA + g * 128 + ax * 64 + fc * 8;
            u32x4 c1 = *(const u32x4*)kp, c2 = *(const u32x4*)(kp + 32);
            if (rope) {
                const int tl = krow - CTXL; const int pos = ax == 0 ? (tl >> 6) : (tl & 63);
                const float* tb = (ax == 0 ? rowtab : coltab) + (pos * 32 + fc * 8) * 2;
                float x1[8], x2[8];
#pragma unroll
                for (int e = 0; e < 4; ++e) { x1[2 * e] = bflo(c1[e]); x1[2 * e + 1] = bfhi(c1[e]); x2[2 * e] = bflo(c2[e]); x2[2 * e + 1] = bfhi(c2[e]); }
#pragma unroll
                for (int e = 0; e < 8; ++e) { const float cs = tb[2 * e], sn = tb[2 * e + 1]; const float o1 = x1[e] * cs - x2[e] * sn, o2 = x1[e] * sn + x2[e] * cs; x1[e] = o1; x2[e] = o2; }
#pragma unroll
                for (int e = 0; e < 4; ++e) { c1[e] = pk2(x1[2 * e], x1[2 * e + 1]); c2[e] = pk2(x2[2 * e], x2[2 * e + 1]); }
            }
            *(LAS u32x4*)(lds + key * KST + (ax * 64 + fc * 8) * 2) = c1;
            *(LAS u32x4*)(lds + key * KST + (ax * 64 + fc * 8 + 32) * 2) = c2;
        }
#pragma unroll
        for (int i = 0; i < 2; ++i) {
            const int idx = tid + NTHR * i, d = idx >> 3, ch = idx & 7;
            const u32x4 v = *(const u32x4*)(vT + (size_t)(g * 128 + d) * T + krow0 + ch * 8);
            LAS u32x2* dst = (LAS u32x2*)(lds + ATT_V_OFF + d * VST + ch * 16);
            dst[0] = (u32x2){v.x, v.y}; dst[1] = (u32x2){v.z, v.w};
        }
        __syncthreads();
        f32x16 p0, p1;
#pragma unroll
        for (int r = 0; r < 16; ++r) { p0[r] = 0.f; p1[r] = 0.f; }
#pragma unroll
        for (int s = 0; s < 8; ++s) {
            const bf16x8 k0 = *(const LAS bf16x8*)(lds + c * KST + (16 * s + 8 * hh) * 2);
            const bf16x8 k1 = *(const LAS bf16x8*)(lds + (32 + c) * KST + (16 * s + 8 * hh) * 2);
            p0 = __builtin_amdgcn_mfma_f32_32x32x16_bf16(k0, qf[s], p0, 0, 0, 0);
            p1 = __builtin_amdgcn_mfma_f32_32x32x16_bf16(k1, qf[s], p1, 0, 0, 0);
        }
        if (mode != 0) {
            const int ii = sub + c;
#pragma unroll
            for (int r = 0; r < 16; ++r) { const int k0i = (r & 3) + 8 * (r >> 2) + 4 * hh, k1i = k0i + 32;
                const bool bad0 = (mode == 1) ? (k0i < ii) : (k0i > ii), bad1 = (mode == 1) ? (k1i < ii) : (k1i > ii);
                if (bad0) p0[r] = -INFINITY; if (bad1) p1[r] = -INFINITY; }
        }
        float mx = p0[0];
#pragma unroll
        for (int r = 0; r < 16; ++r) { mx = fmaxf(mx, p0[r]); mx = fmaxf(mx, p1[r]); }
        mx = fmaxf(mx, __shfl_xor(mx, 32));
        const float mnew = fmaxf(m, mx), alpha = fexp2(m - mnew); m = mnew;
        p0 = p0 - mnew; p1 = p1 - mnew;
#pragma unroll
        for (int r = 0; r < 16; ++r) { p0[r] = fexp2(p0[r]); p1[r] = fexp2(p1[r]); }
        const f32x16 psum = p0 + p1; float rs = 0.f;
#pragma unroll
        for (int r = 0; r < 16; ++r) rs += psum[r];
        lsum = lsum * alpha + rs;
#pragma unroll
        for (int i = 0; i < 4; ++i)
#pragma unroll
            for (int r = 0; r < 16; ++r) o[i][r] *= alpha;
        bf16x8 pf[2][2];
#pragma unroll
        for (int s2 = 0; s2 < 2; ++s2) {
            u32x4 w0, w1;
#pragma unroll
            for (int e = 0; e < 4; ++e) { w0[e] = pk2(p0[8 * s2 + 2 * e], p0[8 * s2 + 2 * e + 1]); w1[e] = pk2(p1[8 * s2 + 2 * e], p1[8 * s2 + 2 * e + 1]); }
            pf[0][s2] = __builtin_bit_cast(bf16x8, w0); pf[1][s2] = __builtin_bit_cast(bf16x8, w1);
        }
#pragma unroll
        for (int dt = 0; dt < 4; ++dt)
#pragma unroll
            for (int kt = 0; kt < 2; ++kt)
#pragma unroll
                for (int s2 = 0; s2 < 2; ++s2) {
                    const LAS unsigned char* vp = lds + ATT_V_OFF + (32 * dt + c) * VST + (32 * kt + 16 * s2 + 4 * hh) * 2;
                    const u32x2 lo = *(const LAS u32x2*)vp, hi = *(const LAS u32x2*)(vp + 16);
                    const u32x4 vv = (u32x4){lo.x, lo.y, hi.x, hi.y};
                    o[dt] = __builtin_amdgcn_mfma_f32_32x32x16_bf16(__builtin_bit_cast(bf16x8, vv), pf[kt][s2], o[dt], 0, 0, 0);
                }
    }
    const float ltot = lsum + __shfl_xor(lsum, 32), inv = 1.0f / ltot;
    bf16_t* op = mix + (size_t)qrow * D + head * 128;
#pragma unroll
    for (int dt = 0; dt < 4; ++dt)
#pragma unroll
        for (int gq = 0; gq < 4; ++gq) {
            u32x2 w; w.x = pk2(o[dt][4 * gq] * inv, o[dt][4 * gq + 1] * inv); w.y = pk2(o[dt][4 * gq + 2] * inv, o[dt][4 * gq + 3] * inv);
            *(u32x2*)(op + 32 * dt + 8 * gq + 4 * hh) = w;
        }
}

__device__ __forceinline__ int row_of(int dir, int n) { return dir == 0 ? n : (n < CTXL ? CTXL - 1 - n : T + CTXL - 1 - n); }

__device__ __forceinline__ float logsigf_(float x) { return fminf(x, 0.f) - __logf(1.0f + fexp(-fabsf(x))); }


template <int MIX> struct GL { static constexpr int NH = MIX ? 4 : 8, V = MIX ? 256 : 128, NVT = V / 32; };
constexpr int GL_KT_STRIDE = 80;
constexpr int GL_QK_STRIDE = 272;
constexpr int GL_RAW_OFF = 70 * 1024;
constexpr int GL_GD_OFF = 120 * 1024;
constexpr int GL_RED_OFF = 130 * 1024;
static_assert(GL_RED_OFF + 1024 <= MISC_OFF, "GL LDS map");
struct GLArgs { const bf16_t* proj; const bf16_t* vT; bf16_t* kvt; float* dec; bf16_t* mix; const float* lbl; const float* upf; const float* upb; const float* biasf; const float* biasb; const float* gain; };

template <int MIX> __device__ __forceinline__ int gl_scan_chunk(int dir, int step) { return dir == 0 ? step : (step < 8 ? 7 - step : NCHUNK + 7 - step); }

template <int MIX, bool NEEDQ>
__device__ __forceinline__ void gl_stage_raw(const GLArgs& g, LAS unsigned char* lds, int R0, int head, int tid) {
    constexpr int NT = MIX == 0 ? (NEEDQ ? 3 : 2) : (NEEDQ ? 2 : 1);
#pragma unroll
    for (int i = 0; i < 2 * NT; ++i) {
        const int idx = tid + NTHR * i, tile = idx >> 10, rem = idx & 1023, row = rem >> 4, ch = rem & 15;
        int col, slot;
        if constexpr (MIX == 0) { slot = tile; col = (tile == 0 ? P0_FF : (tile == 1 ? P0_FB : P0_QH)) + head * 128 + ch * 8; }
        else { slot = tile == 0 ? 0 : 2; col = (tile == 0 ? G_K : G_Q) + head * 128 + ch * 8; }
        const u32x4 v = *(const u32x4*)(g.proj + (size_t)(R0 + row) * (MIX ? N1 : N0) + col);
        *(LAS u32x4*)(lds + GL_RAW_OFF + slot * 16384 + row * 256 + ch * 16) = v;
    }
}
template <int MIX, bool NEEDQ>
__device__ __forceinline__ void gl_load(const LAS unsigned char* lds, int rloc, int k, int dir, unsigned short& x0, unsigned short& x1) {
    x1 = 0;
    x0 = *(const LAS bf16_t*)(lds + GL_RAW_OFF + (MIX == 0 ? dir : 0) * 16384 + rloc * 256 + k * 2);
    if (NEEDQ) x1 = *(const LAS bf16_t*)(lds + GL_RAW_OFF + 2 * 16384 + rloc * 256 + k * 2);
}
template <int MIX, bool NEEDQ>
__device__ __forceinline__ void gl_comp(unsigned short x0, unsigned short x1, float lbk, const float (&up)[16], float bias, const LAS float* gdrow, float& d, float& kv, float& q) {
    if constexpr (MIX == 0) {
        const float f = lbk + (1.0f - lbk) * sigmoidf_(bf2f(x0));
        d = f; kv = 1.0f - f; if (NEEDQ) q = siluf_(bf2f(x1));
    } else {
        f32x2 xa = {bias, 0.f};
#pragma unroll
        for (int q4 = 0; q4 < 4; ++q4) { const f32x4 gd = *(const LAS f32x4*)(gdrow + 4 * q4);
            xa = __builtin_elementwise_fma((f32x2){gd[0], gd[1]}, (f32x2){up[4 * q4], up[4 * q4 + 1]}, xa);
            xa = __builtin_elementwise_fma((f32x2){gd[2], gd[3]}, (f32x2){up[4 * q4 + 2], up[4 * q4 + 3]}, xa); }
        const float x = xa[0] + xa[1];
        d = fexp(logsigf_(x) * 0.0625f); kv = bf2f(x0); if (NEEDQ) q = bf2f(x1) * 0.08838834764831845f;
    }
}
template <int MIX>
__device__ __forceinline__ void gl_stage_gd(const GLArgs& g, LAS unsigned char* lds, int R0, int tid) {
    if constexpr (MIX == 1) {
        LAS float* gds = (LAS float*)(lds + GL_GD_OFF);
        for (int idx = tid; idx < 2048; idx += NTHR) { const int row = idx >> 5, dj = idx & 31, dir = dj >> 4, j = dj & 15;
            gds[(dir * 64 + row) * 16 + j] = bf2f(g.proj[(size_t)(R0 + row) * N1 + (dir ? G_GDB : G_GDF) + j]); }
    }
}
template <int MIX>
__device__ __forceinline__ void gl_walker_consts(const GLArgs& g, int head, int k, int dir, float& lbk, float (&up)[16], float& bias) {
    lbk = 0.f; bias = 0.f;
#pragma unroll
    for (int j = 0; j < 16; ++j) up[j] = 0.f;
    if constexpr (MIX == 0) { const int kk = head * 128 + k; lbk = 1.0f / (1.0f + fexp(g.lbl[1024 + kk] - g.lbl[kk])); }
    else { const float* upp = dir ? g.upb : g.upf; const int ch = head * 128 + k;
#pragma unroll
        for (int j = 0; j < 16; ++j) up[j] = upp[j * 512 + ch];
        bias = (dir ? g.biasb : g.biasf)[ch]; }
}

template <int MIX>
__device__ __forceinline__ void gl_phaseA(const GLArgs& g, LAS unsigned char* lds, int tid, int bid, int nblk) {
    constexpr int NH = GL<MIX>::NH, V = GL<MIX>::V, NVT = GL<MIX>::NVT;
    const int lane = tid & 63, wave = tid >> 6, c = lane & 31, hh = lane >> 5;
    const int wk = tid & 127, wc2 = (tid >> 7) & 1, wdir = tid >> 8;
    const int dir = wave >> 2, c2 = (wave >> 1) & 1, kh = wave & 1;
    for (int item = bid; item < NH * (T / 64); item += nblk) {
        const int head = item % NH, nb = item / NH, R0 = nb * 64;
        __syncthreads();
        gl_stage_gd<MIX>(g, lds, R0, tid); gl_stage_raw<MIX, false>(g, lds, R0, head, tid);
        const int rbase = R0 + 32 * c2, cr = (R0 >> 5) + c2;
        const bf16_t* vsrc = g.vT + (size_t)((MIX ? 0 : 256) + head * V) * T + rbase;
        bf16x8 bfv[NVT][2];
#pragma unroll
        for (int vt = 0; vt < NVT; ++vt)
#pragma unroll
            for (int s = 0; s < 2; ++s) bfv[vt][s] = *(const bf16x8*)(vsrc + (size_t)(32 * vt + c) * T + 16 * s + 8 * hh);
        float lbk, up[16], bias; gl_walker_consts<MIX>(g, head, wk, wdir, lbk, up, bias);
        __syncthreads();
        {
            float tail = 1.0f;
            LAS bf16_t* kt = (LAS bf16_t*)(lds + (wdir * 2 + wc2) * (128 * GL_KT_STRIDE) + wk * GL_KT_STRIDE);
#pragma unroll 8
            for (int s = 0; s < 32; ++s) {
                const int t = wdir == 0 ? 31 - s : s; unsigned short x0, x1; gl_load<MIX, false>(lds, 32 * wc2 + t, wk, wdir, x0, x1);
                float d, kv, q; gl_comp<MIX, false>(x0, x1, lbk, up, bias, (const LAS float*)(lds + GL_GD_OFF) + (wdir * 64 + 32 * wc2 + t) * 16, d, kv, q);
                kt[t] = (bf16_t)f2bf(kv * tail); tail *= d;
            }
            g.dec[((size_t)(wdir * NH + head) * NCHUNK + (R0 >> 5) + wc2) * 128 + wk] = tail;
        }
        __syncthreads();
        {
            const LAS unsigned char* ktile = lds + (dir * 2 + c2) * (128 * GL_KT_STRIDE);
            bf16x8 af[2][2];
#pragma unroll
            for (int kt2 = 0; kt2 < 2; ++kt2)
#pragma unroll
                for (int s = 0; s < 2; ++s) af[kt2][s] = *(const LAS bf16x8*)(ktile + (32 * (2 * kh + kt2) + c) * GL_KT_STRIDE + (16 * s + 8 * hh) * 2);
            bf16_t* kvo = g.kvt + ((size_t)(dir * NH + head) * NCHUNK + cr) * (V * 128);
#pragma unroll
            for (int pass = 0; pass < NVT / 4; ++pass) {
                f32x16 acc[4][2];
#pragma unroll
                for (int vt = 0; vt < 4; ++vt)
#pragma unroll
                    for (int kt2 = 0; kt2 < 2; ++kt2)
#pragma unroll
                        for (int r = 0; r < 16; ++r) acc[vt][kt2][r] = 0.f;
#pragma unroll
                for (int vt = 0; vt < 4; ++vt)
#pragma unroll
                    for (int s = 0; s < 2; ++s)
#pragma unroll
                        for (int kt2 = 0; kt2 < 2; ++kt2) acc[vt][kt2] = __builtin_amdgcn_mfma_f32_32x32x16_bf16(bfv[4 * pass + vt][s], af[kt2][s], acc[vt][kt2], 0, 0, 0);
#pragma unroll
                for (int vt = 0; vt < 4; ++vt)
#pragma unroll
                    for (int kt2 = 0; kt2 < 2; ++kt2)
#pragma unroll
                        for (int r = 0; r < 16; ++r) {
                            const int v = 32 * (4 * pass + vt) + (r & 3) + 8 * (r >> 2) + 4 * hh;
                            kvo[(size_t)v * 128 + 32 * (2 * kh + kt2) + c] = (bf16_t)f2bf(acc[vt][kt2][r]);
                        }
            }
        }
    }
}

template <int MIX, int KPT>
__device__ __forceinline__ void gl_phaseB(const GLArgs& g, int gidx) {
    constexpr int NH = GL<MIX>::NH, V = GL<MIX>::V, KG = 128 / KPT;
    if (gidx < 0 || gidx >= 2 * NH * V * KG) return;
    const int kq = gidx % KG; int rest = gidx / KG; const int v = rest % V; rest /= V; const int head = rest % NH, dir = rest / NH;
    bf16_t* base = g.kvt + (size_t)(dir * NH + head) * NCHUNK * (V * 128) + (size_t)v * 128 + KPT * kq;
    const float* dbase = g.dec + (size_t)(dir * NH + head) * NCHUNK * 128 + KPT * kq;
    float st[KPT];
#pragma unroll
    for (int e = 0; e < KPT; ++e) st[e] = 0.f;
    constexpr int UB = 10;
    unsigned kv[UB][KPT / 2], kvn[UB][KPT / 2]; float dd[UB][KPT], ddn[UB][KPT];
#define GLB_LOAD(KV, DD, ST0) do { _Pragma("unroll") for (int u = 0; u < UB; ++u) { const int cr_ = gl_scan_chunk<MIX>(dir, (ST0) + u); \
        if constexpr (KPT == 4) { const u32x2 k_ = *(const u32x2*)(base + (size_t)cr_ * (V * 128)); KV[u][0] = k_.x; KV[u][1] = k_.y; const f32x4 d_ = *(const f32x4*)(dbase + (size_t)cr_ * 128); DD[u][0] = d_[0]; DD[u][1] = d_[1]; DD[u][2] = d_[2]; DD[u][3] = d_[3]; } \
        else { _Pragma("unroll") for (int e = 0; e < KPT / 2; ++e) KV[u][e] = *((const unsigned*)(base + (size_t)cr_ * (V * 128)) + e); \
        _Pragma("unroll") for (int e = 0; e < KPT; ++e) DD[u][e] = dbase[(size_t)cr_ * 128 + e]; } } } while (0)
    GLB_LOAD(kv, dd, 0);
    for (int st0 = 0; st0 < NCHUNK; st0 += UB) {
        if (st0 + UB < NCHUNK) GLB_LOAD(kvn, ddn, st0 + UB);
#pragma unroll
        for (int u = 0; u < UB; ++u) { const int cr = gl_scan_chunk<MIX>(dir, st0 + u);
            if constexpr (KPT == 4) { *(u32x2*)(base + (size_t)cr * (V * 128)) = (u32x2){pk2(st[0], st[1]), pk2(st[2], st[3])}; }
#pragma unroll
            for (int e = 0; e < KPT / 2; ++e) { if constexpr (KPT != 4) *((unsigned*)(base + (size_t)cr * (V * 128)) + e) = pk2(st[2 * e], st[2 * e + 1]);
                st[2 * e] = fmaf(dd[u][2 * e], st[2 * e], bflo(kv[u][e])); st[2 * e + 1] = fmaf(dd[u][2 * e + 1], st[2 * e + 1], bfhi(kv[u][e])); } }
#pragma unroll
        for (int u = 0; u < UB; ++u) {
#pragma unroll
            for (int e = 0; e < KPT / 2; ++e) kv[u][e] = kvn[u][e];
#pragma unroll
            for (int e = 0; e < KPT; ++e) dd[u][e] = ddn[u][e]; }
    }
#undef GLB_LOAD
}

template <int MIX>
__device__ __forceinline__ void gl_phaseC(const GLArgs& g, LAS unsigned char* lds, int tid, int bid, int nblk) {
    constexpr int NH = GL<MIX>::NH, V = GL<MIX>::V, NVT = GL<MIX>::NVT, NP = NVT / 4;
    const int lane = tid & 63, wave = tid >> 6, c = lane & 31, hh = lane >> 5;
    const int wk = tid & 127, wc2 = (tid >> 7) & 1, wdir = tid >> 8;
    constexpr int TILE = 32 * GL_QK_STRIDE;
    for (int item = bid; item < NH * (T / 64); item += nblk) {
        const int head = item % NH, nb = item / NH, R0 = nb * 64;
        if (MIX == 1 && R0 < CTXL) continue;
        __syncthreads();
        gl_stage_gd<MIX>(g, lds, R0, tid); gl_stage_raw<MIX, true>(g, lds, R0, head, tid);
        const int c2 = wave >> 2, vg = wave & 3, rbase = R0 + 32 * c2, cr = (R0 >> 5) + c2;
        bf16x8 sf2[2][8]; u32x4 vf2[2][NP][2];
#pragma unroll
        for (int dir = 0; dir < 2; ++dir) {
            const bf16_t* sb_ = g.kvt + ((size_t)(dir * NH + head) * NCHUNK + cr) * (V * 128);
#pragma unroll
            for (int p = 0; p < NP; ++p) {
                const int vrow = 32 * (vg + 4 * p) + c;
                const bf16_t* vp = g.vT + (size_t)((MIX ? 0 : 256) + head * V + vrow) * T + rbase;
#pragma unroll
                for (int s2 = 0; s2 < 2; ++s2) { const u32x2 lo = *(const u32x2*)(vp + 16 * s2 + 4 * hh), hi = *(const u32x2*)(vp + 16 * s2 + 8 + 4 * hh); vf2[dir][p][s2] = (u32x4){lo.x, lo.y, hi.x, hi.y}; }
            }
#pragma unroll
            for (int s = 0; s < 8; ++s) sf2[dir][s] = *(const bf16x8*)(sb_ + (size_t)(32 * vg + c) * 128 + 16 * s + 8 * hh);
        }
        float lbk, up[16], bias; gl_walker_consts<MIX>(g, head, wk, wdir, lbk, up, bias);
        __syncthreads();
        {
            const int rbase = R0 + 32 * wc2; float P = 1.0f;
            LAS unsigned char* qt = lds + ((wdir * 2 + wc2) * 2) * TILE; LAS unsigned char* kt = qt + TILE;
#pragma unroll 8
            for (int s = 0; s < 32; ++s) {
                const int t = wdir == 0 ? s : 31 - s; unsigned short x0, x1; gl_load<MIX, true>(lds, 32 * wc2 + t, wk, wdir, x0, x1);
                float d, kv, q; gl_comp<MIX, true>(x0, x1, lbk, up, bias, (const LAS float*)(lds + GL_GD_OFF) + (wdir * 64 + 32 * wc2 + t) * 16, d, kv, q);
                P *= d;
                *(LAS bf16_t*)(qt + t * GL_QK_STRIDE + wk * 2) = (bf16_t)f2bf(q * P);
                *(LAS bf16_t*)(kt + t * GL_QK_STRIDE + wk * 2) = (bf16_t)f2bf(kv * fminf(__builtin_amdgcn_rcpf(P), 1e30f));
            }
        }
        __syncthreads();
        f32x16 o[NP];
#pragma unroll
        for (int p = 0; p < NP; ++p)
#pragma unroll
            for (int r = 0; r < 16; ++r) o[p][r] = 0.f;
        __builtin_amdgcn_sched_barrier(0);
#pragma unroll
        for (int dir = 0; dir < 2; ++dir) {
            const LAS unsigned char* qt = lds + ((dir * 2 + c2) * 2) * TILE; const LAS unsigned char* kt = qt + TILE;
            const bf16_t* sbase = g.kvt + ((size_t)(dir * NH + head) * NCHUNK + cr) * (V * 128);
            bf16x8 sf[8]; u32x4 vf[NP][2];
#pragma unroll
            for (int s = 0; s < 8; ++s) sf[s] = sf2[dir][s];
#pragma unroll
            for (int p = 0; p < NP; ++p) { vf[p][0] = vf2[dir][p][0]; vf[p][1] = vf2[dir][p][1]; }
            bf16x8 qf[8];
            f32x16 x;
#pragma unroll
            for (int r = 0; r < 16; ++r) x[r] = 0.f;
#pragma unroll
            for (int s = 0; s < 8; ++s) { qf[s] = *(const LAS bf16x8*)(qt + c * GL_QK_STRIDE + (16 * s + 8 * hh) * 2);
                const bf16x8 kf = *(const LAS bf16x8*)(kt + c * GL_QK_STRIDE + (16 * s + 8 * hh) * 2);
                x = __builtin_amdgcn_mfma_f32_32x32x16_bf16(kf, qf[s], x, 0, 0, 0); }
#pragma unroll
            for (int r = 0; r < 16; ++r) { const int j = (r & 3) + 8 * (r >> 2) + 4 * hh; const bool keep = dir == 0 ? (j <= c) : (j >= c); if (!keep) x[r] = 0.f; }
            bf16x8 xf[2];
#pragma unroll
            for (int s2 = 0; s2 < 2; ++s2) { u32x4 w;
#pragma unroll
                for (int e = 0; e < 4; ++e) w[e] = pk2(x[8 * s2 + 2 * e], x[8 * s2 + 2 * e + 1]);
                xf[s2] = __builtin_bit_cast(bf16x8, w); }
#pragma unroll
            for (int p = 0; p < NP; ++p) {
                bf16x8 sn[8];
                if (p + 1 < NP) {
#pragma unroll
                    for (int s = 0; s < 8; ++s) sn[s] = *(const bf16x8*)(sbase + (size_t)(32 * (vg + 4 * (p + 1)) + c) * 128 + 16 * s + 8 * hh);
                }
                __builtin_amdgcn_sched_barrier(0);
#pragma unroll
                for (int s2 = 0; s2 < 2; ++s2) o[p] = __builtin_amdgcn_mfma_f32_32x32x16_bf16(__builtin_bit_cast(bf16x8, vf[p][s2]), xf[s2], o[p], 0, 0, 0);
#pragma unroll
                for (int s = 0; s < 8; ++s) o[p] = __builtin_amdgcn_mfma_f32_32x32x16_bf16(sf[s], qf[s], o[p], 0, 0, 0);
                if (p + 1 < NP) {
#pragma unroll
                    for (int s = 0; s < 8; ++s) sf[s] = sn[s];
                }
            }
        }
        float ss = 0.f;
#pragma unroll
        for (int p = 0; p < NP; ++p)
#pragma unroll
            for (int r = 0; r < 16; ++r) ss += o[p][r] * o[p][r];
        ss += __shfl_xor(ss, 32);
        LAS float* red = (LAS float*)(lds + GL_RED_OFF);
        if (hh == 0) red[(c2 * 4 + vg) * 32 + c] = ss;
        __syncthreads();
        const float tot = (red[(c2 * 4 + 0) * 32 + c] + red[(c2 * 4 + 1) * 32 + c]) + (red[(c2 * 4 + 2) * 32 + c] + red[(c2 * 4 + 3) * 32 + c]);
        const float rs = __builtin_amdgcn_rsqf(tot * (1.0f / V) + NORM_EPS);
        const int r = rbase + c;
#pragma unroll
        for (int p = 0; p < NP; ++p)
#pragma unroll
            for (int gq = 0; gq < 4; ++gq) {
                const int v0 = 32 * (vg + 4 * p) + 8 * gq + 4 * hh;
                const f32x4 gn = *(const f32x4*)(g.gain + v0);
                const u32x2 gt = *(const u32x2*)(g.proj + (size_t)r * (MIX ? N1 : N0) + (MIX ? G_GR : P0_GH) + head * V + v0);
                u32x2 w; w.x = pk2(o[p][4 * gq] * rs * gn[0] * siluf_(bflo(gt.x)), o[p][4 * gq + 1] * rs * gn[1] * siluf_(bfhi(gt.x)));
                w.y = pk2(o[p][4 * gq + 2] * rs * gn[2] * siluf_(bflo(gt.y)), o[p][4 * gq + 3] * rs * gn[3] * siluf_(bfhi(gt.y)));
                bf16_t* op = MIX ? g.mix + (size_t)(r - CTXL) * D + head * V + v0 : g.mix + (size_t)r * D + 1024 + head * V + v0;
                *(u32x2*)op = w;
            }
    }
}

constexpr int RW_TS = 144, RW_TILE = 32 * RW_TS, RW_WAVE_LDS = 14336;
__host__ __device__ constexpr int rw_tri(int t) { return t <= 0 ? 0 : ((t - 1) / 4 + 1) * (2 * ((t - 1) / 4) + (t - 1) % 4); }
constexpr int RW_TRI_BYTES = 16 * rw_tri(32);
#ifndef RW_LB
#define RW_LB 2
#endif
static_assert(RW_TRI_BYTES + 2048 <= RW_TILE, "triangle rows + the parked fragments must fit the third tile slot");
struct RWArgs { const bf16_t* RP; const bf16_t* GOUT; bf16_t* MF; bf16_t* NB; bf16_t* QB; bf16_t* OB; bf16_t* mix; const float* rk; const float* lnw; const float* lnb; const float* ka; };
__device__ __forceinline__ int rw_scan_chunk(int dir, int cs) { return dir == 0 ? cs : (cs < 8 ? 7 - cs : NCHUNK + 7 - cs); }
__device__ __forceinline__ float rdlane(float v, int l) { return __int_as_float(__builtin_amdgcn_readlane(__float_as_int(v), l)); }
template <bool PERM>
__device__ __forceinline__ void rw_pack(const float (&x)[32], int hh, u32x4 (&f)[2][2]) {
#pragma unroll
    for (int s2 = 0; s2 < 2; ++s2)
#pragma unroll
        for (int e = 0; e < 4; ++e) {
            const int t0 = PERM ? 16 * s2 + 8 * ((2 * e) >> 2) + ((2 * e) & 3) : 16 * s2 + 2 * e;
            const int t1 = PERM ? t0 + 4 : t0 + 8;
            const unsigned p0 = pk2(x[t0], x[t0 + 1]), p1 = pk2(x[t1], x[t1 + 1]);
            const auto rr = __builtin_amdgcn_permlane32_swap(p0, p1, false, false);
            f[0][s2][e] = rr[0]; f[1][s2][e] = rr[1];
        }
    (void)hh;
}
__device__ __forceinline__ void rw_pack_pairs(const unsigned (&xp)[16], int hh, u32x4 (&f)[2][2]) {
#pragma unroll
    for (int s2 = 0; s2 < 2; ++s2)
#pragma unroll
        for (int e = 0; e < 4; ++e) { const auto rr = __builtin_amdgcn_permlane32_swap(xp[8 * s2 + e], xp[8 * s2 + 4 + e], false, false); f[0][s2][e] = rr[0]; f[1][s2][e] = rr[1]; }
    (void)hh;
}
__device__ __forceinline__ void rw_pack_pairs_perm(const unsigned (&xp)[16], int hh, u32x4 (&f)[2][2]) {
#pragma unroll
    for (int s2 = 0; s2 < 2; ++s2)
#pragma unroll
        for (int e = 0; e < 4; ++e) { const int t0 = 16 * s2 + 8 * (e >> 1) + 2 * (e & 1);
            const auto rr = __builtin_amdgcn_permlane32_swap(xp[t0 >> 1], xp[(t0 + 4) >> 1], false, false); f[0][s2][e] = rr[0]; f[1][s2][e] = rr[1]; }
    (void)hh;
}
__device__ __forceinline__ bf16x8 acc_frag(const f32x16& x, int s2) {
    u32x4 w;
#pragma unroll
    for (int e = 0; e < 4; ++e) w[e] = pk2(x[8 * s2 + 2 * e], x[8 * s2 + 2 * e + 1]);
    return __builtin_bit_cast(bf16x8, w);
}
#define MFMA32(A, B, C) __builtin_amdgcn_mfma_f32_32x32x16_bf16(A, B, C, 0, 0, 0)

__device__ __forceinline__ void rwkv_stageA(const RWArgs& g, LAS unsigned char* wl, int item, int lane) {
    __builtin_assume(item >= 0 && item < 2 * 16 * NCHUNK);
    const int dir = item / (16 * NCHUNK), rem = item - dir * 16 * NCHUNK, head = rem / NCHUNK, cs = rem - head * NCHUNK;
    const int cr = rw_scan_chunk(dir, cs), rbase = 32 * cr, c = lane & 31, hh = lane >> 5;
    LAS unsigned char* s0 = wl; LAS unsigned char* s1 = wl + RW_TILE; LAS unsigned char* s2p = wl + 2 * RW_TILE; LAS float* gam = (LAS float*)(wl + 3 * RW_TILE);
    unsigned vp[16], bp[16], kp[16];
    {
        float gprev = 1.0f; const bf16_t* rp0 = g.RP + head * 64; unsigned vo0 = (unsigned)lane * 2u, vo2 = vo0 + 4096u, vo4 = vo0 + 8192u, vo5 = vo0 + (unsigned)(5 + dir) * 2048u; asm volatile("" : "+v"(vo2), "+v"(vo4), "+v"(vo5)); const float kac = g.ka[head * 64 + lane];
#pragma unroll
        for (int sb = 0; sb < 32; sb += 16) {
            unsigned short raw[16][6];
#pragma unroll
            for (int u = 0; u < 16; ++u) { const int s = sb + u; const int r = rbase + (dir ? 31 - s : s); const char* pb = (const char*)(rp0 + (size_t)r * 7168);
                raw[u][0] = *(const bf16_t*)(pb + vo0); raw[u][1] = *(const bf16_t*)(pb + 2048 + vo0); raw[u][2] = *(const bf16_t*)(pb + vo2); raw[u][3] = *(const bf16_t*)(pb + 2048 + vo2);
                raw[u][4] = *(const bf16_t*)(pb + vo4); raw[u][5] = *(const bf16_t*)(pb + vo5); }
#pragma unroll
            for (int u = 0; u < 16; u += 2) { const int s = sb + u;
                float bq[2], kq[2], aq[2], rq[2];
#pragma unroll
                for (int h = 0; h < 2; ++h) {
                    const float rr = bf2f(raw[u + h][0]), kk = bf2f(raw[u + h][3]), aa = bf2f(raw[u + h][4]), lw = bf2f(raw[u + h][5]);
                    const float km = bf2f(raw[u + h][1]) * (1.0f + (aa - 1.0f) * kac);
                    const float gcur = gprev * fexp(lw), ginv = __builtin_amdgcn_rcpf(gcur);
                    bq[h] = kk * aa * ginv; kq[h] = km * ginv; aq[h] = -kk * gprev; rq[h] = rr * gcur;
                    gprev = gcur;
                }
                const unsigned bt2 = pk2(bq[0], bq[1]), kt2 = pk2(kq[0], kq[1]), at2 = pk2(aq[0], aq[1]), rt2 = pk2(rq[0], rq[1]);
                *(LAS bf16_t*)(s0 + s * RW_TS + lane * 2) = (bf16_t)(at2 & 0xffffu); *(LAS bf16_t*)(s0 + (s + 1) * RW_TS + lane * 2) = (bf16_t)(at2 >> 16);
                *(LAS bf16_t*)(s1 + s * RW_TS + lane * 2) = (bf16_t)(rt2 & 0xffffu); *(LAS bf16_t*)(s1 + (s + 1) * RW_TS + lane * 2) = (bf16_t)(rt2 >> 16);
                *(LAS bf16_t*)(s2p + s * RW_TS + lane * 2) = (bf16_t)(kt2 & 0xffffu); *(LAS bf16_t*)(s2p + (s + 1) * RW_TS + lane * 2) = (bf16_t)(kt2 >> 16);
                bp[s >> 1] = bt2; kp[s >> 1] = kt2; vp[s >> 1] = (unsigned)raw[u][2] | ((unsigned)raw[u + 1][2] << 16);
            }
        }
        gam[lane] = gprev;
    }
    LDS_WAIT();
    f32x16 g1, g2, g3, g4;
#pragma unroll
    for (int r = 0; r < 16; ++r) { g1[r] = 0.f; g2[r] = 0.f; g3[r] = 0.f; g4[r] = 0.f; }
    {
        bf16x8 fa[4], fr[4], fk[4];
#pragma unroll
        for (int ks = 0; ks < 4; ++ks) { fa[ks] = *(const LAS bf16x8*)(s0 + c * RW_TS + (16 * ks + 8 * hh) * 2); fr[ks] = *(const LAS bf16x8*)(s1 + c * RW_TS + (16 * ks + 8 * hh) * 2);
            fk[ks] = *(const LAS bf16x8*)(s2p + c * RW_TS + (16 * ks + 8 * hh) * 2); }
        LDS_WAIT();
#pragma unroll
        for (int s = 0; s < 32; ++s) *(LAS bf16_t*)(s2p + s * RW_TS + lane * 2) = (bf16_t)((s & 1) ? (bp[s >> 1] >> 16) : (bp[s >> 1] & 0xffffu));
        LDS_WAIT();
#pragma unroll
        for (int ks = 0; ks < 4; ++ks) {
            const bf16x8 fb = *(const LAS bf16x8*)(s2p + c * RW_TS + (16 * ks + 8 * hh) * 2);
            g1 = MFMA32(fb, fa[ks], g1); g2 = MFMA32(fk[ks], fa[ks], g2); g3 = MFMA32(fb, fr[ks], g3); g4 = MFMA32(fk[ks], fr[ks], g4);
        }
    }
#pragma unroll
    for (int r = 0; r < 16; ++r) { const int i = (r & 3) + 8 * (r >> 2) + 4 * hh; if (i > c) { g3[r] = 0.f; g4[r] = 0.f; } }
    const bf16x8 b3[2] = {acc_frag(g3, 0), acc_frag(g3, 1)}, b4[2] = {acc_frag(g4, 0), acc_frag(g4, 1)};
    LDS_WAIT();
    {
        int toff = 4 * rw_tri(c); asm volatile("" : "+v"(toff));
#pragma unroll
        for (int gq = 0; gq < 4; ++gq) { const int i0 = 8 * gq + 4 * hh;
            if (i0 < c) *(LAS f32x4*)(s2p + (toff + i0) * 4) = (f32x4){g1[4 * gq], g1[4 * gq + 1], g1[4 * gq + 2], g1[4 * gq + 3]}; }
        *(LAS bf16x8*)(s2p + RW_TRI_BYTES + lane * 16) = b4[0]; *(LAS bf16x8*)(s2p + RW_TRI_BYTES + 1024 + lane * 16) = b4[1];
    }
    f32x16 wxA, wxB;
    {
#pragma unroll
        for (int r = 0; r < 16; ++r) { const int i = (r & 3) + 8 * (r >> 2) + 4 * hh; if (i >= c) g2[r] = 0.f; }
        const bf16x8 a2[2] = {acc_frag(g2, 0), acc_frag(g2, 1)};
        u32x4 fVq[2][2]; rw_pack_pairs_perm(vp, hh, fVq);
        f32x16 x0, x1;
#pragma unroll
        for (int r = 0; r < 16; ++r) { x0[r] = 0.f; x1[r] = 0.f; }
#pragma unroll
        for (int q = 0; q < 2; ++q) { x0 = MFMA32(a2[q], __builtin_bit_cast(bf16x8, fVq[0][q]), x0); x1 = MFMA32(a2[q], __builtin_bit_cast(bf16x8, fVq[1][q]), x1); }
#pragma unroll
        for (int r = 0; r < 16; ++r) { const auto rr = __builtin_amdgcn_permlane32_swap(__float_as_uint(x0[r]), __float_as_uint(x1[r]), false, false); wxA[r] = __uint_as_float(rr[0]); wxB[r] = __uint_as_float(rr[1]); }
    }
    LDS_WAIT();
    float p[32], w[32];
    {
        f32x2 pw[32];
#pragma unroll
        for (int t = 0; t < 32; ++t) {
            f32x2 acc = {bf2f(*(const LAS bf16_t*)(s0 + t * RW_TS + lane * 2)), ((t >> 2) & 1) ? wxB[(t & 3) + 4 * (t >> 3)] : wxA[(t & 3) + 4 * (t >> 3)]};
#pragma unroll
            for (int ib = 0; ib < (t + 3) / 4; ib += RW_LB) {
                f32x4 lab[RW_LB];
#pragma unroll
                for (int b = 0; b < RW_LB; ++b) if (ib + b < (t + 3) / 4) lab[b] = *(const LAS f32x4*)(s2p + (4 * rw_tri(t) + 4 * (ib + b)) * 4);
#pragma unroll
                for (int b = 0; b < RW_LB; ++b) if (ib + b < (t + 3) / 4) {
                    const f32x2 l01 = {lab[b][0], lab[b][1]}, l23 = {lab[b][2], lab[b][3]};
                    const int i0 = 4 * (ib + b), n = t - i0;
#define RW_F0 "v_pk_fma_f32 %0, %1, %3, %0 op_sel_hi:[0,1,1]"
#define RW_F1 "\n\tv_pk_fma_f32 %0, %1, %4, %0 op_sel:[1,0,0] op_sel_hi:[1,1,1]"
#define RW_F2 "\n\tv_pk_fma_f32 %0, %2, %5, %0 op_sel_hi:[0,1,1]"
#define RW_F3 "\n\tv_pk_fma_f32 %0, %2, %6, %0 op_sel:[1,0,0] op_sel_hi:[1,1,1]"
                    if (n >= 4)      asm(RW_F0 RW_F1 RW_F2 RW_F3 : "+v"(acc) : "v"(l01), "v"(l23), "v"(pw[i0]), "v"(pw[i0 + 1]), "v"(pw[i0 + 2]), "v"(pw[i0 + 3]));
                    else if (n == 3) asm(RW_F0 RW_F1 RW_F2       : "+v"(acc) : "v"(l01), "v"(l23), "v"(pw[i0]), "v"(pw[i0 + 1]), "v"(pw[i0 + 2]));
                    else if (n == 2) asm(RW_F0 RW_F1             : "+v"(acc) : "v"(l01), "v"(l23), "v"(pw[i0]), "v"(pw[i0 + 1]));
                    else             asm(RW_F0                   : "+v"(acc) : "v"(l01), "v"(l23), "v"(pw[i0]));
#undef RW_F0
#undef RW_F1
#undef RW_F2
#undef RW_F3
                }
            }
            pw[t] = acc;
        }
#pragma unroll
        for (int t = 0; t < 32; ++t) { p[t] = pw[t][0]; w[t] = pw[t][1]; }
    }
#define BF(x) __builtin_bit_cast(bf16x8, x)
    u32x4 fBn[2][2], fKn[2][2];
    rw_pack_pairs(bp, hh, fBn); rw_pack_pairs(kp, hh, fKn);
    {
        u32x4 fPn[2][2], fPp[2][2];
        rw_pack<false>(p, hh, fPn); rw_pack<true>(p, hh, fPp);
        bf16_t* mf = g.MF + (size_t)item * 4096;
#pragma unroll
        for (int n = 0; n < 2; ++n) {
            const float gk = gam[32 * n + c];
#pragma unroll
            for (int mp = 0; mp < 2; ++mp) {
                f32x16 x;
#pragma unroll
                for (int r = 0; r < 16; ++r) x[r] = 0.f;
#pragma unroll
                for (int q = 0; q < 2; ++q) x = MFMA32(BF(fPn[mp][q]), BF(fBn[n][q]), x);
#pragma unroll
                for (int r = 0; r < 16; ++r) { const int kprime = (r & 3) + 8 * (r >> 2) + 4 * hh; x[r] = gk * (x[r] + ((mp == n && kprime == c) ? 1.0f : 0.0f)); }
#pragma unroll
                for (int q = 0; q < 2; ++q) *(bf16x8*)(mf + (size_t)(((n * 2 + mp) * 2 + q) * 64 + lane) * 8) = acc_frag(x, q);
            }
        }
        const int r = rbase + (dir ? 31 - c : c);
        bf16_t* qrow = g.QB + ((size_t)dir * T + r) * 1024 + head * 64;
#pragma unroll
        for (int mp = 0; mp < 2; ++mp) {
            f32x16 x;
#pragma unroll
            for (int rr = 0; rr < 16; ++rr) x[rr] = 0.f;
#pragma unroll
            for (int q = 0; q < 2; ++q) x = MFMA32(BF(fPp[mp][q]), b3[q], x);
#pragma unroll
            for (int gq = 0; gq < 4; ++gq) { const int k0 = 32 * mp + 8 * gq + 4 * hh; const u32x2 rt = *(const LAS u32x2*)(s1 + c * RW_TS + k0 * 2);
                u32x2 o; o.x = pk2(x[4 * gq] + bflo(rt.x), x[4 * gq + 1] + bfhi(rt.x)); o.y = pk2(x[4 * gq + 2] + bflo(rt.y), x[4 * gq + 3] + bfhi(rt.y));
                *(u32x2*)(qrow + k0) = o; }
        }
    }
    asm volatile("" ::: "memory");
    {
        u32x4 fWn[2][2], fVn[2][2], fWp[2][2], fVp[2][2];
        rw_pack<false>(w, hh, fWn); rw_pack_pairs(vp, hh, fVn); rw_pack<true>(w, hh, fWp); rw_pack_pairs_perm(vp, hh, fVp);
        bf16_t* nb = g.NB + (size_t)item * 4096;
#pragma unroll
        for (int n = 0; n < 2; ++n)
#pragma unroll
            for (int m = 0; m < 2; ++m) {
                f32x16 x;
#pragma unroll
                for (int r = 0; r < 16; ++r) x[r] = 0.f;
#pragma unroll
                for (int q = 0; q < 2; ++q) { x = MFMA32(BF(fBn[m][q]), BF(fWn[n][q]), x); x = MFMA32(BF(fKn[m][q]), BF(fVn[n][q]), x); }
                u32x4 o0, o1;
#pragma unroll
                for (int gq = 0; gq < 4; ++gq) { const f32x4 gg = *(const LAS f32x4*)(gam + 32 * m + 8 * gq + 4 * hh);
                    const unsigned a0 = pk2(x[4 * gq] * gg[0], x[4 * gq + 1] * gg[1]), a1 = pk2(x[4 * gq + 2] * gg[2], x[4 * gq + 3] * gg[3]);
                    if (gq < 2) { o0[2 * gq] = a0; o0[2 * gq + 1] = a1; } else { o1[2 * (gq - 2)] = a0; o1[2 * (gq - 2) + 1] = a1; } }
                u32x4* dst = (u32x4*)(nb + (size_t)((n * 2 + m) * 64 + lane) * 16);
                dst[0] = o0; dst[1] = o1;
            }
        const int lrow = (dir ? 31 - c : c) + 32 * hh;
        bf16_t* ob = g.OB + ((size_t)((dir * 16 + head) * NCHUNK + cr)) * 2048;
#pragma unroll
        for (int n = 0; n < 2; ++n) {
            f32x16 x;
#pragma unroll
            for (int rr = 0; rr < 16; ++rr) x[rr] = 0.f;
#pragma unroll
            for (int q = 0; q < 2; ++q) { x = MFMA32(BF(fWp[n][q]), b3[q], x); x = MFMA32(BF(fVp[n][q]), *(const LAS bf16x8*)(s2p + RW_TRI_BYTES + q * 1024 + lane * 16), x); }
            u32x4 o0, o1;
#pragma unroll
            for (int e = 0; e < 4; ++e) { o0[e] = pk2(x[2 * e], x[2 * e + 1]); o1[e] = pk2(x[8 + 2 * e], x[8 + 2 * e + 1]); }
            u32x4* dst = (u32x4*)(ob + (size_t)(n * 64 + lrow) * 16);
            dst[0] = o0; dst[1] = o1;
        }
    }
    LDS_WAIT();
}

constexpr int RWB_SLOT = 12288, RWB_FLAGS = MISC_OFF + 1536;
__device__ __forceinline__ void rwkv_stageB(const RWArgs& g, LAS unsigned char* lds, int tk, int wave, int lane) {
    const int n = tk & 1, dh = tk >> 1;
    const bf16_t* mfb = g.MF + (size_t)dh * NCHUNK * 4096; bf16_t* nbb = g.NB + (size_t)dh * NCHUNK * 4096 + (size_t)n * 2048;
    volatile LAS unsigned* flags = (volatile LAS unsigned*)(lds + RWB_FLAGS);
    if (wave != 0) {
        const int sl = wave - 1; LAS unsigned char* slot = lds + sl * RWB_SLOT;
        for (int cs = sl; cs < NCHUNK; cs += 7) {
            u32x4 v[12];
            const u32x4* mp_ = (const u32x4*)(mfb + (size_t)cs * 4096); const u32x4* np_ = (const u32x4*)(nbb + (size_t)cs * 4096);
#pragma unroll
            for (int q = 0; q < 8; ++q) v[q] = mp_[q * 64 + lane];
#pragma unroll
            for (int q = 0; q < 4; ++q) v[8 + q] = np_[q * 64 + lane];
            unsigned sp = 0; while ((int)flags[8] + 7 <= cs) { __builtin_amdgcn_s_sleep(1); if (++sp > (1u << 26)) break; }
#pragma unroll
            for (int q = 0; q < 12; ++q) *(LAS u32x4*)(slot + q * 1024 + lane * 16) = v[q];
            LDS_WAIT();
            if (lane == 0) flags[sl] = (unsigned)(cs + 1);
        }
        return;
    }
    f32x16 H[2];
#pragma unroll
    for (int m = 0; m < 2; ++m)
#pragma unroll
        for (int r = 0; r < 16; ++r) H[m][r] = 0.f;
    for (int cs = 0; cs < NCHUNK; ++cs) {
        const int sl = cs % 7; const LAS unsigned char* slot = lds + sl * RWB_SLOT;
        { unsigned sp = 0; while (flags[sl] != (unsigned)(cs + 1)) { __builtin_amdgcn_s_sleep(1); if (++sp > (1u << 26)) break; } }
        bf16x8 cm[2][2][2]; u32x4 cn[2][2];
#pragma unroll
        for (int m = 0; m < 2; ++m) {
#pragma unroll
            for (int mp = 0; mp < 2; ++mp)
#pragma unroll
                for (int q = 0; q < 2; ++q) cm[m][mp][q] = *(const LAS bf16x8*)(slot + ((m * 2 + mp) * 2 + q) * 1024 + lane * 16);
            cn[m][0] = *(const LAS u32x4*)(slot + 8192 + (m * 64 + lane) * 32); cn[m][1] = *(const LAS u32x4*)(slot + 8192 + (m * 64 + lane) * 32 + 16);
        }
        LDS_WAIT();
        if (lane == 0) flags[8] = (unsigned)(cs + 1);
        bf16x8 hb[2][2];
#pragma unroll
        for (int mp = 0; mp < 2; ++mp)
#pragma unroll
            for (int q = 0; q < 2; ++q) hb[mp][q] = acc_frag(H[mp], q);
        bf16_t* hf = nbb + (size_t)cs * 4096;
#pragma unroll
        for (int mp = 0; mp < 2; ++mp)
#pragma unroll
            for (int q = 0; q < 2; ++q) *(bf16x8*)(hf + (size_t)((mp * 2 + q) * 64 + lane) * 8) = hb[mp][q];
        f32x16 Hn[2];
#pragma unroll
        for (int m = 0; m < 2; ++m) {
#pragma unroll
            for (int e = 0; e < 4; ++e) { Hn[m][2 * e] = bflo(cn[m][0][e]); Hn[m][2 * e + 1] = bfhi(cn[m][0][e]); Hn[m][8 + 2 * e] = bflo(cn[m][1][e]); Hn[m][8 + 2 * e + 1] = bfhi(cn[m][1][e]); }
#pragma unroll
            for (int mp = 0; mp < 2; ++mp)
#pragma unroll
                for (int q = 0; q < 2; ++q) Hn[m] = MFMA32(cm[m][mp][q], hb[mp][q], Hn[m]);
        }
        H[0] = Hn[0]; H[1] = Hn[1];
    }
}

__device__ __forceinline__ void rwkv_stageC(const RWArgs& g, int head, int cr, int lane) {
    const int c = lane & 31, hh = lane >> 5, r = 32 * cr + c, t = r - CTXL;
    f32x16 o[2];
#pragma unroll
    for (int n = 0; n < 2; ++n)
#pragma unroll
        for (int q = 0; q < 16; ++q) o[n][q] = 0.f;
    bf16x8 qf[2][2][2], hf[2][2][2][2]; u32x4 ov[2][2][2];
#pragma unroll
    for (int dir = 0; dir < 2; ++dir) {
        const int cs = rw_scan_chunk(dir, cr);
        const bf16_t* qrow = g.QB + ((size_t)dir * T + r) * 1024 + head * 64;
        const bf16_t* hfb = g.NB + ((size_t)(dir * 16 + head) * NCHUNK + cs) * 4096;
        const bf16_t* ob = g.OB + ((size_t)((dir * 16 + head) * NCHUNK + cr)) * 2048;
#pragma unroll
        for (int mp = 0; mp < 2; ++mp)
#pragma unroll
            for (int q = 0; q < 2; ++q) { const u32x2 lo = *(const u32x2*)(qrow + 32 * mp + 16 * q + 4 * hh), hi = *(const u32x2*)(qrow + 32 * mp + 16 * q + 8 + 4 * hh);
                qf[dir][mp][q] = __builtin_bit_cast(bf16x8, ((u32x4){lo.x, lo.y, hi.x, hi.y})); }
#pragma unroll
        for (int n = 0; n < 2; ++n) {
            const u32x4* src = (const u32x4*)(ob + (size_t)(n * 64 + lane) * 16); ov[dir][n][0] = src[0]; ov[dir][n][1] = src[1];
#pragma unroll
            for (int mp = 0; mp < 2; ++mp)
#pragma unroll
                for (int q = 0; q < 2; ++q) hf[dir][n][mp][q] = *(const bf16x8*)(hfb + (size_t)n * 2048 + (size_t)((mp * 2 + q) * 64 + lane) * 8);
        }
    }
    const bf16_t* rp = g.RP + (size_t)r * 7168 + head * 64;
    u32x4 ra[4], ka[4], aa4[4];
#pragma unroll
    for (int q4 = 0; q4 < 4; ++q4) { ra[q4] = *(const u32x4*)(rp + 32 * hh + 8 * q4); ka[q4] = *(const u32x4*)(rp + 1024 + 32 * hh + 8 * q4); aa4[q4] = *(const u32x4*)(rp + 4096 + 32 * hh + 8 * q4); }
    __builtin_amdgcn_sched_barrier(0);
#pragma unroll
    for (int dir = 0; dir < 2; ++dir)
#pragma unroll
        for (int n = 0; n < 2; ++n) {
#pragma unroll
            for (int e = 0; e < 4; ++e) { o[n][2 * e] += bflo(ov[dir][n][0][e]); o[n][2 * e + 1] += bfhi(ov[dir][n][0][e]); o[n][8 + 2 * e] += bflo(ov[dir][n][1][e]); o[n][8 + 2 * e + 1] += bfhi(ov[dir][n][1][e]); }
#pragma unroll
            for (int mp = 0; mp < 2; ++mp)
#pragma unroll
                for (int q = 0; q < 2; ++q) o[n] = MFMA32(hf[dir][n][mp][q], qf[dir][mp][q], o[n]);
        }
    float sm = 0.f;
#pragma unroll
    for (int n = 0; n < 2; ++n)
#pragma unroll
        for (int q = 0; q < 16; ++q) sm += o[n][q];
    sm += __shfl_xor(sm, 32); const float mu = sm * (1.0f / 64.0f);
    float sv = 0.f;
#pragma unroll
    for (int n = 0; n < 2; ++n)
#pragma unroll
        for (int q = 0; q < 16; ++q) { const float d = o[n][q] - mu; sv += d * d; }
    sv += __shfl_xor(sv, 32); const float rs = __builtin_amdgcn_rsqf(sv * (1.0f / 64.0f) + 64e-5f);
    float bs = 0.f;
#pragma unroll
    for (int q4 = 0; q4 < 4; ++q4) { const float* rk = g.rk + head * 64 + 32 * hh + 8 * q4; const float* kac = g.ka + head * 64 + 32 * hh + 8 * q4;
#pragma unroll
        for (int e = 0; e < 4; ++e) { const float km0 = bflo(ka[q4][e]) * (1.0f + (bflo(aa4[q4][e]) - 1.0f) * kac[2 * e]), km1 = bfhi(ka[q4][e]) * (1.0f + (bfhi(aa4[q4][e]) - 1.0f) * kac[2 * e + 1]);
            bs = fmaf(bflo(ra[q4][e]) * km0, rk[2 * e], bs); bs = fmaf(bfhi(ra[q4][e]) * km1, rk[2 * e + 1], bs); } }
    bs += __shfl_xor(bs, 32);
#pragma unroll
    for (int n = 0; n < 2; ++n)
#pragma unroll
        for (int gq = 0; gq < 4; ++gq) {
            const int v0 = 32 * n + 8 * gq + 4 * hh, ch = head * 64 + v0;
            const u32x2 vv = *(const u32x2*)(rp + 2048 + v0), go = *(const u32x2*)(g.GOUT + (size_t)r * 1024 + ch);
            const f32x4 lw = *(const f32x4*)(g.lnw + ch), lb = *(const f32x4*)(g.lnb + ch);
            const float e0 = ((o[n][4 * gq] - mu) * rs * lw[0] + lb[0] + bs * bflo(vv.x)) * bflo(go.x), e1 = ((o[n][4 * gq + 1] - mu) * rs * lw[1] + lb[1] + bs * bfhi(vv.x)) * bfhi(go.x);
            const float e2 = ((o[n][4 * gq + 2] - mu) * rs * lw[2] + lb[2] + bs * bflo(vv.y)) * bflo(go.y), e3 = ((o[n][4 * gq + 3] - mu) * rs * lw[3] + lb[3] + bs * bfhi(vv.y)) * bfhi(go.y);
            u32x2 w; w.x = pk2(e0, e1); w.y = pk2(e2, e3);
            *(u32x2*)(g.mix + (size_t)t * D + 1024 + ch) = w;
        }
}
#undef BF

__device__ __forceinline__ void shifted4(const bf16_t* P, int r, int col, const float* mup, const float* mun, float (&o)[4]) {
    const u32x2 p = *(const u32x2*)(P + (size_t)r * N1 + col);
    u32x2 pv = (u32x2){0u, 0u}, nx = (u32x2){0u, 0u};
    if (!(r == 0 || r == CTXL)) pv = *(const u32x2*)(P + (size_t)(r - 1) * N1 + col);
    if (!(r == CTXL - 1 || r == T - 1)) nx = *(const u32x2*)(P + (size_t)(r + 1) * N1 + col);
    const f32x4 mp = *(const f32x4*)(mup + col - R_R), mn = *(const f32x4*)(mun + col - R_R);
    const float pc[4] = {bflo(p.x), bfhi(p.x), bflo(p.y), bfhi(p.y)}, pp[4] = {bflo(pv.x), bfhi(pv.x), bflo(pv.y), bfhi(pv.y)}, pn[4] = {bflo(nx.x), bfhi(nx.x), bflo(nx.y), bfhi(nx.y)};
#pragma unroll
    for (int e = 0; e < 4; ++e) o[e] = pc[e] + mp[e] * (pp[e] - pc[e]) + mn[e] * (pn[e] - pc[e]);
}
__device__ __forceinline__ void st4bf(bf16_t* p, float a0, float a1, float a2, float a3) { u32x2 w; w.x = pk2(a0, a1); w.y = pk2(a2, a3); *(u32x2*)p = w; }
__device__ __forceinline__ void rwkv_xfill(const Args& a, const bf16_t* P, bf16_t* XL, int gtid, int gthreads) {
    const float* mup = a.in[I_MUPREV]; const float* mun = a.in[I_MUNEXT];
    for (int idx = gtid; idx < T * 256; idx += gthreads) {
        const int row = idx >> 8, q = idx & 255, plane = q >> 6, col = (q & 63) * 4;
        float v[4] = {0.f, 0.f, 0.f, 0.f};
        if (plane == 3 || col < 96) {
            shifted4(P, row, R_WDF + (plane == 3 ? 288 : plane * 96) + col, mup, mun, v);
            if (plane < 2) { for (int e = 0; e < 4; ++e) v[e] = tanhf_(v[e]); }
            else if (plane == 3) { for (int e = 0; e < 4; ++e) v[e] = sigmoidf_(v[e]); }
        }
        st4bf(XL + ((size_t)plane * T + row) * 256 + col, v[0], v[1], v[2], v[3]);
    }
}
__device__ __forceinline__ void rwkv_rkv(const Args& a, const bf16_t* P, bf16_t* RP, int gw, int ngw, int lane) {
    const float* mup = a.in[I_MUPREV]; const float* mun = a.in[I_MUNEXT];
    for (int it = gw; it < T * 4; it += ngw) {
        const int r = it >> 2, ch = (it & 3) * 256 + 4 * lane;
        float x[4], k[4], y[4];
        shifted4(P, r, R_R + ch, mup, mun, x); shifted4(P, r, R_K + ch, mup, mun, k); shifted4(P, r, R_V + ch, mup, mun, y);
        bf16_t* rp = RP + (size_t)r * 7168;
        const f32x4 kkc = *(const f32x4*)(a.in[I_KK] + ch);
        float kq[4], ss = 0.f;
#pragma unroll
        for (int e = 0; e < 4; ++e) { kq[e] = k[e] * kkc[e]; ss += kq[e] * kq[e]; }
        ss += __shfl_xor(ss, 1); ss += __shfl_xor(ss, 2); ss += __shfl_xor(ss, 4); ss += __shfl_xor(ss, 8);
        const float rn = __builtin_amdgcn_rsqf(ss + 1e-12f);
        st4bf(rp + ch, x[0], x[1], x[2], x[3]);
        st4bf(rp + 1024 + ch, k[0], k[1], k[2], k[3]);
        st4bf(rp + 2048 + ch, y[0], y[1], y[2], y[3]);
        st4bf(rp + 3072 + ch, kq[0] * rn, kq[1] * rn, kq[2] * rn, kq[3] * rn);
    }
}

__device__ __forceinline__ void moe_tables(LAS unsigned char* lds, const int* blkcnt, int tid) {
    LAS int* tab = (LAS int*)(lds + MOE_TAB_OFF); LAS int* pref = (LAS int*)(lds + PREF_OFF);
    const int lane = tid & 63, e = tid >> 6;
    __syncthreads();
    int cnt[4], run = 0;
#pragma unroll
    for (int i = 0; i < 4; ++i) { cnt[i] = blkcnt[(4 * lane + i) * 8 + e]; run += cnt[i]; }
    int inc = run;
#pragma unroll
    for (int o = 1; o < 64; o <<= 1) { const int v = __shfl_up(inc, o); if (lane >= o) inc += v; }
    int ex = inc - run;
#pragma unroll
    for (int i = 0; i < 4; ++i) { pref[(4 * lane + i) * 8 + e] = ex; ex += cnt[i]; }
    if (lane == 63) tab[e] = inc;
    __syncthreads();
    int off = 0, np = 0, mye = -1;
#pragma unroll
    for (int x = 0; x < 8; ++x) { const int npe = (tab[x] + 255) >> 8; if (tid == 0) tab[8 + x] = off; if (tid >= np && tid < np + npe) mye = x; off += npe * 256; np += npe; }
    if (mye >= 0) tab[18 + tid] = mye;
    if (tid == 0) { tab[16] = off; tab[17] = np; }
    __syncthreads();
}

constexpr int NPH = 23;
__global__ void __launch_bounds__(NTHR, 2) trunk_fwd(Args a) {
    extern __shared__ __attribute__((aligned(16))) unsigned char lds_raw[];
    LAS unsigned char* lds = (LAS unsigned char*)lds_raw;
    const int tid = threadIdx.x, lane = tid & 63, wave = __builtin_amdgcn_readfirstlane(tid >> 6);
    const int bx = blockIdx.x, G = gridDim.x, gw = bx * NWAVES + wave, NGW = G * NWAVES;
    unsigned char* ws = a.ws;
    for (int u = tid; u < (LDS_BYTES - MISC_OFF) / 4; u += NTHR) ((LAS unsigned*)(lds + MISC_OFF))[u] = 0u;
    __syncthreads();
    const int lo = a.ph_lo, hi = a.ph_hi;
    XcdBarrier bar; bar.bar = (unsigned*)(ws + WS_CTL) + CW_BAR; bar.x = 0; bar.st = (volatile LAS unsigned*)(lds + MISC_OFF);
    if (hi - lo > 1) bar = xcd_barrier_post((unsigned*)(ws + WS_CTL) + CW_BAR, (volatile LAS unsigned*)(lds + MISC_OFF));
#ifdef ONLY_PHASE
#define IN(k) ((k) == ONLY_PHASE && lo <= (k) && (k) < hi)
#else
#define IN(k) (lo <= (k) && (k) < hi)
#endif
#define SEAM(k) do { if (IN(k) && IN((k) + 1)) xcd_barrier(bar); } while (0)
#define MODP(l, vec, which) (mod + (size_t)(((l) * 2 + (vec)) * 6 + (which)) * 2048)
    const float* mod = (const float*)(ws + WS_MOD);
    bf16_t* H = (bf16_t*)(ws + WS_H);
    bf16_t* XB = (bf16_t*)(ws + WS_XB);
    float* out = a.out;
    const size_t TS2048 = (size_t)256 * 2048 * 2;

    if (IN(0)) for (int rep_ = 0; rep_ <= (int)((REPMASK >> 0) & 1u); ++rep_) { if (rep_) __syncthreads(); p0_prologue(a, lds, tid, lane, wave); }
    SEAM(0);
    if (IN(1)) for (int rep_ = 0; rep_ <= (int)((REPMASK >> 1) & 1u); ++rep_) { if (rep_) __syncthreads();
        for (int r = gw; r < T; r += NGW) {
            const int vec = r < CTXL ? 1 : 0; const float* xin = vec ? a.in[I_CTX] + (size_t)r * D : a.in[I_X] + (size_t)(r - CTXL) * D;
            f32x4 v[8]; ldrow(xin, lane, v);
            mod_store_i8(v, a.in[I_NMIXPRE0], MODP(0, vec, 1), MODP(0, vec, 0), (signed char*)(ws + WS_H) + (size_t)r * D, (float*)(ws + WS_HSC) + r, lane);
        }
    }
    SEAM(1);
    if (IN(2)) for (int rep_ = 0; rep_ <= (int)((REPMASK >> 2) & 1u); ++rep_) { if (rep_) __syncthreads();
        pg8::SchedPlain S{(const char*)(ws + WS_H), (const char*)(ws + W_IN0T), 65, 21, G, bx, (size_t)256 * 2048, 5 * 65, (const char*)(ws + W_V0T), (const char*)(ws + WS_H), 65, 0};
        pg8::EpiBf16I8 E{(bf16_t*)(ws + A_PROJ0), N0, (bf16_t*)(ws + A_VT), T, (const float*)(ws + WS_HSC), (const float*)(ws + WS_QI0), (const float*)(ws + WS_QV0), (const float*)(ws + WS_HSC)};
        pg8::gemm_phase<pg8::EpiBf16I8, pg8::SchedPlain, true>(lds, 2048, S, E);
    }
    SEAM(2);
    const GLArgs g0{(const bf16_t*)(ws + A_PROJ0), (const bf16_t*)(ws + A_VT), (bf16_t*)(ws + A_KVT0), (float*)(ws + A_DEC0), (bf16_t*)(ws + A_MIX0), a.in[I_LBL], nullptr, nullptr, nullptr, nullptr, a.in[I_HNORM]};
    if (IN(3)) for (int rep_ = 0; rep_ <= (int)((REPMASK >> 3) & 1u); ++rep_) { if (rep_) __syncthreads();
        const float* ropetab = (const float*)(ws + WS_ROPE);
        for (int rq_ = 0; rq_ <= (int)((REPMASK >> 24) & 1u); ++rq_)
        for (int u = bx; u < 520; u += G) {
            const int kind = u < 512 ? 0 : 1, uu = u < 512 ? u : u - 512;
            attn_unit(lds, (const bf16_t*)(ws + A_PROJ0), (const bf16_t*)(ws + A_VT), (bf16_t*)(ws + A_MIX0), a.in[I_SINK], ropetab, kind, uu >> 1, uu & 1, tid);
        }
        for (int rq_ = 0; rq_ <= (int)((REPMASK >> 25) & 1u); ++rq_) gl_phaseA<0>(g0, lds, tid, bx, G);
    }
    SEAM(3);
    if (IN(4)) { gl_phaseB<0, 4>(g0, tid < 256 ? bx * 256 + tid : -1);
        if ((REPMASK >> 23) & 1u) { GLArgs gx = g0; gx.kvt = (bf16_t*)(ws + WS_A + 700 * MiB); gx.dec = (float*)(ws + WS_A + 965 * MiB); gl_phaseB<0, 4>(gx, tid < 256 ? bx * 256 + tid : -1); } }
    SEAM(4);
    if (IN(5)) for (int rep_ = 0; rep_ <= (int)((REPMASK >> 5) & 1u); ++rep_) { if (rep_) __syncthreads(); gl_phaseC<0>(g0, lds, tid, bx, G); }
    SEAM(5);
    if (IN(6)) for (int rep_ = 0; rep_ <= (int)((REPMASK >> 6) & 1u); ++rep_) { if (rep_) __syncthreads();
        pg8::SchedPlain S{(const char*)(ws + A_MIX0), (const char*)(ws + W_OUT0T), 64, 8, G, bx, TS2048, 0, nullptr, nullptr, 1, 1};
        pg8::EpiBf16 E{(bf16_t*)(ws + A_Y0), 2048, nullptr, 0};
        pg8::gemm_phase<pg8::EpiBf16, pg8::SchedPlain>(lds, 4096, S, E);
        pg8::SchedSplit S2{(const char*)(ws + A_MIX0), (const char*)(ws + W_OUT0T), 8, 8, G, bx, TS2048, (size_t)512};
        pg8::EpiF32 E2{(float*)(ws + A_PY0), 2048, (size_t)256 * 2048};
        pg8::gemm_phase<pg8::EpiF32, pg8::SchedSplit>(lds, 4096, S2, E2, 512 + (lo >> 20));
    }
    SEAM(6);
    if (IN(7)) for (int rep_ = 0; rep_ <= (int)((REPMASK >> 7) & 1u); ++rep_) { if (rep_) __syncthreads();
        const bf16_t* Y0 = (const bf16_t*)(ws + A_Y0);
        for (int r = gw; r < T; r += NGW) {
            const int vec = r < CTXL ? 1 : 0; const float* xin = vec ? a.in[I_CTX] + (size_t)r * D : a.in[I_X] + (size_t)(r - CTXL) * D;
            bf16_t* xo = XB + (size_t)r * D;
            f32x4 v[8], b[8]; ldrow(xin, lane, v);
            if (vec) { const float* pp = (const float*)(ws + A_PY0) + (size_t)r * D; ldrow(pp, lane, b);
                for (int ks = 1; ks < 8; ++ks) { f32x4 t2[8]; ldrow(pp + (size_t)ks * 256 * 2048, lane, t2);
#pragma unroll
                    for (int j = 0; j < 8; ++j) b[j] += t2[j]; } }
            else ldrow_bf(Y0 + (size_t)r * D, lane, b);
            add_branch(v, b, a.in[I_NMIXPOST0], MODP(0, vec, 2), lane); strow_bf(xo, lane, v);
            mod_store_i8(v, a.in[I_NFFNPRE0], MODP(0, vec, 4), MODP(0, vec, 3), (signed char*)(ws + WS_H) + (size_t)r * D, (float*)(ws + WS_HSC) + r, lane);
        }
    }
    SEAM(7);
    if (IN(8)) for (int rep_ = 0; rep_ <= (int)((REPMASK >> 8) & 1u); ++rep_) { if (rep_) __syncthreads();
        pg8::SchedPlain S{(const char*)(ws + WS_H), (const char*)(ws + W_GU0T), 65, 44, G, bx, (size_t)256 * 2048, 0, nullptr, nullptr, 1, 0};
        pg8::EpiSwigluI8 E{(bf16_t*)(ws + A_HID0), FF0, (const float*)(ws + WS_HSC), (const float*)(ws + WS_QS0), 0};
        pg8::gemm_phase<pg8::EpiSwigluI8, pg8::SchedPlain, true>(lds, 2048, S, E);
    }
    SEAM(8);
    if (IN(9)) for (int rep_ = 0; rep_ <= (int)((REPMASK >> 9) & 1u); ++rep_) { if (rep_) __syncthreads();
        pg8::SchedPlain S{(const char*)(ws + A_HID0), (const char*)(ws + W_DN0T), 64, 8, G, bx, (size_t)256 * FF0 * 2, 0, nullptr, nullptr, 1, 1};
        pg8::EpiBf16 E{(bf16_t*)(ws + A_F0), 2048, nullptr, 0};
        pg8::gemm_phase<pg8::EpiBf16, pg8::SchedPlain>(lds, 2 * FF0, S, E);
        pg8::SchedSplit S2{(const char*)(ws + A_HID0), (const char*)(ws + W_DN0T), 8, 22, G, bx, (size_t)256 * FF0 * 2, (size_t)512};
        pg8::EpiF32 E2{(float*)(ws + A_PF0), 2048, (size_t)256 * 2048};
        pg8::gemm_phase<pg8::EpiF32, pg8::SchedSplit>(lds, 2 * FF0, S2, E2, 512 + (lo >> 20));
    }
    SEAM(9);
    if (IN(10)) {
        const bf16_t* F0 = (const bf16_t*)(ws + A_F0);
        for (int r = gw; r < T; r += NGW) {
            const int vec = r < CTXL ? 1 : 0; bf16_t* xo = XB + (size_t)r * D;
            f32x4 v[8], b[8]; ldrow_bf(xo, lane, v);
            if (vec) { const float* pp = (const float*)(ws + A_PF0) + (size_t)r * D; ldrow(pp, lane, b);
                for (int ks = 1; ks < 22; ++ks) { f32x4 t2[8]; ldrow(pp + (size_t)ks * 256 * 2048, lane, t2);
#pragma unroll
                    for (int j = 0; j < 8; ++j) b[j] += t2[j]; } }
            else ldrow_bf(F0 + (size_t)r * D, lane, b);
            add_branch(v, b, a.in[I_NFFNPOST0], MODP(0, vec, 5), lane); strow_bf(xo, lane, v);
            mod_store_i8(v, a.in[I_NMIXPRE1], MODP(1, vec, 1), MODP(1, vec, 0), (signed char*)(ws + WS_H) + (size_t)r * D, (float*)(ws + WS_HSC) + r, lane);
        }
    }
    SEAM(10);
    if (IN(11)) for (int rep_ = 0; rep_ <= (int)((REPMASK >> 11) & 1u); ++rep_) { if (rep_) __syncthreads();
        pg8::SchedPlain S{(const char*)(ws + WS_H), (const char*)(ws + W_IN1T), 65, 23, G, bx, (size_t)256 * 2048, 4 * 65, (const char*)(ws + W_GV1T), (const char*)(ws + WS_H), 65, 0};
        pg8::EpiBf16I8 E{(bf16_t*)(ws + A_PROJ1), N1, (bf16_t*)(ws + A_GVT), T, (const float*)(ws + WS_HSC), (const float*)(ws + WS_QI1), (const float*)(ws + WS_QG1), (const float*)(ws + WS_HSC)};
        pg8::gemm_phase<pg8::EpiBf16I8, pg8::SchedPlain, true>(lds, 2048, S, E);
    }
    SEAM(11);
    const GLArgs g1{(const bf16_t*)(ws + A_PROJ1), (const bf16_t*)(ws + A_GVT), (bf16_t*)(ws + A_KVT1), (float*)(ws + A_DEC1), (bf16_t*)(ws + A_MIX1), nullptr, a.in[I_GUPF], a.in[I_GUPB], a.in[I_GBIASF], a.in[I_GBIASB], a.in[I_GLANORM]};
    const RWArgs rwa{(const bf16_t*)(ws + A_RP), (const bf16_t*)(ws + A_GOUT), (bf16_t*)(ws + A_MF), (bf16_t*)(ws + A_NB), (bf16_t*)(ws + A_QB), (bf16_t*)(ws + A_OB), (bf16_t*)(ws + A_MIX1), a.in[I_RK], a.in[I_LNW], a.in[I_LNB], a.in[I_KA]};
    if (IN(12)) for (int rep_ = 0; rep_ <= (int)((REPMASK >> 12) & 1u); ++rep_) { if (rep_) __syncthreads();
        rwkv_xfill(a, (const bf16_t*)(ws + A_PROJ1), (bf16_t*)(ws + A_XL), bx * NTHR + tid, G * NTHR);
        rwkv_rkv(a, (const bf16_t*)(ws + A_PROJ1), (bf16_t*)(ws + A_RP), gw, NGW, lane);
        gl_phaseA<1>(g1, lds, tid, bx, G);
    }
    SEAM(12);
    if (IN(13)) {
        pg8::SchedLora S{(const char*)(ws + A_XL), (const char*)(ws + WS_LORA4), (size_t)T * 512, G, bx};
        pg8::EpiLora E{(bf16_t*)(ws + A_RP), ((long)A_GOUT - (long)A_RP) / 2, (const float*)(ws + WS_LB)};
        pg8::gemm_phase<pg8::EpiLora, pg8::SchedLora>(lds, 512 + (lo >> 20), S, E);
    }
    SEAM(13);
    if (IN(14)) {
        volatile LAS int* ictr = (volatile LAS int*)(lds + MISC_OFF + 1600);
        if (tid == 0) *ictr = 0;
        __syncthreads();
        if (wave >= 4) gl_phaseB<1, 4>(g1, bx * 256 + (tid - 256));
        {
            constexpr int NA = 11;
            const int nw = wave < 4 ? (wave == 0 ? NA + 1 : NA) : 16 - NA, jb = wave < 4 ? wave : 4 * NA + (wave - 4);
            for (int i = 0; i < nw; ++i) { const int j = (wave == 0 && i == NA) ? 64 : jb + 4 * i; rwkv_stageA(rwa, lds + wave * RW_WAVE_LDS, bx + 256 * j, lane); }
        }
    }
    SEAM(14);
    if (IN(15)) {
        if (bx < 64) rwkv_stageB(rwa, lds, bx, wave, lane);
        else for (int rq_ = 0; rq_ <= (int)((REPMASK >> 29) & 1u); ++rq_) gl_phaseC<1>(g1, lds, tid, bx - 64, G - 64);
    }
    SEAM(15);
    if (IN(16)) for (int rep_ = 0; rep_ <= (int)((REPMASK >> 15) & 1u); ++rep_) { if (rep_) __syncthreads();
        for (int it = gw; it < 16 * (NCHUNK - 8); it += NGW) rwkv_stageC(rwa, it & 15, 8 + (it >> 4), lane);
    }
    SEAM(16);
    if (IN(17)) for (int rep_ = 0; rep_ <= (int)((REPMASK >> 18) & 1u); ++rep_) { if (rep_) __syncthreads();
        pg8::SchedPlain S{(const char*)(ws + A_MIX1), (const char*)(ws + W_OUT1T), 64, 8, G, bx, TS2048, 0, nullptr, nullptr, 1, 0};
        pg8::EpiBf16 E{(bf16_t*)(ws + A_Y1), 2048, nullptr, 0};
        pg8::gemm_phase<pg8::EpiBf16, pg8::SchedPlain>(lds, 4096, S, E);
    }
    SEAM(17);
    int* tk_e = (int*)(ws + WS_TK); float* tk_w = (float*)(ws + WS_TK + 128 * 1024); int* tk_lr = (int*)(ws + WS_TK + 256 * 1024); int* tk_pos = (int*)(ws + WS_TK + 384 * 1024);
    int* blkcnt = (int*)(ws + WS_BLKCNT);
    if (IN(18)) {
        LAS int* ecnt = (LAS int*)(lds + ECNT_OFF);
        if (tid < 8) ecnt[tid] = 0;
        __syncthreads();
        const bf16_t* Y1 = (const bf16_t*)(ws + A_Y1); const float* router = a.in[I_ROUTER];
        for (int t = gw; t < SEQ; t += NGW) {
            f32x4 v[8], b[8]; ldrow_bf(XB + (size_t)(t + CTXL) * D, lane, v); ldrow_bf(Y1 + (size_t)t * D, lane, b);
            add_branch(v, b, a.in[I_NMIXPOST1], MODP(1, 0, 2), lane); strow_bf(XB + (size_t)(t + CTXL) * D, lane, v);
            mod_store(v, a.in[I_NFFNPRE1], MODP(1, 0, 4), MODP(1, 0, 3), H + (size_t)t * D, lane);
            float lg[8];
#pragma unroll
            for (int e = 0; e < 8; ++e) lg[e] = 0.f;
#pragma unroll
            for (int j = 0; j < 8; ++j)
#pragma unroll
                for (int q = 0; q < 4; ++q) { const float* rp = router + (size_t)(4 * lane + 256 * j + q) * 8; const f32x4 r0 = *(const f32x4*)rp, r1 = *(const f32x4*)(rp + 4); const float hv = v[j][q];
                    lg[0] = fmaf(hv, r0[0], lg[0]); lg[1] = fmaf(hv, r0[1], lg[1]); lg[2] = fmaf(hv, r0[2], lg[2]); lg[3] = fmaf(hv, r0[3], lg[3]);
                    lg[4] = fmaf(hv, r1[0], lg[4]); lg[5] = fmaf(hv, r1[1], lg[5]); lg[6] = fmaf(hv, r1[2], lg[6]); lg[7] = fmaf(hv, r1[3], lg[7]); }
#pragma unroll
            for (int e = 0; e < 8; ++e) lg[e] = wave_sum(lg[e]);
            int ea = 0; float va = lg[0];
#pragma unroll
            for (int e = 1; e < 8; ++e) if (lg[e] > va) { va = lg[e]; ea = e; }
            int eb = -1; float vb = -INFINITY;
#pragma unroll
            for (int e = 0; e < 8; ++e) if (e != ea && lg[e] > vb) { vb = lg[e]; eb = e; }
            if (eb < 0) eb = (ea + 1) & 7;
            const float wa = 1.0f / (1.0f + fexp(vb - va)), wb = 1.0f - wa;
            if (lane == 0) {
                const int la = __hip_atomic_fetch_add(ecnt + ea, 1, __ATOMIC_RELAXED, __HIP_MEMORY_SCOPE_WORKGROUP);
                const int lb = __hip_atomic_fetch_add(ecnt + eb, 1, __ATOMIC_RELAXED, __HIP_MEMORY_SCOPE_WORKGROUP);
                tk_e[2 * t] = ea; tk_e[2 * t + 1] = eb; tk_w[2 * t] = wa; tk_w[2 * t + 1] = wb; tk_lr[2 * t] = la; tk_lr[2 * t + 1] = lb;
            }
        }
        __syncthreads();
        if (tid < 8) blkcnt[bx * 8 + tid] = ecnt[tid];
    }
    SEAM(18);
    if (IN(19)) for (int rep_ = 0; rep_ <= (int)((REPMASK >> 20) & 1u); ++rep_) { if (rep_) __syncthreads();
        moe_tables(lds, blkcnt, tid);
        const LAS int* tab = (const LAS int*)(lds + MOE_TAB_OFF); const LAS int* pref = (const LAS int*)(lds + PREF_OFF);
        signed char* SORT = (signed char*)(ws + A_SORT); float* ssc = (float*)(ws + WS_SSC);
        for (int t = gw; t < SEQ; t += NGW) {
            const int b = (t % NGW) / NWAVES;
            const u32x4* src = (const u32x4*)(H + (size_t)t * D); u32x4 hv[4]; float mx = 0.f;
#pragma unroll
            for (int j = 0; j < 4; ++j) { hv[j] = src[lane + 64 * j];
#pragma unroll
                for (int e = 0; e < 4; ++e) mx = fmaxf(mx, fmaxf(fabsf(bflo(hv[j][e])), fabsf(bfhi(hv[j][e])))); }
#pragma unroll
            for (int o = 1; o < 64; o <<= 1) mx = fmaxf(mx, __shfl_xor(mx, o));
            const float inv = mx > 0.f ? 127.0f / mx : 0.f, scl = mx > 0.f ? mx * (1.0f / 127.0f) : 1.0f;
            u32x2 qv[4];
#pragma unroll
            for (int j = 0; j < 4; ++j) { unsigned pk[2];
#pragma unroll
                for (int hq = 0; hq < 2; ++hq) { const unsigned w0 = hv[j][2 * hq], w1 = hv[j][2 * hq + 1];
                    const int q0 = (int)__builtin_rintf(bflo(w0) * inv), q1 = (int)__builtin_rintf(bfhi(w0) * inv), q2 = (int)__builtin_rintf(bflo(w1) * inv), q3 = (int)__builtin_rintf(bfhi(w1) * inv);
                    pk[hq] = (unsigned)(q0 & 0xff) | ((unsigned)(q1 & 0xff) << 8) | ((unsigned)(q2 & 0xff) << 16) | ((unsigned)(q3 & 0xff) << 24); }
                qv[j] = (u32x2){pk[0], pk[1]}; }
#pragma unroll
            for (int sl = 0; sl < 2; ++sl) {
                const int e = tk_e[2 * t + sl], lr = tk_lr[2 * t + sl];
                const int pos = tab[8 + e] + pref[b * 8 + e] + lr;
                if (lane == 0) { tk_pos[2 * t + sl] = pos; ssc[pos] = scl; }
                u32x2* dst = (u32x2*)(SORT + (size_t)pos * D);
#pragma unroll
                for (int j = 0; j < 4; ++j) dst[lane + 64 * j] = qv[j];
            }
        }
    }
    SEAM(19);
    if (IN(20)) for (int rep_ = 0; rep_ <= (int)((REPMASK >> 21) & 1u); ++rep_) { if (rep_) __syncthreads();
        moe_tables(lds, blkcnt, tid);
        const LAS int* tab = (const LAS int*)(lds + MOE_TAB_OFF);
        pg8::SchedMoe S{(const char*)(ws + A_SORT), (const char*)(ws + W_MGUT), (size_t)14336 * 2048, tab[17], 56, G, bx, (size_t)256 * 2048, tab + 18};
        pg8::EpiSwigluI8 E{(bf16_t*)(ws + A_HID1), FFE, (const float*)(ws + WS_SSC), (const float*)(ws + WS_QSM), 14336};
        pg8::gemm_phase<pg8::EpiSwigluI8, pg8::SchedMoe, true>(lds, 2048, S, E);
    }
    SEAM(20);
    if (IN(21)) for (int rep_ = 0; rep_ <= (int)((REPMASK >> 22) & 1u); ++rep_) { if (rep_) __syncthreads();
        moe_tables(lds, blkcnt, tid);
        const LAS int* tab = (const LAS int*)(lds + MOE_TAB_OFF);
        const int nwg = tab[17] * 8, nfull = (nwg >> 8) << 8, rem = nwg - nfull;
        const int split = rem == 0 ? 1 : (rem * 8 <= 256 ? 8 : (rem * 4 <= 256 ? 4 : (rem * 2 <= 256 ? 2 : 1)));
        const size_t kslice = (size_t)(2 * FFE) / split;
        pg8::SchedMoeDown S{(const char*)(ws + A_HID1), (const char*)(ws + W_MDNT), (size_t)2048 * FFE * 2, split > 1 ? nfull : nwg, G, bx, (size_t)256 * FFE * 2, tab + 18, 0, 0, nfull, 0};
        pg8::EpiMoeDown E{(bf16_t*)(ws + A_YDN), (float*)(ws + A_PYD)};
        pg8::gemm_phase<pg8::EpiMoeDown, pg8::SchedMoeDown>(lds, 2 * FFE, S, E);
        if (split > 1) {
            pg8::SchedMoeDown S2{(const char*)(ws + A_HID1), (const char*)(ws + W_MDNT), (size_t)2048 * FFE * 2, 0, G, bx, (size_t)256 * FFE * 2, tab + 18, split, rem, nfull, kslice};
            pg8::gemm_phase<pg8::EpiMoeDown, pg8::SchedMoeDown>(lds, 2 * FFE, S2, E, (int)kslice);
        }
    }
    SEAM(21);
    if (IN(22)) {
        const bf16_t* YDN = (const bf16_t*)(ws + A_YDN); const float* PYD = (const float*)(ws + A_PYD);
        moe_tables(lds, blkcnt, tid);
        const LAS int* tab = (const LAS int*)(lds + MOE_TAB_OFF);
        const int nwg = tab[17] * 8, nfull = (nwg >> 8) << 8, rem = nwg - nfull, pfull = nfull >> 3;
        const int split = rem == 0 ? 1 : (rem * 8 <= 256 ? 8 : (rem * 4 <= 256 ? 4 : (rem * 2 <= 256 ? 2 : 1)));
        for (int t = gw; t < SEQ; t += NGW) {
            f32x4 v[8], b[8]; ldrow_bf(XB + (size_t)(t + CTXL) * D, lane, v);
            const int pa = tk_pos[2 * t], pb = tk_pos[2 * t + 1]; const float wa = tk_w[2 * t], wb = tk_w[2 * t + 1];
            if (split > 1 && ((pa >> 8) >= pfull || (pb >> 8) >= pfull)) {
#pragma unroll
                for (int j = 0; j < 8; ++j) b[j] = (f32x4){0.f, 0.f, 0.f, 0.f};
#pragma unroll 1
                for (int sl = 0; sl < 2; ++sl) { const int pos = sl ? pb : pa; const float w = sl ? wb : wa;
                    if ((pos >> 8) >= pfull) { for (int ks = 0; ks < split; ++ks) { f32x4 t2[8]; ldrow(PYD + ((size_t)(((pos >> 8) - pfull) * split + ks) * 256 + (pos & 255)) * 2048, lane, t2);
#pragma unroll
                            for (int j = 0; j < 8; ++j) b[j] += t2[j] * w; } }
                    else {
#pragma unroll
                        for (int j = 0; j < 8; ++j) { const u32x2 y = *(const u32x2*)(YDN + (size_t)pos * D + 4 * lane + 256 * j); b[j] += (f32x4){bflo(y.x), bfhi(y.x), bflo(y.y), bfhi(y.y)} * w; } } }
                add_branch(v, b, a.in[I_NFFNPOST1], MODP(1, 0, 5), lane); strow(out + (size_t)t * D, lane, v);
                continue;
            }
#pragma unroll
            for (int j = 0; j < 8; ++j) { const u32x2 ya = *(const u32x2*)(YDN + (size_t)pa * D + 4 * lane + 256 * j), yb = *(const u32x2*)(YDN + (size_t)pb * D + 4 * lane + 256 * j);
                b[j] = (f32x4){wa * bflo(ya.x) + wb * bflo(yb.x), wa * bfhi(ya.x) + wb * bfhi(yb.x), wa * bflo(ya.y) + wb * bflo(yb.y), wa * bfhi(ya.y) + wb * bfhi(yb.y)}; }
            add_branch(v, b, a.in[I_NFFNPOST1], MODP(1, 0, 5), lane); strow(out + (size_t)t * D, lane, v);
        }
    }
#undef IN
#undef SEAM
#undef MODP
}

extern "C" void kernel_launch(void* const* d_in, const int* in_sizes, int n_in, void* d_out, int out_size, void* d_ws, size_t ws_size, hipStream_t stream) {
    static int state = 0;
    if (state == 0) {
        state = -1;
        if (n_in != 49 || out_size != SEQ * D || ws_size < WS_END) { fprintf(stderr, "kernel_launch: unexpected shapes (n_in %d, out %d, ws %zu, need %zu)\n", n_in, out_size, ws_size, (size_t)WS_END); return; }
        if (hipFuncSetAttribute((const void*)trunk_fwd, hipFuncAttributeMaxDynamicSharedMemorySize, LDS_BYTES) != hipSuccess) { fprintf(stderr, "kernel_launch: hipFuncSetAttribute failed\n"); return; }
        int per_cu = 0; (void)hipOccupancyMaxActiveBlocksPerMultiprocessor(&per_cu, (const void*)trunk_fwd, NTHR, LDS_BYTES); (void)hipGetLastError();
        if (per_cu < 1) fprintf(stderr, "kernel_launch: occupancy query says %d\n", per_cu);
        state = 1;
    }
    if (state < 0) return;
    (void)hipMemsetAsync((char*)d_ws + WS_CTL, 0, CTL_ZERO_BYTES, stream);
    Args a{};
    for (int i = 0; i < 49; ++i) a.in[i] = (const float*)d_in[i];
    a.out = (float*)d_out; a.ws = (unsigned char*)d_ws;
    const int grid = 256;
#if N_LAUNCH_MODE == 0
    for (int ph = 0; ph < NPH; ++ph) { a.ph_lo = ph; a.ph_hi = ph + 1; hipLaunchKernelGGL(trunk_fwd, dim3(grid), dim3(NTHR), LDS_BYTES, stream, a); }
#else
    a.ph_lo = 0; a.ph_hi = NPH; hipLaunchKernelGGL(trunk_fwd, dim3(grid), dim3(NTHR), LDS_BYTES, stream, a);
#endif
}
```
